# Optimizing an MI355X kernel written in HIP

```python
import math
import jax
import jax.numpy as jnp
from jax import lax
import numpy as np

D_MODEL = 1024
BATCH = 16
SEQ = 2048
DEPTH = 2

PLE_DIM = 256
D_FF = 2816
N_BRANCH = 4
BRANCH_WIDTH = 256
CONV_WIDTH = 4
NORM_EPS = 1e-6

GDN_HEADS = 4
GDN_DK = 64
GDN_DV = 64
GDN_CHUNK = 64

MLSTM_HEADS = 4
MLSTM_DK = 64
MLSTM_DV = 64
MLSTM_CHUNK = 64

S5_GROUPS = 16
S5_GROUP_CH = 16
S5_STATE = 64

MOBA_HEADS = 4
MOBA_HEAD_DIM = 64
MOBA_BLOCK = 256
MOBA_TOPK = 3
MOBA_Q_SUB = 32
ROPE_THETA = 10000.0

IN_SPLITS = (
    2 * GDN_HEADS * GDN_DK + GDN_HEADS * GDN_DV,
    GDN_HEADS * GDN_DV,
    GDN_HEADS,
    GDN_HEADS,
    2 * MLSTM_HEADS * MLSTM_DK,
    MLSTM_HEADS * MLSTM_DV,
    MLSTM_HEADS * MLSTM_DV,
    MLSTM_HEADS,
    MLSTM_HEADS,
    S5_GROUPS * S5_GROUP_CH,
    3 * MOBA_HEADS * MOBA_HEAD_DIM,
)
N_IN = sum(IN_SPLITS)

kernel_name = 'hybrid_gated_parallel_mixer_block'


def split_cols(t, sizes):
    cuts = [int(c) for c in np.cumsum(sizes)[:-1]]
    return jnp.split(t, cuts, axis=-1)


def rms_norm(x, w):
    xf = x.astype(jnp.float32)
    y = xf * lax.rsqrt(jnp.mean(xf * xf, axis=-1, keepdims=True) + NORM_EPS)
    return (y * w.astype(jnp.float32)).astype(x.dtype)


def l2_normalize(x):
    return x * lax.rsqrt(jnp.sum(x * x, axis=-1, keepdims=True) + NORM_EPS)


def causal_conv(x, w):
    k_w, c = w.shape
    return lax.conv_general_dilated(
        x, w[:, None, :].astype(x.dtype), window_strides=(1,), padding=[(k_w - 1, 0)],
        dimension_numbers=('NWC', 'WIO', 'NWC'), feature_group_count=c)


def rope(x, positions):
    dh = x.shape[-1]
    inv_freq = ROPE_THETA ** (-jnp.arange(0, dh, 2, dtype=jnp.float32) / dh)
    ang = positions.astype(jnp.float32)[..., None] * inv_freq
    cos = jnp.cos(ang)[:, :, None, :]
    sin = jnp.sin(ang)[:, :, None, :]
    xf = x.astype(jnp.float32)
    x1, x2 = jnp.split(xf, 2, axis=-1)
    return jnp.concatenate([x1 * cos - x2 * sin, x2 * cos + x1 * sin], axis=-1).astype(x.dtype)


def swiglu(u, w_gu, w_down):
    gate, up = jnp.split(u @ w_gu, 2, axis=-1)
    return (jax.nn.silu(gate) * up) @ w_down


def to_chunks(t, chunk):
    b, s = t.shape[:2]
    t = t.reshape((b, s // chunk, chunk) + t.shape[2:])
    return jnp.moveaxis(t, 3, 1)


def gated_deltanet(qkv, z, b_pre, a_pre, conv_w, a_log, dt_bias, norm_w):
    bsz, s, _ = qkv.shape
    h, dk, dv, L = GDN_HEADS, GDN_DK, GDN_DV, GDN_CHUNK
    f32 = jnp.float32
    qkv = jax.nn.silu(causal_conv(qkv, conv_w)).astype(f32)
    q, k, v = split_cols(qkv, (h * dk, h * dk, h * dv))
    q = l2_normalize(q.reshape(bsz, s, h, dk)) * (dk ** -0.5)
    k = l2_normalize(k.reshape(bsz, s, h, dk))
    v = v.reshape(bsz, s, h, dv)
    beta = jax.nn.sigmoid(b_pre.astype(f32))
    g = -jnp.exp(a_log.astype(f32)) * jax.nn.softplus(a_pre.astype(f32) + dt_bias.astype(f32))
    q, k, v, beta, g = (to_chunks(t, L) for t in (q, k, v, beta, g))
    gc = jnp.cumsum(g, axis=-1)
    causal = jnp.tril(jnp.ones((L, L), dtype=bool))
    strict = jnp.tril(jnp.ones((L, L), dtype=bool), -1)
    decay = jnp.exp(jnp.where(causal, gc[..., :, None] - gc[..., None, :], -jnp.inf))
    k_beta = k * beta[..., None]
    m_low = jnp.where(strict, jnp.einsum('bhnid,bhnjd->bhnij', k_beta, k) * decay, 0.0)
    t_mat = jnp.eye(L, dtype=f32) + m_low
    u_vals = lax.linalg.triangular_solve(t_mat, v * beta[..., None], left_side=True, lower=True)
    w_keys = lax.linalg.triangular_solve(t_mat, k_beta * jnp.exp(gc)[..., None], left_side=True, lower=True)
    qk = jnp.einsum('bhnid,bhnjd->bhnij', q, k) * decay
    q_dec = q * jnp.exp(gc)[..., None]
    k_dec = k * jnp.exp(gc[..., -1:] - gc)[..., None]
    chunk_decay = jnp.exp(gc[..., -1])

    def step(state, inp):
        qk_c, q_c, k_c, u_c, w_c, d_c = inp
        v_new = u_c - jnp.einsum('bhld,bhde->bhle', w_c, state)
        out = jnp.einsum('bhld,bhde->bhle', q_c, state) + jnp.einsum('bhlm,bhme->bhle', qk_c, v_new)
        state = state * d_c[..., None, None] + jnp.einsum('bhld,bhle->bhde', k_c, v_new)
        return state, out

    xs = tuple(jnp.moveaxis(t, 2, 0) for t in (qk, q_dec, k_dec, u_vals, w_keys, chunk_decay))
    _, o = lax.scan(step, jnp.zeros((bsz, h, dk, dv), f32), xs)
    o = o.transpose(1, 0, 3, 2, 4).reshape(bsz, s, h, dv)
    o = rms_norm(o, norm_w) * jax.nn.silu(z.astype(f32).reshape(bsz, s, h, dv))
    return o.reshape(bsz, s, h * dv).astype(z.dtype)


def mlstm(qk, v, o_pre, i_pre, f_pre, conv_w, i_bias, f_bias, norm_w):
    bsz, s, _ = v.shape
    h, dk, dv, L = MLSTM_HEADS, MLSTM_DK, MLSTM_DV, MLSTM_CHUNK
    f32 = jnp.float32
    qk = jax.nn.silu(causal_conv(qk, conv_w)).astype(f32)
    q, k = jnp.split(qk, 2, axis=-1)
    q = q.reshape(bsz, s, h, dk)
    k = k.reshape(bsz, s, h, dk) * (dk ** -0.5)
    vv = v.astype(f32).reshape(bsz, s, h, dv)
    log_i = i_pre.astype(f32) + i_bias.astype(f32)
    log_f = jax.nn.log_sigmoid(f_pre.astype(f32) + f_bias.astype(f32))
    q, k, vv, log_i, log_f = (to_chunks(t, L) for t in (q, k, vv, log_i, log_f))
    b = jnp.cumsum(log_f, axis=-1)
    causal = jnp.tril(jnp.ones((L, L), dtype=bool))
    d_intra = jnp.where(causal, b[..., :, None] - b[..., None, :] + log_i[..., None, :], -jnp.inf)
    a_key = b[..., -1:] - b + log_i
    m_key = jnp.max(a_key, axis=-1)
    g_chunk = b[..., -1]

    def step(carry, inp):
        c_mem, n_mem, m_mem = carry
        k_c, v_c, a_c, mk_c, g_c = inp
        m_new = jnp.maximum(g_c + m_mem, mk_c)
        carry_scale = jnp.exp(g_c + m_mem - m_new)
        k_w = k_c * jnp.exp(a_c - m_new[..., None])[..., None]
        c_new = c_mem * carry_scale[..., None, None] + jnp.einsum('bhld,bhle->bhde', k_w, v_c)
        n_new = n_mem * carry_scale[..., None] + jnp.sum(k_w, axis=-2)
        return (c_new, n_new, m_new), (c_mem, n_mem, m_mem)

    xs = tuple(jnp.moveaxis(t, 2, 0) for t in (k, vv, a_key, m_key, g_chunk))
    init = (jnp.zeros((bsz, h, dk, dv), f32), jnp.zeros((bsz, h, dk), f32), jnp.zeros((bsz, h), f32))
    _, (c_prev, n_prev, m_prev) = lax.scan(step, init, xs)
    c_prev = jnp.moveaxis(c_prev, 0, 2)
    n_prev = jnp.moveaxis(n_prev, 0, 2)
    m_prev = jnp.moveaxis(m_prev, 0, 2)
    m_inter = b + m_prev[..., None]
    m_t = jnp.maximum(m_inter, jnp.max(d_intra, axis=-1))
    w_inter = jnp.exp(m_inter - m_t)
    s_qk = jnp.einsum('bhnld,bhnmd->bhnlm', q, k) * jnp.exp(d_intra - m_t[..., None])
    num = (w_inter[..., None] * jnp.einsum('bhnld,bhnde->bhnle', q, c_prev)
           + jnp.einsum('bhnlm,bhnme->bhnle', s_qk, vv))
    qn = w_inter * jnp.einsum('bhnld,bhnd->bhnl', q, n_prev) + jnp.sum(s_qk, axis=-1)
    h_tilde = num / jnp.maximum(jnp.abs(qn), jnp.exp(-m_t))[..., None]
    h_tilde = h_tilde.transpose(0, 2, 3, 1, 4).reshape(bsz, s, h, dv)
    h_norm = rms_norm(h_tilde, norm_w.reshape(h, dv)).reshape(bsz, s, h * dv)
    return (jax.nn.sigmoid(o_pre.astype(f32)) * h_norm).astype(v.dtype)


def s5_ssm(u, lam_re, lam_im, b_re, b_im, c_re, c_im, d_skip, log_dt, w_glu, b_glu):
    bsz, s, _ = u.shape
    G, N, P = S5_GROUPS, S5_GROUP_CH, S5_STATE
    f32 = jnp.float32
    uf = u.astype(f32).reshape(bsz, s, G, N)
    dt = jnp.exp(log_dt.astype(f32))[:, None]
    lr, li = lam_re.astype(f32), lam_im.astype(f32)
    mag = jnp.exp(lr * dt)
    a_re = mag * jnp.cos(li * dt)
    a_im = mag * jnp.sin(li * dt)
    den = lr * lr + li * li
    z_re = ((a_re - 1.0) * lr + a_im * li) / den
    z_im = (a_im * lr - (a_re - 1.0) * li) / den
    br, bi = b_re.astype(f32), b_im.astype(f32)
    bb_re = z_re[..., None] * br - z_im[..., None] * bi
    bb_im = z_re[..., None] * bi + z_im[..., None] * br
    bu_re = jnp.einsum('bsgn,gpn->bsgp', uf, bb_re)
    bu_im = jnp.einsum('bsgn,gpn->bsgp', uf, bb_im)
    a_re_s = jnp.broadcast_to(a_re, (1, s, G, P))
    a_im_s = jnp.broadcast_to(a_im, (1, s, G, P))

    def combine(left, right):
        ar1, ai1, br1, bi1 = left
        ar2, ai2, br2, bi2 = right
        return (ar2 * ar1 - ai2 * ai1, ar2 * ai1 + ai2 * ar1,
                ar2 * br1 - ai2 * bi1 + br2, ar2 * bi1 + ai2 * br1 + bi2)

    _, _, x_re, x_im = lax.associative_scan(combine, (a_re_s, a_im_s, bu_re, bu_im), axis=1)
    y = (jnp.einsum('gnp,bsgp->bsgn', c_re.astype(f32), x_re)
         - jnp.einsum('gnp,bsgp->bsgn', c_im.astype(f32), x_im)
         + d_skip.astype(f32).reshape(G, N) * uf)
    y = jax.nn.gelu(y.reshape(bsz, s, G * N))
    y = y * jax.nn.sigmoid(y @ w_glu.astype(f32) + b_glu.astype(f32))
    return y.astype(u.dtype)


def moba_attention(qkv, positions):
    bsz, s, _ = qkv.shape
    h, dh, blk, qs = MOBA_HEADS, MOBA_HEAD_DIM, MOBA_BLOCK, MOBA_Q_SUB
    f32 = jnp.float32
    q, k, v = jnp.split(qkv, 3, axis=-1)
    q = rope(q.reshape(bsz, s, h, dh), positions).transpose(0, 2, 1, 3)
    k = rope(k.reshape(bsz, s, h, dh), positions).transpose(0, 2, 1, 3)
    v = v.reshape(bsz, s, h, dh).transpose(0, 2, 1, 3)
    nb = -(-s // blk)
    pad = nb * blk - s
    k_blocks = jnp.pad(k, ((0, 0), (0, 0), (0, pad), (0, 0))).reshape(bsz, h, nb, blk, dh)
    v_blocks = jnp.pad(v, ((0, 0), (0, 0), (0, pad), (0, 0))).reshape(bsz, h, nb, blk, dh)
    k_mean = jnp.mean(k_blocks.astype(f32), axis=3)
    q_block = jnp.arange(s) // blk
    gate = jnp.einsum('bhsd,bhnd->bhsn', q.astype(f32), k_mean)
    past = jnp.arange(nb)[None, :] < q_block[:, None]
    gate = jnp.where(past, gate, -jnp.inf)
    n_sel = min(MOBA_TOPK, nb)
    _, sel = lax.top_k(gate, n_sel)
    sel_ok = sel < q_block[:, None]
    scale = dh ** -0.5
    bi = jnp.arange(bsz)[:, None, None, None]
    hi = jnp.arange(h)[None, :, None, None]

    def attend(sub):
        start = sub * qs
        q_s = lax.dynamic_slice_in_dim(q, start, qs, axis=2)
        sel_s = lax.dynamic_slice_in_dim(sel, start, qs, axis=2)
        ok_s = lax.dynamic_slice_in_dim(sel_ok, start, qs, axis=2)
        k_sel = k_blocks[bi, hi, sel_s]
        v_sel = v_blocks[bi, hi, sel_s]
        own = start // blk
        k_own = lax.dynamic_index_in_dim(k_blocks, own, axis=2, keepdims=False)
        v_own = lax.dynamic_index_in_dim(v_blocks, own, axis=2, keepdims=False)
        s_sel = jnp.einsum('bhqd,bhqnkd->bhqnk', q_s, k_sel).astype(f32) * scale
        s_sel = jnp.where(ok_s[..., None], s_sel, -jnp.inf)
        s_own = jnp.einsum('bhqd,bhkd->bhqk', q_s, k_own).astype(f32) * scale
        q_pos = start + jnp.arange(qs)
        k_pos = own * blk + jnp.arange(blk)
        s_own = jnp.where(k_pos[None, :] <= q_pos[:, None], s_own, -jnp.inf)
        scores = jnp.concatenate([s_sel.reshape(bsz, h, qs, n_sel * blk), s_own], axis=-1)
        probs = jax.nn.softmax(scores, axis=-1).astype(v.dtype)
        p_sel = probs[..., :n_sel * blk].reshape(bsz, h, qs, n_sel, blk)
        p_own = probs[..., n_sel * blk:]
        return (jnp.einsum('bhqnk,bhqnkd->bhqd', p_sel, v_sel)
                + jnp.einsum('bhqk,bhkd->bhqd', p_own, v_own))

    out = lax.map(attend, jnp.arange(s // qs))
    return out.transpose(1, 0, 3, 2, 4).reshape(bsz, s, h * dh)


def token_mixing(u, positions, w_in, gdn_conv, gdn_a_log, gdn_dt_bias, gdn_norm,
                 mlstm_conv, mlstm_i_bias, mlstm_f_bias, mlstm_norm,
                 s5_lambda_re, s5_lambda_im, s5_b_re, s5_b_im, s5_c_re, s5_c_im, s5_d, s5_log_dt,
                 s5_w_glu, s5_b_glu, w_gate, w_branch, w_out):
    (gdn_qkv, gdn_z, gdn_b, gdn_a, ml_qk, ml_v, ml_o, ml_i, ml_f, s5_u, moba_qkv) = split_cols(u @ w_in, IN_SPLITS)
    y_gdn = gated_deltanet(gdn_qkv, gdn_z, gdn_b, gdn_a, gdn_conv, gdn_a_log, gdn_dt_bias, gdn_norm)
    y_mlstm = mlstm(ml_qk, ml_v, ml_o, ml_i, ml_f, mlstm_conv, mlstm_i_bias, mlstm_f_bias, mlstm_norm)
    y_s5 = s5_ssm(s5_u, s5_lambda_re, s5_lambda_im, s5_b_re, s5_b_im, s5_c_re, s5_c_im, s5_d, s5_log_dt,
                  s5_w_glu, s5_b_glu)
    y_moba = moba_attention(moba_qkv, positions)
    ys = (y_gdn, y_mlstm, y_s5, y_moba)
    merged = jax.nn.sigmoid(u @ w_gate[0]) * (ys[0] @ w_branch[0])
    for n in range(1, N_BRANCH):
        merged = merged + jax.nn.sigmoid(u @ w_gate[n]) * (ys[n] @ w_branch[n])
    return merged @ w_out


def setup_inputs(seed: int = 0) -> dict:
    key = jax.random.key(seed)
    ks = iter(jax.random.split(key, 64))
    f32 = jnp.float32
    L, D = DEPTH, D_MODEL

    def nrm(shape, scale):
        return jax.random.normal(next(ks), shape, f32) * scale

    def gain(shape):
        return 1.0 + nrm(shape, 0.02)

    def log_uniform(shape, lo, hi):
        return jax.random.uniform(next(ks), shape, f32, minval=math.log(lo), maxval=math.log(hi))

    x = nrm((BATCH, SEQ, D), 1.0)
    p = nrm((DEPTH, BATCH, SEQ, PLE_DIM), 1.0)
    offset = jax.random.randint(next(ks), (BATCH, 1), 0, 4096, dtype=jnp.int32)
    positions = offset + jnp.arange(SEQ, dtype=jnp.int32)[None, :]
    G, N, P = S5_GROUPS, S5_GROUP_CH, S5_STATE
    gdn_dt = jnp.exp(log_uniform((L, GDN_HEADS), 1e-3, 1e-1))
    return {
        'x': x,
        'p': p,
        'positions': positions,
        'ffn1_norm': gain((L, D)),
        'ffn1_w_gu': nrm((L, D, 2 * D_FF), D ** -0.5),
        'ffn1_w_down': nrm((L, D_FF, D), D_FF ** -0.5),
        'mix_norm': gain((L, D)),
        'w_in': nrm((L, D, N_IN), D ** -0.5),
        'gdn_conv': nrm((L, CONV_WIDTH, IN_SPLITS[0]), CONV_WIDTH ** -0.5),
        'gdn_a_log': jnp.log(jax.random.uniform(next(ks), (L, GDN_HEADS), f32, minval=1.0, maxval=16.0)),
        'gdn_dt_bias': gdn_dt + jnp.log(-jnp.expm1(-gdn_dt)),
        'gdn_norm': gain((L, GDN_DV)),
        'mlstm_conv': nrm((L, CONV_WIDTH, IN_SPLITS[4]), CONV_WIDTH ** -0.5),
        'mlstm_i_bias': nrm((L, MLSTM_HEADS), 0.1),
        'mlstm_f_bias': jnp.linspace(3.0, 6.0, MLSTM_HEADS, dtype=f32)[None, :] + nrm((L, MLSTM_HEADS), 0.1),
        'mlstm_norm': gain((L, MLSTM_HEADS * MLSTM_DV)),
        's5_lambda_re': -0.5 + nrm((L, G, P), 0.01),
        's5_lambda_im': jnp.pi * jnp.arange(P, dtype=f32) + nrm((L, G, P), 0.01),
        's5_b_re': nrm((L, G, P, N), (2 * N) ** -0.5),
        's5_b_im': nrm((L, G, P, N), (2 * N) ** -0.5),
        's5_c_re': nrm((L, G, N, P), (2 * P) ** -0.5),
        's5_c_im': nrm((L, G, N, P), (2 * P) ** -0.5),
        's5_d': nrm((L, G * N), 0.5),
        's5_log_dt': log_uniform((L, G), 1e-3, 1e-1),
        's5_w_glu': nrm((L, G * N, G * N), (G * N) ** -0.5),
        's5_b_glu': nrm((L, G * N), 0.01),
        'w_gate': nrm((L, N_BRANCH, D, D), D ** -0.5),
        'w_branch': nrm((L, N_BRANCH, BRANCH_WIDTH, D), BRANCH_WIDTH ** -0.5),
        'w_out': nrm((L, D, D), D ** -0.5),
        'ffn2_norm': gain((L, D)),
        'ffn2_w_gu': nrm((L, D, 2 * D_FF), D ** -0.5),
        'ffn2_w_down': nrm((L, D_FF, D), D_FF ** -0.5),
        'ple_norm': gain((L, D)),
        'ple_w_proj': nrm((L, PLE_DIM, D), PLE_DIM ** -0.5),
        'ple_w_gate': nrm((L, D, D), D ** -0.5),
        'final_norm': gain((D,)),
    }


def reference(x, p, positions, ffn1_norm, ffn1_w_gu, ffn1_w_down, mix_norm, w_in,
              gdn_conv, gdn_a_log, gdn_dt_bias, gdn_norm,
              mlstm_conv, mlstm_i_bias, mlstm_f_bias, mlstm_norm,
              s5_lambda_re, s5_lambda_im, s5_b_re, s5_b_im, s5_c_re, s5_c_im, s5_d, s5_log_dt,
              s5_w_glu, s5_b_glu, w_gate, w_branch, w_out,
              ffn2_norm, ffn2_w_gu, ffn2_w_down, ple_norm, ple_w_proj, ple_w_gate, final_norm):
    h = x
    for i in range(DEPTH):
        h = h + 0.5 * swiglu(rms_norm(h, ffn1_norm[i]), ffn1_w_gu[i], ffn1_w_down[i])
        h = h + token_mixing(
            rms_norm(h, mix_norm[i]), positions, w_in[i],
            gdn_conv[i], gdn_a_log[i], gdn_dt_bias[i], gdn_norm[i],
            mlstm_conv[i], mlstm_i_bias[i], mlstm_f_bias[i], mlstm_norm[i],
            s5_lambda_re[i], s5_lambda_im[i], s5_b_re[i], s5_b_im[i], s5_c_re[i], s5_c_im[i],
            s5_d[i], s5_log_dt[i], s5_w_glu[i], s5_b_glu[i],
            w_gate[i], w_branch[i], w_out[i])
        h = h + 0.5 * swiglu(rms_norm(h, ffn2_norm[i]), ffn2_w_gu[i], ffn2_w_down[i])
        h = h + (p[i] @ ple_w_proj[i]) * jax.nn.sigmoid(rms_norm(h, ple_norm[i]) @ ple_w_gate[i])
    return rms_norm(h, final_norm)
```

```cpp
#include <hip/hip_runtime.h>
#include <cstdio>
#include <cstdint>
namespace pg8 {
#define PG8_LAS __attribute__((address_space(3)))
typedef unsigned short bf16_t;
typedef short bf16x8 __attribute__((ext_vector_type(8)));
typedef float f32x4 __attribute__((ext_vector_type(4)));
typedef unsigned u32x4 __attribute__((ext_vector_type(4)));
constexpr int BM = 256, BK = 64, HALF = 128, HTB = HALF * BK * 2  , STAGE_BYTES = 8 * HTB, NXCD = 8, WGM = 8;

__host__ __device__ __forceinline__ int lds_byte(int r, int c) { const int st = (r >> 4) * 2 + (c >> 5), rr = r & 15, cc = c & 31, ob = rr * 64 + cc * 2; return st * 1024 + (ob ^ (((ob >> 9) & 1) << 5)); }
__host__ __device__ __forceinline__ void stage_rc(int b, int& R, int& C) { const int st = b / 1024, sb = b % 1024, swz = sb ^ (((sb >> 9) & 1) << 5); R = (st >> 1) * 16 + swz / 64; C = (st & 1) * 32 + (swz % 64) / 2; }
__host__ __device__ __forceinline__ int perm32(int rho) { const int n = rho >> 4, i = rho & 15; return 8 * (i >> 2) + 4 * n + (i & 3); }

struct Unit { int pm, pn; };
struct Gemm { const bf16_t* A; const bf16_t* Bt; int M, N, K; int ashift; size_t astride; };

struct StaticOrder {
    int nM, nN, nwg, G, c;
    __host__ __device__ void init(int M, int N, int G_, int c_) { nM = M / BM; nN = N / BM; nwg = nM * nN; G = G_; c = c_; }
    __host__ __device__ bool next(int i, Unit& u) const {
        const long L = (long)i * G + c; if (L >= nwg) return false;
        int wgid = (int)L; { const int q = nwg / NXCD, r = nwg % NXCD, xcd = wgid % NXCD, off = wgid / NXCD; wgid = (xcd < r ? xcd * (q + 1) : r * (q + 1) + (xcd - r) * q) + off; }
        const int nig = WGM * nN, gid = wgid / nig, fm = gid * WGM, gsz = (nM - fm) < WGM ? (nM - fm) : WGM;
        u.pm = fm + ((wgid % nig) % gsz); u.pn = (wgid % nig) / gsz; return true;
    }
    __device__ __forceinline__ void a_ready(const Unit&) const {}
    __device__ __forceinline__ void done(const Unit&) const {}
};


typedef unsigned u32x2 __attribute__((ext_vector_type(2)));
__device__ __forceinline__ unsigned cvt_pk_bf16(float lo, float hi) { unsigned r; asm volatile("v_cvt_pk_bf16_f32 %0, %1, %2" : "=v"(r) : "v"(lo), "v"(hi)); return r; }
__device__ __forceinline__ float bf_lo(unsigned w) { return __uint_as_float(w << 16); }
__device__ __forceinline__ float bf_hi(unsigned w) { return __uint_as_float(w & 0xffff0000u); }
__device__ __forceinline__ float sigm(float x) { return __builtin_amdgcn_rcpf(1.0f + __expf(-x)); }
__device__ __forceinline__ float silu(float x) { return x * sigm(x); }
constexpr float RMS_EPS = 1e-6f;
__device__ __forceinline__ float rms_scale(const float* rowss, int row) { return rsqrtf(rowss[row] * (1.0f / 1024.0f) + RMS_EPS); }
__device__ __forceinline__ u32x4 pack8(const f32x4 a, const f32x4 b) { u32x4 w; w.x = cvt_pk_bf16(a[0], a[1]); w.y = cvt_pk_bf16(a[2], a[3]); w.z = cvt_pk_bf16(b[0], b[1]); w.w = cvt_pk_bf16(b[2], b[3]); return w; }

struct EpiSwiGLU {
    static constexpr bool PERM = true, AFTER_DRAIN = false;
    bf16_t* act; const float* rowss; int ldc;
    __device__ __forceinline__ void operator()(const f32x4 (&acc)[2][2][4][2], const Unit& u, int wr, int wc, int fr, int fq) const {
        const int row0 = u.pm * BM + wr * 64 + fr, col0 = u.pn * 128 + wc * 32 + 8 * fq;
#pragma unroll
        for (int ai = 0; ai < 2; ++ai)
#pragma unroll
            for (int m = 0; m < 4; ++m) { const int row = row0 + ai * HALF + m * 16; const float r = rms_scale(rowss, row);
                f32x4 o0, o1;
#pragma unroll
                for (int e = 0; e < 4; ++e) { o0[e] = silu(acc[ai][0][m][0][e] * r) * (acc[ai][1][m][0][e] * r); o1[e] = silu(acc[ai][0][m][1][e] * r) * (acc[ai][1][m][1][e] * r); }
                *(u32x4*)(act + (size_t)row * ldc + col0) = pack8(o0, o1);
                asm volatile("" ::: "memory"); }
    }
};
struct EpiBf16P {
    static constexpr bool PERM = true, AFTER_DRAIN = false;
    bf16_t* O; int ldc;
    __device__ __forceinline__ void operator()(const f32x4 (&acc)[2][2][4][2], const Unit& u, int wr, int wc, int fr, int fq) const {
        const int row0 = u.pm * BM + wr * 64 + fr, col0 = u.pn * BM + wc * 32 + 8 * fq;
#pragma unroll
        for (int ai = 0; ai < 2; ++ai)
#pragma unroll
            for (int m = 0; m < 4; ++m) { bf16_t* rowp = O + (size_t)(row0 + ai * HALF + m * 16) * ldc + col0;
#pragma unroll
                for (int bj = 0; bj < 2; ++bj) *(u32x4*)(rowp + bj * HALF) = pack8(acc[ai][bj][m][0], acc[ai][bj][m][1]); }
    }
};
struct EpiRes {
    static constexpr bool PERM = true, AFTER_DRAIN = false;
    const float* base; float* out; bf16_t* hb; float* rowss_next; float scale;
    __device__ __forceinline__ void operator()(const f32x4 (&acc)[2][2][4][2], const Unit& u, int wr, int wc, int fr, int fq) const {
        const int row0 = u.pm * BM + wr * 64 + fr, col0 = u.pn * BM + wc * 32 + 8 * fq;
#pragma unroll
        for (int ai = 0; ai < 2; ++ai)
#pragma unroll
            for (int m = 0; m < 4; ++m) { const int row = row0 + ai * HALF + m * 16; const size_t off = (size_t)row * 1024 + col0; float ss = 0.f;
#pragma unroll
                for (int bj = 0; bj < 2; ++bj) { const f32x4 b0 = *(const f32x4*)(base + off + bj * HALF), b1 = *(const f32x4*)(base + off + bj * HALF + 4);
                    const f32x4 v0 = b0 + acc[ai][bj][m][0] * scale, v1 = b1 + acc[ai][bj][m][1] * scale;
                    *(f32x4*)(out + off + bj * HALF) = v0; *(f32x4*)(out + off + bj * HALF + 4) = v1; *(u32x4*)(hb + off + bj * HALF) = pack8(v0, v1);
                    ss += (v0[0] * v0[0] + v0[1] * v0[1]) + (v0[2] * v0[2] + v0[3] * v0[3]) + (v1[0] * v1[0] + v1[1] * v1[1]) + (v1[2] * v1[2] + v1[3] * v1[3]); }
                ss += __shfl_xor(ss, 16); ss += __shfl_xor(ss, 32);
                if (fq == 0) __hip_atomic_fetch_add(rowss_next + row, ss, __ATOMIC_RELAXED, __HIP_MEMORY_SCOPE_AGENT);
                asm volatile("" ::: "memory"); }
    }
};
struct EpiMixIn {
    static constexpr bool PERM = true, AFTER_DRAIN = false;
    bf16_t* proj; float* scal; const float* rowss;
    __device__ __forceinline__ void operator()(const f32x4 (&acc)[2][2][4][2], const Unit& u, int wr, int wc, int fr, int fq) const {
        const int row0 = u.pm * BM + wr * 64 + fr;
        if (u.pn < 12) { const int col0 = u.pn * BM + wc * 32 + 8 * fq;
#pragma unroll
            for (int ai = 0; ai < 2; ++ai)
#pragma unroll
                for (int m = 0; m < 4; ++m) { const int row = row0 + ai * HALF + m * 16; const float r = rms_scale(rowss, row); bf16_t* rowp = proj + (size_t)row * 3072 + col0;
#pragma unroll
                    for (int bj = 0; bj < 2; ++bj) *(u32x4*)(rowp + bj * HALF) = pack8(acc[ai][bj][m][0] * r, acc[ai][bj][m][1] * r); }
        } else if (wc == 0 && fq < 2) {
#pragma unroll
            for (int ai = 0; ai < 2; ++ai)
#pragma unroll
                for (int m = 0; m < 4; ++m) { const int row = row0 + ai * HALF + m * 16; const float r = rms_scale(rowss, row); float* rowp = scal + (size_t)row * 16 + 8 * fq;
                    *(f32x4*)(rowp) = acc[ai][0][m][0] * r; *(f32x4*)(rowp + 4) = acc[ai][0][m][1] * r; }
        }
    }
};
struct EpiGateMerge {
    static constexpr bool PERM = false, AFTER_DRAIN = false;
    const bf16_t* P; bf16_t* merged; const float* rowss;
    __device__ __forceinline__ void operator()(const f32x4 (&acc)[2][2][4][2], const Unit& u, int wr, int wc, int fr, int fq) const {
        const int row0 = u.pm * BM + wr * 64 + fr, j0 = u.pn * 64 + wc * 16 + 4 * fq;
#pragma unroll
        for (int ai = 0; ai < 2; ++ai)
#pragma unroll
            for (int m = 0; m < 4; ++m) { const int row = row0 + ai * HALF + m * 16; const float r = rms_scale(rowss, row); const bf16_t* prow = P + (size_t)row * 4096 + j0;
                f32x4 s = (f32x4){0.f, 0.f, 0.f, 0.f};
#pragma unroll
                for (int bj = 0; bj < 2; ++bj)
#pragma unroll
                    for (int n = 0; n < 2; ++n) { const u32x2 pv = *(const u32x2*)(prow + (2 * bj + n) * 1024); const f32x4 a = acc[ai][bj][m][n];
                        s[0] += sigm(a[0] * r) * bf_lo(pv.x); s[1] += sigm(a[1] * r) * bf_hi(pv.x); s[2] += sigm(a[2] * r) * bf_lo(pv.y); s[3] += sigm(a[3] * r) * bf_hi(pv.y); }
                u32x2 w; w.x = cvt_pk_bf16(s[0], s[1]); w.y = cvt_pk_bf16(s[2], s[3]); *(u32x2*)(merged + (size_t)row * 1024 + j0) = w;
                asm volatile("" ::: "memory"); }
    }
};
struct EpiGLU {
    static constexpr bool PERM = true, AFTER_DRAIN = false;
    const bf16_t* yg; bf16_t* out; const float* bias;
    __device__ __forceinline__ void operator()(const f32x4 (&acc)[2][2][4][2], const Unit& u, int wr, int wc, int fr, int fq) const {
        const int row0 = u.pm * BM + wr * 64 + fr, col0 = u.pn * BM + wc * 32 + 8 * fq;
#pragma unroll
        for (int ai = 0; ai < 2; ++ai)
#pragma unroll
            for (int m = 0; m < 4; ++m) { const size_t off = (size_t)(row0 + ai * HALF + m * 16) * 256 + col0;
#pragma unroll
                for (int bj = 0; bj < 2; ++bj) { const u32x4 y = *(const u32x4*)(yg + off + bj * HALF); const f32x4 b0 = *(const f32x4*)(bias + col0 + bj * HALF), b1 = *(const f32x4*)(bias + col0 + bj * HALF + 4);
                    const f32x4 a0 = acc[ai][bj][m][0] + b0, a1 = acc[ai][bj][m][1] + b1; f32x4 o0, o1;
                    o0[0] = bf_lo(y.x) * sigm(a0[0]); o0[1] = bf_hi(y.x) * sigm(a0[1]); o0[2] = bf_lo(y.y) * sigm(a0[2]); o0[3] = bf_hi(y.y) * sigm(a0[3]);
                    o1[0] = bf_lo(y.z) * sigm(a1[0]); o1[1] = bf_hi(y.z) * sigm(a1[1]); o1[2] = bf_lo(y.w) * sigm(a1[2]); o1[3] = bf_hi(y.w) * sigm(a1[3]);
                    *(u32x4*)(out + off + bj * HALF) = pack8(o0, o1); }
                asm volatile("" ::: "memory"); }
    }
};
struct EpiPle {
    static constexpr bool PERM = true, AFTER_DRAIN = false;
    float* h; const bf16_t* T; bf16_t* hb; const float* rowss; float* rowss_next;
    __device__ __forceinline__ void operator()(const f32x4 (&acc)[2][2][4][2], const Unit& u, int wr, int wc, int fr, int fq) const {
        const int row0 = u.pm * BM + wr * 64 + fr, col0 = u.pn * BM + wc * 32 + 8 * fq;
#pragma unroll
        for (int ai = 0; ai < 2; ++ai)
#pragma unroll
            for (int m = 0; m < 4; ++m) { const int row = row0 + ai * HALF + m * 16; const float r = rms_scale(rowss, row); const size_t off = (size_t)row * 1024 + col0; float ss = 0.f;
#pragma unroll
                for (int bj = 0; bj < 2; ++bj) { const f32x4 b0 = *(const f32x4*)(h + off + bj * HALF), b1 = *(const f32x4*)(h + off + bj * HALF + 4); const u32x4 t = *(const u32x4*)(T + off + bj * HALF);
                    const f32x4 a0 = acc[ai][bj][m][0] * r, a1 = acc[ai][bj][m][1] * r; f32x4 v0, v1;
                    v0[0] = b0[0] + bf_lo(t.x) * sigm(a0[0]); v0[1] = b0[1] + bf_hi(t.x) * sigm(a0[1]); v0[2] = b0[2] + bf_lo(t.y) * sigm(a0[2]); v0[3] = b0[3] + bf_hi(t.y) * sigm(a0[3]);
                    v1[0] = b1[0] + bf_lo(t.z) * sigm(a1[0]); v1[1] = b1[1] + bf_hi(t.z) * sigm(a1[1]); v1[2] = b1[2] + bf_lo(t.w) * sigm(a1[2]); v1[3] = b1[3] + bf_hi(t.w) * sigm(a1[3]);
                    *(f32x4*)(h + off + bj * HALF) = v0; *(f32x4*)(h + off + bj * HALF + 4) = v1; *(u32x4*)(hb + off + bj * HALF) = pack8(v0, v1);
                    ss += (v0[0] * v0[0] + v0[1] * v0[1]) + (v0[2] * v0[2] + v0[3] * v0[3]) + (v1[0] * v1[0] + v1[1] * v1[1]) + (v1[2] * v1[2] + v1[3] * v1[3]); }
                ss += __shfl_xor(ss, 16); ss += __shfl_xor(ss, 32);
                if (fq == 0) __hip_atomic_fetch_add(rowss_next + row, ss, __ATOMIC_RELAXED, __HIP_MEMORY_SCOPE_AGENT);
                asm volatile("" ::: "memory"); }
    }
};

template <class Epi, class Sched, bool ALIGN_EPI = false, bool SP2 = false>
__device__ __forceinline__ void gemm_phase(PG8_LAS unsigned char* lds, const Gemm g, const Sched& S, const Epi& E) {
    int tid_ = threadIdx.x; asm volatile("" : "+v"(tid_));
    const int tid = tid_, wid = __builtin_amdgcn_readfirstlane(tid >> 6), lane = tid & 63, wr = wid >> 2, wc = wid & 3, fr = lane & 15, fq = lane >> 4;
    const int K = g.K, nt = K / BK;
    unsigned voffA[2], voffB[2];
#pragma unroll
    for (int i = 0; i < 2; ++i) { int R, C; stage_rc(tid * 16 + i * 8192, R, C); const int Rb = Epi::PERM ? ((R & ~31) + perm32(R & 31)) : R;
        voffA[i] = (unsigned)(R * K + C) * 2u; voffB[i] = (unsigned)(Rb * K + C) * 2u; }
    const size_t kstep = (size_t)(BK * 2);
    const size_t hstep = (size_t)HALF * K * 2;
    const size_t tstep = 2 * hstep;
    const unsigned ldsw = (unsigned)wid * 1024u;
    const int aoff = lds_byte(wr * 64 + fr, fq * 8), boff = lds_byte(wc * 32 + fr, fq * 8);
#define PG8_SA(b, h) (((b) * 2 + (h)) * HTB)
#define PG8_SB(b, h) ((4 + (b) * 2 + (h)) * HTB)
#define PG8_STAGE(bufoff, gbase, voff) do { _Pragma("unroll") for (int _i = 0; _i < 2; ++_i) \
        __builtin_amdgcn_global_load_lds((const unsigned*)((const char*)(gbase) + (voff)[_i]), (PG8_LAS unsigned*)(lds + (bufoff) + ldsw + _i * 8192), 16, 0, 0); } while (0)
#define PG8_LDA(dst, b, h) do { _Pragma("unroll") for (int m = 0; m < 4; ++m) _Pragma("unroll") for (int k = 0; k < 2; ++k) dst[m][k] = *(const PG8_LAS bf16x8*)(lds + PG8_SA(b, h) + aoff + m * 2048 + k * 1024); } while (0)
#define PG8_LDB(dst, b, h) do { _Pragma("unroll") for (int n = 0; n < 2; ++n) _Pragma("unroll") for (int k = 0; k < 2; ++k) dst[n][k] = *(const PG8_LAS bf16x8*)(lds + PG8_SB(b, h) + boff + n * 2048 + k * 1024); } while (0)
#define PG8_MMA(ai, bj, At, Bt) do { __builtin_amdgcn_s_setprio(1); _Pragma("unroll") for (int m = 0; m < 4; ++m) _Pragma("unroll") for (int n = 0; n < 2; ++n) _Pragma("unroll") for (int k = 0; k < 2; ++k) \
        acc[ai][bj][m][n] = __builtin_amdgcn_mfma_f32_16x16x32_bf16(Bt[n][k], At[m][k], acc[ai][bj][m][n], 0, 0, 0); __builtin_amdgcn_s_setprio(0); } while (0)
#define PG8_WAIT_V(n) asm volatile("s_waitcnt vmcnt(" #n ")" ::: "memory")
#define PG8_WAIT_L(n) asm volatile("s_waitcnt lgkmcnt(" #n ")" ::: "memory")
#define PG8_BAR __builtin_amdgcn_s_barrier()
#define PG8_SCHED __builtin_amdgcn_sched_barrier(0)
    Unit cur, nxt; int ui = 0;
    if (!S.next(0, cur)) return;
    f32x4 acc[2][2][4][2];
#pragma unroll
    for (int a = 0; a < 2; ++a)
#pragma unroll
        for (int b = 0; b < 2; ++b)
#pragma unroll
            for (int m = 0; m < 4; ++m)
#pragma unroll
                for (int n = 0; n < 2; ++n) acc[a][b][m][n] = (f32x4){0.f, 0.f, 0.f, 0.f};
    bf16x8 At[4][2], B0[2][2], B1[2][2];
    const char* cA = (const char*)g.A + (size_t)(cur.pn >> g.ashift) * g.astride + (size_t)cur.pm * tstep; const char* cB = (const char*)g.Bt + (size_t)cur.pn * tstep;
    S.a_ready(cur);
    if constexpr (SP2) {
        PG8_STAGE(PG8_SB(0, 0), cB, voffB); PG8_STAGE(PG8_SB(0, 1), cB + hstep, voffB); PG8_STAGE(PG8_SA(0, 0), cA, voffA); PG8_STAGE(PG8_SA(0, 1), cA + hstep, voffA);
        if (wr == 1) PG8_BAR;
        PG8_WAIT_V(2); PG8_BAR;
        PG8_STAGE(PG8_SB(1, 0), cB + kstep, voffB); PG8_STAGE(PG8_SA(1, 0), cA + kstep, voffA); PG8_STAGE(PG8_SB(1, 1), cB + hstep + kstep, voffB);
        PG8_WAIT_V(6); PG8_BAR;
    } else {
        PG8_STAGE(PG8_SB(0, 0), cB, voffB); PG8_STAGE(PG8_SA(0, 0), cA, voffA); PG8_STAGE(PG8_SB(0, 1), cB + hstep, voffB); PG8_STAGE(PG8_SA(0, 1), cA + hstep, voffA);
        if (wr == 1) PG8_BAR;
        PG8_WAIT_V(4); PG8_BAR;
        PG8_STAGE(PG8_SB(1, 0), cB + kstep, voffB); PG8_STAGE(PG8_SA(1, 0), cA + kstep, voffA); PG8_STAGE(PG8_SB(1, 1), cB + hstep + kstep, voffB);
        PG8_WAIT_V(6); PG8_BAR;
    }
    for (;;) {
        const bool has_next = S.next(ui + 1, nxt);
        const char* nA = has_next ? (const char*)g.A + (size_t)(nxt.pn >> g.ashift) * g.astride + (size_t)nxt.pm * tstep : cA; const char* nB = has_next ? (const char*)g.Bt + (size_t)nxt.pn * tstep : cB;
        for (int t = 0; t < nt; t += 2) {
            const bool last = (t == nt - 2);
            const char* a1 = cA + (size_t)(t + 1) * kstep;
            const char* a2 = last ? nA : cA + (size_t)(t + 2) * kstep; const char* b2 = last ? nB : cB + (size_t)(t + 2) * kstep;
            const char* a3 = a2 + kstep; const char* b3 = b2 + kstep;
            if (last && has_next) S.a_ready(nxt);
            if constexpr (SP2) {
            PG8_LDB(B0, 0, 0); PG8_LDB(B1, 0, 1); PG8_SCHED; PG8_LDA(At, 0, 0); PG8_STAGE(PG8_SA(1, 1), a1 + hstep, voffA);
            PG8_WAIT_V(8); PG8_WAIT_L(0); PG8_BAR; PG8_MMA(0, 0, At, B0); PG8_MMA(0, 1, At, B1); PG8_BAR; PG8_SCHED;
            PG8_LDA(At, 0, 1); PG8_STAGE(PG8_SB(0, 0), b2, voffB); PG8_STAGE(PG8_SB(0, 1), b2 + hstep, voffB); PG8_STAGE(PG8_SA(0, 0), a2, voffA);
            PG8_WAIT_V(8); PG8_WAIT_L(0); PG8_BAR; PG8_MMA(1, 0, At, B0); PG8_MMA(1, 1, At, B1); PG8_BAR; PG8_SCHED;
            PG8_LDB(B0, 1, 0); PG8_LDB(B1, 1, 1); PG8_SCHED; PG8_LDA(At, 1, 0); PG8_STAGE(PG8_SA(0, 1), a2 + hstep, voffA);
            PG8_WAIT_V(8); PG8_WAIT_L(0); PG8_BAR; PG8_MMA(0, 0, At, B0); PG8_MMA(0, 1, At, B1); PG8_BAR; PG8_SCHED;
            PG8_LDA(At, 1, 1); PG8_STAGE(PG8_SB(1, 0), b3, voffB); PG8_STAGE(PG8_SB(1, 1), b3 + hstep, voffB); PG8_STAGE(PG8_SA(1, 0), a3, voffA);
            PG8_WAIT_V(8); PG8_WAIT_L(0); PG8_BAR; PG8_MMA(1, 0, At, B0); PG8_MMA(1, 1, At, B1); PG8_BAR; PG8_SCHED;
            } else {
            PG8_LDB(B0, 0, 0); PG8_SCHED; PG8_LDA(At, 0, 0); PG8_STAGE(PG8_SA(1, 1), a1 + hstep, voffA);
            PG8_WAIT_L(8); PG8_BAR; PG8_WAIT_L(0); PG8_MMA(0, 0, At, B0); PG8_BAR; PG8_SCHED;
            PG8_LDB(B1, 0, 1); PG8_STAGE(PG8_SB(0, 0), b2, voffB);
            PG8_BAR; PG8_WAIT_L(0); PG8_MMA(0, 1, At, B1); PG8_BAR;
            PG8_LDA(At, 0, 1); PG8_STAGE(PG8_SA(0, 0), a2, voffA);
            PG8_BAR; PG8_WAIT_L(0); PG8_MMA(1, 0, At, B0); PG8_BAR; PG8_SCHED;
            PG8_STAGE(PG8_SB(0, 1), b2 + hstep, voffB);
            PG8_WAIT_V(6); PG8_BAR; PG8_MMA(1, 1, At, B1); PG8_BAR;
            PG8_LDB(B0, 1, 0); PG8_SCHED; PG8_LDA(At, 1, 0); PG8_STAGE(PG8_SA(0, 1), a2 + hstep, voffA);
            PG8_WAIT_L(8); PG8_BAR; PG8_WAIT_L(0); PG8_MMA(0, 0, At, B0); PG8_BAR; PG8_SCHED;
            PG8_LDB(B1, 1, 1); PG8_STAGE(PG8_SB(1, 0), b3, voffB);
            PG8_BAR; PG8_WAIT_L(0); PG8_MMA(0, 1, At, B1); PG8_BAR;
            PG8_LDA(At, 1, 1); PG8_STAGE(PG8_SA(1, 0), a3, voffA);
            PG8_BAR; PG8_WAIT_L(0); PG8_MMA(1, 0, At, B0); PG8_BAR; PG8_SCHED;
            PG8_STAGE(PG8_SB(1, 1), b3 + hstep, voffB);
            PG8_WAIT_V(6); PG8_BAR; PG8_MMA(1, 1, At, B1); PG8_BAR;
            }
        }
        if constexpr (ALIGN_EPI) { if (wr == 0) PG8_BAR; }
        if constexpr (!Epi::AFTER_DRAIN) { E(acc, cur, wr, wc, fr, fq); S.done(cur); }
        if (!has_next) break;
#pragma unroll
        for (int a = 0; a < 2; ++a)
#pragma unroll
            for (int b = 0; b < 2; ++b)
#pragma unroll
                for (int m = 0; m < 4; ++m)
#pragma unroll
                    for (int n = 0; n < 2; ++n) acc[a][b][m][n] = (f32x4){0.f, 0.f, 0.f, 0.f};
        cur = nxt; cA = nA; cB = nB; ++ui;
        if constexpr (ALIGN_EPI) { if (wr == 1) PG8_BAR; }
    }
    PG8_WAIT_V(0);
    if constexpr (!ALIGN_EPI) { if (wr == 0) PG8_BAR; }
    PG8_BAR;
    if constexpr (Epi::AFTER_DRAIN) { E.fused(acc, cur, wr, wc, fr, fq, lds, wid, lane); S.done(cur); }
#undef PG8_SA
#undef PG8_SB
#undef PG8_STAGE
#undef PG8_LDA
#undef PG8_LDB
#undef PG8_MMA
#undef PG8_WAIT_V
#undef PG8_WAIT_L
#undef PG8_BAR
#undef PG8_SCHED
}
}


constexpr int NWAVES = 8;
constexpr int BATCH = 16, SEQ = 2048, D = 1024, M = BATCH * SEQ, FF = 2816, NGU = 2 * FF, PLED = 256, DEPTH = 2;
constexpr int NIN_SRC = 3088, NIN = 3328, NPROJ = 3072, NGATE = 4096;
constexpr int PC_GQ = 0, PC_GZ = 768, PC_MQ = 1024, PC_MV = 1536, PC_MO = 1792, PC_S5 = 2048, PC_AQ = 2304, PC_AK = 2560, PC_AV = 2816;

constexpr size_t MiB = 1u << 20;
constexpr size_t WS_CTL = 0, CTL_ZERO_BYTES = 3 * MiB;
constexpr size_t WS_ROWSS = 1 * MiB;
constexpr size_t WS_KMEAN = 3 * MiB;
constexpr size_t WS_S5P = 3 * MiB + 512 * 1024;
constexpr size_t WS_SCAL = 4 * MiB;
constexpr size_t WS_W = 8 * MiB;
constexpr size_t W_GU1 = 0, W_D1 = W_GU1 + (size_t)NGU * D * 2, W_IN = W_D1 + (size_t)D * FF * 2, W_GATE = W_IN + (size_t)NIN * D * 2, W_BR = W_GATE + (size_t)NGATE * D * 2,
                 W_GLU = W_BR + (size_t)4096 * 256 * 2, W_OUT = W_GLU + (size_t)256 * 256 * 2, W_GU2 = W_OUT + (size_t)D * D * 2, W_D2 = W_GU2 + (size_t)NGU * D * 2,
                 W_PLE = W_D2 + (size_t)D * FF * 2, W_PG = W_PLE + (size_t)D * PLED * 2, W_END = W_PG + (size_t)D * D * 2;
static_assert(W_END <= 56 * MiB, "weights fit");
constexpr size_t WS_HB = 64 * MiB;
constexpr size_t WS_PB = 128 * MiB;
constexpr size_t WS_Y = 144 * MiB;
constexpr size_t WS_YG = 208 * MiB;
constexpr size_t WS_VT = 224 * MiB;
constexpr size_t WS_BIG = 256 * MiB;
constexpr size_t WS_END = 512 * MiB;
constexpr int CW_BAR = 4096, CW_QUEUE = 8192;

constexpr int RING_OFF = 0;
constexpr int LDS_BYTES = 147456;
constexpr int LDSCTL_OFF = LDS_BYTES - 1024;
constexpr int WAVE_LDS = 17408;

#define GAS __attribute__((address_space(1)))
#define LAS __attribute__((address_space(3)))
typedef unsigned short bf16;
typedef unsigned v4u __attribute__((ext_vector_type(4)));
typedef float f32x4 __attribute__((ext_vector_type(4)));
typedef short bf16x8 __attribute__((ext_vector_type(8)));
typedef GAS unsigned gu32;
typedef GAS unsigned long long gu64;
#define RLX_AGENT __ATOMIC_RELAXED, __HIP_MEMORY_SCOPE_AGENT
#define LDS_WAIT() asm volatile("s_waitcnt lgkmcnt(0)" ::: "memory")
#define VM_WAIT() asm volatile("s_waitcnt vmcnt(0)" ::: "memory")
__device__ __forceinline__ unsigned long long rt() { return __builtin_amdgcn_s_memrealtime(); }
__device__ __forceinline__ unsigned f2bf(float f) { unsigned u = __builtin_bit_cast(unsigned, f); return (u + 0x7fffu + ((u >> 16) & 1u)) >> 16; }
__device__ __forceinline__ unsigned pk2(float lo, float hi) { return f2bf(lo) | (f2bf(hi) << 16); }

#define XB_TMO      128
#define XB_XCNT(j)  (256  + 64 * (j))
#define XB_XSUB(j)  (1280 + 64 * (j))
#define XB_XGEN(j)  (2304 + 64 * (j))
#define XB_TOP      3328
#define XB_TOPGEN   3392
#define XCD_BAR_WORDS 3456
#define XB_SPIN_CAP (1u << 21)

__device__ __forceinline__ unsigned xb_ld(unsigned* p)              { return __hip_atomic_load(p, __ATOMIC_RELAXED, __HIP_MEMORY_SCOPE_AGENT); }
__device__ __forceinline__ unsigned xb_add(unsigned* p, unsigned v) { return __hip_atomic_fetch_add(p, v, __ATOMIC_RELAXED, __HIP_MEMORY_SCOPE_AGENT); }
__device__ __forceinline__ unsigned xb_xcc_id() { return (unsigned)__builtin_amdgcn_s_getreg((3 << 11) | 20) & 0xFu; }
#define XB_SPIN(cond, bar) do { unsigned _sp = 0; while (cond) { __builtin_amdgcn_s_sleep(1); \
    if ((++_sp & 255u) == 0u) { if (xb_ld(&(bar)[XB_TMO])) break; if (_sp > XB_SPIN_CAP) { atomicAdd(&(bar)[XB_TMO], 1u); break; } } } } while (0)

struct XcdBarrier {
    unsigned* bar; unsigned x;
    volatile LAS unsigned* st;
};

__device__ __forceinline__ XcdBarrier xcd_barrier_post(unsigned* bar, volatile LAS unsigned* st) {
    XcdBarrier b; b.bar = bar; b.x = xb_xcc_id(); b.st = st;
    if (threadIdx.x == 0) (void)xb_add(&bar[XB_XCNT(b.x)], 1u);
    return b;
}
__device__ __forceinline__ void xcd_barrier_complete(unsigned* bar, unsigned x, unsigned& nloc, unsigned& nx) {
    const unsigned G = gridDim.x * gridDim.y * gridDim.z;
    unsigned sum, cnt, mine, sp = 0u;
    for (;;) {
        sum = 0u; cnt = 0u; mine = 0u;
#pragma unroll
        for (unsigned j = 0; j < 16; ++j) { const unsigned c = xb_ld(&bar[XB_XCNT(j)]); sum += c; cnt += (c > 0u) ? 1u : 0u; mine = (j == x) ? c : mine; }
        if (sum == G) break;
        __builtin_amdgcn_s_sleep(1);
        if ((++sp & 255u) == 0u) { if (xb_ld(&bar[XB_TMO])) break; if (sp > XB_SPIN_CAP) { atomicAdd(&bar[XB_TMO], 1u); break; } }
    }
    nloc = mine > 0u ? mine : 1u; nx = cnt > 0u ? cnt : 1u;
}

__device__ __forceinline__ void xcd_barrier(const XcdBarrier& b) {
    asm volatile("s_waitcnt vmcnt(0)" ::: "memory");
    __syncthreads();
    if (threadIdx.x == 0) {
        unsigned* bar = b.bar;
        __builtin_amdgcn_s_waitcnt(0);
        unsigned nloc = b.st[0], nx = b.st[1];
        if (nloc == 0u) { xcd_barrier_complete(bar, b.x, nloc, nx); b.st[0] = nloc; b.st[1] = nx; }
        const unsigned old = xb_add(&bar[XB_XSUB(b.x)], 1u);
        const unsigned gen = old / nloc;
        if (old + 1u == (gen + 1u) * nloc) {
            __builtin_amdgcn_fence(__ATOMIC_RELEASE, "agent");
            asm volatile("s_waitcnt vmcnt(0)" ::: "memory");
            const unsigned og = xb_add(&bar[XB_TOP], 1u);
            const unsigned tg = og / nx;
            if (og + 1u == (tg + 1u) * nx) xb_add(&bar[XB_TOPGEN], 1u);
            else XB_SPIN(xb_ld(&bar[XB_TOPGEN]) == tg, bar);
            __builtin_amdgcn_fence(__ATOMIC_ACQUIRE, "agent");
            xb_add(&bar[XB_XGEN(b.x)], 1u);
            asm volatile("s_waitcnt vmcnt(0)" ::: "memory");
        } else {
            XB_SPIN(xb_ld(&bar[XB_XGEN(b.x)]) == gen, bar);
            __builtin_amdgcn_fence(__ATOMIC_ACQUIRE, "agent");
            asm volatile("s_waitcnt vmcnt(0)" ::: "memory");
        }
    }
    __syncthreads();
}


__device__ __forceinline__ float wave_sum(float v) {
#pragma unroll
    for (int o = 1; o < 64; o <<= 1) v += __shfl_xor(v, o);
    return v;
}
__device__ __forceinline__ float wave_max(float v) {
#pragma unroll
    for (int o = 1; o < 64; o <<= 1) v = fmaxf(v, __shfl_xor(v, o));
    return v;
}
__device__ __forceinline__ float red8(float v) { v += __shfl_xor(v, 1); v += __shfl_xor(v, 2); v += __shfl_xor(v, 4); return v; }
__device__ __forceinline__ float bf2f(bf16 b) { return __uint_as_float(((unsigned)b) << 16); }
__device__ __forceinline__ float sigm(float x) { return __builtin_amdgcn_rcpf(1.0f + __expf(-x)); }
__device__ __forceinline__ float silu(float x) { return x * sigm(x); }

template <class Map>
__device__ __forceinline__ void cvt_item(const float* __restrict__ W, int ld, const float* __restrict__ gain, bf16* Bt, int K, int item, int nblk, LAS float* scr, int lane, Map map) {
    const int kb = item / nblk, nb = item % nblk, k0 = 64 * kb, n0 = 32 * nb;
    const long so = map(n0 + (lane & 31));
#pragma unroll 8
    for (int i = 0; i < 32; ++i) { const int kk = 2 * i + (lane >> 5); float v = 0.f;
        if (so >= 0) { v = W[so + (size_t)(k0 + kk) * ld]; if (gain) v *= gain[k0 + kk]; }
        scr[kk * 33 + (lane & 31)] = v; }
    LDS_WAIT(); asm volatile("" ::: "memory");
    const int c = lane & 7;
#pragma unroll
    for (int j = 0; j < 4; ++j) { const int n = (lane >> 3) + 8 * j; const LAS float* s = scr + (8 * c) * 33 + n;
        v4u o; o.x = pk2(s[0 * 33], s[1 * 33]); o.y = pk2(s[2 * 33], s[3 * 33]); o.z = pk2(s[4 * 33], s[5 * 33]); o.w = pk2(s[6 * 33], s[7 * 33]);
        *(GAS v4u*)(Bt + (size_t)(n0 + n) * K + k0 + 8 * c) = o; }
    LDS_WAIT(); asm volatile("" ::: "memory");
}
struct MapId { __device__ long operator()(int r) const { return r; } };
struct MapGU { __device__ long operator()(int r) const { const int pn = r >> 8, c = r & 255; return c < 128 ? 128 * pn + c : FF + 128 * pn + (c - 128); } };
struct MapIn { __device__ long operator()(int r) const { if (r < 1024) return r; if (r < 2048) return 1032 + (r - 1024); if (r < 3072) return 2064 + (r - 2048); if (r < 3080) return 1024 + (r - 3072); if (r < 3088) return 2056 + (r - 3080); return -1; } };
struct MapGate { __device__ long operator()(int r) const { const int pn = r >> 8, c = r & 255, b = 2 * (c >> 7) + ((c >> 4) & 1), jl = 16 * ((c >> 5) & 3) + 4 * ((c >> 2) & 3) + (c & 3); return (long)b * (D * D) + 64 * pn + jl; } };
struct MapBr { __device__ long operator()(int r) const { return (long)(r >> 10) * (256 * D) + (r & 1023); } };

struct LayerW {
    const float *ffn1_norm, *ffn1_w_gu, *ffn1_w_down, *mix_norm, *w_in, *gdn_conv, *gdn_a_log, *gdn_dt_bias, *gdn_norm, *mlstm_conv, *mlstm_i_bias, *mlstm_f_bias, *mlstm_norm,
                *s5_lre, *s5_lim, *s5_bre, *s5_bim, *s5_cre, *s5_cim, *s5_d, *s5_log_dt, *s5_w_glu, *s5_b_glu, *w_gate, *w_branch, *w_out, *ffn2_norm, *ffn2_w_gu, *ffn2_w_down, *ple_norm, *ple_w_proj, *ple_w_gate;
};

__device__ __forceinline__ void prologue_weights(const LayerW& L, unsigned char* wsw, LAS unsigned char* lds, int gw, int ngw, int wave, int lane) {
    LAS float* scr = (LAS float*)(lds + RING_OFF + wave * 16384);
    constexpr int I_GU = (D / 64) * (NGU / 32), I_DN = (FF / 64) * (D / 32), I_IN = (D / 64) * (NIN / 32), I_GT = (D / 64) * (NGATE / 32), I_BR = (256 / 64) * (4096 / 32), I_GL = (256 / 64) * (256 / 32),
                  I_OUT = (D / 64) * (D / 32), I_PLE = (PLED / 64) * (D / 32), I_PG = I_OUT;
    constexpr int NITEMS = 2 * I_GU + 2 * I_DN + I_IN + I_GT + I_BR + I_GL + I_OUT + I_PLE + I_PG;
    for (int it = gw; it < NITEMS; it += ngw) {
        int r = it;
        if (r < I_GU) { cvt_item(L.ffn1_w_gu, NGU, L.ffn1_norm, (bf16*)(wsw + W_GU1), D, r, NGU / 32, scr, lane, MapGU()); continue; } r -= I_GU;
        if (r < I_GU) { cvt_item(L.ffn2_w_gu, NGU, L.ffn2_norm, (bf16*)(wsw + W_GU2), D, r, NGU / 32, scr, lane, MapGU()); continue; } r -= I_GU;
        if (r < I_DN) { cvt_item(L.ffn1_w_down, D, nullptr, (bf16*)(wsw + W_D1), FF, r, D / 32, scr, lane, MapId()); continue; } r -= I_DN;
        if (r < I_DN) { cvt_item(L.ffn2_w_down, D, nullptr, (bf16*)(wsw + W_D2), FF, r, D / 32, scr, lane, MapId()); continue; } r -= I_DN;
        if (r < I_IN) { cvt_item(L.w_in, NIN_SRC, L.mix_norm, (bf16*)(wsw + W_IN), D, r, NIN / 32, scr, lane, MapIn()); continue; } r -= I_IN;
        if (r < I_GT) { cvt_item(L.w_gate, D, L.mix_norm, (bf16*)(wsw + W_GATE), D, r, NGATE / 32, scr, lane, MapGate()); continue; } r -= I_GT;
        if (r < I_BR) { cvt_item(L.w_branch, D, nullptr, (bf16*)(wsw + W_BR), 256, r, 4096 / 32, scr, lane, MapBr()); continue; } r -= I_BR;
        if (r < I_GL) { cvt_item(L.s5_w_glu, 256, nullptr, (bf16*)(wsw + W_GLU), 256, r, 256 / 32, scr, lane, MapId()); continue; } r -= I_GL;
        if (r < I_OUT) { cvt_item(L.w_out, D, nullptr, (bf16*)(wsw + W_OUT), D, r, D / 32, scr, lane, MapId()); continue; } r -= I_OUT;
        if (r < I_PLE) { cvt_item(L.ple_w_proj, D, nullptr, (bf16*)(wsw + W_PLE), PLED, r, D / 32, scr, lane, MapId()); continue; } r -= I_PLE;
        cvt_item(L.ple_w_gate, D, L.ple_norm, (bf16*)(wsw + W_PG), D, r, D / 32, scr, lane, MapId());
    }
}
__device__ __forceinline__ void prologue_s5(const LayerW& L, float* s5p, int gtid, int ngt) {
    for (int i = gtid; i < 1024; i += ngt) { const int g = i >> 6;
        const float dt = expf(L.s5_log_dt[g]), lr = L.s5_lre[i], li = L.s5_lim[i];
        const float th = li * dt; float sn, cs; sincosf(th, &sn, &cs);
        const float em1 = expm1f(lr * dt), mag = em1 + 1.0f;
        const float are = mag * cs, aim = mag * sn;
        const float sh = sinf(0.5f * th); const float arem1 = em1 * cs - 2.0f * sh * sh;
        const float den = lr * lr + li * li;
        const float zre = (arem1 * lr + aim * li) / den, zim = (aim * lr - arem1 * li) / den;
        s5p[i] = are; s5p[1024 + i] = aim;
        for (int n = 0; n < 16; ++n) { const float br = L.s5_bre[i * 16 + n], bi = L.s5_bim[i * 16 + n];
            s5p[2048 + i * 16 + n] = zre * br - zim * bi; s5p[2048 + 16384 + i * 16 + n] = zre * bi + zim * br; } }
}
__device__ __forceinline__ void cvt_rows_bf16(const float* src, bf16* dst, size_t n, size_t gtid, size_t ngt) {
    for (size_t i = gtid * 8; i < n; i += ngt * 8) { const f32x4 a = *(const GAS f32x4*)(src + i), b = *(const GAS f32x4*)(src + i + 4);
        v4u o; o.x = pk2(a[0], a[1]); o.y = pk2(a[2], a[3]); o.z = pk2(b[0], b[1]); o.w = pk2(b[2], b[3]); *(GAS v4u*)(dst + i) = o; }
}
__device__ __forceinline__ void x_to_hb(const float* x, bf16* hb, float* rowss, int gw, int ngw, int lane) {
    for (int m = gw; m < M; m += ngw) { const GAS f32x4* xr = (const GAS f32x4*)(x + (size_t)m * D) + lane; f32x4 v[4]; float s = 0.f;
#pragma unroll
        for (int j = 0; j < 4; ++j) { v[j] = xr[64 * j]; s += (v[j][0] * v[j][0] + v[j][1] * v[j][1]) + (v[j][2] * v[j][2] + v[j][3] * v[j][3]); }
        s = wave_sum(s); if (lane == 0) rowss[m] = s;
        GAS unsigned long long* o8 = (GAS unsigned long long*)(hb + (size_t)m * D) + lane;
#pragma unroll
        for (int j = 0; j < 4; ++j) o8[64 * j] = (unsigned long long)pk2(v[j][0], v[j][1]) | ((unsigned long long)pk2(v[j][2], v[j][3]) << 32); }
}
__device__ __forceinline__ void final_norm(float* h, const float* rowss, const float* w, int gw, int ngw, int lane) {
    for (int m = gw; m < M; m += ngw) { GAS f32x4* xr = (GAS f32x4*)(h + (size_t)m * D) + lane; const float r = rsqrtf(rowss[m] * (1.0f / 1024.0f) + 1e-6f);
#pragma unroll
        for (int j = 0; j < 4; ++j) { const f32x4 v = xr[64 * j], g = *((const GAS f32x4*)w + lane + 64 * j); xr[64 * j] = v * r * g; } }
}

__device__ __forceinline__ void moba_prep(bf16* proj, const int* positions, float* kmean, bf16* vt, LAS unsigned char* lds, int tid) {
    LAS float* part = (LAS float*)lds;
    LAS bf16* tile = (LAS bf16*)(lds + 4096);
    for (int item = blockIdx.x; item < 512; item += gridDim.x) {
        const int bh = item >> 3, blk = item & 7, b = bh >> 2, h = bh & 3; const int t0 = b * SEQ + blk * 256;
        const int i = tid & 31; const float invf = expf(-(float)i * (2.0f / 64.0f) * 9.210340371976184f);
        float ks1 = 0.f, ks2 = 0.f;
        for (int j = 0; j < 16; ++j) { const int t = (tid >> 5) + 16 * j; const size_t row = (size_t)(t0 + t);
            const float ang = (float)positions[row] * invf; float sn, cs; sincosf(ang, &sn, &cs);
            bf16* qp = proj + row * NPROJ + PC_AQ + h * 64 + i; bf16* kp = proj + row * NPROJ + PC_AK + h * 64 + i;
            const float q1 = bf2f(qp[0]), q2 = bf2f(qp[32]), k1 = bf2f(kp[0]), k2 = bf2f(kp[32]);
            const float qo1 = q1 * cs - q2 * sn, qo2 = q2 * cs + q1 * sn, ko1 = k1 * cs - k2 * sn, ko2 = k2 * cs + k1 * sn;
            qp[0] = (bf16)f2bf(qo1); qp[32] = (bf16)f2bf(qo2); kp[0] = (bf16)f2bf(ko1); kp[32] = (bf16)f2bf(ko2);
            ks1 += ko1; ks2 += ko2; }
        part[(tid >> 5) * 64 + i] = ks1; part[(tid >> 5) * 64 + 32 + i] = ks2;
        for (int idx = tid; idx < 256 * 64; idx += 512) { const int t = idx >> 6, d = idx & 63; tile[d * 258 + t] = proj[(size_t)(t0 + t) * NPROJ + PC_AV + h * 64 + d]; }
        __syncthreads();
        if (tid < 64) { float s = 0.f; for (int j = 0; j < 16; ++j) s += part[j * 64 + tid]; kmean[(size_t)(bh * 8 + blk) * 64 + tid] = s * (1.0f / 256.0f); }
        for (int idx = tid; idx < 64 * 256; idx += 512) { const int d = idx >> 8, t = idx & 255; vt[((size_t)bh * 64 + d) * SEQ + blk * 256 + t] = tile[d * 258 + t]; }
        __syncthreads();
    }
}

__device__ __forceinline__ float softplusf(float x) { return x > 20.f ? x : log1pf(__expf(x)); }
__device__ __forceinline__ void gdn_seq(const bf16* proj, const float* scal, const LayerW& L, bf16* y0, LAS unsigned char* lds, int bh, int tid, int wave, int lane) {
    LAS float* qn = (LAS float*)lds; LAS float* kn = qn + 4096; LAS float* vv = kn + 4096; LAS float* ob = vv + 4096; LAS float* ab = ob + 4096;
    const int b = bh >> 2, h = bh & 3, e = tid >> 3, dg = tid & 7;
    const float alog = __expf(L.gdn_a_log[h]), dtb = L.gdn_dt_bias[h];
    float S[8];
#pragma unroll
    for (int j = 0; j < 8; ++j) S[j] = 0.f;
    for (int c = 0; c < SEQ / 64; ++c) {
        const size_t r0 = (size_t)b * SEQ + c * 64;
        for (int idx = tid; idx < 64 * 192; idx += 512) { const int t = idx / 192, cc = idx - t * 192, which = cc >> 6, d = cc & 63, col = which * 256 + h * 64 + d; float a = 0.f;
#pragma unroll
            for (int j = 0; j < 4; ++j) { const int s = c * 64 + t - 3 + j; if (s >= 0) a += L.gdn_conv[j * 768 + col] * bf2f(proj[((size_t)b * SEQ + s) * NPROJ + PC_GQ + col]); }
            (which == 0 ? qn : which == 1 ? kn : vv)[t * 64 + d] = silu(a); }
        if (tid < 64) { const size_t row = r0 + tid; const float be = sigm(scal[row * 16 + h]); const float g = -alog * softplusf(scal[row * 16 + 4 + h] + dtb); ab[tid * 2] = __expf(g); ab[tid * 2 + 1] = be; }
        __syncthreads();
        for (int rr = wave; rr < 128; rr += 8) { LAS float* p = (rr < 64 ? qn + rr * 64 : kn + (rr - 64) * 64); const float x = p[lane]; const float ss = wave_sum(x * x);
            p[lane] = x * rsqrtf(ss + 1e-6f) * (rr < 64 ? 0.125f : 1.0f); }
        __syncthreads();
        for (int t = 0; t < 64; ++t) {
            const f32x4 k0 = *(const LAS f32x4*)(kn + t * 64 + 8 * dg), k1 = *(const LAS f32x4*)(kn + t * 64 + 8 * dg + 4);
            const f32x4 q0 = *(const LAS f32x4*)(qn + t * 64 + 8 * dg), q1 = *(const LAS f32x4*)(qn + t * 64 + 8 * dg + 4);
            const float ve = vv[t * 64 + e], al = ab[2 * t], be = ab[2 * t + 1];
            float sk = (S[0] * k0[0] + S[1] * k0[1]) + (S[2] * k0[2] + S[3] * k0[3]) + (S[4] * k1[0] + S[5] * k1[1]) + (S[6] * k1[2] + S[7] * k1[3]);
            sk = red8(sk);
            const float vn = be * (ve - al * sk);
#pragma unroll
            for (int j = 0; j < 4; ++j) { S[j] = al * S[j] + k0[j] * vn; S[4 + j] = al * S[4 + j] + k1[j] * vn; }
            float o = (S[0] * q0[0] + S[1] * q0[1]) + (S[2] * q0[2] + S[3] * q0[3]) + (S[4] * q1[0] + S[5] * q1[1]) + (S[6] * q1[2] + S[7] * q1[3]);
            o = red8(o);
            if (dg == 0) ob[t * 64 + e] = o;
        }
        __syncthreads();
        for (int tt = 0; tt < 8; ++tt) { const int t = wave * 8 + tt; const size_t row = r0 + t; const float o = ob[t * 64 + lane]; const float ms = wave_sum(o * o) * (1.0f / 64.0f);
            const float z = bf2f(proj[row * NPROJ + PC_GZ + h * 64 + lane]);
            y0[row * 256 + h * 64 + lane] = (bf16)f2bf(o * rsqrtf(ms + 1e-6f) * L.gdn_norm[lane] * silu(z)); }
    }
    __syncthreads();
}
__device__ __forceinline__ void mlstm_seq(const bf16* proj, const float* scal, const LayerW& L, bf16* y1, LAS unsigned char* lds, int bh, int tid, int wave, int lane) {
    LAS float* qn = (LAS float*)lds; LAS float* kn = qn + 4096; LAS float* vv = kn + 4096; LAS float* ob = vv + 4096; LAS float* ab = ob + 4096;
    const int b = bh >> 2, h = bh & 3, e = tid >> 3, dg = tid & 7;
    const float ib = L.mlstm_i_bias[h], fb = L.mlstm_f_bias[h];
    float C[8], nn[8];
#pragma unroll
    for (int j = 0; j < 8; ++j) { C[j] = 0.f; nn[j] = 0.f; }
    for (int c = 0; c < SEQ / 64; ++c) {
        const size_t r0 = (size_t)b * SEQ + c * 64;
        for (int idx = tid; idx < 64 * 128; idx += 512) { const int t = idx >> 7, cc = idx & 127, which = cc >> 6, d = cc & 63, col = which * 256 + h * 64 + d; float a = 0.f;
#pragma unroll
            for (int j = 0; j < 4; ++j) { const int s = c * 64 + t - 3 + j; if (s >= 0) a += L.mlstm_conv[j * 512 + col] * bf2f(proj[((size_t)b * SEQ + s) * NPROJ + PC_MQ + col]); }
            if (which == 0) qn[t * 64 + d] = silu(a); else kn[t * 64 + d] = silu(a) * 0.125f; }
        for (int idx = tid; idx < 64 * 64; idx += 512) { const int t = idx >> 6, d = idx & 63; vv[t * 64 + d] = bf2f(proj[(r0 + t) * NPROJ + PC_MV + h * 64 + d]); }
        if (tid < 64) { const size_t row = r0 + tid; ab[tid * 2] = __expf(scal[row * 16 + 8 + h] + ib); ab[tid * 2 + 1] = sigm(scal[row * 16 + 12 + h] + fb); }
        __syncthreads();
        for (int t = 0; t < 64; ++t) {
            const f32x4 k0 = *(const LAS f32x4*)(kn + t * 64 + 8 * dg), k1 = *(const LAS f32x4*)(kn + t * 64 + 8 * dg + 4);
            const f32x4 q0 = *(const LAS f32x4*)(qn + t * 64 + 8 * dg), q1 = *(const LAS f32x4*)(qn + t * 64 + 8 * dg + 4);
            const float ve = vv[t * 64 + e], ig = ab[2 * t], fg = ab[2 * t + 1];
#pragma unroll
            for (int j = 0; j < 4; ++j) { const float a0 = ig * k0[j], a1 = ig * k1[j]; C[j] = fg * C[j] + a0 * ve; C[4 + j] = fg * C[4 + j] + a1 * ve; nn[j] = fg * nn[j] + a0; nn[4 + j] = fg * nn[4 + j] + a1; }
            float num = (C[0] * q0[0] + C[1] * q0[1]) + (C[2] * q0[2] + C[3] * q0[3]) + (C[4] * q1[0] + C[5] * q1[1]) + (C[6] * q1[2] + C[7] * q1[3]);
            float qd = (nn[0] * q0[0] + nn[1] * q0[1]) + (nn[2] * q0[2] + nn[3] * q0[3]) + (nn[4] * q1[0] + nn[5] * q1[1]) + (nn[6] * q1[2] + nn[7] * q1[3]);
            num = red8(num); qd = red8(qd);
            if (dg == 0) ob[t * 64 + e] = num / fmaxf(fabsf(qd), 1.0f);
        }
        __syncthreads();
        for (int tt = 0; tt < 8; ++tt) { const int t = wave * 8 + tt; const size_t row = r0 + t; const float o = ob[t * 64 + lane]; const float ms = wave_sum(o * o) * (1.0f / 64.0f);
            const float og = bf2f(proj[row * NPROJ + PC_MO + h * 64 + lane]);
            y1[row * 256 + h * 64 + lane] = (bf16)f2bf(sigm(og) * o * rsqrtf(ms + 1e-6f) * L.mlstm_norm[h * 64 + lane]); }
    }
    __syncthreads();
}
__device__ __forceinline__ float gelu_tanh(float y) { const float z = 0.7978845608028654f * (y + 0.044715f * y * y * y); const float th = 1.0f - 2.0f * __builtin_amdgcn_rcpf(1.0f + __expf(2.0f * z)); return 0.5f * y * (1.0f + th); }
__device__ __forceinline__ void s5_wave(const bf16* proj, const float* s5p, const LayerW& L, bf16* yg, LAS unsigned char* wl, int item, int lane) {
    const int b = item >> 4, g = item & 15, p = lane;
    LAS float* xs = (LAS float*)wl;
    LAS float* cc = xs + 16 * 130;
    float bbr[16], bbi[16];
#pragma unroll
    for (int n = 0; n < 16; ++n) { bbr[n] = s5p[2048 + (g * 64 + p) * 16 + n]; bbi[n] = s5p[2048 + 16384 + (g * 64 + p) * 16 + n]; }
    const float ar = s5p[g * 64 + p], ai = s5p[1024 + g * 64 + p];
    for (int n = 0; n < 16; ++n) { cc[p * 32 + (n >> 2) * 8 + (n & 3)] = L.s5_cre[(g * 16 + n) * 64 + p]; cc[p * 32 + (n >> 2) * 8 + 4 + (n & 3)] = L.s5_cim[(g * 16 + n) * 64 + p]; }
    const int t = lane & 15, ng = lane >> 4;
    float dsk[4];
#pragma unroll
    for (int j = 0; j < 4; ++j) dsk[j] = L.s5_d[g * 16 + 4 * ng + j];
    float xr = 0.f, xi = 0.f;
    for (int c = 0; c < SEQ / 16; ++c) {
        const size_t r0 = (size_t)b * SEQ + c * 16;
        for (int tt = 0; tt < 16; ++tt) { const v4u u0 = *(const GAS v4u*)(proj + (r0 + tt) * NPROJ + PC_S5 + g * 16), u1 = *(const GAS v4u*)(proj + (r0 + tt) * NPROJ + PC_S5 + g * 16 + 8);
            const unsigned uw[8] = {u0.x, u0.y, u0.z, u0.w, u1.x, u1.y, u1.z, u1.w}; float br = 0.f, bi = 0.f;
#pragma unroll
            for (int k = 0; k < 8; ++k) { const float ua = __uint_as_float(uw[k] << 16), ub = __uint_as_float(uw[k] & 0xffff0000u); br += bbr[2 * k] * ua + bbr[2 * k + 1] * ub; bi += bbi[2 * k] * ua + bbi[2 * k + 1] * ub; }
            const float nr = ar * xr - ai * xi + br, ni = ar * xi + ai * xr + bi; xr = nr; xi = ni;
            xs[tt * 130 + 2 * p] = xr; xs[tt * 130 + 2 * p + 1] = xi; }
        LDS_WAIT(); asm volatile("" ::: "memory");
        float acc[4] = {0.f, 0.f, 0.f, 0.f};
        for (int pp = 0; pp < 64; ++pp) { const float xre = xs[t * 130 + 2 * pp], xim = xs[t * 130 + 2 * pp + 1]; const f32x4 cr = *(const LAS f32x4*)(cc + pp * 32 + ng * 8), ci = *(const LAS f32x4*)(cc + pp * 32 + ng * 8 + 4);
#pragma unroll
            for (int j = 0; j < 4; ++j) acc[j] += cr[j] * xre - ci[j] * xim; }
        const size_t row = r0 + t; const unsigned long long uu = *(const GAS unsigned long long*)(proj + row * NPROJ + PC_S5 + g * 16 + 4 * ng);
        const float u4[4] = {__uint_as_float((unsigned)uu << 16), __uint_as_float((unsigned)uu & 0xffff0000u), __uint_as_float((unsigned)(uu >> 32) << 16), __uint_as_float((unsigned)(uu >> 32) & 0xffff0000u)};
        float o[4];
#pragma unroll
        for (int j = 0; j < 4; ++j) o[j] = gelu_tanh(acc[j] + dsk[j] * u4[j]);
        *(GAS unsigned long long*)(yg + row * 256 + g * 16 + 4 * ng) = (unsigned long long)pk2(o[0], o[1]) | ((unsigned long long)pk2(o[2], o[3]) << 32);
        LDS_WAIT(); asm volatile("" ::: "memory");
    }
}
__device__ __forceinline__ void moba_query(const bf16* proj, const float* kmean, bf16* y3, LAS unsigned char* wl, int bh, int t, int lane) {
    LAS float* qbuf = (LAS float*)wl; LAS float* pbuf = qbuf + 64;
    const int b = bh >> 2, h = bh & 3, qb = t >> 8; const size_t row = (size_t)b * SEQ + t;
    const float qv = bf2f(proj[row * NPROJ + PC_AQ + h * 64 + lane]);
    qbuf[lane] = qv;
    float gs[7];
#pragma unroll
    for (int n = 0; n < 7; ++n) gs[n] = (n < qb) ? wave_sum(qv * kmean[(size_t)(bh * 8 + n) * 64 + lane]) : -3.0e38f;
    unsigned selmask = 0;
#pragma unroll
    for (int r = 0; r < 3; ++r) { int best = -1; float bv = -3.0e38f;
#pragma unroll
        for (int n = 0; n < 7; ++n) if (n < qb && !((selmask >> n) & 1u) && gs[n] > bv) { bv = gs[n]; best = n; }
        if (best >= 0) selmask |= 1u << best; }
    selmask |= 1u << qb;
    LDS_WAIT(); asm volatile("" ::: "memory");
    float mx = -3.0e38f; int slot = 0;
    for (int nb = 0; nb <= qb; ++nb) { if (!((selmask >> nb) & 1u)) continue;
        for (int ti = 0; ti < 4; ++ti) { const size_t krow = (size_t)b * SEQ + nb * 256 + ti * 64 + lane; const GAS v4u* kp = (const GAS v4u*)(proj + krow * NPROJ + PC_AK + h * 64); float s = 0.f;
#pragma unroll
            for (int cch = 0; cch < 8; ++cch) { const v4u kw = kp[cch]; const f32x4 qa = *(const LAS f32x4*)(qbuf + 8 * cch), qc = *(const LAS f32x4*)(qbuf + 8 * cch + 4);
                s += qa[0] * __uint_as_float(kw.x << 16) + qa[1] * __uint_as_float(kw.x & 0xffff0000u) + qa[2] * __uint_as_float(kw.y << 16) + qa[3] * __uint_as_float(kw.y & 0xffff0000u)
                   + qc[0] * __uint_as_float(kw.z << 16) + qc[1] * __uint_as_float(kw.z & 0xffff0000u) + qc[2] * __uint_as_float(kw.w << 16) + qc[3] * __uint_as_float(kw.w & 0xffff0000u); }
            s *= 0.125f; if (nb == qb && ti * 64 + lane > (t & 255)) s = -1.0e30f;
            pbuf[slot * 256 + ti * 64 + lane] = s; mx = fmaxf(mx, s); }
        ++slot; }
    mx = wave_max(mx);
    float sum = 0.f;
    for (int i = 0; i < slot * 4; ++i) { const float ev = __expf(pbuf[i * 64 + lane] - mx); pbuf[i * 64 + lane] = ev; sum += ev; }
    sum = wave_sum(sum);
    LDS_WAIT(); asm volatile("" ::: "memory");
    float acc = 0.f; slot = 0;
    for (int nb = 0; nb <= qb; ++nb) { if (!((selmask >> nb) & 1u)) continue;
        const bf16* vp = proj + ((size_t)b * SEQ + nb * 256) * NPROJ + PC_AV + h * 64 + lane;
        for (int kk = 0; kk < 256; kk += 4) { const f32x4 pv = *(const LAS f32x4*)(pbuf + slot * 256 + kk);
            acc += pv[0] * bf2f(vp[(size_t)(kk + 0) * NPROJ]) + pv[1] * bf2f(vp[(size_t)(kk + 1) * NPROJ]) + pv[2] * bf2f(vp[(size_t)(kk + 2) * NPROJ]) + pv[3] * bf2f(vp[(size_t)(kk + 3) * NPROJ]); }
        ++slot; }
    y3[row * 256 + h * 64 + lane] = (bf16)f2bf(acc / sum);
    LDS_WAIT(); asm volatile("" ::: "memory");
}

#ifndef PHASE_MASK
#define PHASE_MASK 0xFFFFFFFFu
#endif
#define PH(k) ((PHASE_MASK >> (k)) & 1u)
struct Args { const float* in[36]; float* out; unsigned char* ws; };
__device__ __forceinline__ LayerW layer_ptrs(const Args& a, int l) {
    LayerW L;
    L.ffn1_norm = a.in[3] + (size_t)l * D; L.ffn1_w_gu = a.in[4] + (size_t)l * D * NGU; L.ffn1_w_down = a.in[5] + (size_t)l * FF * D; L.mix_norm = a.in[6] + (size_t)l * D; L.w_in = a.in[7] + (size_t)l * D * NIN_SRC;
    L.gdn_conv = a.in[8] + (size_t)l * 4 * 768; L.gdn_a_log = a.in[9] + l * 4; L.gdn_dt_bias = a.in[10] + l * 4; L.gdn_norm = a.in[11] + l * 64;
    L.mlstm_conv = a.in[12] + (size_t)l * 4 * 512; L.mlstm_i_bias = a.in[13] + l * 4; L.mlstm_f_bias = a.in[14] + l * 4; L.mlstm_norm = a.in[15] + l * 256;
    L.s5_lre = a.in[16] + l * 1024; L.s5_lim = a.in[17] + l * 1024; L.s5_bre = a.in[18] + l * 16384; L.s5_bim = a.in[19] + l * 16384; L.s5_cre = a.in[20] + l * 16384; L.s5_cim = a.in[21] + l * 16384;
    L.s5_d = a.in[22] + l * 256; L.s5_log_dt = a.in[23] + l * 16; L.s5_w_glu = a.in[24] + (size_t)l * 65536; L.s5_b_glu = a.in[25] + l * 256;
    L.w_gate = a.in[26] + (size_t)l * 4 * D * D; L.w_branch = a.in[27] + (size_t)l * 4 * 256 * D; L.w_out = a.in[28] + (size_t)l * D * D;
    L.ffn2_norm = a.in[29] + (size_t)l * D; L.ffn2_w_gu = a.in[30] + (size_t)l * D * NGU; L.ffn2_w_down = a.in[31] + (size_t)l * FF * D;
    L.ple_norm = a.in[32] + (size_t)l * D; L.ple_w_proj = a.in[33] + (size_t)l * PLED * D; L.ple_w_gate = a.in[34] + (size_t)l * D * D;
    return L;
}

__global__ void __launch_bounds__(NWAVES * 64, 2) mk_fwd(Args args) {
    extern __shared__ __attribute__((aligned(16))) unsigned char lds_raw[];
    LAS unsigned char* lds = (LAS unsigned char*)lds_raw;
    const int G = gridDim.x;
    for (int u = threadIdx.x; u < (LDS_BYTES - LDSCTL_OFF) / 4; u += NWAVES * 64) ((LAS unsigned*)(lds + LDSCTL_OFF))[u] = 0u;
    __syncthreads();
    XcdBarrier bar = xcd_barrier_post((unsigned*)(args.ws + WS_CTL) + CW_BAR, (volatile LAS unsigned*)(lds + LDSCTL_OFF) + 8);
#define GRID_BAR() xcd_barrier(bar)
#define WSP(T, off) ((T*)(wsl + (off)))
#define LAUNDER() unsigned char* wsl = args.ws; asm volatile("" : "+s"(wsl)); int K256 = 256, K1024 = 1024, KFF = FF; asm volatile("" : "+s"(K256), "+s"(K1024), "+s"(KFF)); (void)K256; (void)K1024; (void)KFF; int tid = threadIdx.x; asm volatile("" : "+v"(tid)); const int lane = tid & 63, wave = __builtin_amdgcn_readfirstlane(tid >> 6); (void)lane; (void)wave
#define GW (blockIdx.x * NWAVES + wave)
#define NGW (G * NWAVES)

    for (int l = 0; l < DEPTH; ++l) {
#if PH(0)
        { LAUNDER(); const LayerW L = layer_ptrs(args, l);
          prologue_weights(L, args.ws + WS_W, lds, GW, NGW, wave, lane);
          cvt_rows_bf16(args.in[1] + (size_t)l * M * PLED, WSP(bf16, WS_PB), (size_t)M * PLED, (size_t)blockIdx.x * 512 + tid, (size_t)G * 512);
          prologue_s5(L, WSP(float, WS_S5P), blockIdx.x * 512 + tid, G * 512);
          if (l == 0) x_to_hb(args.in[0], WSP(bf16, WS_HB), WSP(float, WS_ROWSS), GW, NGW, lane); }
        GRID_BAR();
#endif
#if PH(1)
        { LAUNDER(); pg8::Gemm g{WSP(const pg8::bf16_t, l == 0 ? WS_HB : WS_Y), WSP(const pg8::bf16_t, WS_W + W_GU1), M, NGU, K1024, 30, 0}; pg8::StaticOrder S; S.init(M, NGU, G, (int)blockIdx.x);
          pg8::EpiSwiGLU E{WSP(pg8::bf16_t, WS_BIG), WSP(float, WS_ROWSS) + (size_t)(4 * l) * M, FF};
          pg8::gemm_phase<pg8::EpiSwiGLU, pg8::StaticOrder, true, true>(lds + RING_OFF, g, S, E); }
        GRID_BAR();
#endif
#if PH(2)
        { LAUNDER(); pg8::Gemm g{WSP(const pg8::bf16_t, WS_BIG), WSP(const pg8::bf16_t, WS_W + W_D1), M, D, KFF, 30, 0}; pg8::StaticOrder S; S.init(M, D, G, (int)blockIdx.x);
          pg8::EpiRes E{l == 0 ? args.in[0] : args.out, args.out, WSP(pg8::bf16_t, WS_HB), WSP(float, WS_ROWSS) + (size_t)(4 * l + 1) * M, 0.5f};
          pg8::gemm_phase<pg8::EpiRes, pg8::StaticOrder, true, true>(lds + RING_OFF, g, S, E); }
        GRID_BAR();
#endif
#if PH(3)
        { LAUNDER(); pg8::Gemm g{WSP(const pg8::bf16_t, WS_HB), WSP(const pg8::bf16_t, WS_W + W_IN), M, NIN, K1024, 30, 0}; pg8::StaticOrder S; S.init(M, NIN, G, (int)blockIdx.x);
          pg8::EpiMixIn E{WSP(pg8::bf16_t, WS_BIG), WSP(float, WS_SCAL), WSP(float, WS_ROWSS) + (size_t)(4 * l + 1) * M};
          pg8::gemm_phase<pg8::EpiMixIn, pg8::StaticOrder, true, true>(lds + RING_OFF, g, S, E); }
        GRID_BAR();
#endif
#if PH(4)
        { LAUNDER(); moba_prep(WSP(bf16, WS_BIG), (const int*)args.in[2], WSP(float, WS_KMEAN), WSP(bf16, WS_VT), lds, tid); }
        GRID_BAR();
#endif
#if PH(5)
        { LAUNDER(); const LayerW L = layer_ptrs(args, l);
          for (int it = blockIdx.x; it < 64; it += G) gdn_seq(WSP(const bf16, WS_BIG), WSP(const float, WS_SCAL), L, WSP(bf16, WS_Y), lds, it, tid, wave, lane); }
#endif
#if PH(6)
        { LAUNDER(); const LayerW L = layer_ptrs(args, l);
          for (int it = blockIdx.x; it < 64 + 64; it += G) if (it >= 64) mlstm_seq(WSP(const bf16, WS_BIG), WSP(const float, WS_SCAL), L, WSP(bf16, WS_Y) + (size_t)M * 256, lds, it - 64, tid, wave, lane); }
#endif
#if PH(7)
        { LAUNDER(); const LayerW L = layer_ptrs(args, l);
          for (int it = blockIdx.x; it < 128 + 32; it += G) if (it >= 128) s5_wave(WSP(const bf16, WS_BIG), WSP(const float, WS_S5P), L, WSP(bf16, WS_YG), lds + wave * WAVE_LDS, (it - 128) * 8 + wave, lane); }
#endif
#if PH(8)
        { LAUNDER(); unsigned* qctr = WSP(unsigned, WS_CTL) + CW_QUEUE + 64 * l;
          for (;;) { unsigned idx = 0; if (lane == 0) idx = __hip_atomic_fetch_add(qctr, 1u, RLX_AGENT); idx = __builtin_amdgcn_readfirstlane(idx);
              if (idx >= 16384u) break;
              const int qb = 7 - (int)(idx >> 11), bh = (idx >> 5) & 63, sub = idx & 31;
              for (int qq = 0; qq < 8; ++qq) moba_query(WSP(const bf16, WS_BIG), WSP(const float, WS_KMEAN), WSP(bf16, WS_Y) + (size_t)3 * M * 256, lds + wave * WAVE_LDS, bh, qb * 256 + sub * 8 + qq, lane); } }
#endif
        GRID_BAR();
#if PH(9)
        { LAUNDER(); pg8::Gemm g{WSP(const pg8::bf16_t, WS_YG), WSP(const pg8::bf16_t, WS_W + W_GLU), M, 256, K256, 30, 0}; pg8::StaticOrder S; S.init(M, 256, G, (int)blockIdx.x);
          pg8::EpiGLU E{WSP(const pg8::bf16_t, WS_YG), WSP(pg8::bf16_t, WS_Y) + (size_t)2 * M * 256, args.in[25] + l * 256};
          pg8::gemm_phase<pg8::EpiGLU, pg8::StaticOrder, true, true>(lds + RING_OFF, g, S, E); }
        GRID_BAR();
#endif
#if PH(10)
        { LAUNDER(); pg8::Gemm g{WSP(const pg8::bf16_t, WS_Y), WSP(const pg8::bf16_t, WS_W + W_BR), M, 4096, K256, 2, (size_t)M * 256 * 2}; pg8::StaticOrder S; S.init(M, 4096, G, (int)blockIdx.x);
          pg8::EpiBf16P E{WSP(pg8::bf16_t, WS_BIG), 4096};
          pg8::gemm_phase<pg8::EpiBf16P, pg8::StaticOrder, true, true>(lds + RING_OFF, g, S, E); }
        GRID_BAR();
#endif
#if PH(11)
        { LAUNDER(); pg8::Gemm g{WSP(const pg8::bf16_t, WS_HB), WSP(const pg8::bf16_t, WS_W + W_GATE), M, NGATE, K1024, 30, 0}; pg8::StaticOrder S; S.init(M, NGATE, G, (int)blockIdx.x);
          pg8::EpiGateMerge E{WSP(const pg8::bf16_t, WS_BIG), WSP(pg8::bf16_t, WS_Y), WSP(float, WS_ROWSS) + (size_t)(4 * l + 1) * M};
          pg8::gemm_phase<pg8::EpiGateMerge, pg8::StaticOrder, true, true>(lds + RING_OFF, g, S, E); }
        GRID_BAR();
#endif
#if PH(12)
        { LAUNDER(); pg8::Gemm g{WSP(const pg8::bf16_t, WS_Y), WSP(const pg8::bf16_t, WS_W + W_OUT), M, D, K1024, 30, 0}; pg8::StaticOrder S; S.init(M, D, G, (int)blockIdx.x);
          pg8::EpiRes E{args.out, args.out, WSP(pg8::bf16_t, WS_HB), WSP(float, WS_ROWSS) + (size_t)(4 * l + 2) * M, 1.0f};
          pg8::gemm_phase<pg8::EpiRes, pg8::StaticOrder, true, true>(lds + RING_OFF, g, S, E); }
        GRID_BAR();
#endif
#if PH(13)
        { LAUNDER(); pg8::Gemm g{WSP(const pg8::bf16_t, WS_HB), WSP(const pg8::bf16_t, WS_W + W_GU2), M, NGU, K1024, 30, 0}; pg8::StaticOrder S; S.init(M, NGU, G, (int)blockIdx.x);
          pg8::EpiSwiGLU E{WSP(pg8::bf16_t, WS_BIG), WSP(float, WS_ROWSS) + (size_t)(4 * l + 2) * M, FF};
          pg8::gemm_phase<pg8::EpiSwiGLU, pg8::StaticOrder, true, true>(lds + RING_OFF, g, S, E); }
        GRID_BAR();
#endif
#if PH(14)
        { LAUNDER(); pg8::Gemm g{WSP(const pg8::bf16_t, WS_BIG), WSP(const pg8::bf16_t, WS_W + W_D2), M, D, KFF, 30, 0}; pg8::StaticOrder S; S.init(M, D, G, (int)blockIdx.x);
          pg8::EpiRes E{args.out, args.out, WSP(pg8::bf16_t, WS_HB), WSP(float, WS_ROWSS) + (size_t)(4 * l + 3) * M, 0.5f};
          pg8::gemm_phase<pg8::EpiRes, pg8::StaticOrder, true, true>(lds + RING_OFF, g, S, E); }
        GRID_BAR();
#endif
#if PH(15)
        { LAUNDER(); pg8::Gemm g{WSP(const pg8::bf16_t, WS_PB), WSP(const pg8::bf16_t, WS_W + W_PLE), M, D, K256, 30, 0}; pg8::StaticOrder S; S.init(M, D, G, (int)blockIdx.x);
          pg8::EpiBf16P E{WSP(pg8::bf16_t, WS_Y), D};
          pg8::gemm_phase<pg8::EpiBf16P, pg8::StaticOrder, true, true>(lds + RING_OFF, g, S, E); }
        GRID_BAR();
#endif
#if PH(16)
        { LAUNDER(); pg8::Gemm g{WSP(const pg8::bf16_t, WS_HB), WSP(const pg8::bf16_t, WS_W + W_PG), M, D, K1024, 30, 0}; pg8::StaticOrder S; S.init(M, D, G, (int)blockIdx.x);
          pg8::EpiPle E{args.out, WSP(const pg8::bf16_t, WS_Y), WSP(pg8::bf16_t, WS_Y), WSP(float, WS_ROWSS) + (size_t)(4 * l + 3) * M, WSP(float, WS_ROWSS) + (size_t)(4 * l + 4) * M};
          pg8::gemm_phase<pg8::EpiPle, pg8::StaticOrder, true, true>(lds + RING_OFF, g, S, E); }
        GRID_BAR();
#endif
    }
#if PH(17)
    { LAUNDER(); final_norm(args.out, WSP(float, WS_ROWSS) + (size_t)8 * M, args.in[35], GW, NGW, lane); }
#endif
}

extern "C" void kernel_launch(void* const* d_in, const int* in_sizes, int n_in, void* d_out, int out_size, void* d_ws, size_t ws_size, hipStream_t stream) {
    static int grid = 0;
    if (grid == 0) {
        if (n_in != 36 || out_size != M * D || ws_size < WS_END) { fprintf(stderr, "kernel_launch: unexpected shapes (n_in %d, out %d, ws %zu); nothing launched\n", n_in, out_size, ws_size); grid = -1; return; }
        int dev = 0, cus = 0, per_cu = 0;
        if (hipGetDevice(&dev) != hipSuccess || hipDeviceGetAttribute(&cus, hipDeviceAttributeMultiprocessorCount, dev) != hipSuccess) { grid = -1; return; }
        if (hipFuncSetAttribute((const void*)mk_fwd, hipFuncAttributeMaxDynamicSharedMemorySize, LDS_BYTES) != hipSuccess) { fprintf(stderr, "kernel_launch: hipFuncSetAttribute failed\n"); grid = -1; return; }
        if (hipOccupancyMaxActiveBlocksPerMultiprocessor(&per_cu, (const void*)mk_fwd, NWAVES * 64, LDS_BYTES) != hipSuccess || per_cu < 1) { fprintf(stderr, "kernel_launch: occupancy query says %d\n", per_cu); per_cu = 1; }
        (void)hipGetLastError();
        grid = cus;
    }
    if (grid < 0) return;
    if (hipMemsetAsync((char*)d_ws + WS_CTL, 0, CTL_ZERO_BYTES, stream) != hipSuccess) return;
    Args a{};
    for (int i = 0; i < 36; ++i) a.in[i] = (const float*)d_in[i];
    a.out = (float*)d_out; a.ws = (unsigned char*)d_ws;
    hipLaunchKernelGGL(mk_fwd, dim3(grid), dim3(NWAVES * 64), LDS_BYTES, stream, a);
}
```

```cpp
#include <hip/hip_runtime.h>
#include <cstdio>
#include <cstdint>
namespace pg8 {
#define PG8_LAS __attribute__((address_space(3)))
typedef unsigned short bf16_t;
typedef short bf16x8 __attribute__((ext_vector_type(8)));
typedef float f32x4 __attribute__((ext_vector_type(4)));
typedef unsigned u32x4 __attribute__((ext_vector_type(4)));
constexpr int BM = 256, BK = 64, HALF = 128, HTB = HALF * BK * 2  , STAGE_BYTES = 8 * HTB, NXCD = 8, WGM = 8;

__host__ __device__ __forceinline__ int lds_byte(int r, int c) { const int st = (r >> 4) * 2 + (c >> 5), rr = r & 15, cc = c & 31, ob = rr * 64 + cc * 2; return st * 1024 + (ob ^ (((ob >> 9) & 1) << 5)); }
__host__ __device__ __forceinline__ void stage_rc(int b, int& R, int& C) { const int st = b / 1024, sb = b % 1024, swz = sb ^ (((sb >> 9) & 1) << 5); R = (st >> 1) * 16 + swz / 64; C = (st & 1) * 32 + (swz % 64) / 2; }
__host__ __device__ __forceinline__ int perm32(int rho) { const int n = rho >> 4, i = rho & 15; return 8 * (i >> 2) + 4 * n + (i & 3); }

struct Unit { int pm, pn; };
struct Gemm { const bf16_t* A; const bf16_t* Bt; int M, N, K; int ashift; size_t astride; };

struct StaticOrder {
    int nM, nN, nwg, G, c, pmx;
    __host__ __device__ __forceinline__ void init(int M, int N, int G_, int c_, int pmx_ = 0) { nM = M / BM; nN = N / BM; nwg = nM * nN; G = G_; c = c_; pmx = pmx_; }
    __host__ __device__ __forceinline__ bool next(int i, Unit& u) const {
        const long L = (long)i * G + c; if (L >= nwg) return false;
        int wgid = (int)L; { const int q = nwg / NXCD, r = nwg % NXCD, xcd = wgid % NXCD, off = wgid / NXCD; wgid = (xcd < r ? xcd * (q + 1) : r * (q + 1) + (xcd - r) * q) + off; }
        const int nig = WGM * nN, gid = wgid / nig, fm = gid * WGM, gsz = (nM - fm) < WGM ? (nM - fm) : WGM;
        u.pm = (fm + ((wgid % nig) % gsz)) ^ pmx; u.pn = (wgid % nig) / gsz; return true;
    }
    __device__ __forceinline__ void a_ready(const Unit&) const {}
    __device__ __forceinline__ void done(const Unit&) const {}
};
struct PanelOrder {
    int pm0, stride, nM, nN;
    __host__ __device__ __forceinline__ bool next(int i, Unit& u) const { const int p = pm0 + (i / nN) * stride; if (p >= nM) return false; u.pm = p; u.pn = i % nN; return true; }
    __device__ __forceinline__ void a_ready(const Unit&) const {}
    __device__ __forceinline__ void done(const Unit&) const {}
};
struct OneUnit {
    Unit u;
    __host__ __device__ __forceinline__ bool next(int i, Unit& o) const { if (i != 0) return false; o = u; return true; }
    __device__ __forceinline__ void a_ready(const Unit&) const {}
    __device__ __forceinline__ void done(const Unit&) const {}
};

typedef unsigned u32x2 __attribute__((ext_vector_type(2)));
__device__ __forceinline__ unsigned cvt_pk_bf16(float lo, float hi) { unsigned r; asm volatile("v_cvt_pk_bf16_f32 %0, %1, %2" : "=v"(r) : "v"(lo), "v"(hi)); return r; }
__device__ __forceinline__ unsigned cvt_pk_bf16_t(float lo, float hi) { unsigned r; asm volatile("s_nop 1\n\tv_cvt_pk_bf16_f32 %0, %1, %2" : "=v"(r) : "v"(lo), "v"(hi)); return r; }
__device__ __forceinline__ float bf_lo(unsigned w) { return __uint_as_float(w << 16); }
__device__ __forceinline__ float bf_hi(unsigned w) { return __uint_as_float(w & 0xffff0000u); }
__device__ __forceinline__ float sigm(float x) { return __builtin_amdgcn_rcpf(1.0f + __expf(-x)); }
__device__ __forceinline__ float silu(float x) { return x * sigm(x); }
constexpr float RMS_EPS = 1e-6f;
typedef unsigned long long rowss_t;
constexpr float RSS_SCALE = 16777216.0f;
__device__ __forceinline__ float rms_scale(const rowss_t* rowss, int row) { return rsqrtf((float)rowss[row] * (1.0f / (1024.0f * RSS_SCALE)) + RMS_EPS); }
__device__ __forceinline__ void rowss_add(rowss_t* p, float ss) { __hip_atomic_fetch_add(p, (rowss_t)(ss * RSS_SCALE), __ATOMIC_RELAXED, __HIP_MEMORY_SCOPE_AGENT); }
__device__ __forceinline__ u32x4 pack8(const f32x4 a, const f32x4 b) { u32x4 w; w.x = cvt_pk_bf16(a[0], a[1]); w.y = cvt_pk_bf16(a[2], a[3]); w.z = cvt_pk_bf16(b[0], b[1]); w.w = cvt_pk_bf16(b[2], b[3]); return w; }

#define EPI_ROW(ai, m) (row0 + (ai) * HALF + (m) * 16)
__device__ __forceinline__ void load_scales(const rowss_t* rowss, int row0, float (&r)[8]) {
    rowss_t v[8];
#pragma unroll
    for (int g = 0; g < 8; ++g) v[g] = rowss[EPI_ROW(g >> 2, g & 3)];
#pragma unroll
    for (int g = 0; g < 8; ++g) r[g] = rsqrtf((float)v[g] * (1.0f / (1024.0f * RSS_SCALE)) + RMS_EPS);
}
struct EpiSwiGLU {
    static constexpr bool PERM = true, AFTER_DRAIN = false;
    bf16_t* act; const rowss_t* rowss; int ldc;
    __device__ __forceinline__ void operator()(const f32x4 (&acc)[2][2][4][2], const Unit& u, int wr, int wc, int fr, int fq) const {
        const int row0 = u.pm * BM + wr * 64 + fr, col0 = u.pn * 128 + wc * 32 + 8 * fq;
        float rs[8]; load_scales(rowss, row0, rs);
#pragma unroll
        for (int ai = 0; ai < 2; ++ai)
#pragma unroll
            for (int m = 0; m < 4; ++m) { const int row = EPI_ROW(ai, m); const float r = rs[ai * 4 + m];
                f32x4 o0, o1;
#pragma unroll
                for (int e = 0; e < 4; ++e) { o0[e] = silu(acc[ai][0][m][0][e] * r) * (acc[ai][1][m][0][e] * r); o1[e] = silu(acc[ai][0][m][1][e] * r) * (acc[ai][1][m][1][e] * r); }
                *(u32x4*)(act + (size_t)row * ldc + col0) = pack8(o0, o1); }
    }
};
struct EpiBf16P {
    static constexpr bool PERM = true, AFTER_DRAIN = false;
    bf16_t* O; int ldc;
    __device__ __forceinline__ void operator()(const f32x4 (&acc)[2][2][4][2], const Unit& u, int wr, int wc, int fr, int fq) const {
        const int row0 = u.pm * BM + wr * 64 + fr, col0 = u.pn * BM + wc * 32 + 8 * fq;
#pragma unroll
        for (int ai = 0; ai < 2; ++ai)
#pragma unroll
            for (int m = 0; m < 4; ++m) { bf16_t* rowp = O + (size_t)EPI_ROW(ai, m) * ldc + col0;
#pragma unroll
                for (int bj = 0; bj < 2; ++bj) *(u32x4*)(rowp + bj * HALF) = pack8(acc[ai][bj][m][0], acc[ai][bj][m][1]); }
    }
};
__device__ __forceinline__ void unpack8(const u32x4 w, f32x4& a, f32x4& b) { a[0] = bf_lo(w.x); a[1] = bf_hi(w.x); a[2] = bf_lo(w.y); a[3] = bf_hi(w.y); b[0] = bf_lo(w.z); b[1] = bf_hi(w.z); b[2] = bf_lo(w.w); b[3] = bf_hi(w.w); }
__device__ __forceinline__ float sumsq8(const f32x4 v0, const f32x4 v1) { return (v0[0] * v0[0] + v0[1] * v0[1]) + (v0[2] * v0[2] + v0[3] * v0[3]) + (v1[0] * v1[0] + v1[1] * v1[1]) + (v1[2] * v1[2] + v1[3] * v1[3]); }
struct EpiRes {
    static constexpr bool PERM = true, AFTER_DRAIN = false;
    const bf16_t* base; bf16_t* hb; rowss_t* rowss_next; float scale;
    __device__ __forceinline__ void operator()(const f32x4 (&acc)[2][2][4][2], const Unit& u, int wr, int wc, int fr, int fq) const {
        const int row0 = u.pm * BM + wr * 64 + fr, col0 = u.pn * BM + wc * 32 + 8 * fq;
#pragma unroll
        for (int ai = 0; ai < 2; ++ai) {
            u32x4 bw[4][2];
#pragma unroll
            for (int m = 0; m < 4; ++m)
#pragma unroll
                for (int bj = 0; bj < 2; ++bj) bw[m][bj] = *(const u32x4*)(base + (size_t)EPI_ROW(ai, m) * 1024 + col0 + bj * HALF);
#pragma unroll
            for (int m = 0; m < 4; ++m) { const int row = EPI_ROW(ai, m); const size_t off = (size_t)row * 1024 + col0; float ss = 0.f;
#pragma unroll
                for (int bj = 0; bj < 2; ++bj) { f32x4 b0, b1; unpack8(bw[m][bj], b0, b1);
                    const f32x4 v0 = b0 + acc[ai][bj][m][0] * scale, v1 = b1 + acc[ai][bj][m][1] * scale;
                    *(u32x4*)(hb + off + bj * HALF) = pack8(v0, v1); ss += sumsq8(v0, v1); }
                ss += __shfl_xor(ss, 16); ss += __shfl_xor(ss, 32);
                if (fq == 0) rowss_add(rowss_next + row, ss); }
            asm volatile("" ::: "memory"); }
    }
};
struct EpiMixIn {
    static constexpr bool PERM = true, AFTER_DRAIN = false;
    bf16_t* proj; float* scal; const rowss_t* rowss;
    __device__ __forceinline__ void operator()(const f32x4 (&acc)[2][2][4][2], const Unit& u, int wr, int wc, int fr, int fq) const {
        const int row0 = u.pm * BM + wr * 64 + fr;
        float rs[8]; load_scales(rowss, row0, rs);
        if (u.pn < 9) { const int col0 = u.pn * BM + wc * 32 + 8 * fq;
#pragma unroll
            for (int ai = 0; ai < 2; ++ai)
#pragma unroll
                for (int m = 0; m < 4; ++m) { const float r = rs[ai * 4 + m]; bf16_t* rowp = proj + (size_t)EPI_ROW(ai, m) * 3072 + col0;
#pragma unroll
                    for (int bj = 0; bj < 2; ++bj) *(u32x4*)(rowp + bj * HALF) = pack8(acc[ai][bj][m][0] * r, acc[ai][bj][m][1] * r); }
        } else if (wc == 0 && fq < 2) {
#pragma unroll
            for (int ai = 0; ai < 2; ++ai)
#pragma unroll
                for (int m = 0; m < 4; ++m) { const float r = rs[ai * 4 + m]; float* rowp = scal + (size_t)EPI_ROW(ai, m) * 16 + 8 * fq;
                    *(f32x4*)(rowp) = acc[ai][0][m][0] * r; *(f32x4*)(rowp + 4) = acc[ai][0][m][1] * r; }
        }
    }
};
struct EpiGateMerge {
    static constexpr bool PERM = false, AFTER_DRAIN = false;
    const bf16_t* P; bf16_t* merged; const rowss_t* rowss;
    __device__ __forceinline__ void operator()(const f32x4 (&acc)[2][2][4][2], const Unit& u, int wr, int wc, int fr, int fq) const {
        const int row0 = u.pm * BM + wr * 64 + fr, j0 = u.pn * 64 + wc * 16 + 4 * fq;
        float rs[8]; load_scales(rowss, row0, rs);
#pragma unroll
        for (int ai = 0; ai < 2; ++ai) {
            u32x2 pw[4][4];
#pragma unroll
            for (int m = 0; m < 4; ++m)
#pragma unroll
                for (int b = 0; b < 4; ++b) pw[m][b] = *(const u32x2*)(P + (size_t)EPI_ROW(ai, m) * 4096 + j0 + b * 1024);
#pragma unroll
            for (int m = 0; m < 4; ++m) { const float r = rs[ai * 4 + m];
                f32x4 s = (f32x4){0.f, 0.f, 0.f, 0.f};
#pragma unroll
                for (int bj = 0; bj < 2; ++bj)
#pragma unroll
                    for (int n = 0; n < 2; ++n) { const u32x2 pv = pw[m][2 * bj + n]; const f32x4 a = acc[ai][bj][m][n];
                        s[0] += sigm(a[0] * r) * bf_lo(pv.x); s[1] += sigm(a[1] * r) * bf_hi(pv.x); s[2] += sigm(a[2] * r) * bf_lo(pv.y); s[3] += sigm(a[3] * r) * bf_hi(pv.y); }
                u32x2 w; w.x = cvt_pk_bf16(s[0], s[1]); w.y = cvt_pk_bf16(s[2], s[3]); *(u32x2*)(merged + (size_t)EPI_ROW(ai, m) * 1024 + j0) = w; }
            asm volatile("" ::: "memory"); }
    }
};
struct EpiGateMergeAD {
    static constexpr bool PERM = false, AFTER_DRAIN = true;
    const bf16_t* P; bf16_t* merged; const rowss_t* rowss;
    __device__ __forceinline__ void fused(f32x4 (&acc)[2][2][4][2], const Unit& u, int wr, int wc, int fr, int fq, PG8_LAS unsigned char* lds, int wid, int lane) const {
        const int row0 = u.pm * BM + wr * 64 + fr, j0 = u.pn * 64 + wc * 16 + 4 * fq;
        float rs[8]; load_scales(rowss, row0, rs);
#ifdef AD_BARS
#pragma unroll
        for (int s = 0; s < 16; ++s) { asm volatile("s_waitcnt vmcnt(0) lgkmcnt(0)" ::: "memory"); __builtin_amdgcn_s_barrier(); asm volatile("" ::: "memory"); }
#endif

        u32x2 gp[2][2][4][2];
#pragma unroll
        for (int ai = 0; ai < 2; ++ai)
#pragma unroll
            for (int bj = 0; bj < 2; ++bj)
#pragma unroll
                for (int m = 0; m < 4; ++m)
#pragma unroll
                    for (int n = 0; n < 2; ++n) { const float r = rs[ai * 4 + m]; const f32x4 a = acc[ai][bj][m][n];
                        gp[ai][bj][m][n].x = cvt_pk_bf16_t(sigm(a[0] * r), sigm(a[1] * r)); gp[ai][bj][m][n].y = cvt_pk_bf16_t(sigm(a[2] * r), sigm(a[3] * r));
                        acc[ai][bj][m][n] = (f32x4){0.f, 0.f, 0.f, 0.f}; }
#pragma unroll
        for (int ai = 0; ai < 2; ++ai) {
            u32x2 pw[4][4];
#pragma unroll
            for (int m = 0; m < 4; ++m)
#pragma unroll
                for (int b = 0; b < 4; ++b) pw[m][b] = *(const u32x2*)(P + (size_t)EPI_ROW(ai, m) * 4096 + j0 + b * 1024);
#pragma unroll
            for (int m = 0; m < 4; ++m) {
                f32x4 s = (f32x4){0.f, 0.f, 0.f, 0.f};
#pragma unroll
                for (int bj = 0; bj < 2; ++bj)
#pragma unroll
                    for (int n = 0; n < 2; ++n) { const u32x2 pv = pw[m][2 * bj + n]; const u32x2 g = gp[ai][bj][m][n];
                        s[0] += bf_lo(g.x) * bf_lo(pv.x); s[1] += bf_hi(g.x) * bf_hi(pv.x); s[2] += bf_lo(g.y) * bf_lo(pv.y); s[3] += bf_hi(g.y) * bf_hi(pv.y); }
                u32x2 w; w.x = cvt_pk_bf16(s[0], s[1]); w.y = cvt_pk_bf16(s[2], s[3]); *(u32x2*)(merged + (size_t)EPI_ROW(ai, m) * 1024 + j0) = w; }
            asm volatile("" ::: "memory"); }
    }
};
struct EpiGLU {
    static constexpr bool PERM = true, AFTER_DRAIN = false;
    const bf16_t* yg; bf16_t* out; const float* bias;
    __device__ __forceinline__ void operator()(const f32x4 (&acc)[2][2][4][2], const Unit& u, int wr, int wc, int fr, int fq) const {
        const int row0 = u.pm * BM + wr * 64 + fr, col0 = u.pn * BM + wc * 32 + 8 * fq;
        f32x4 bb[2][2];
#pragma unroll
        for (int bj = 0; bj < 2; ++bj) { bb[bj][0] = *(const f32x4*)(bias + col0 + bj * HALF); bb[bj][1] = *(const f32x4*)(bias + col0 + bj * HALF + 4); }
#pragma unroll
        for (int ai = 0; ai < 2; ++ai) {
            u32x4 yw[4][2];
#pragma unroll
            for (int m = 0; m < 4; ++m)
#pragma unroll
                for (int bj = 0; bj < 2; ++bj) yw[m][bj] = *(const u32x4*)(yg + (size_t)EPI_ROW(ai, m) * 256 + col0 + bj * HALF);
#pragma unroll
            for (int m = 0; m < 4; ++m) { const size_t off = (size_t)EPI_ROW(ai, m) * 256 + col0;
#pragma unroll
                for (int bj = 0; bj < 2; ++bj) { f32x4 y0, y1; unpack8(yw[m][bj], y0, y1); const f32x4 a0 = acc[ai][bj][m][0] + bb[bj][0], a1 = acc[ai][bj][m][1] + bb[bj][1]; f32x4 o0, o1;
#pragma unroll
                    for (int e = 0; e < 4; ++e) { o0[e] = y0[e] * sigm(a0[e]); o1[e] = y1[e] * sigm(a1[e]); }
                    *(u32x4*)(out + off + bj * HALF) = pack8(o0, o1); } }
            asm volatile("" ::: "memory"); }
    }
};
struct EpiPle {
    static constexpr bool PERM = true, AFTER_DRAIN = false;
    const bf16_t* h; const bf16_t* T; bf16_t* hout; const rowss_t* rowss; rowss_t* rowss_next;
    __device__ __forceinline__ void operator()(const f32x4 (&acc)[2][2][4][2], const Unit& u, int wr, int wc, int fr, int fq) const {
        const int row0 = u.pm * BM + wr * 64 + fr, col0 = u.pn * BM + wc * 32 + 8 * fq;
        float rs[8]; load_scales(rowss, row0, rs);
#pragma unroll
        for (int ai = 0; ai < 2; ++ai)
#pragma unroll
          for (int mh = 0; mh < 2; ++mh) {
            u32x4 bw[2][2], tw[2][2];
#pragma unroll
            for (int mm = 0; mm < 2; ++mm)
#pragma unroll
                for (int bj = 0; bj < 2; ++bj) { const size_t off = (size_t)EPI_ROW(ai, 2 * mh + mm) * 1024 + col0 + bj * HALF; bw[mm][bj] = *(const u32x4*)(h + off); tw[mm][bj] = *(const u32x4*)(T + off); }
#pragma unroll
            for (int mm = 0; mm < 2; ++mm) { const int m = 2 * mh + mm; const int row = EPI_ROW(ai, m); const float r = rs[ai * 4 + m]; const size_t off = (size_t)row * 1024 + col0; float ss = 0.f;
#pragma unroll
                for (int bj = 0; bj < 2; ++bj) { f32x4 b0, b1, t0, t1; unpack8(bw[mm][bj], b0, b1); unpack8(tw[mm][bj], t0, t1);
                    const f32x4 a0 = acc[ai][bj][m][0] * r, a1 = acc[ai][bj][m][1] * r; f32x4 v0, v1;
#pragma unroll
                    for (int e = 0; e < 4; ++e) { v0[e] = b0[e] + t0[e] * sigm(a0[e]); v1[e] = b1[e] + t1[e] * sigm(a1[e]); }
                    *(u32x4*)(hout + off + bj * HALF) = pack8(v0, v1); ss += sumsq8(v0, v1); }
                ss += __shfl_xor(ss, 16); ss += __shfl_xor(ss, 32);
                if (fq == 0) rowss_add(rowss_next + row, ss); }
            asm volatile("" ::: "memory"); }
    }
};

__device__ __forceinline__ float dpp_row_xor(float v, int step) {
    const int x = __float_as_int(v); int r;
    switch (step) { case 0: r = __builtin_amdgcn_update_dpp(0, x, 0xB1, 0xF, 0xF, true); break; case 1: r = __builtin_amdgcn_update_dpp(0, x, 0x4E, 0xF, 0xF, true); break;
                    case 2: r = __builtin_amdgcn_update_dpp(0, x, 0x141, 0xF, 0xF, true); break; default: r = __builtin_amdgcn_update_dpp(0, x, 0x140, 0xF, 0xF, true); break; }
    return __int_as_float(r);
}
struct EpiMoba {
    static constexpr bool PERM = true, AFTER_DRAIN = false;
    bf16_t* proj; bf16_t* vt; float* kmean; const float* rope; const rowss_t* rowss;
    __device__ __forceinline__ void operator()(const f32x4 (&acc)[2][2][4][2], const Unit& u, int wr, int wc, int fr_in, int fq_in) const {
        int fr = fr_in, fq = fq_in; asm volatile("" : "+v"(fr), "+v"(fq));
        const int row0 = u.pm * BM + wr * 64 + fr;
        float rs[8]; load_scales(rowss, row0, rs);
        if (u.pn < 2) {
            const int pc = (u.pn == 0 ? 2304 : 2560) + wc * 64 + 8 * fq;
            f32x4 ks[4];
#pragma unroll
            for (int j = 0; j < 4; ++j) ks[j] = (f32x4){0.f, 0.f, 0.f, 0.f};
#pragma unroll
            for (int ai = 0; ai < 2; ++ai)
#pragma unroll
              for (int mh = 0; mh < 2; ++mh) {
                f32x4 cs[2][4];
#pragma unroll
                for (int mm = 0; mm < 2; ++mm) { const float* tp = rope + (size_t)EPI_ROW(ai, 2 * mh + mm) * 64 + 8 * fq; cs[mm][0] = *(const f32x4*)(tp); cs[mm][1] = *(const f32x4*)(tp + 4); cs[mm][2] = *(const f32x4*)(tp + 32); cs[mm][3] = *(const f32x4*)(tp + 36); }
#pragma unroll
                for (int mm = 0; mm < 2; ++mm) { const int m = 2 * mh + mm; const float r = rs[ai * 4 + m]; bf16_t* rowp = proj + (size_t)EPI_ROW(ai, m) * 3072 + pc;
                    const f32x4 a0 = acc[ai][0][m][0] * r, a1 = acc[ai][0][m][1] * r, b0 = acc[ai][1][m][0] * r, b1 = acc[ai][1][m][1] * r;
                    const f32x4 o10 = a0 * cs[mm][0] - b0 * cs[mm][2], o11 = a1 * cs[mm][1] - b1 * cs[mm][3], o20 = b0 * cs[mm][0] + a0 * cs[mm][2], o21 = b1 * cs[mm][1] + a1 * cs[mm][3];
                    *(u32x4*)(rowp) = pack8(o10, o11); *(u32x4*)(rowp + 32) = pack8(o20, o21);
                    ks[0] += o10; ks[1] += o11; ks[2] += o20; ks[3] += o21; }
                asm volatile("" ::: "memory"); }
            if (u.pn == 1) {
#pragma unroll
                for (int j = 0; j < 4; ++j)
#pragma unroll
                    for (int e = 0; e < 4; ++e) { float v = ks[j][e];
#pragma unroll
                        for (int st = 0; st < 4; ++st) v += dpp_row_xor(v, st);
                        ks[j][e] = v; }
                if (fr == 0) { const int b = u.pm >> 3, blk = u.pm & 7; float* kp = kmean + (size_t)((b * 4 + wc) * 8 + blk) * 64 + 8 * fq;
#pragma unroll
                    for (int e = 0; e < 4; ++e) { __hip_atomic_fetch_add(kp + e, ks[0][e] * (1.0f / 256.0f), __ATOMIC_RELAXED, __HIP_MEMORY_SCOPE_AGENT); __hip_atomic_fetch_add(kp + 4 + e, ks[1][e] * (1.0f / 256.0f), __ATOMIC_RELAXED, __HIP_MEMORY_SCOPE_AGENT);
                        __hip_atomic_fetch_add(kp + 32 + e, ks[2][e] * (1.0f / 256.0f), __ATOMIC_RELAXED, __HIP_MEMORY_SCOPE_AGENT); __hip_atomic_fetch_add(kp + 36 + e, ks[3][e] * (1.0f / 256.0f), __ATOMIC_RELAXED, __HIP_MEMORY_SCOPE_AGENT); } }
            }
        } else {
            const int b = u.pm >> 3, s0 = (u.pm & 7) * 256 + wr * 64 + fr;
#pragma unroll
            for (int ai = 0; ai < 2; ++ai)
#pragma unroll
                for (int m = 0; m < 4; ++m) { const float r = rs[ai * 4 + m]; const int s = s0 + ai * HALF + m * 16;
#pragma unroll
                    for (int bj = 0; bj < 2; ++bj) { const int hh = 2 * bj + (wc >> 1), d0 = 32 * (wc & 1) + 8 * fq; bf16_t* vp = vt + ((size_t)(b * 4 + hh) * 64 + d0) * 2048 + s;
                        const u32x4 w = pack8(acc[ai][bj][m][0] * r, acc[ai][bj][m][1] * r);
                        vp[0 * 2048] = (bf16_t)(w.x & 0xffffu); vp[1 * 2048] = (bf16_t)(w.x >> 16); vp[2 * 2048] = (bf16_t)(w.y & 0xffffu); vp[3 * 2048] = (bf16_t)(w.y >> 16);
                        vp[4 * 2048] = (bf16_t)(w.z & 0xffffu); vp[5 * 2048] = (bf16_t)(w.z >> 16); vp[6 * 2048] = (bf16_t)(w.w & 0xffffu); vp[7 * 2048] = (bf16_t)(w.w >> 16); } }
        }
    }
};


struct EpiGateP {
    static constexpr bool PERM = false, AFTER_DRAIN = true;
    const bf16_t* Y; const bf16_t* Wbr; bf16_t* merged; const rowss_t* rowss;
    size_t ybstride;
    __device__ __forceinline__ void fused(f32x4 (&acc)[2][2][4][2], const Unit& u, int wr, int wc, int fr, int fq, PG8_LAS unsigned char* lds, int wid, int lane) const {
        const int row0 = u.pm * BM + wr * 64 + fr;
        float rs[8]; load_scales(rowss, row0, rs);
        const int tid = wid * 64 + lane;
        unsigned voffA[2]; unsigned voffB;
#pragma unroll
        for (int i = 0; i < 2; ++i) { int R, C; stage_rc(tid * 16 + i * 8192, R, C); voffA[i] = (unsigned)(R * 256 + C) * 2u; }
        { int R, C; stage_rc(tid * 16, R, C); voffB = (unsigned)(R * 256 + C) * 2u; }
        const unsigned ldsw = (unsigned)wid * 1024u;
        const int aoff = lds_byte(wr * 64 + fr, fq * 8), boff = lds_byte(wc * 16 + fr, fq * 8);
        const char* ya = (const char*)Y + (size_t)u.pm * BM * 256 * 2;
        const char* wb = (const char*)Wbr + (size_t)u.pn * 64 * 256 * 2;
#define GP_STAGE(s_) do { const int b_ = (s_) >> 2, kt_ = (s_) & 3; const char* ga_ = ya + (size_t)b_ * ybstride * 2 + kt_ * 128; const char* gb_ = wb + (size_t)b_ * 1024 * 256 * 2 + kt_ * 128; PG8_LAS unsigned char* d_ = lds + ((s_) % 3) * 40960; \
            _Pragma("unroll") for (int h_ = 0; h_ < 2; ++h_) _Pragma("unroll") for (int i_ = 0; i_ < 2; ++i_) \
                __builtin_amdgcn_global_load_lds((const unsigned*)(ga_ + (size_t)h_ * HALF * 256 * 2 + voffA[i_]), (PG8_LAS unsigned*)(d_ + h_ * 16384 + ldsw + i_ * 8192), 16, 0, 0); \
            __builtin_amdgcn_global_load_lds((const unsigned*)(gb_ + voffB), (PG8_LAS unsigned*)(d_ + 32768 + ldsw), 16, 0, 0); } while (0)
        GP_STAGE(0); GP_STAGE(1);
        u32x2 gp[2][2][4][2];
#pragma unroll
        for (int ai = 0; ai < 2; ++ai)
#pragma unroll
            for (int bj = 0; bj < 2; ++bj)
#pragma unroll
                for (int m = 0; m < 4; ++m)
#pragma unroll
                    for (int n = 0; n < 2; ++n) { const float r = rs[ai * 4 + m]; const f32x4 a = acc[ai][bj][m][n];
                        gp[ai][bj][m][n].x = cvt_pk_bf16_t(sigm(a[0] * r), sigm(a[1] * r)); gp[ai][bj][m][n].y = cvt_pk_bf16_t(sigm(a[2] * r), sigm(a[3] * r));
                        acc[ai][bj][m][n] = (f32x4){0.f, 0.f, 0.f, 0.f}; }
#pragma unroll
        for (int s = 0; s < 16; ++s) {
            if (s < 15) asm volatile("s_waitcnt vmcnt(5)" ::: "memory"); else asm volatile("s_waitcnt vmcnt(0)" ::: "memory");
            __builtin_amdgcn_s_barrier(); asm volatile("" ::: "memory");
            if (s + 2 < 16) GP_STAGE(s + 2);
            const PG8_LAS unsigned char* bo = lds + (s % 3) * 40960; const int bj = (s >> 2) >> 1, n = (s >> 2) & 1;
            bf16x8 Bf[2];
#pragma unroll
            for (int k = 0; k < 2; ++k) Bf[k] = *(const PG8_LAS bf16x8*)(bo + 32768 + boff + k * 1024);
#pragma unroll
            for (int ai = 0; ai < 2; ++ai) { bf16x8 At[4][2];
#pragma unroll
                for (int m = 0; m < 4; ++m)
#pragma unroll
                    for (int k = 0; k < 2; ++k) At[m][k] = *(const PG8_LAS bf16x8*)(bo + ai * 16384 + aoff + m * 2048 + k * 1024);
#pragma unroll
                for (int m = 0; m < 4; ++m)
#pragma unroll
                    for (int k = 0; k < 2; ++k) acc[ai][bj][m][n] = __builtin_amdgcn_mfma_f32_16x16x32_bf16(Bf[k], At[m][k], acc[ai][bj][m][n], 0, 0, 0); }
            asm volatile("s_waitcnt lgkmcnt(0)" ::: "memory");
        }
#undef GP_STAGE
        const int j0 = u.pn * 64 + wc * 16 + 4 * fq;
#pragma unroll
        for (int ai = 0; ai < 2; ++ai)
#pragma unroll
            for (int m = 0; m < 4; ++m) { f32x4 s4 = (f32x4){0.f, 0.f, 0.f, 0.f};
#pragma unroll
                for (int bj = 0; bj < 2; ++bj)
#pragma unroll
                    for (int n = 0; n < 2; ++n) { const u32x2 g = gp[ai][bj][m][n]; const f32x4 p = acc[ai][bj][m][n];
                        s4[0] += bf_lo(g.x) * p[0]; s4[1] += bf_hi(g.x) * p[1]; s4[2] += bf_lo(g.y) * p[2]; s4[3] += bf_hi(g.y) * p[3]; }
                u32x2 w; w.x = cvt_pk_bf16(s4[0], s4[1]); w.y = cvt_pk_bf16(s4[2], s4[3]); *(u32x2*)(merged + (size_t)EPI_ROW(ai, m) * 1024 + j0) = w; }
    }
};
template <class Epi, class Sched, bool ALIGN_EPI = false, bool SP2 = false>
__device__ __forceinline__ void gemm_phase(PG8_LAS unsigned char* lds, const Gemm g, const Sched& S, const Epi& E) {
    int tid_ = threadIdx.x; asm volatile("" : "+v"(tid_));
    const int tid = tid_, wid = __builtin_amdgcn_readfirstlane(tid >> 6), lane = tid & 63, wr = wid >> 2, wc = wid & 3, fr = lane & 15, fq = lane >> 4;
    const int K = g.K, nt = K / BK;
    unsigned voffA[2], voffB[2];
#pragma unroll
    for (int i = 0; i < 2; ++i) { int R, C; stage_rc(tid * 16 + i * 8192, R, C); const int Rb = Epi::PERM ? ((R & ~31) + perm32(R & 31)) : R;
        voffA[i] = (unsigned)(R * K + C) * 2u; voffB[i] = (unsigned)(Rb * K + C) * 2u; }
    const size_t kstep = (size_t)(BK * 2);
    const size_t hstep = (size_t)HALF * K * 2;
    const size_t tstep = 2 * hstep;
    const unsigned ldsw = (unsigned)wid * 1024u;
    const int aoff = lds_byte(wr * 64 + fr, fq * 8), boff = lds_byte(wc * 32 + fr, fq * 8);
#define PG8_SA(b, h) (((b) * 2 + (h)) * HTB)
#define PG8_SB(b, h) ((4 + (b) * 2 + (h)) * HTB)
#define PG8_STAGE(bufoff, gbase, voff) do { _Pragma("unroll") for (int _i = 0; _i < 2; ++_i) \
        __builtin_amdgcn_global_load_lds((const unsigned*)((const char*)(gbase) + (voff)[_i]), (PG8_LAS unsigned*)(lds + (bufoff) + ldsw + _i * 8192), 16, 0, 0); } while (0)
#define PG8_LDA(dst, b, h) do { _Pragma("unroll") for (int m = 0; m < 4; ++m) _Pragma("unroll") for (int k = 0; k < 2; ++k) dst[m][k] = *(const PG8_LAS bf16x8*)(lds + PG8_SA(b, h) + aoff + m * 2048 + k * 1024); } while (0)
#define PG8_LDB(dst, b, h) do { _Pragma("unroll") for (int n = 0; n < 2; ++n) _Pragma("unroll") for (int k = 0; k < 2; ++k) dst[n][k] = *(const PG8_LAS bf16x8*)(lds + PG8_SB(b, h) + boff + n * 2048 + k * 1024); } while (0)
#define PG8_MMA(ai, bj, At, Bt) do { __builtin_amdgcn_s_setprio(1); _Pragma("unroll") for (int m = 0; m < 4; ++m) _Pragma("unroll") for (int n = 0; n < 2; ++n) _Pragma("unroll") for (int k = 0; k < 2; ++k) \
        acc[ai][bj][m][n] = __builtin_amdgcn_mfma_f32_16x16x32_bf16(Bt[n][k], At[m][k], acc[ai][bj][m][n], 0, 0, 0); __builtin_amdgcn_s_setprio(0); } while (0)
#define PG8_WAIT_V(n) asm volatile("s_waitcnt vmcnt(" #n ")" ::: "memory")
#define PG8_WAIT_L(n) asm volatile("s_waitcnt lgkmcnt(" #n ")" ::: "memory")
#define PG8_BAR __builtin_amdgcn_s_barrier()
#define PG8_SCHED __builtin_amdgcn_sched_barrier(0)
    Unit cur, nxt; int ui = 0;
    if (!S.next(0, cur)) return;
    f32x4 acc[2][2][4][2];
#pragma unroll
    for (int a = 0; a < 2; ++a)
#pragma unroll
        for (int b = 0; b < 2; ++b)
#pragma unroll
            for (int m = 0; m < 4; ++m)
#pragma unroll
                for (int n = 0; n < 2; ++n) acc[a][b][m][n] = (f32x4){0.f, 0.f, 0.f, 0.f};
    bf16x8 At[4][2], B0[2][2], B1[2][2];
    const char* cA = (const char*)g.A + (size_t)(cur.pn >> g.ashift) * g.astride + (size_t)cur.pm * tstep; const char* cB = (const char*)g.Bt + (size_t)cur.pn * tstep;
    S.a_ready(cur);
    if constexpr (SP2) {
        PG8_STAGE(PG8_SB(0, 0), cB, voffB); PG8_STAGE(PG8_SB(0, 1), cB + hstep, voffB); PG8_STAGE(PG8_SA(0, 0), cA, voffA); PG8_STAGE(PG8_SA(0, 1), cA + hstep, voffA);
        if (wr == 1) PG8_BAR;
        PG8_WAIT_V(2); PG8_BAR;
        PG8_STAGE(PG8_SB(1, 0), cB + kstep, voffB); PG8_STAGE(PG8_SA(1, 0), cA + kstep, voffA); PG8_STAGE(PG8_SB(1, 1), cB + hstep + kstep, voffB);
        PG8_WAIT_V(6); PG8_BAR;
    } else {
        PG8_STAGE(PG8_SB(0, 0), cB, voffB); PG8_STAGE(PG8_SA(0, 0), cA, voffA); PG8_STAGE(PG8_SB(0, 1), cB + hstep, voffB); PG8_STAGE(PG8_SA(0, 1), cA + hstep, voffA);
        if (wr == 1) PG8_BAR;
        PG8_WAIT_V(4); PG8_BAR;
        PG8_STAGE(PG8_SB(1, 0), cB + kstep, voffB); PG8_STAGE(PG8_SA(1, 0), cA + kstep, voffA); PG8_STAGE(PG8_SB(1, 1), cB + hstep + kstep, voffB);
        PG8_WAIT_V(6); PG8_BAR;
    }
    for (;;) {
        const bool has_next = S.next(ui + 1, nxt);
        const char* nA = has_next ? (const char*)g.A + (size_t)(nxt.pn >> g.ashift) * g.astride + (size_t)nxt.pm * tstep : cA; const char* nB = has_next ? (const char*)g.Bt + (size_t)nxt.pn * tstep : cB;
        for (int t = 0; t < nt; t += 2) {
            const bool last = (t == nt - 2);
            const char* a1 = cA + (size_t)(t + 1) * kstep;
            const char* a2 = last ? nA : cA + (size_t)(t + 2) * kstep; const char* b2 = last ? nB : cB + (size_t)(t + 2) * kstep;
            const char* a3 = a2 + kstep; const char* b3 = b2 + kstep;
            if (last && has_next) S.a_ready(nxt);
            if constexpr (SP2) {
            PG8_LDB(B0, 0, 0); PG8_LDB(B1, 0, 1); PG8_SCHED; PG8_LDA(At, 0, 0); PG8_STAGE(PG8_SA(1, 1), a1 + hstep, voffA);
            PG8_WAIT_V(8); PG8_WAIT_L(0); PG8_BAR; PG8_MMA(0, 0, At, B0); PG8_MMA(0, 1, At, B1); PG8_BAR; PG8_SCHED;
            PG8_LDA(At, 0, 1); PG8_STAGE(PG8_SB(0, 0), b2, voffB); PG8_STAGE(PG8_SB(0, 1), b2 + hstep, voffB); PG8_STAGE(PG8_SA(0, 0), a2, voffA);
            PG8_WAIT_V(8); PG8_WAIT_L(0); PG8_BAR; PG8_MMA(1, 0, At, B0); PG8_MMA(1, 1, At, B1); PG8_BAR; PG8_SCHED;
            PG8_LDB(B0, 1, 0); PG8_LDB(B1, 1, 1); PG8_SCHED; PG8_LDA(At, 1, 0); PG8_STAGE(PG8_SA(0, 1), a2 + hstep, voffA);
            PG8_WAIT_V(8); PG8_WAIT_L(0); PG8_BAR; PG8_MMA(0, 0, At, B0); PG8_MMA(0, 1, At, B1); PG8_BAR; PG8_SCHED;
            PG8_LDA(At, 1, 1); PG8_STAGE(PG8_SB(1, 0), b3, voffB); PG8_STAGE(PG8_SB(1, 1), b3 + hstep, voffB); PG8_STAGE(PG8_SA(1, 0), a3, voffA);
            PG8_WAIT_V(8); PG8_WAIT_L(0); PG8_BAR; PG8_MMA(1, 0, At, B0); PG8_MMA(1, 1, At, B1); PG8_BAR; PG8_SCHED;
            } else {
            PG8_LDB(B0, 0, 0); PG8_SCHED; PG8_LDA(At, 0, 0); PG8_STAGE(PG8_SA(1, 1), a1 + hstep, voffA);
            PG8_WAIT_L(8); PG8_BAR; PG8_WAIT_L(0); PG8_MMA(0, 0, At, B0); PG8_BAR; PG8_SCHED;
            PG8_LDB(B1, 0, 1); PG8_STAGE(PG8_SB(0, 0), b2, voffB);
            PG8_BAR; PG8_WAIT_L(0); PG8_MMA(0, 1, At, B1); PG8_BAR;
            PG8_LDA(At, 0, 1); PG8_STAGE(PG8_SA(0, 0), a2, voffA);
            PG8_BAR; PG8_WAIT_L(0); PG8_MMA(1, 0, At, B0); PG8_BAR; PG8_SCHED;
            PG8_STAGE(PG8_SB(0, 1), b2 + hstep, voffB);
            PG8_WAIT_V(6); PG8_BAR; PG8_MMA(1, 1, At, B1); PG8_BAR;
            PG8_LDB(B0, 1, 0); PG8_SCHED; PG8_LDA(At, 1, 0); PG8_STAGE(PG8_SA(0, 1), a2 + hstep, voffA);
            PG8_WAIT_L(8); PG8_BAR; PG8_WAIT_L(0); PG8_MMA(0, 0, At, B0); PG8_BAR; PG8_SCHED;
            PG8_LDB(B1, 1, 1); PG8_STAGE(PG8_SB(1, 0), b3, voffB);
            PG8_BAR; PG8_WAIT_L(0); PG8_MMA(0, 1, At, B1); PG8_BAR;
            PG8_LDA(At, 1, 1); PG8_STAGE(PG8_SA(1, 0), a3, voffA);
            PG8_BAR; PG8_WAIT_L(0); PG8_MMA(1, 0, At, B0); PG8_BAR; PG8_SCHED;
            PG8_STAGE(PG8_SB(1, 1), b3 + hstep, voffB);
            PG8_WAIT_V(6); PG8_BAR; PG8_MMA(1, 1, At, B1); PG8_BAR;
            }
        }
        if constexpr (ALIGN_EPI) { if (wr == 0) PG8_BAR; }
        if constexpr (!Epi::AFTER_DRAIN) { E(acc, cur, wr, wc, fr, fq); S.done(cur); }
        if (!has_next) break;
#pragma unroll
        for (int a = 0; a < 2; ++a)
#pragma unroll
            for (int b = 0; b < 2; ++b)
#pragma unroll
                for (int m = 0; m < 4; ++m)
#pragma unroll
                    for (int n = 0; n < 2; ++n) acc[a][b][m][n] = (f32x4){0.f, 0.f, 0.f, 0.f};
        cur = nxt; cA = nA; cB = nB; ++ui;
        if constexpr (ALIGN_EPI) { if (wr == 1) PG8_BAR; }
    }
    PG8_WAIT_V(0);
    if constexpr (!ALIGN_EPI) { if (wr == 0) PG8_BAR; }
    PG8_BAR;
    if constexpr (Epi::AFTER_DRAIN) { E.fused(acc, cur, wr, wc, fr, fq, lds, wid, lane); S.done(cur); }
#undef PG8_SA
#undef PG8_SB
#undef PG8_STAGE
#undef PG8_LDA
#undef PG8_LDB
#undef PG8_MMA
#undef PG8_WAIT_V
#undef PG8_WAIT_L
#undef PG8_BAR
#undef PG8_SCHED
}
}


constexpr int NWAVES = 8;
constexpr int BATCH = 16, SEQ = 2048, D = 1024, M = BATCH * SEQ, FF = 2816, NGU = 2 * FF, PLED = 256, DEPTH = 2;
constexpr int NIN_SRC = 3088, NIN = 3328, NPROJ = 3072, NGATE = 4096;
constexpr int PC_GQ = 0, PC_GZ = 768, PC_MQ = 1024, PC_MV = 1536, PC_MO = 1792, PC_S5 = 2048, PC_AQ = 2304, PC_AK = 2560, PC_AV = 2816;

constexpr size_t MiB = 1u << 20;
constexpr size_t WS_CTL = 0, CTL_ZERO_BYTES = 4 * MiB;
constexpr size_t WS_ROWSS = 1 * MiB;
constexpr size_t WS_KMEAN = 3 * MiB + 512 * 1024;
constexpr size_t WS_S5P = 6 * MiB + 512 * 1024;
constexpr size_t WS_SCAL = 4 * MiB;
constexpr size_t WS_W = 8 * MiB;
constexpr size_t W_GU1 = 0, W_D1 = W_GU1 + (size_t)NGU * D * 2, W_IN = W_D1 + (size_t)D * FF * 2, W_GATE = W_IN + (size_t)NIN * D * 2, W_BR = W_GATE + (size_t)NGATE * D * 2,
                 W_GLU = W_BR + (size_t)4096 * 256 * 2, W_OUT = W_GLU + (size_t)256 * 256 * 2, W_GU2 = W_OUT + (size_t)D * D * 2, W_D2 = W_GU2 + (size_t)NGU * D * 2,
                 W_PLE = W_D2 + (size_t)D * FF * 2, W_PG = W_PLE + (size_t)D * PLED * 2, W_END = W_PG + (size_t)D * D * 2;
static_assert(W_END <= 56 * MiB, "weights fit");
constexpr size_t WS_HB = 64 * MiB;
constexpr size_t WS_PB = 128 * MiB;
constexpr size_t WS_Y = 144 * MiB;
constexpr size_t WS_YG = 208 * MiB;
constexpr size_t WS_VT = 224 * MiB;
constexpr size_t WS_BIG = 256 * MiB;
constexpr size_t WS_END = 512 * MiB;
constexpr size_t OUT_W1 = 0, OUT_T = 56 * MiB, OUT_ROPE = 120 * MiB;
constexpr int CW_BAR = 4096, CW_QUEUE = 8192, CW_FLAG = 12288, CW_S5F = 16384, CW_GRP = 20480;

constexpr int RING_OFF = 0;
constexpr int LDS_BYTES = 147456;
constexpr int LDSCTL_OFF = LDS_BYTES - 1024;
constexpr int WAVE_LDS = 17408;

#define GAS __attribute__((address_space(1)))
#define LAS __attribute__((address_space(3)))
typedef unsigned short bf16;
typedef unsigned v4u __attribute__((ext_vector_type(4)));
typedef float f32x4 __attribute__((ext_vector_type(4)));
typedef short bf16x8 __attribute__((ext_vector_type(8)));
typedef GAS unsigned gu32;
typedef GAS unsigned long long gu64;
#define RLX_AGENT __ATOMIC_RELAXED, __HIP_MEMORY_SCOPE_AGENT
#define LDS_WAIT() asm volatile("s_waitcnt lgkmcnt(0)" ::: "memory")
#define VM_WAIT() asm volatile("s_waitcnt vmcnt(0)" ::: "memory")
__device__ __forceinline__ unsigned long long rt() { return __builtin_amdgcn_s_memrealtime(); }
__device__ __forceinline__ unsigned f2bf(float f) { unsigned u = __builtin_bit_cast(unsigned, f); return (u + 0x7fffu + ((u >> 16) & 1u)) >> 16; }
typedef float pk2_f32x2 __attribute__((ext_vector_type(2)));
typedef __bf16 pk2_bf16x2 __attribute__((ext_vector_type(2)));
__device__ __forceinline__ unsigned pk2(float lo, float hi) { const pk2_f32x2 v = {lo, hi}; return __builtin_bit_cast(unsigned, __builtin_convertvector(v, pk2_bf16x2)); }

#define XB_TMO      128
#define XB_XCNT(j)  (256  + 64 * (j))
#define XB_XSUB(j)  (1280 + 64 * (j))
#define XB_XGEN(j)  (2304 + 64 * (j))
#define XB_TOP      3328
#define XB_TOPGEN   3392
#define XCD_BAR_WORDS 3456
#define XB_SPIN_CAP (1u << 21)

__device__ __forceinline__ unsigned xb_ld(unsigned* p)              { return __hip_atomic_load(p, __ATOMIC_RELAXED, __HIP_MEMORY_SCOPE_AGENT); }
__device__ __forceinline__ unsigned xb_add(unsigned* p, unsigned v) { return __hip_atomic_fetch_add(p, v, __ATOMIC_RELAXED, __HIP_MEMORY_SCOPE_AGENT); }
__device__ __forceinline__ unsigned xb_xcc_id() { return (unsigned)__builtin_amdgcn_s_getreg((3 << 11) | 20) & 0xFu; }
#define XB_SPIN(cond, bar) do { unsigned _sp = 0; while (cond) { __builtin_amdgcn_s_sleep(1); \
    if ((++_sp & 255u) == 0u) { if (xb_ld(&(bar)[XB_TMO])) break; if (_sp > XB_SPIN_CAP) { atomicAdd(&(bar)[XB_TMO], 1u); break; } } } } while (0)

struct XcdBarrier {
    unsigned* bar; unsigned x;
    volatile LAS unsigned* st;
};

__device__ __forceinline__ XcdBarrier xcd_barrier_post(unsigned* bar, volatile LAS unsigned* st) {
    XcdBarrier b; b.bar = bar; b.x = xb_xcc_id(); b.st = st;
    if (threadIdx.x == 0) (void)xb_add(&bar[XB_XCNT(b.x)], 1u);
    return b;
}
__device__ __forceinline__ void xcd_barrier_complete(unsigned* bar, unsigned x, unsigned& nloc, unsigned& nx) {
    const unsigned G = gridDim.x * gridDim.y * gridDim.z;
    unsigned sum, cnt, mine, sp = 0u;
    for (;;) {
        sum = 0u; cnt = 0u; mine = 0u;
#pragma unroll
        for (unsigned j = 0; j < 16; ++j) { const unsigned c = xb_ld(&bar[XB_XCNT(j)]); sum += c; cnt += (c > 0u) ? 1u : 0u; mine = (j == x) ? c : mine; }
        if (sum == G) break;
        __builtin_amdgcn_s_sleep(1);
        if ((++sp & 255u) == 0u) { if (xb_ld(&bar[XB_TMO])) break; if (sp > XB_SPIN_CAP) { atomicAdd(&bar[XB_TMO], 1u); break; } }
    }
    nloc = mine > 0u ? mine : 1u; nx = cnt > 0u ? cnt : 1u;
}

__device__ __forceinline__ void xcd_barrier(const XcdBarrier& b) {
    asm volatile("s_waitcnt vmcnt(0)" ::: "memory");
    __syncthreads();
    if (threadIdx.x == 0) {
        unsigned* bar = b.bar;
        __builtin_amdgcn_s_waitcnt(0);
        unsigned nloc = b.st[0], nx = b.st[1];
        if (nloc == 0u) { xcd_barrier_complete(bar, b.x, nloc, nx); b.st[0] = nloc; b.st[1] = nx; }
        const unsigned old = xb_add(&bar[XB_XSUB(b.x)], 1u);
        const unsigned gen = old / nloc;
        if (old + 1u == (gen + 1u) * nloc) {
            __builtin_amdgcn_fence(__ATOMIC_RELEASE, "agent");
            asm volatile("s_waitcnt vmcnt(0)" ::: "memory");
            const unsigned og = xb_add(&bar[XB_TOP], 1u);
            const unsigned tg = og / nx;
            if (og + 1u == (tg + 1u) * nx) xb_add(&bar[XB_TOPGEN], 1u);
            else XB_SPIN(xb_ld(&bar[XB_TOPGEN]) == tg, bar);
            __builtin_amdgcn_fence(__ATOMIC_ACQUIRE, "agent");
            xb_add(&bar[XB_XGEN(b.x)], 1u);
            asm volatile("s_waitcnt vmcnt(0)" ::: "memory");
        } else {
            XB_SPIN(xb_ld(&bar[XB_XGEN(b.x)]) == gen, bar);
            __builtin_amdgcn_fence(__ATOMIC_ACQUIRE, "agent");
            asm volatile("s_waitcnt vmcnt(0)" ::: "memory");
        }
    }
    __syncthreads();
}

__device__ __forceinline__ void group_barrier(unsigned* ctr, unsigned target) {
    asm volatile("s_waitcnt vmcnt(0)" ::: "memory");
    __syncthreads();
    if (threadIdx.x == 0) {
        __builtin_amdgcn_s_waitcnt(0);
        __builtin_amdgcn_fence(__ATOMIC_RELEASE, "agent");
        asm volatile("s_waitcnt vmcnt(0)" ::: "memory");
        (void)xb_add(ctr, 1u);
        unsigned sp = 0; while (xb_ld(ctr) < target) { __builtin_amdgcn_s_sleep(1); if (++sp > (1u << 22)) break; }
        __builtin_amdgcn_fence(__ATOMIC_ACQUIRE, "agent");
        asm volatile("s_waitcnt vmcnt(0)" ::: "memory");
    }
    __syncthreads();
}


__device__ __forceinline__ float wave_sum(float v) {
#pragma unroll
    for (int o = 1; o < 64; o <<= 1) v += __shfl_xor(v, o);
    return v;
}
__device__ __forceinline__ float wave_max(float v) {
#pragma unroll
    for (int o = 1; o < 64; o <<= 1) v = fmaxf(v, __shfl_xor(v, o));
    return v;
}
__device__ __forceinline__ float red8(float v) { v += __shfl_xor(v, 1); v += __shfl_xor(v, 2); v += __shfl_xor(v, 4); return v; }
__device__ __forceinline__ float bf2f(bf16 b) { return __uint_as_float(((unsigned)b) << 16); }
__device__ __forceinline__ float sigm(float x) { return __builtin_amdgcn_rcpf(1.0f + __expf(-x)); }
__device__ __forceinline__ float silu(float x) { return x * sigm(x); }

template <class Map>
__device__ __forceinline__ void cvt_item(const float* __restrict__ W, int ld, const float* __restrict__ gain, bf16* Bt, int K, int item, int nblk, LAS float* scr, int lane, Map map) {
    const int kb = item / nblk, nb = item % nblk, k0 = 64 * kb, n0 = 32 * nb;
    const int n4 = lane & 7, kr = lane >> 3; const long so = map(n0 + 4 * n4);
    f32x4 v[8]; float gn[8];
#pragma unroll
    for (int i = 0; i < 8; ++i) { v[i] = (f32x4){0.f, 0.f, 0.f, 0.f}; gn[i] = 1.0f;
        if (so >= 0) { v[i] = *(const GAS f32x4*)(W + so + (size_t)(k0 + 8 * i + kr) * ld); if (gain) gn[i] = gain[k0 + 8 * i + kr]; } }
#pragma unroll
    for (int i = 0; i < 8; ++i) { LAS float* d = scr + (8 * i + kr) * 33 + 4 * n4; const f32x4 w = v[i] * gn[i]; d[0] = w[0]; d[1] = w[1]; d[2] = w[2]; d[3] = w[3]; }
    LDS_WAIT(); asm volatile("" ::: "memory");
    const int c = lane & 7;
#pragma unroll
    for (int j = 0; j < 4; ++j) { const int n = (lane >> 3) + 8 * j; const LAS float* s = scr + (8 * c) * 33 + n;
        v4u o; o.x = pk2(s[0 * 33], s[1 * 33]); o.y = pk2(s[2 * 33], s[3 * 33]); o.z = pk2(s[4 * 33], s[5 * 33]); o.w = pk2(s[6 * 33], s[7 * 33]);
        *(GAS v4u*)(Bt + (size_t)(n0 + n) * K + k0 + 8 * c) = o; }
    LDS_WAIT(); asm volatile("" ::: "memory");
}
struct MapId { __device__ long operator()(int r) const { return r; } };
struct MapGU { __device__ long operator()(int r) const { const int pn = r >> 8, c = r & 255; return c < 128 ? 128 * pn + c : FF + 128 * pn + (c - 128); } };
struct MapIn { __device__ long operator()(int r) const { if (r < 1024) return r; if (r < 2048) return 1032 + (r - 1024); if (r < 2304) return 2064 + (r - 2048);
    if (r < 2560) { const int c = r - 2304; return c < 8 ? 1024 + c : c < 16 ? 2056 + (c - 8) : -1; }
    const int t = (r - 2560) >> 8, c = (r - 2560) & 255; if (t < 2) return 2320 + 256 * t + ((c >> 5) & 3) * 64 + (c >> 7) * 32 + (c & 31); return 2320 + 512 + c; } };
struct MapGate { __device__ long operator()(int r) const { const int pn = r >> 8, c = r & 255, b = 2 * (c >> 7) + ((c >> 4) & 1), jl = 16 * ((c >> 5) & 3) + 4 * ((c >> 2) & 3) + (c & 3); return (long)b * (D * D) + 64 * pn + jl; } };
struct MapBr { __device__ long operator()(int r) const { return (long)(r >> 10) * (256 * D) + (r & 1023); } };

struct LayerW {
    const float *ffn1_norm, *ffn1_w_gu, *ffn1_w_down, *mix_norm, *w_in, *gdn_conv, *gdn_a_log, *gdn_dt_bias, *gdn_norm, *mlstm_conv, *mlstm_i_bias, *mlstm_f_bias, *mlstm_norm,
                *s5_lre, *s5_lim, *s5_bre, *s5_bim, *s5_cre, *s5_cim, *s5_d, *s5_log_dt, *s5_w_glu, *s5_b_glu, *w_gate, *w_branch, *w_out, *ffn2_norm, *ffn2_w_gu, *ffn2_w_down, *ple_norm, *ple_w_proj, *ple_w_gate;
};

__device__ __forceinline__ void prologue_weights(const LayerW& L, unsigned char* wsw, LAS unsigned char* lds, int gw, int ngw, int wave, int lane) {
    LAS float* scr = (LAS float*)(lds + RING_OFF + wave * WAVE_LDS);
    constexpr int I_GU = (D / 64) * (NGU / 32), I_DN = (FF / 64) * (D / 32), I_IN = (D / 64) * (NIN / 32), I_GT = (D / 64) * (NGATE / 32), I_BR = (256 / 64) * (4096 / 32), I_GL = (256 / 64) * (256 / 32),
                  I_OUT = (D / 64) * (D / 32), I_PLE = (PLED / 64) * (D / 32), I_PG = I_OUT;
    constexpr int NITEMS = 2 * I_GU + 2 * I_DN + I_IN + I_GT + I_BR + I_GL + I_OUT + I_PLE + I_PG;
    for (int it = gw; it < NITEMS; it += ngw) {
        int r = it;
        if (r < I_GU) { cvt_item(L.ffn1_w_gu, NGU, L.ffn1_norm, (bf16*)(wsw + W_GU1), D, r, NGU / 32, scr, lane, MapGU()); continue; } r -= I_GU;
        if (r < I_GU) { cvt_item(L.ffn2_w_gu, NGU, L.ffn2_norm, (bf16*)(wsw + W_GU2), D, r, NGU / 32, scr, lane, MapGU()); continue; } r -= I_GU;
        if (r < I_DN) { cvt_item(L.ffn1_w_down, D, nullptr, (bf16*)(wsw + W_D1), FF, r, D / 32, scr, lane, MapId()); continue; } r -= I_DN;
        if (r < I_DN) { cvt_item(L.ffn2_w_down, D, nullptr, (bf16*)(wsw + W_D2), FF, r, D / 32, scr, lane, MapId()); continue; } r -= I_DN;
        if (r < I_IN) { cvt_item(L.w_in, NIN_SRC, L.mix_norm, (bf16*)(wsw + W_IN), D, r, NIN / 32, scr, lane, MapIn()); continue; } r -= I_IN;
        if (r < I_GT) { cvt_item(L.w_gate, D, L.mix_norm, (bf16*)(wsw + W_GATE), D, r, NGATE / 32, scr, lane, MapGate()); continue; } r -= I_GT;
        if (r < I_BR) { cvt_item(L.w_branch, D, nullptr, (bf16*)(wsw + W_BR), 256, r, 4096 / 32, scr, lane, MapBr()); continue; } r -= I_BR;
        if (r < I_GL) { cvt_item(L.s5_w_glu, 256, nullptr, (bf16*)(wsw + W_GLU), 256, r, 256 / 32, scr, lane, MapId()); continue; } r -= I_GL;
        if (r < I_OUT) { cvt_item(L.w_out, D, nullptr, (bf16*)(wsw + W_OUT), D, r, D / 32, scr, lane, MapId()); continue; } r -= I_OUT;
        if (r < I_PLE) { cvt_item(L.ple_w_proj, D, nullptr, (bf16*)(wsw + W_PLE), PLED, r, D / 32, scr, lane, MapId()); continue; } r -= I_PLE;
        cvt_item(L.ple_w_gate, D, L.ple_norm, (bf16*)(wsw + W_PG), D, r, D / 32, scr, lane, MapId());
    }
}
__device__ __forceinline__ void prologue_s5(const LayerW& L, float* s5p, int gtid, int ngt) {
    for (int i = gtid; i < 1024; i += ngt) { const int g = i >> 6;
        const float dt = expf(L.s5_log_dt[g]), lr = L.s5_lre[i], li = L.s5_lim[i];
        const float th = li * dt; float sn, cs; sincosf(th, &sn, &cs);
        const float em1 = expm1f(lr * dt), mag = em1 + 1.0f;
        const float are = mag * cs, aim = mag * sn;
        const float sh = sinf(0.5f * th); const float arem1 = em1 * cs - 2.0f * sh * sh;
        const float den = lr * lr + li * li;
        const float zre = (arem1 * lr + aim * li) / den, zim = (aim * lr - arem1 * li) / den;
        s5p[i] = are; s5p[1024 + i] = aim;
        for (int n = 0; n < 16; ++n) { const float br = L.s5_bre[i * 16 + n], bi = L.s5_bim[i * 16 + n];
            s5p[2048 + i * 16 + n] = zre * br - zim * bi; s5p[2048 + 16384 + i * 16 + n] = zre * bi + zim * br; } }
}
__device__ __forceinline__ void cvt_rows_bf16(const float* src, bf16* dst, size_t n, size_t gtid, size_t ngt) {
    size_t i = gtid * 8;
    for (; i + 3 * ngt * 8 < n; i += 4 * ngt * 8) {
        f32x4 a[4], b[4];
#pragma unroll
        for (int u = 0; u < 4; ++u) { a[u] = *(const GAS f32x4*)(src + i + u * ngt * 8); b[u] = *(const GAS f32x4*)(src + i + u * ngt * 8 + 4); }
#pragma unroll
        for (int u = 0; u < 4; ++u) { v4u o; o.x = pk2(a[u][0], a[u][1]); o.y = pk2(a[u][2], a[u][3]); o.z = pk2(b[u][0], b[u][1]); o.w = pk2(b[u][2], b[u][3]); *(GAS v4u*)(dst + i + u * ngt * 8) = o; } }
    for (; i < n; i += ngt * 8) { const f32x4 a = *(const GAS f32x4*)(src + i), b = *(const GAS f32x4*)(src + i + 4);
        v4u o; o.x = pk2(a[0], a[1]); o.y = pk2(a[2], a[3]); o.z = pk2(b[0], b[1]); o.w = pk2(b[2], b[3]); *(GAS v4u*)(dst + i) = o; }
}
__device__ __forceinline__ void prologue_rope(const int* positions, float* rope, size_t gtid, size_t ngt) {
    for (size_t i = gtid; i < (size_t)M * 32; i += ngt) { const size_t row = i >> 5; const int k = (int)(i & 31);
        const float invf = expf(-(float)k * (2.0f / 64.0f) * 9.210340371976184f); float sn, cs; sincosf((float)positions[row] * invf, &sn, &cs);
        rope[row * 64 + k] = cs; rope[row * 64 + 32 + k] = sn; }
}
__device__ __forceinline__ void x_to_hb(const float* x, bf16* hb, pg8::rowss_t* rowss, int gw, int ngw, int lane) {
    for (int m0 = gw; m0 < M; m0 += 2 * ngw) {
        f32x4 v[2][4]; float s[2];
#pragma unroll
        for (int u = 0; u < 2; ++u) { const int m = m0 + u * ngw; if (m < M) { const GAS f32x4* xr = (const GAS f32x4*)(x + (size_t)m * D) + lane;
#pragma unroll
            for (int j = 0; j < 4; ++j) v[u][j] = xr[64 * j]; } }
#pragma unroll
        for (int u = 0; u < 2; ++u) { const int m = m0 + u * ngw; if (m < M) { s[u] = 0.f;
#pragma unroll
            for (int j = 0; j < 4; ++j) s[u] += (v[u][j][0] * v[u][j][0] + v[u][j][1] * v[u][j][1]) + (v[u][j][2] * v[u][j][2] + v[u][j][3] * v[u][j][3]);
            s[u] = wave_sum(s[u]); if (lane == 0) rowss[m] = (pg8::rowss_t)(s[u] * pg8::RSS_SCALE);
            GAS unsigned long long* o8 = (GAS unsigned long long*)(hb + (size_t)m * D) + lane;
#pragma unroll
            for (int j = 0; j < 4; ++j) o8[64 * j] = (unsigned long long)pk2(v[u][j][0], v[u][j][1]) | ((unsigned long long)pk2(v[u][j][2], v[u][j][3]) << 32); } } }
}
__device__ __forceinline__ void final_norm(const bf16* h, float* out, const pg8::rowss_t* rowss, const float* w, int gw, int ngw, int lane) {
    const GAS f32x4* wp = (const GAS f32x4*)(w + 16 * lane); const f32x4 g0 = wp[0], g1 = wp[1], g2 = wp[2], g3 = wp[3];
    for (int m0 = gw; m0 < M; m0 += 4 * ngw) {
        v4u hw[4][2]; float r[4];
#pragma unroll
        for (int u = 0; u < 4; ++u) { const int m = m0 + u * ngw; if (m < M) { const GAS v4u* hp = (const GAS v4u*)(h + (size_t)m * D + 16 * lane); hw[u][0] = hp[0]; hw[u][1] = hp[1]; r[u] = pg8::rms_scale(rowss, m); } }
#pragma unroll
        for (int u = 0; u < 4; ++u) { const int m = m0 + u * ngw; if (m < M) { GAS f32x4* op = (GAS f32x4*)(out + (size_t)m * D + 16 * lane); const float rr = r[u];
            op[0] = (f32x4){__uint_as_float(hw[u][0].x << 16) * rr * g0[0], __uint_as_float(hw[u][0].x & 0xffff0000u) * rr * g0[1], __uint_as_float(hw[u][0].y << 16) * rr * g0[2], __uint_as_float(hw[u][0].y & 0xffff0000u) * rr * g0[3]};
            op[1] = (f32x4){__uint_as_float(hw[u][0].z << 16) * rr * g1[0], __uint_as_float(hw[u][0].z & 0xffff0000u) * rr * g1[1], __uint_as_float(hw[u][0].w << 16) * rr * g1[2], __uint_as_float(hw[u][0].w & 0xffff0000u) * rr * g1[3]};
            op[2] = (f32x4){__uint_as_float(hw[u][1].x << 16) * rr * g2[0], __uint_as_float(hw[u][1].x & 0xffff0000u) * rr * g2[1], __uint_as_float(hw[u][1].y << 16) * rr * g2[2], __uint_as_float(hw[u][1].y & 0xffff0000u) * rr * g2[3]};
            op[3] = (f32x4){__uint_as_float(hw[u][1].z << 16) * rr * g3[0], __uint_as_float(hw[u][1].z & 0xffff0000u) * rr * g3[1], __uint_as_float(hw[u][1].w << 16) * rr * g3[2], __uint_as_float(hw[u][1].w & 0xffff0000u) * rr * g3[3]}; } } }
}

__device__ __forceinline__ float softplusf(float x) { return fmaxf(x, 0.f) + __logf(1.0f + __expf(-fabsf(x))); }
__device__ __forceinline__ float gelu_tanh(float y) { const float z = 0.7978845608028654f * (y + 0.044715f * y * y * y); const float th = 1.0f - 2.0f * __builtin_amdgcn_rcpf(1.0f + __expf(2.0f * z)); return 0.5f * y * (1.0f + th); }
template <int NQG>
__device__ __forceinline__ void moba_mfma_item(const bf16* proj, const float* kmean, const bf16* vt, bf16* y3, int bh, int qb, int wsl, int lane) {
    constexpr int NQ = 16 * NQG;
    const int b = bh >> 2, h = bh & 3, fr = lane & 15, fq = lane >> 4;
    const int t0 = qb * 256 + wsl * NQ; const size_t rowb = (size_t)b * SEQ;
    unsigned selmask = 0;
    { const GAS v4u* qp = (const GAS v4u*)(proj + (rowb + t0 + (lane & (NQ - 1))) * NPROJ + PC_AQ + h * 64);
      float qv[64];
#pragma unroll
      for (int c = 0; c < 8; ++c) { const v4u w = qp[c]; qv[8 * c + 0] = __uint_as_float(w.x << 16); qv[8 * c + 1] = __uint_as_float(w.x & 0xffff0000u); qv[8 * c + 2] = __uint_as_float(w.y << 16); qv[8 * c + 3] = __uint_as_float(w.y & 0xffff0000u);
          qv[8 * c + 4] = __uint_as_float(w.z << 16); qv[8 * c + 5] = __uint_as_float(w.z & 0xffff0000u); qv[8 * c + 6] = __uint_as_float(w.w << 16); qv[8 * c + 7] = __uint_as_float(w.w & 0xffff0000u); }
      float gs[7];
#pragma unroll
      for (int n = 0; n < 7; ++n) { float a = -3.0e38f; if (n < qb) { const float* km = kmean + (size_t)(bh * 8 + n) * 64; a = 0.f;
#pragma unroll
              for (int d = 0; d < 64; ++d) a += qv[d] * km[d]; }
          gs[n] = a; }
#pragma unroll
      for (int r = 0; r < 3; ++r) { int best = -1; float bv = -3.0e38f;
#pragma unroll
          for (int n = 0; n < 7; ++n) if (n < qb && !((selmask >> n) & 1u) && gs[n] > bv) { bv = gs[n]; best = n; }
          if (best >= 0) selmask |= 1u << best; } }
    unsigned mskp = 0;
#pragma unroll
    for (int qg = 0; qg < NQG; ++qg) mskp |= ((unsigned)__shfl((int)selmask, 16 * qg + fr) & 0xffu) << (8 * qg);
    unsigned umask = 0;
#pragma unroll
    for (int n = 0; n < 7; ++n) if (__ballot((selmask >> n) & 1u) != 0ull) umask |= 1u << n;
    bf16x8 qf[NQG][2];
#pragma unroll
    for (int qg = 0; qg < NQG; ++qg)
#pragma unroll
        for (int ks = 0; ks < 2; ++ks) qf[qg][ks] = *(const GAS bf16x8*)(proj + (rowb + t0 + 16 * qg + fr) * NPROJ + PC_AQ + h * 64 + 32 * ks + 8 * fq);
    f32x4 o[4][NQG];
#pragma unroll
    for (int dt = 0; dt < 4; ++dt)
#pragma unroll
        for (int qg = 0; qg < NQG; ++qg) o[dt][qg] = (f32x4){0.f, 0.f, 0.f, 0.f};
    float mrun[NQG], lrun[NQG];
#pragma unroll
    for (int qg = 0; qg < NQG; ++qg) { mrun[qg] = -1.0e30f; lrun[qg] = 0.f; }
    const float cexp = 0.125f * 1.4426950408889634f;
    const int kperm = 8 * (fr >> 2) + (fr & 3);
    for (int it = 0; it <= qb; ++it) {
        const int nb = (it == 0) ? qb : it - 1;
        if (it > 0 && !((umask >> nb) & 1u)) continue;
        const int nsteps = (it == 0) ? (wsl * NQ + NQ - 1) / 32 + 1 : 8;
        bf16x8 kfn[2][2];
        { const size_t kb0 = rowb + nb * 256;
#pragma unroll
          for (int kt = 0; kt < 2; ++kt)
#pragma unroll
              for (int ks = 0; ks < 2; ++ks) kfn[kt][ks] = *(const GAS bf16x8*)(proj + (kb0 + kperm + 4 * kt) * NPROJ + PC_AK + h * 64 + 32 * ks + 8 * fq); }
        for (int st = 0; st < nsteps; ++st) {
            bf16x8 kf[2][2], vf[4];
#pragma unroll
            for (int kt = 0; kt < 2; ++kt) { kf[kt][0] = kfn[kt][0]; kf[kt][1] = kfn[kt][1]; }
#pragma unroll
            for (int dt = 0; dt < 4; ++dt) vf[dt] = *(const GAS bf16x8*)(vt + ((size_t)bh * 64 + 16 * dt + fr) * SEQ + nb * 256 + 32 * st + 8 * fq);
            if (st + 1 < nsteps) { const size_t kb = rowb + nb * 256 + 32 * (st + 1);
#pragma unroll
                for (int kt = 0; kt < 2; ++kt)
#pragma unroll
                    for (int ks = 0; ks < 2; ++ks) kfn[kt][ks] = *(const GAS bf16x8*)(proj + (kb + kperm + 4 * kt) * NPROJ + PC_AK + h * 64 + 32 * ks + 8 * fq); }
            f32x4 s[2][NQG];
#pragma unroll
            for (int kt = 0; kt < 2; ++kt)
#pragma unroll
                for (int qg = 0; qg < NQG; ++qg) { f32x4 a = (f32x4){0.f, 0.f, 0.f, 0.f};
                    a = __builtin_amdgcn_mfma_f32_16x16x32_bf16(kf[kt][0], qf[qg][0], a, 0, 0, 0); a = __builtin_amdgcn_mfma_f32_16x16x32_bf16(kf[kt][1], qf[qg][1], a, 0, 0, 0); s[kt][qg] = a; }
            bf16x8 pf[NQG];
#pragma unroll
            for (int qg = 0; qg < NQG; ++qg) {
                const int qloc = NQ * wsl + 16 * qg + fr; const bool sel = (mskp >> (8 * qg + nb)) & 1u;
                float mx = -1.0e30f;
#pragma unroll
                for (int kt = 0; kt < 2; ++kt)
#pragma unroll
                    for (int i = 0; i < 4; ++i) { const int kloc = 32 * st + 8 * fq + 4 * kt + i; const bool ok = (it == 0) ? (kloc <= qloc) : sel; const float v = ok ? s[kt][qg][i] : -1.0e30f; s[kt][qg][i] = v; mx = fmaxf(mx, v); }
                mx = fmaxf(mx, __shfl_xor(mx, 16)); mx = fmaxf(mx, __shfl_xor(mx, 32));
                const float mnew = fmaxf(mrun[qg], mx), alpha = __builtin_amdgcn_exp2f((mrun[qg] - mnew) * cexp); mrun[qg] = mnew;
                float ps = 0.f; float p[8];
#pragma unroll
                for (int kt = 0; kt < 2; ++kt)
#pragma unroll
                    for (int i = 0; i < 4; ++i) { const float e = __builtin_amdgcn_exp2f((s[kt][qg][i] - mnew) * cexp); p[4 * kt + i] = e; ps += e; }
                lrun[qg] = lrun[qg] * alpha + ps;
#pragma unroll
                for (int dt = 0; dt < 4; ++dt) o[dt][qg] *= alpha;
                v4u pw; pw.x = pk2(p[0], p[1]); pw.y = pk2(p[2], p[3]); pw.z = pk2(p[4], p[5]); pw.w = pk2(p[6], p[7]);
                pf[qg] = __builtin_bit_cast(bf16x8, pw);
            }
#pragma unroll
            for (int dt = 0; dt < 4; ++dt)
#pragma unroll
                for (int qg = 0; qg < NQG; ++qg) o[dt][qg] = __builtin_amdgcn_mfma_f32_16x16x32_bf16(vf[dt], pf[qg], o[dt][qg], 0, 0, 0);
        }
    }
#pragma unroll
    for (int qg = 0; qg < NQG; ++qg) { float l = lrun[qg]; l += __shfl_xor(l, 16); l += __shfl_xor(l, 32); const float inv = 1.0f / l;
        bf16* orow = y3 + (rowb + t0 + 16 * qg + fr) * 256 + h * 64 + 4 * fq;
#pragma unroll
        for (int dt = 0; dt < 4; ++dt) { const f32x4 v = o[dt][qg] * inv; *(GAS unsigned long long*)(orow + 16 * dt) = (unsigned long long)pk2(v[0], v[1]) | ((unsigned long long)pk2(v[2], v[3]) << 32); } }
}
typedef float f32x2 __attribute__((ext_vector_type(2)));
typedef unsigned u32x2_t __attribute__((ext_vector_type(2)));
constexpr int S2_XA = 0, S2_KN = 16384, S2_VV = 32768, S2_AB = 49152, S2_BUF = 50176, S2_OB = 2 * S2_BUF, S2_QD = S2_OB + 32768, S2_XT = S2_QD + 512, S2_CW = S2_XT + 32 * 68 * 4, S2_FA = S2_KN + 8960  ;
static_assert(S2_CW + 3 * 4 * 64 * 4 + 128 + 256 <= LDSCTL_OFF, "LDS map of the sequential mixers");
template <bool GDN>
__device__ __forceinline__ void seq_mixer2(const bf16* proj, const float* scal, const float* convw, const float* p0, const float* p1, const float* normw, bf16* yout, LAS unsigned char* lds, int bh, int tid) {
    const int wave = __builtin_amdgcn_readfirstlane(tid >> 6), lane = tid & 63;
    const int b = bh >> 2, h = bh & 3; const size_t rowb = (size_t)b * SEQ;
    constexpr int CIN = GDN ? 768 : 512, PCQ = GDN ? PC_GQ : PC_MQ;
    if (wave == 4) { LAS float* cwl = (LAS float*)(lds + S2_CW);
        for (int i = lane; i < 3 * 4 * 64; i += 64) { const int ty = i >> 8, j = (i >> 6) & 3, dd = i & 63; cwl[i] = (GDN || ty < 2) ? convw[j * CIN + ty * 256 + h * 64 + dd] : 0.f; }
        if (lane < 32) cwl[768 + lane] = 0.f; { unsigned no_ = (unsigned)(((GDN ? 0 : h * 64) + lane) * 4); asm volatile("" : "+v"(no_)); cwl[800 + lane] = *(const float*)((const char*)normw + no_); } }
    __syncthreads();
    if (wave < 4) {
        const int fr = lane & 15, fq = lane >> 4, e = 16 * wave + fr, sel = fr & 3;
        f32x4 ST[4];
#pragma unroll
        for (int T = 0; T < 4; ++T) ST[T] = (f32x4){0.f, 0.f, 0.f, 0.f};
        const unsigned wmask = (fq == 0) ? 0xffffffffu : 0u;
        v4u b0 = (v4u){0u, 0u, 0u, 0u}, b1 = b0, b2 = b0, b3 = b0;
        __builtin_amdgcn_s_setprio(3);
        for (int c = 0; c < SEQ / 64; ++c) {
            __syncthreads();
            const LAS bf16* XA = (const LAS bf16*)(lds + (c & 1) * S2_BUF + S2_XA) + (sel >> 1) * 128 + (sel & 1) * 64 + 8 * fq;
            const LAS unsigned char* KP = lds + (c & 1) * S2_BUF + S2_KN + fr * 16;
            const LAS float* VV = (const LAS float*)(lds + (c & 1) * S2_BUF + S2_VV) + e; const LAS float* AB = (const LAS float*)(lds + (c & 1) * S2_BUF + S2_AB);
            LAS float* OB = (LAS float*)(lds + S2_OB + (c & 1) * 16384) + e;
            bf16x8 a0n, a1n, kpn; f32x4 ab1n, ab2n; float v1n, v2n;
#define S2_LOAD(tp) do { a0n = *(const LAS bf16x8*)(XA + (tp) * 256); a1n = *(const LAS bf16x8*)(XA + (tp) * 256 + 32); kpn = *(const LAS bf16x8*)(KP + (tp) * 272); \
            v1n = VV[(tp) * 128]; v2n = VV[(tp) * 128 + 64]; ab1n = *(const LAS f32x4*)(AB + 8 * (tp)); ab2n = *(const LAS f32x4*)(AB + 8 * (tp) + 4); } while (0)
            S2_LOAD(0);
#pragma unroll 4
            for (int tp = 0; tp < 32; ++tp) {
                const bf16x8 a0 = a0n, a1 = a1n, kp = kpn; const f32x4 ab1 = ab1n, ab2 = ab2n; const float ve1 = v1n, ve2 = v2n;
                v4u bl, bhh; bl.x = pk2(ST[0][0], ST[0][1]); bl.y = pk2(ST[0][2], ST[0][3]); bl.z = pk2(ST[1][0], ST[1][1]); bl.w = pk2(ST[1][2], ST[1][3]);
                bhh.x = pk2(ST[2][0], ST[2][1]); bhh.y = pk2(ST[2][2], ST[2][3]); bhh.z = pk2(ST[3][0], ST[3][1]); bhh.w = pk2(ST[3][2], ST[3][3]);
                f32x4 d = (f32x4){0.f, 0.f, 0.f, 0.f};
                d = __builtin_amdgcn_mfma_f32_16x16x32_bf16(a0, __builtin_bit_cast(bf16x8, bl), d, 0, 0, 0);
                d = __builtin_amdgcn_mfma_f32_16x16x32_bf16(a1, __builtin_bit_cast(bf16x8, bhh), d, 0, 0, 0);
                __builtin_amdgcn_sched_barrier(0);
                S2_LOAD(tp + 1);
                __builtin_amdgcn_sched_barrier(0);
                float o1, o2, vn1, vn2;
                if (GDN) { vn1 = ve1 - ab1[1] * d[0]; o1 = ab1[0] * d[1] + vn1 * ab1[2];
                    const float sk2 = ab1[0] * d[2] + ab2[3] * vn1, sq2 = ab1[0] * d[3] + ab1[3] * vn1;
                    vn2 = ve2 - ab2[1] * sk2; o2 = ab2[0] * sq2 + vn2 * ab2[2]; }
                else { vn1 = ve1; o1 = ab1[0] * d[1] + ve1 * ab1[2]; const float sq2 = ab1[0] * d[3] + ab1[3] * ve1; vn2 = ve2; o2 = ab2[0] * sq2 + ve2 * ab2[2]; }
                const float aa = ab1[0] * ab2[0], c1 = ab2[0] * vn1;
#pragma unroll
                for (int T = 0; T < 4; ++T) ST[T] *= aa;
                const unsigned w = pk2(c1, vn2) & wmask;
                b0.x = w; b1.y = w; b2.z = w; b3.w = w;
                ST[0] = __builtin_amdgcn_mfma_f32_16x16x32_bf16(kp, __builtin_bit_cast(bf16x8, b0), ST[0], 0, 0, 0);
                ST[1] = __builtin_amdgcn_mfma_f32_16x16x32_bf16(kp, __builtin_bit_cast(bf16x8, b1), ST[1], 0, 0, 0);
                ST[2] = __builtin_amdgcn_mfma_f32_16x16x32_bf16(kp, __builtin_bit_cast(bf16x8, b2), ST[2], 0, 0, 0);
                ST[3] = __builtin_amdgcn_mfma_f32_16x16x32_bf16(kp, __builtin_bit_cast(bf16x8, b3), ST[3], 0, 0, 0);
                OB[tp * 128] = o1; OB[tp * 128 + 64] = o2;
            }
#undef S2_LOAD
        }
        __builtin_amdgcn_s_setprio(0);
        __syncthreads();
        __syncthreads();
    } else {
        const float s0 = GDN ? __expf(p0[h]) : p0[h], s1 = p1[h];
        const int ht = tid - 256, dgrp = ht & 7, d0 = 8 * dgrp, tg = ht >> 3;
        const int xpos = (dgrp >> 2) * 32 + (dgrp & 1) * 16 + ((dgrp >> 1) & 1) * 4;
        const LAS float* CW0 = (const LAS float*)(lds + S2_CW) + d0;
        const int e0 = (lane & 7) * 8;
        float nstate = 0.f;
#define S2_UNPK(W_, A_) do { const v4u w_ = (W_); A_[0] = __uint_as_float(w_.x << 16); A_[1] = __uint_as_float(w_.x & 0xffff0000u); A_[2] = __uint_as_float(w_.y << 16); A_[3] = __uint_as_float(w_.y & 0xffff0000u); \
                    A_[4] = __uint_as_float(w_.z << 16); A_[5] = __uint_as_float(w_.z & 0xffff0000u); A_[6] = __uint_as_float(w_.w << 16); A_[7] = __uint_as_float(w_.w & 0xffff0000u); } while (0)
        v4u rq[5], rk[5], rv[5]; float sg[2][2]; v4u zws[2];
        const int zh = 2 * (wave - 4);
#define S2_PREF(cn) do { const int s_ = (cn) * 64 + 2 * tg; \
            unsigned off_ = (unsigned)((((int)rowb + s_ - 3) * NPROJ + PCQ + h * 64 + d0) * 2); asm volatile("" : "+v"(off_));     \
            _Pragma("unroll") for (int r = 0; r < 5; ++r) { rq[r] = (v4u){0u, 0u, 0u, 0u}; rk[r] = rq[r]; \
                if (s_ - 3 + r >= 0) { const char* src_ = (const char*)proj + (off_ + (unsigned)(r * NPROJ * 2)); rq[r] = *(const GAS v4u*)src_; rk[r] = *(const GAS v4u*)(src_ + 512); } } } while (0)
#define S2_PREF_V(cn) do { const int s_ = (cn) * 64 + 2 * tg; \
            unsigned off_ = (unsigned)((((int)rowb + s_ - 3) * NPROJ + PCQ + h * 64 + d0) * 2); asm volatile("" : "+v"(off_)); \
            _Pragma("unroll") for (int r = 0; r < 5; ++r) { rv[r] = (v4u){0u, 0u, 0u, 0u}; \
                if (s_ - 3 + r >= 0) { const char* src_ = (const char*)proj + (off_ + (unsigned)(r * NPROJ * 2)); \
                    if (GDN) rv[r] = *(const GAS v4u*)(src_ + 1024); else if (r >= 3) rv[r] = *(const GAS v4u*)(src_ + (PC_MV - PCQ) * 2); } } \
            unsigned so_ = (unsigned)((((int)rowb + s_) * 16 + h) * 4); asm volatile("" : "+v"(so_)); const float* sb_ = (const float*)((const char*)scal + so_); \
            _Pragma("unroll") for (int i = 0; i < 2; ++i) { sg[i][0] = sb_[i * 16 + (GDN ? 0 : 8)]; sg[i][1] = sb_[i * 16 + (GDN ? 4 : 12)]; } } while (0)
#define S2_PREF_Z(cc_) do { unsigned zo_ = (unsigned)((((int)rowb + (cc_) * 64 + (lane >> 3) + zh * 8) * NPROJ + (GDN ? PC_GZ : PC_MO) + h * 64 + e0) * 2); asm volatile("" : "+v"(zo_)); \
            _Pragma("unroll") for (int i8 = 0; i8 < 2; ++i8) zws[i8] = *(const GAS v4u*)((const char*)proj + (zo_ + (unsigned)(i8 * 8 * NPROJ * 2))); } while (0)
        S2_PREF(0);
        for (int c = 0; c <= SEQ / 64 + 1; ++c) {
            if (c >= 2) {
                const int cc = c - 2; const LAS float* OB = (const LAS float*)(lds + S2_OB + (cc & 1) * 16384); const LAS float* QD = (const LAS float*)(lds + S2_QD) + (cc & 1) * 64;
#pragma unroll
                for (int i8 = 0; i8 < 2; ++i8) { const int t = (zh + i8) * 8 + (lane >> 3); const size_t row = rowb + cc * 64 + t;
                    f32x4 oa = *(const LAS f32x4*)(OB + t * 64 + e0), ob = *(const LAS f32x4*)(OB + t * 64 + e0 + 4);
                    if (!GDN) { const float inv = 1.0f / fmaxf(fabsf(QD[t]), 1.0f); oa *= inv; ob *= inv; }
                    float ss = (oa[0] * oa[0] + oa[1] * oa[1]) + (oa[2] * oa[2] + oa[3] * oa[3]) + (ob[0] * ob[0] + ob[1] * ob[1]) + (ob[2] * ob[2] + ob[3] * ob[3]);
                    ss += __shfl_xor(ss, 1); ss += __shfl_xor(ss, 2); ss += __shfl_xor(ss, 4);
                    const float r = rsqrtf(ss * (1.0f / 64.0f) + 1e-6f);
                    float z[8]; S2_UNPK(zws[i8], z);
                    float y[8]; const f32x4 nw0 = *(const LAS f32x4*)(lds + S2_CW + 3200 + 4 * e0), nw1 = *(const LAS f32x4*)(lds + S2_CW + 3200 + 4 * e0 + 16);
#pragma unroll
                    for (int i = 0; i < 8; ++i) { const float ov = (i < 4 ? oa[i] * nw0[i & 3] : ob[i - 4] * nw1[i & 3]) * r; y[i] = GDN ? ov * silu(z[i]) : ov * sigm(z[i]); }
                    v4u yo; yo.x = pk2(y[0], y[1]); yo.y = pk2(y[2], y[3]); yo.z = pk2(y[4], y[5]); yo.w = pk2(y[6], y[7]);
                    *(GAS v4u*)((char*)yout + (unsigned)(((int)row * 256 + h * 64 + e0) * 2)) = yo; }
            }
            if (c < SEQ / 64) {
                S2_PREF_V(c);
                LAS bf16* XA = (LAS bf16*)(lds + (c & 1) * S2_BUF + S2_XA); LAS unsigned char* KPb = lds + (c & 1) * S2_BUF + S2_KN; LAS float* VV = (LAS float*)(lds + (c & 1) * S2_BUF + S2_VV); LAS float* AB = (LAS float*)(lds + (c & 1) * S2_BUF + S2_AB);
#pragma unroll
                for (int i = 0; i < 2; ++i) { const int t = 2 * tg + i;
                    const LAS float* CW = CW0; asm volatile("" : "+v"(CW));
                    float q[8], k[8];
#pragma unroll
                    for (int ii = 0; ii < 8; ++ii) { q[ii] = 0.f; k[ii] = 0.f; }
#pragma unroll
                    for (int j = 0; j < 4; ++j) { const f32x4 wq0 = *(const LAS f32x4*)(CW + j * 64), wq1 = *(const LAS f32x4*)(CW + j * 64 + 4), wk0 = *(const LAS f32x4*)(CW + (4 + j) * 64), wk1 = *(const LAS f32x4*)(CW + (4 + j) * 64 + 4);
                        float x[8]; S2_UNPK(rq[i + j], x);
#pragma unroll
                        for (int ii = 0; ii < 4; ++ii) { q[ii] += wq0[ii] * x[ii]; q[4 + ii] += wq1[ii] * x[4 + ii]; }
                        S2_UNPK(rk[i + j], x);
#pragma unroll
                        for (int ii = 0; ii < 4; ++ii) { k[ii] += wk0[ii] * x[ii]; k[4 + ii] += wk1[ii] * x[4 + ii]; }
                        if (j & 1) asm volatile("" ::: "memory"); }
                    float ssq = 0.f, ssk = 0.f;
#pragma unroll
                    for (int ii = 0; ii < 8; ++ii) { q[ii] = silu(q[ii]); k[ii] = silu(k[ii]); ssq += q[ii] * q[ii]; ssk += k[ii] * k[ii]; }
                    float scq = 1.0f, sck = 1.0f;
                    if (GDN) { ssq += __shfl_xor(ssq, 1); ssk += __shfl_xor(ssk, 1); ssq += __shfl_xor(ssq, 2); ssk += __shfl_xor(ssk, 2); ssq += __shfl_xor(ssq, 4); ssk += __shfl_xor(ssk, 4);
                        scq = rsqrtf(ssq + 1e-6f) * 0.125f; sck = rsqrtf(ssk + 1e-6f); }
                    else sck = 0.125f * __expf(sg[i][0] + s0);
                    float kq = 0.f;
#pragma unroll
                    for (int ii = 0; ii < 8; ++ii) { q[ii] *= scq; k[ii] *= sck; kq += q[ii] * k[ii]; }
                    kq += __shfl_xor(kq, 1); kq += __shfl_xor(kq, 2); kq += __shfl_xor(kq, 4);
                    float k12 = 0.f, kq12 = 0.f;
                    float kp[8];
                    if (i == 1) { const u32x2_t w0 = *(const LAS u32x2_t*)(XA + (t - 1) * 128 + xpos), w1 = *(const LAS u32x2_t*)(XA + (t - 1) * 128 + xpos + 8);
                        kp[0] = __uint_as_float(w0.x << 16); kp[1] = __uint_as_float(w0.x & 0xffff0000u); kp[2] = __uint_as_float(w0.y << 16); kp[3] = __uint_as_float(w0.y & 0xffff0000u);
                        kp[4] = __uint_as_float(w1.x << 16); kp[5] = __uint_as_float(w1.x & 0xffff0000u); kp[6] = __uint_as_float(w1.y << 16); kp[7] = __uint_as_float(w1.y & 0xffff0000u);
#pragma unroll
                        for (int ii = 0; ii < 8; ++ii) { k12 += kp[ii] * k[ii]; kq12 += kp[ii] * q[ii]; }
                        k12 += __shfl_xor(k12, 1); kq12 += __shfl_xor(kq12, 1); k12 += __shfl_xor(k12, 2); kq12 += __shfl_xor(kq12, 2); k12 += __shfl_xor(k12, 4); kq12 += __shfl_xor(kq12, 4); }
                    v4u qb, kb; qb.x = pk2(q[0], q[1]); qb.y = pk2(q[2], q[3]); qb.z = pk2(q[4], q[5]); qb.w = pk2(q[6], q[7]); kb.x = pk2(k[0], k[1]); kb.y = pk2(k[2], k[3]); kb.z = pk2(k[4], k[5]); kb.w = pk2(k[6], k[7]);
                    *(LAS u32x2_t*)(XA + t * 128 + xpos) = (u32x2_t){kb.x, kb.y}; *(LAS u32x2_t*)(XA + t * 128 + xpos + 8) = (u32x2_t){kb.z, kb.w};
                    *(LAS u32x2_t*)(XA + t * 128 + 64 + xpos) = (u32x2_t){qb.x, qb.y}; *(LAS u32x2_t*)(XA + t * 128 + 64 + xpos + 8) = (u32x2_t){qb.z, qb.w};
                    if (i == 1) {
#pragma unroll
                        for (int ii = 0; ii < 8; ++ii) *(LAS unsigned*)(KPb + tg * 272 + (8 * (dgrp & 1) + ii) * 16 + (dgrp >> 1) * 4) = pk2(kp[ii], k[ii]); }
                    float be = 1.0f;
                    if (GDN) be = sigm(sg[i][0]);
                    if (dgrp == 0) { f32x4 abv;
                        if (GDN) { const float al = __expf(-s0 * softplusf(sg[i][1] + s1)); abv = (f32x4){al, al * be, kq, k12}; }
                        else { abv = (f32x4){sigm(sg[i][1] + s1), 0.f, kq, 0.f}; *(LAS float*)(lds + (c & 1) * S2_BUF + S2_FA + 4 * t) = abv[0]; }
                        *(LAS f32x4*)(AB + 4 * t) = abv; if (i == 1) AB[4 * (t - 1) + 3] = kq12; }
                    float v[8];
                    if (GDN) {
#pragma unroll
                        for (int ii = 0; ii < 8; ++ii) v[ii] = 0.f;
#pragma unroll
                        for (int j = 0; j < 4; ++j) { float x[8]; S2_UNPK(rv[i + j], x); const f32x4 wv0 = *(const LAS f32x4*)(CW + (8 + j) * 64), wv1 = *(const LAS f32x4*)(CW + (8 + j) * 64 + 4);
#pragma unroll
                            for (int ii = 0; ii < 4; ++ii) { v[ii] += wv0[ii] * x[ii]; v[4 + ii] += wv1[ii] * x[4 + ii]; } }
#pragma unroll
                        for (int ii = 0; ii < 8; ++ii) v[ii] = silu(v[ii]) * be;
                    } else S2_UNPK(rv[3 + i], v);
                    *(LAS f32x4*)(VV + t * 64 + d0) = (f32x4){v[0], v[1], v[2], v[3]}; *(LAS f32x4*)(VV + t * 64 + d0 + 4) = (f32x4){v[4], v[5], v[6], v[7]};
                    asm volatile("" ::: "memory"); }
                if (c + 1 < SEQ / 64) S2_PREF(c + 1);
            }
            if (c >= 1 && c <= SEQ / 64) S2_PREF_Z(c - 1);
            __syncthreads();
            if (!GDN && wave == 5 && c < SEQ / 64) {
                const int lpos = 32 * (lane >> 5) + 8 * ((lane & 15) >> 2) + 4 * ((lane >> 4) & 1) + (lane & 3); const LAS bf16* XQ = (const LAS bf16*)(lds + (c & 1) * S2_BUF + S2_XA) + 64 + lpos; const LAS bf16* XK = (const LAS bf16*)(lds + (c & 1) * S2_BUF + S2_XA) + lpos; const LAS float* AB = (const LAS float*)(lds + (c & 1) * S2_BUF + S2_AB);
                LAS float* QD = (LAS float*)(lds + S2_QD) + (c & 1) * 64; LAS float* XT = (LAS float*)(lds + S2_XT); const LAS float* FA = (const LAS float*)(lds + (c & 1) * S2_BUF + S2_FA);
                for (int hf = 0; hf < 2; ++hf) {
#pragma unroll 1
                    for (int g16 = 0; g16 < 2; ++g16) {
                        const int t0 = hf * 32 + g16 * 16; float fa[16], ka[16], qa[16], xo[16];
#pragma unroll
                        for (int j4 = 0; j4 < 4; ++j4) { const f32x4 f4 = *(const LAS f32x4*)(FA + t0 + 4 * j4); fa[4 * j4] = f4[0]; fa[4 * j4 + 1] = f4[1]; fa[4 * j4 + 2] = f4[2]; fa[4 * j4 + 3] = f4[3]; }
#pragma unroll
                        for (int j = 0; j < 16; ++j) { ka[j] = bf2f(XK[(t0 + j) * 128]); qa[j] = bf2f(XQ[(t0 + j) * 128]); }
#pragma unroll
                        for (int j = 0; j < 16; ++j) { nstate = nstate * fa[j] + ka[j]; xo[j] = nstate * qa[j]; }
#pragma unroll
                        for (int j = 0; j < 16; ++j) XT[(g16 * 16 + j) * 68 + lane] = xo[j];
                    }
                    LDS_WAIT(); asm volatile("" ::: "memory");
                    const LAS float* xr = XT + (lane & 31) * 68 + (lane >> 5) * 32; f32x4 s4 = (f32x4){0.f, 0.f, 0.f, 0.f};
#pragma unroll
                    for (int dd = 0; dd < 8; ++dd) s4 += *(const LAS f32x4*)(xr + 4 * dd);
                    float sm = (s4[0] + s4[1]) + (s4[2] + s4[3]);
                    sm += __shfl_xor(sm, 32);
                    if (lane < 32) QD[hf * 32 + lane] = sm;
                    LDS_WAIT(); asm volatile("" ::: "memory");
                }
            }
        }
#undef S2_UNPK
#undef S2_PREF
#undef S2_PREF_V
#undef S2_PREF_Z
    }
}
__device__ __forceinline__ void s5_wave_mfma(const bf16* proj, const float* s5p, const float* cre, const float* cim, const float* dsk_in, bf16* yg, LAS unsigned char* wl, int item, int lane) {
    const int b = item >> 4, g = item & 15, fr = lane & 15, fq = lane >> 4, p = lane;
    LAS float* bu = (LAS float*)wl;
    LAS bf16* xs = (LAS bf16*)(wl + 16 * 132 * 4);
    bf16x8 bfr[8];
#pragma unroll
    for (int tau = 0; tau < 8; ++tau) { const int pp = 16 * tau + fr, ps = pp >> 1, c = pp & 1; v4u w = (v4u){0u, 0u, 0u, 0u};
        if (fq < 2) { const float* src = s5p + 2048 + (c ? 16384 : 0) + (size_t)(g * 64 + ps) * 16 + 8 * fq; w.x = pk2(src[0], src[1]); w.y = pk2(src[2], src[3]); w.z = pk2(src[4], src[5]); w.w = pk2(src[6], src[7]); }
        bfr[tau] = __builtin_bit_cast(bf16x8, w); }
    bf16x8 cfr[4];
#pragma unroll
    for (int ks = 0; ks < 4; ++ks) { const int p0 = (32 * ks + 8 * fq) >> 1; const float* r = cre + (size_t)(g * 16 + fr) * 64 + p0; const float* im = cim + (size_t)(g * 16 + fr) * 64 + p0;
        v4u w; w.x = pk2(r[0], -im[0]); w.y = pk2(r[1], -im[1]); w.z = pk2(r[2], -im[2]); w.w = pk2(r[3], -im[3]); cfr[ks] = __builtin_bit_cast(bf16x8, w); }
    const float ar = s5p[g * 64 + p], ai = s5p[1024 + g * 64 + p];
    float dsk[4];
#pragma unroll
    for (int j = 0; j < 4; ++j) dsk[j] = dsk_in[g * 16 + 4 * fq + j];
    float xr = 0.f, xi = 0.f;
    const size_t rowb = (size_t)b * SEQ;
    const bf16* ubase = proj + (rowb + fr) * NPROJ + PC_S5 + g * 16;
    v4u unext = (v4u){0u, 0u, 0u, 0u}; unsigned long long usk_next = 0ull;
    if (fq < 2) unext = *(const GAS v4u*)(ubase + 8 * fq);
    usk_next = *(const GAS unsigned long long*)(ubase + 4 * fq);
    for (int c = 0; c < SEQ / 16; ++c) {
        const v4u ucur = unext; const unsigned long long usk = usk_next;
        if (c + 1 < SEQ / 16) { const bf16* un = ubase + (size_t)(c + 1) * 16 * NPROJ; if (fq < 2) unext = *(const GAS v4u*)(un + 8 * fq); usk_next = *(const GAS unsigned long long*)(un + 4 * fq); }
        const bf16x8 ufr = __builtin_bit_cast(bf16x8, ucur);
#pragma unroll
        for (int tau = 0; tau < 8; ++tau) { f32x4 d = (f32x4){0.f, 0.f, 0.f, 0.f}; d = __builtin_amdgcn_mfma_f32_16x16x32_bf16(bfr[tau], ufr, d, 0, 0, 0);
            *(LAS f32x4*)(bu + fr * 132 + 16 * tau + 4 * fq) = d; }
        LDS_WAIT(); asm volatile("" ::: "memory");
#pragma unroll 4
        for (int t = 0; t < 16; ++t) { const f32x2 bb = *(const LAS f32x2*)(bu + t * 132 + 2 * p);
            const float nr = ar * xr - ai * xi + bb.x, ni = ar * xi + ai * xr + bb.y; xr = nr; xi = ni;
            *(LAS unsigned*)(xs + t * 136 + 2 * p) = pk2(xr, xi); }
        LDS_WAIT(); asm volatile("" ::: "memory");
        f32x4 y = (f32x4){0.f, 0.f, 0.f, 0.f};
#pragma unroll
        for (int ks = 0; ks < 4; ++ks) { const bf16x8 xf = *(const LAS bf16x8*)(xs + fr * 136 + 32 * ks + 8 * fq); y = __builtin_amdgcn_mfma_f32_16x16x32_bf16(cfr[ks], xf, y, 0, 0, 0); }
        const float u4[4] = {__uint_as_float((unsigned)usk << 16), __uint_as_float((unsigned)usk & 0xffff0000u), __uint_as_float((unsigned)(usk >> 32) << 16), __uint_as_float((unsigned)(usk >> 32) & 0xffff0000u)};
        float o[4];
#pragma unroll
        for (int j = 0; j < 4; ++j) o[j] = gelu_tanh(y[j] + dsk[j] * u4[j]);
        *(GAS unsigned long long*)(yg + (rowb + c * 16 + fr) * 256 + g * 16 + 4 * fq) = (unsigned long long)pk2(o[0], o[1]) | ((unsigned long long)pk2(o[2], o[3]) << 32);
        LDS_WAIT(); asm volatile("" ::: "memory");
    }
}
#ifndef PHASE_MASK
#define PHASE_MASK 0xFFFFFFFFu
#endif
#define PH(k) ((PHASE_MASK >> (k)) & 1u)
#ifndef SEQ_REPS
#define SEQ_REPS 1
#endif
#ifndef DOWN_FLIP
#define DOWN_FLIP 0
#endif
#ifndef DOWN_SP2
#define DOWN_SP2 true
#endif
#ifndef DOWN_ALIGN
#define DOWN_ALIGN true
#endif
#ifndef DOWN_PMX
#define DOWN_PMX 15
#endif
#ifndef MOBA_NQG
#define MOBA_NQG 4
#endif
struct Args { const float* in[36]; float* out; unsigned char* ws; };
typedef const Args __attribute__((address_space(4))) CArgs;
__device__ __forceinline__ LayerW layer_ptrs(CArgs& a, int l) {
    LayerW L;
    L.ffn1_norm = a.in[3] + (size_t)l * D; L.ffn1_w_gu = a.in[4] + (size_t)l * D * NGU; L.ffn1_w_down = a.in[5] + (size_t)l * FF * D; L.mix_norm = a.in[6] + (size_t)l * D; L.w_in = a.in[7] + (size_t)l * D * NIN_SRC;
    L.gdn_conv = a.in[8] + (size_t)l * 4 * 768; L.gdn_a_log = a.in[9] + l * 4; L.gdn_dt_bias = a.in[10] + l * 4; L.gdn_norm = a.in[11] + l * 64;
    L.mlstm_conv = a.in[12] + (size_t)l * 4 * 512; L.mlstm_i_bias = a.in[13] + l * 4; L.mlstm_f_bias = a.in[14] + l * 4; L.mlstm_norm = a.in[15] + l * 256;
    L.s5_lre = a.in[16] + l * 1024; L.s5_lim = a.in[17] + l * 1024; L.s5_bre = a.in[18] + l * 16384; L.s5_bim = a.in[19] + l * 16384; L.s5_cre = a.in[20] + l * 16384; L.s5_cim = a.in[21] + l * 16384;
    L.s5_d = a.in[22] + l * 256; L.s5_log_dt = a.in[23] + l * 16; L.s5_w_glu = a.in[24] + (size_t)l * 65536; L.s5_b_glu = a.in[25] + l * 256;
    L.w_gate = a.in[26] + (size_t)l * 4 * D * D; L.w_branch = a.in[27] + (size_t)l * 4 * 256 * D; L.w_out = a.in[28] + (size_t)l * D * D;
    L.ffn2_norm = a.in[29] + (size_t)l * D; L.ffn2_w_gu = a.in[30] + (size_t)l * D * NGU; L.ffn2_w_down = a.in[31] + (size_t)l * FF * D;
    L.ple_norm = a.in[32] + (size_t)l * D; L.ple_w_proj = a.in[33] + (size_t)l * PLED * D; L.ple_w_gate = a.in[34] + (size_t)l * D * D;
    return L;
}

__global__ void __launch_bounds__(NWAVES * 64, 2) mk_fwd(Args args_k) {
    (void)args_k;
#define KARGP() ((CArgs*)__builtin_amdgcn_kernarg_segment_ptr())
    extern __shared__ __attribute__((aligned(16))) unsigned char lds_raw[];
    LAS unsigned char* lds = (LAS unsigned char*)lds_raw;
    const int G = gridDim.x;
    for (int u = threadIdx.x; u < (LDS_BYTES - LDSCTL_OFF) / 4; u += NWAVES * 64) ((LAS unsigned*)(lds + LDSCTL_OFF))[u] = 0u;
    __syncthreads();
    (void)xcd_barrier_post((unsigned*)(KARGP()->ws + WS_CTL) + CW_BAR, (volatile LAS unsigned*)(lds + LDSCTL_OFF) + 8);
#define GRID_BAR() do { CArgs* gp_ = KARGP(); asm volatile("" : "+s"(gp_)); unsigned char* bw_ = gp_->ws; asm volatile("" : "+s"(bw_)); XcdBarrier bar_; bar_.bar = (unsigned*)(bw_ + WS_CTL) + CW_BAR; bar_.x = xb_xcc_id(); bar_.st = (volatile LAS unsigned*)(lds + LDSCTL_OFF) + 8; xcd_barrier(bar_); } while (0)
    unsigned gbn = 0;
#define GROUP_BAR() do { ++gbn; CArgs* gq_ = KARGP(); asm volatile("" : "+s"(gq_)); unsigned char* gw_ = gq_->ws; asm volatile("" : "+s"(gw_)); const unsigned gi_ = blockIdx.x & 7u; \
        group_barrier((unsigned*)(gw_ + WS_CTL) + CW_GRP + 64 * gi_, gbn * (((unsigned)G - gi_ + 7u) >> 3)); } while (0)
#define WSP(T, off) ((T*)(wsl + (off)))
#define LAUNDER() CArgs* ap_ = KARGP(); asm volatile("" : "+s"(ap_)); unsigned char* wsl = ap_->ws; asm volatile("" : "+s"(wsl)); int K256 = 256, K1024 = 1024, KFF = FF; asm volatile("" : "+s"(K256), "+s"(K1024), "+s"(KFF)); (void)K256; (void)K1024; (void)KFF; int tid = threadIdx.x; asm volatile("" : "+v"(tid)); const int lane = tid & 63, wave = __builtin_amdgcn_readfirstlane(tid >> 6); (void)lane; (void)wave; int bid = blockIdx.x; asm volatile("" : "+s"(bid)); (void)bid
#define GW (blockIdx.x * NWAVES + wave)
#define NGW (G * NWAVES)

#if PH(0)
#ifdef PROBE_REP0
#pragma nounroll
    for (int rep_ = 0; rep_ < PROBE_REP0; ++rep_)
#endif
    { LAUNDER(); const LayerW L = layer_ptrs(*ap_, 0); const LayerW L1 = layer_ptrs(*ap_, 1);
#ifndef PW_REPS
#define PW_REPS 1
#endif
      for (int rpw_ = 0; rpw_ < PW_REPS; ++rpw_)
      prologue_weights(L, ap_->ws + WS_W, lds, GW, NGW, wave, lane);
      prologue_s5(L, WSP(float, WS_S5P), blockIdx.x * 512 + tid, G * 512);
      prologue_s5(L1, WSP(float, WS_S5P) + 40960, blockIdx.x * 512 + tid, G * 512);
      prologue_rope((const int*)ap_->in[2], (float*)((unsigned char*)ap_->out + OUT_ROPE), (size_t)blockIdx.x * 512 + tid, (size_t)G * 512);
      x_to_hb(ap_->in[0], WSP(bf16, WS_HB), WSP(pg8::rowss_t, WS_ROWSS), GW, NGW, lane); }
    GRID_BAR();
#endif
    const int hb0 = (G >= 256) ? 128 : 0;
    for (int l = 0; l < DEPTH; ++l) {
#define WB(off) ((const pg8::bf16_t*)((l == 0 ? wsl + WS_W : (unsigned char*)ap_->out + OUT_W1) + (off)))
#define HCUR() ((const pg8::bf16_t*)(l == 0 ? wsl + WS_HB : (unsigned char*)ap_->out + OUT_T))
#if PH(1)
#ifndef GU_REPS
#define GU_REPS 1
#endif
        for (int repg_ = 0; repg_ < GU_REPS; ++repg_)
        { LAUNDER(); pg8::Gemm g{HCUR(), WB(W_GU1), M, NGU, K1024, 30, 0}; pg8::StaticOrder S; S.init(M, NGU, G, bid);
          pg8::EpiSwiGLU E{WSP(pg8::bf16_t, WS_BIG), WSP(pg8::rowss_t, WS_ROWSS) + (size_t)(4 * l) * M, FF};
          pg8::gemm_phase<pg8::EpiSwiGLU, pg8::StaticOrder, true, true>(lds + RING_OFF, g, S, E);
          GROUP_BAR(); }
#endif
#if PH(2)
        { LAUNDER(); pg8::Gemm g{WSP(const pg8::bf16_t, WS_BIG), WB(W_D1), M, D, KFF, 30, 0}; pg8::StaticOrder S; S.init(M, D, G, bid, DOWN_PMX);
          pg8::EpiRes E{HCUR(), WSP(pg8::bf16_t, WS_HB), WSP(pg8::rowss_t, WS_ROWSS) + (size_t)(4 * l + 1) * M, 0.5f};
          pg8::gemm_phase<pg8::EpiRes, pg8::StaticOrder, DOWN_ALIGN, DOWN_SP2>(lds + RING_OFF, g, S, E); }
        GRID_BAR();
#endif
#ifdef PROBE_BARS
        for (int pb_ = 0; pb_ < PROBE_BARS; ++pb_) GRID_BAR();
#endif
#if PH(3)
        { LAUNDER(); pg8::Gemm g{WSP(const pg8::bf16_t, WS_HB), WB(W_IN), M, 2560, K1024, 30, 0}; pg8::StaticOrder S; S.init(M, 2560, G, bid);
          pg8::EpiMixIn E{WSP(pg8::bf16_t, WS_BIG), WSP(float, WS_SCAL), WSP(pg8::rowss_t, WS_ROWSS) + (size_t)(4 * l + 1) * M};
          pg8::gemm_phase<pg8::EpiMixIn, pg8::StaticOrder, true, true>(lds + RING_OFF, g, S, E); }
        GRID_BAR();
#endif
#ifdef PROBE_IDLE_US
        { const unsigned long long t0_ = __builtin_amdgcn_s_memrealtime(); while (__builtin_amdgcn_s_memrealtime() - t0_ < (unsigned long long)PROBE_IDLE_US * 100ull) __builtin_amdgcn_s_sleep(32); __syncthreads(); }
#endif
#if PH(5)
        { LAUNDER(); const LayerW L = layer_ptrs(*ap_, l);
          for (int rep_ = 0; rep_ < SEQ_REPS; ++rep_)
          for (int it = blockIdx.x; it < 64; it += G) seq_mixer2<true>(WSP(const bf16, WS_BIG), WSP(const float, WS_SCAL), L.gdn_conv, L.gdn_a_log, L.gdn_dt_bias, L.gdn_norm, WSP(bf16, WS_Y), lds, it, tid); }
#endif
#if PH(6)
        { LAUNDER(); const LayerW L = layer_ptrs(*ap_, l);
          for (int rep_ = 0; rep_ < SEQ_REPS; ++rep_)
          for (int it = blockIdx.x; it < 64 + 64; it += G) if (it >= 64) seq_mixer2<false>(WSP(const bf16, WS_BIG), WSP(const float, WS_SCAL), L.mlstm_conv, L.mlstm_i_bias, L.mlstm_f_bias, L.mlstm_norm, WSP(bf16, WS_Y) + (size_t)M * 256, lds, it - 64, tid); }
#endif
#if PH(15)
        const int gb0 = (G >= 256) ? hb0 + 32 : hb0;
        if ((int)blockIdx.x >= gb0) {
          { LAUNDER(); pg8::Gemm g{WSP(const pg8::bf16_t, WS_HB), WB(W_IN + (size_t)2560 * D * 2), M, 768, K1024, 30, 0}; pg8::StaticOrder S; S.init(M, 768, G - gb0, bid - gb0);
            pg8::EpiMoba E{WSP(pg8::bf16_t, WS_BIG), WSP(pg8::bf16_t, WS_VT), WSP(float, WS_KMEAN) + (size_t)l * 32768, (const float*)((unsigned char*)ap_->out + OUT_ROPE), WSP(pg8::rowss_t, WS_ROWSS) + (size_t)(4 * l + 1) * M};
            pg8::gemm_phase<pg8::EpiMoba, pg8::StaticOrder, true, true>(lds + RING_OFF, g, S, E);
            asm volatile("s_waitcnt vmcnt(0)" ::: "memory"); __syncthreads();
            if (tid == 0) { __builtin_amdgcn_fence(__ATOMIC_RELEASE, "agent"); asm volatile("s_waitcnt vmcnt(0)" ::: "memory"); __hip_atomic_fetch_add(WSP(unsigned, WS_CTL) + CW_FLAG + 64 * l, 1u, RLX_AGENT); } }
          { LAUNDER(); const int nh = G - gb0, c0 = (int)blockIdx.x - gb0;
            for (int pm = c0; pm < M / 256; pm += nh) cvt_rows_bf16(ap_->in[1] + ((size_t)l * M + (size_t)pm * 256) * PLED, WSP(bf16, WS_PB) + (size_t)pm * 256 * PLED, (size_t)256 * PLED, (size_t)tid, (size_t)512);
            asm volatile("s_waitcnt vmcnt(0)" ::: "memory"); __syncthreads();
            pg8::Gemm g{WSP(const pg8::bf16_t, WS_PB), WB(W_PLE), M, D, K256, 30, 0}; pg8::PanelOrder S{c0, nh, M / 256, 4};
            pg8::EpiBf16P E{(pg8::bf16_t*)((unsigned char*)ap_->out + OUT_T), D};
            pg8::gemm_phase<pg8::EpiBf16P, pg8::PanelOrder, true, true>(lds + RING_OFF, g, S, E); }
          __syncthreads();
          const int wb0 = gb0;
          if (l == 0 && (int)blockIdx.x >= wb0) { LAUNDER(); const LayerW L1 = layer_ptrs(*ap_, 1);
            prologue_weights(L1, (unsigned char*)ap_->out + OUT_W1, lds, ((int)blockIdx.x - wb0) * NWAVES + wave, (G - wb0) * NWAVES, wave, lane); }
        }
#endif
#if PH(7)
        { LAUNDER(); const LayerW L = layer_ptrs(*ap_, l); const int c0 = (int)blockIdx.x - hb0;
#ifndef S5_REPS
#define S5_REPS 1
#endif
          for (int rep5_ = 0; rep5_ < S5_REPS; ++rep5_)
          if (c0 >= 0) for (int it = c0; it < 32; it += G - hb0)
              s5_wave_mfma(WSP(const bf16, WS_BIG), WSP(const float, WS_S5P) + 40960 * l, L.s5_cre, L.s5_cim, L.s5_d, WSP(bf16, WS_YG), lds + wave * WAVE_LDS, it * 8 + wave, lane); }
        if (G >= 256 && (int)blockIdx.x >= hb0 && (int)blockIdx.x < hb0 + 32) {
          LAUNDER(); const int c0 = (int)blockIdx.x - hb0; unsigned* f5 = WSP(unsigned, WS_CTL) + CW_S5F + (l * 16 + (c0 >> 1)) * 64;
          asm volatile("s_waitcnt vmcnt(0)" ::: "memory"); __syncthreads();
          if (tid == 0) { __builtin_amdgcn_fence(__ATOMIC_RELEASE, "agent"); asm volatile("s_waitcnt vmcnt(0)" ::: "memory"); __hip_atomic_fetch_add(f5, 1u, RLX_AGENT);
              unsigned sp = 0; while (__hip_atomic_load(f5, RLX_AGENT) < 2u) { __builtin_amdgcn_s_sleep(2); if (++sp > (1u << 22)) break; } }
          __syncthreads();
          __builtin_amdgcn_fence(__ATOMIC_ACQUIRE, "agent"); asm volatile("s_waitcnt vmcnt(0)" ::: "memory");
          const int p0 = 8 * (c0 >> 1) + 4 * (c0 & 1);
          pg8::Gemm g{WSP(const pg8::bf16_t, WS_YG), WB(W_GLU), M, 256, K256, 30, 0}; pg8::PanelOrder S{p0, 1, p0 + 4, 1};
          pg8::EpiGLU E{WSP(const pg8::bf16_t, WS_YG), WSP(pg8::bf16_t, WS_Y) + (size_t)2 * M * 256, ap_->in[25] + l * 256};
          pg8::gemm_phase<pg8::EpiGLU, pg8::PanelOrder, true, true>(lds + RING_OFF, g, S, E); }
#endif
#if PH(8)
        { LAUNDER(); unsigned* flag = WSP(unsigned, WS_CTL) + CW_FLAG + 64 * l; const unsigned need = (unsigned)(G - gb0);
          __syncthreads();
          if (tid == 0) { unsigned sp = 0; while (__hip_atomic_load(flag, RLX_AGENT) < need) { __builtin_amdgcn_s_sleep(2); if (++sp > (1u << 22)) break; } }
          __syncthreads();
          __builtin_amdgcn_fence(__ATOMIC_ACQUIRE, "agent"); asm volatile("s_waitcnt vmcnt(0)" ::: "memory");
          unsigned* qctr = WSP(unsigned, WS_CTL) + CW_QUEUE + 64 * l;
          for (;;) { unsigned idx = 0; if (lane == 0) idx = __hip_atomic_fetch_add(qctr, 1u, RLX_AGENT); idx = __builtin_amdgcn_readfirstlane(idx);
              if (idx >= 8192u / MOBA_NQG) break;
              const int qsl = idx & (16 / MOBA_NQG - 1), bh = (idx / (16 / MOBA_NQG)) & 63, qb = 7 - (int)(idx / (1024 / MOBA_NQG));
              moba_mfma_item<MOBA_NQG>(WSP(const bf16, WS_BIG), WSP(const float, WS_KMEAN) + (size_t)l * 32768, WSP(const bf16, WS_VT), WSP(bf16, WS_Y) + (size_t)3 * M * 256, bh, qb, qsl, lane); } }
#endif
        GRID_BAR();
#if PH(11)
#ifndef G11_REPS
#define G11_REPS 1
#endif
        for (int rep11_ = 0; rep11_ < G11_REPS; ++rep11_)
        { LAUNDER(); pg8::StaticOrder S0; S0.init(M, NGATE, G, bid);
          pg8::Gemm g{WSP(const pg8::bf16_t, WS_HB), WB(W_GATE), M, NGATE, K1024, 30, 0};
          pg8::EpiGateP E{WSP(const pg8::bf16_t, WS_Y), WB(W_BR), WSP(pg8::bf16_t, WS_BIG + 184 * MiB), WSP(pg8::rowss_t, WS_ROWSS) + (size_t)(4 * l + 1) * M, (size_t)M * 256};
#pragma nounroll
          for (int r = 0; ; ++r) { pg8::OneUnit S1; if (!S0.next(r, S1.u)) break;
              pg8::gemm_phase<pg8::EpiGateP, pg8::OneUnit, false, true>(lds + RING_OFF, g, S1, E);
              __syncthreads(); }
          GROUP_BAR(); }
#endif
#if PH(12)
#ifndef OUT_REPS
#define OUT_REPS 1
#endif
        for (int rep12_ = 0; rep12_ < OUT_REPS; ++rep12_)
        { LAUNDER(); pg8::Gemm g{WSP(const pg8::bf16_t, WS_BIG + 184 * MiB), WB(W_OUT), M, D, K1024, 30, 0}; pg8::StaticOrder S; S.init(M, D, G, bid);
          const bool real_ = (rep12_ + 1 == OUT_REPS);
          pg8::EpiRes E{WSP(const pg8::bf16_t, WS_HB), real_ ? WSP(pg8::bf16_t, WS_HB) : WSP(pg8::bf16_t, WS_BIG + 128 * MiB), real_ ? WSP(pg8::rowss_t, WS_ROWSS) + (size_t)(4 * l + 2) * M : WSP(pg8::rowss_t, WS_BIG + 200 * MiB), 1.0f};
          pg8::gemm_phase<pg8::EpiRes, pg8::StaticOrder, true, true>(lds + RING_OFF, g, S, E);
          GROUP_BAR(); }
#endif
#if PH(13)
#ifndef GU_REPS
#define GU_REPS 1
#endif
        for (int repg_ = 0; repg_ < GU_REPS; ++repg_)
        { LAUNDER(); pg8::Gemm g{WSP(const pg8::bf16_t, WS_HB), WB(W_GU2), M, NGU, K1024, 30, 0}; pg8::StaticOrder S; S.init(M, NGU, G, bid);
          pg8::EpiSwiGLU E{WSP(pg8::bf16_t, WS_BIG), WSP(pg8::rowss_t, WS_ROWSS) + (size_t)(4 * l + 2) * M, FF};
          pg8::gemm_phase<pg8::EpiSwiGLU, pg8::StaticOrder, true, true>(lds + RING_OFF, g, S, E);
          GROUP_BAR(); }
#endif
#if PH(14)
#ifndef DOWN_REPS
#define DOWN_REPS 1
#endif
        for (int rep14_ = 0; rep14_ < DOWN_REPS; ++rep14_)
        { LAUNDER(); pg8::Gemm g{WSP(const pg8::bf16_t, WS_BIG), WB(W_D2), M, D, KFF, 30, 0}; pg8::StaticOrder S; S.init(M, D, G, bid, DOWN_PMX);
          const bool real_ = (rep14_ + 1 == DOWN_REPS);
          pg8::EpiRes E{WSP(const pg8::bf16_t, WS_HB), real_ ? WSP(pg8::bf16_t, WS_HB) : WSP(pg8::bf16_t, WS_BIG + 184 * MiB), real_ ? WSP(pg8::rowss_t, WS_ROWSS) + (size_t)(4 * l + 3) * M : WSP(pg8::rowss_t, WS_BIG + 250 * MiB), 0.5f};
          pg8::gemm_phase<pg8::EpiRes, pg8::StaticOrder, DOWN_ALIGN, DOWN_SP2>(lds + RING_OFF, g, S, E);
          GROUP_BAR(); }
#endif
#if PH(16)
#ifndef PLE_REPS
#define PLE_REPS 1
#endif
        for (int rep16_ = 0; rep16_ < PLE_REPS; ++rep16_)
        { LAUNDER(); pg8::Gemm g{WSP(const pg8::bf16_t, WS_HB), WB(W_PG), M, D, K1024, 30, 0}; pg8::StaticOrder S; S.init(M, D, G, bid);
          const bool real_ = (rep16_ + 1 == PLE_REPS);
          pg8::EpiPle E{WSP(const pg8::bf16_t, WS_HB), (const pg8::bf16_t*)((unsigned char*)ap_->out + OUT_T), !real_ ? WSP(pg8::bf16_t, WS_BIG + 128 * MiB) : l == 0 ? (pg8::bf16_t*)((unsigned char*)ap_->out + OUT_T) : WSP(pg8::bf16_t, WS_BIG + 184 * MiB),
                        WSP(pg8::rowss_t, WS_ROWSS) + (size_t)(4 * l + 3) * M, real_ ? WSP(pg8::rowss_t, WS_ROWSS) + (size_t)(4 * l + 4) * M : WSP(pg8::rowss_t, WS_BIG + 200 * MiB)};
          pg8::gemm_phase<pg8::EpiPle, pg8::StaticOrder, true, true>(lds + RING_OFF, g, S, E);
          if (l + 1 < DEPTH) GROUP_BAR(); else GRID_BAR(); }
#endif
    }
#if PH(17)
#ifdef PROBE_REP0
#pragma nounroll
    for (int rep_ = 0; rep_ < PROBE_REP0; ++rep_)
#endif
    { LAUNDER(); final_norm(WSP(const bf16, WS_BIG + 184 * MiB), ap_->out, WSP(pg8::rowss_t, WS_ROWSS) + (size_t)8 * M, ap_->in[35], GW, NGW, lane); }
#endif
}

extern "C" void kernel_launch(void* const* d_in, const int* in_sizes, int n_in, void* d_out, int out_size, void* d_ws, size_t ws_size, hipStream_t stream) {
    static int grid = 0;
    if (grid == 0) {
        if (n_in != 36 || out_size != M * D || ws_size < WS_END) { fprintf(stderr, "kernel_launch: unexpected shapes (n_in %d, out %d, ws %zu); nothing launched\n", n_in, out_size, ws_size); grid = -1; return; }
        int dev = 0, cus = 0, per_cu = 0;
        if (hipGetDevice(&dev) != hipSuccess || hipDeviceGetAttribute(&cus, hipDeviceAttributeMultiprocessorCount, dev) != hipSuccess) { grid = -1; return; }
        if (hipFuncSetAttribute((const void*)mk_fwd, hipFuncAttributeMaxDynamicSharedMemorySize, LDS_BYTES) != hipSuccess) { fprintf(stderr, "kernel_launch: hipFuncSetAttribute failed\n"); grid = -1; return; }
        if (hipOccupancyMaxActiveBlocksPerMultiprocessor(&per_cu, (const void*)mk_fwd, NWAVES * 64, LDS_BYTES) != hipSuccess || per_cu < 1) { fprintf(stderr, "kernel_launch: occupancy query says %d\n", per_cu); per_cu = 1; }
        (void)hipGetLastError();
        if (cus < 256) { fprintf(stderr, "kernel_launch: %d CUs; the mixer phase's workgroup roles need 256; nothing launched\n", cus); grid = -1; return; }
        grid = 256;
    }
    if (grid < 0) return;
    if (hipMemsetAsync((char*)d_ws + WS_CTL, 0, CTL_ZERO_BYTES, stream) != hipSuccess) return;
    Args a{};
    for (int i = 0; i < 36; ++i) a.in[i] = (const float*)d_in[i];
    a.out = (float*)d_out; a.ws = (unsigned char*)d_ws;
    hipLaunchKernelGGL(mk_fwd, dim3(grid), dim3(NWAVES * 64), LDS_BYTES, stream, a);
}
```

```cpp
#include <hip/hip_runtime.h>
#include <cstdio>
#include <cstdint>
namespace pg8 {
#define PG8_LAS __attribute__((address_space(3)))
typedef unsigned short bf16_t;
typedef short bf16x8 __attribute__((ext_vector_type(8)));
typedef float f32x4 __attribute__((ext_vector_type(4)));
typedef unsigned u32x4 __attribute__((ext_vector_type(4)));
constexpr int BM = 256, BK = 64, HALF = 128, HTB = HALF * BK * 2  , STAGE_BYTES = 8 * HTB, NXCD = 8, WGM = 8;

__host__ __device__ __forceinline__ int lds_byte(int r, int c) { const int st = (r >> 4) * 2 + (c >> 5), rr = r & 15, cc = c & 31, ob = rr * 64 + cc * 2; return st * 1024 + (ob ^ (((ob >> 9) & 1) << 5)); }
__host__ __device__ __forceinline__ void stage_rc(int b, int& R, int& C) { const int st = b / 1024, sb = b % 1024, swz = sb ^ (((sb >> 9) & 1) << 5); R = (st >> 1) * 16 + swz / 64; C = (st & 1) * 32 + (swz % 64) / 2; }
__host__ __device__ __forceinline__ int perm32(int rho) { const int n = rho >> 4, i = rho & 15; return 8 * (i >> 2) + 4 * n + (i & 3); }

struct Unit { int pm, pn; };
struct Gemm { const bf16_t* A; const bf16_t* Bt; int M, N, K; int ashift; size_t astride; };

struct StaticOrder {
    int nM, nN, nwg, G, c;
    __host__ __device__ __forceinline__ void init(int M, int N, int G_, int c_) { nM = M / BM; nN = N / BM; nwg = nM * nN; G = G_; c = c_; }
    __host__ __device__ __forceinline__ bool next(int i, Unit& u) const {
        const long L = (long)i * G + c; if (L >= nwg) return false;
        int wgid = (int)L; { const int q = nwg / NXCD, r = nwg % NXCD, xcd = wgid % NXCD, off = wgid / NXCD; wgid = (xcd < r ? xcd * (q + 1) : r * (q + 1) + (xcd - r) * q) + off; }
        const int nig = WGM * nN, gid = wgid / nig, fm = gid * WGM, gsz = (nM - fm) < WGM ? (nM - fm) : WGM;
        u.pm = fm + ((wgid % nig) % gsz); u.pn = (wgid % nig) / gsz; return true;
    }
    __device__ __forceinline__ void a_ready(const Unit&) const {}
    __device__ __forceinline__ void done(const Unit&) const {}
};
struct PanelOrder {
    int pm0, stride, nM, nN;
    __host__ __device__ __forceinline__ bool next(int i, Unit& u) const { const int p = pm0 + (i / nN) * stride; if (p >= nM) return false; u.pm = p; u.pn = i % nN; return true; }
    __device__ __forceinline__ void a_ready(const Unit&) const {}
    __device__ __forceinline__ void done(const Unit&) const {}
};
struct OneUnit {
    Unit u;
    __host__ __device__ __forceinline__ bool next(int i, Unit& o) const { if (i != 0) return false; o = u; return true; }
    __device__ __forceinline__ void a_ready(const Unit&) const {}
    __device__ __forceinline__ void done(const Unit&) const {}
};

typedef unsigned u32x2 __attribute__((ext_vector_type(2)));
__device__ __forceinline__ unsigned cvt_pk_bf16(float lo, float hi) { unsigned r; asm volatile("v_cvt_pk_bf16_f32 %0, %1, %2" : "=v"(r) : "v"(lo), "v"(hi)); return r; }
__device__ __forceinline__ unsigned cvt_pk_bf16_t(float lo, float hi) { unsigned r; asm volatile("s_nop 1\n\tv_cvt_pk_bf16_f32 %0, %1, %2" : "=v"(r) : "v"(lo), "v"(hi)); return r; }
__device__ __forceinline__ float bf_lo(unsigned w) { return __uint_as_float(w << 16); }
__device__ __forceinline__ float bf_hi(unsigned w) { return __uint_as_float(w & 0xffff0000u); }
__device__ __forceinline__ float sigm(float x) { return __builtin_amdgcn_rcpf(1.0f + __expf(-x)); }
__device__ __forceinline__ float silu(float x) { return x * sigm(x); }
constexpr float RMS_EPS = 1e-6f;
typedef unsigned long long rowss_t;
constexpr float RSS_SCALE = 16777216.0f;
__device__ __forceinline__ float rms_scale(const rowss_t* rowss, int row) { return rsqrtf((float)rowss[row] * (1.0f / (1024.0f * RSS_SCALE)) + RMS_EPS); }
__device__ __forceinline__ void rowss_add(rowss_t* p, float ss) { __hip_atomic_fetch_add(p, (rowss_t)(ss * RSS_SCALE), __ATOMIC_RELAXED, __HIP_MEMORY_SCOPE_AGENT); }
__device__ __forceinline__ u32x4 pack8(const f32x4 a, const f32x4 b) { u32x4 w; w.x = cvt_pk_bf16(a[0], a[1]); w.y = cvt_pk_bf16(a[2], a[3]); w.z = cvt_pk_bf16(b[0], b[1]); w.w = cvt_pk_bf16(b[2], b[3]); return w; }

#define EPI_ROW(ai, m) (row0 + (ai) * HALF + (m) * 16)
__device__ __forceinline__ void load_scales(const rowss_t* rowss, int row0, float (&r)[8]) {
    rowss_t v[8];
#pragma unroll
    for (int g = 0; g < 8; ++g) v[g] = rowss[EPI_ROW(g >> 2, g & 3)];
#pragma unroll
    for (int g = 0; g < 8; ++g) r[g] = rsqrtf((float)v[g] * (1.0f / (1024.0f * RSS_SCALE)) + RMS_EPS);
}
__device__ __forceinline__ void cached_scales(const rowss_t* rowss, PG8_LAS float* sc, int pm, int wr, int wc, int fr, int fq, float (&r)[8]) {
    const int tag = *(const PG8_LAS int*)(sc + 256);
    if (tag != pm) {
        const int tid = (wr * 4 + wc) * 64 + fq * 16 + fr;
        if (tid < 256) { const rowss_t v = *(const __attribute__((address_space(1))) rowss_t*)(rowss + (size_t)pm * BM + tid); sc[tid] = rsqrtf((float)v * (1.0f / (1024.0f * RSS_SCALE)) + RMS_EPS); }
        asm volatile("s_waitcnt lgkmcnt(0)" ::: "memory");
        __builtin_amdgcn_s_barrier();
        if (tid == 0) *(PG8_LAS int*)(sc + 256) = pm;
    }
    asm volatile("" ::: "memory");
#pragma unroll
    for (int g = 0; g < 8; ++g) r[g] = sc[wr * 64 + fr + (g >> 2) * HALF + (g & 3) * 16];
}
struct EpiSwiGLU {
    static constexpr bool PERM = true, AFTER_DRAIN = false; static constexpr int TAIL_OPS = 8;
    bf16_t* act; const rowss_t* rowss; int ldc; PG8_LAS float* sc;
    __device__ __forceinline__ void operator()(const f32x4 (&acc)[2][2][4][2], const Unit& u, int wr, int wc, int fr, int fq) const {
        const int row0 = u.pm * BM + wr * 64 + fr, col0 = u.pn * 128 + wc * 32 + 8 * fq;
        float rs[8]; cached_scales(rowss, sc, u.pm, wr, wc, fr, fq, rs);
#pragma unroll
        for (int ai = 0; ai < 2; ++ai)
#pragma unroll
            for (int m = 0; m < 4; ++m) { const int row = EPI_ROW(ai, m); const float r = rs[ai * 4 + m];
                f32x4 o0, o1;
#pragma unroll
                for (int e = 0; e < 4; ++e) { o0[e] = silu(acc[ai][0][m][0][e] * r) * (acc[ai][1][m][0][e] * r); o1[e] = silu(acc[ai][0][m][1][e] * r) * (acc[ai][1][m][1][e] * r); }
                *(u32x4*)(act + (size_t)row * ldc + col0) = pack8(o0, o1); }
    }
};
struct EpiBf16P {
    static constexpr bool PERM = true, AFTER_DRAIN = false; static constexpr int TAIL_OPS = 0;
    bf16_t* O; int ldc;
    __device__ __forceinline__ void operator()(const f32x4 (&acc)[2][2][4][2], const Unit& u, int wr, int wc, int fr, int fq) const {
        const int row0 = u.pm * BM + wr * 64 + fr, col0 = u.pn * BM + wc * 32 + 8 * fq;
#pragma unroll
        for (int ai = 0; ai < 2; ++ai)
#pragma unroll
            for (int m = 0; m < 4; ++m) { bf16_t* rowp = O + (size_t)EPI_ROW(ai, m) * ldc + col0;
#pragma unroll
                for (int bj = 0; bj < 2; ++bj) *(u32x4*)(rowp + bj * HALF) = pack8(acc[ai][bj][m][0], acc[ai][bj][m][1]); }
    }
};
__device__ __forceinline__ void unpack8(const u32x4 w, f32x4& a, f32x4& b) { a[0] = bf_lo(w.x); a[1] = bf_hi(w.x); a[2] = bf_lo(w.y); a[3] = bf_hi(w.y); b[0] = bf_lo(w.z); b[1] = bf_hi(w.z); b[2] = bf_lo(w.w); b[3] = bf_hi(w.w); }
__device__ __forceinline__ float sumsq8(const f32x4 v0, const f32x4 v1) { return (v0[0] * v0[0] + v0[1] * v0[1]) + (v0[2] * v0[2] + v0[3] * v0[3]) + (v1[0] * v1[0] + v1[1] * v1[1]) + (v1[2] * v1[2] + v1[3] * v1[3]); }
struct EpiRes {
    static constexpr bool PERM = true, AFTER_DRAIN = false; static constexpr int TAIL_OPS = 0;
    const bf16_t* base; bf16_t* hb; rowss_t* rowss_next; float scale;
    __device__ __forceinline__ void operator()(const f32x4 (&acc)[2][2][4][2], const Unit& u, int wr, int wc, int fr, int fq) const {
        const int row0 = u.pm * BM + wr * 64 + fr, col0 = u.pn * BM + wc * 32 + 8 * fq;
#pragma unroll
        for (int ai = 0; ai < 2; ++ai) {
            u32x4 bw[4][2];
#pragma unroll
            for (int m = 0; m < 4; ++m)
#pragma unroll
                for (int bj = 0; bj < 2; ++bj) bw[m][bj] = *(const u32x4*)(base + (size_t)EPI_ROW(ai, m) * 1024 + col0 + bj * HALF);
#pragma unroll
            for (int m = 0; m < 4; ++m) { const int row = EPI_ROW(ai, m); const size_t off = (size_t)row * 1024 + col0; float ss = 0.f;
#pragma unroll
                for (int bj = 0; bj < 2; ++bj) { f32x4 b0, b1; unpack8(bw[m][bj], b0, b1);
                    const f32x4 v0 = b0 + acc[ai][bj][m][0] * scale, v1 = b1 + acc[ai][bj][m][1] * scale;
                    *(u32x4*)(hb + off + bj * HALF) = pack8(v0, v1); ss += sumsq8(v0, v1); }
                ss += __shfl_xor(ss, 16); ss += __shfl_xor(ss, 32);
                if (fq == 0) rowss_add(rowss_next + row, ss); }
            asm volatile("" ::: "memory"); }
    }
};
struct EpiMixIn {
    static constexpr bool PERM = true, AFTER_DRAIN = false; static constexpr int TAIL_OPS = 0;
    bf16_t* proj; float* scal; const rowss_t* rowss; PG8_LAS float* sc;
    __device__ __forceinline__ void operator()(const f32x4 (&acc)[2][2][4][2], const Unit& u, int wr, int wc, int fr, int fq) const {
        const int row0 = u.pm * BM + wr * 64 + fr;
        float rs[8]; cached_scales(rowss, sc, u.pm, wr, wc, fr, fq, rs);
        if (u.pn < 9) { const int col0 = u.pn * BM + wc * 32 + 8 * fq;
#pragma unroll
            for (int ai = 0; ai < 2; ++ai)
#pragma unroll
                for (int m = 0; m < 4; ++m) { const float r = rs[ai * 4 + m]; bf16_t* rowp = proj + (size_t)EPI_ROW(ai, m) * 3072 + col0;
#pragma unroll
                    for (int bj = 0; bj < 2; ++bj) *(u32x4*)(rowp + bj * HALF) = pack8(acc[ai][bj][m][0] * r, acc[ai][bj][m][1] * r); }
        } else if (wc == 0 && fq < 2) {
#pragma unroll
            for (int ai = 0; ai < 2; ++ai)
#pragma unroll
                for (int m = 0; m < 4; ++m) { const float r = rs[ai * 4 + m]; float* rowp = scal + (size_t)EPI_ROW(ai, m) * 16 + 8 * fq;
                    *(f32x4*)(rowp) = acc[ai][0][m][0] * r; *(f32x4*)(rowp + 4) = acc[ai][0][m][1] * r; }
        }
    }
};
struct EpiGateMerge {
    static constexpr bool PERM = false, AFTER_DRAIN = false; static constexpr int TAIL_OPS = 0;
    const bf16_t* P; bf16_t* merged; const rowss_t* rowss;
    __device__ __forceinline__ void operator()(const f32x4 (&acc)[2][2][4][2], const Unit& u, int wr, int wc, int fr, int fq) const {
        const int row0 = u.pm * BM + wr * 64 + fr, j0 = u.pn * 64 + wc * 16 + 4 * fq;
        float rs[8]; load_scales(rowss, row0, rs);
#pragma unroll
        for (int ai = 0; ai < 2; ++ai) {
            u32x2 pw[4][4];
#pragma unroll
            for (int m = 0; m < 4; ++m)
#pragma unroll
                for (int b = 0; b < 4; ++b) pw[m][b] = *(const u32x2*)(P + (size_t)EPI_ROW(ai, m) * 4096 + j0 + b * 1024);
#pragma unroll
            for (int m = 0; m < 4; ++m) { const float r = rs[ai * 4 + m];
                f32x4 s = (f32x4){0.f, 0.f, 0.f, 0.f};
#pragma unroll
                for (int bj = 0; bj < 2; ++bj)
#pragma unroll
                    for (int n = 0; n < 2; ++n) { const u32x2 pv = pw[m][2 * bj + n]; const f32x4 a = acc[ai][bj][m][n];
                        s[0] += sigm(a[0] * r) * bf_lo(pv.x); s[1] += sigm(a[1] * r) * bf_hi(pv.x); s[2] += sigm(a[2] * r) * bf_lo(pv.y); s[3] += sigm(a[3] * r) * bf_hi(pv.y); }
                u32x2 w; w.x = cvt_pk_bf16(s[0], s[1]); w.y = cvt_pk_bf16(s[2], s[3]); *(u32x2*)(merged + (size_t)EPI_ROW(ai, m) * 1024 + j0) = w; }
            asm volatile("" ::: "memory"); }
    }
};
struct EpiGateMergeAD {
    static constexpr bool PERM = false, AFTER_DRAIN = true; static constexpr int TAIL_OPS = 0;
    const bf16_t* P; bf16_t* merged; const rowss_t* rowss;
    __device__ __forceinline__ void fused(f32x4 (&acc)[2][2][4][2], const Unit& u, int wr, int wc, int fr, int fq, PG8_LAS unsigned char* lds, int wid, int lane) const {
        const int row0 = u.pm * BM + wr * 64 + fr, j0 = u.pn * 64 + wc * 16 + 4 * fq;
        float rs[8]; load_scales(rowss, row0, rs);
#ifdef AD_BARS
#pragma unroll
        for (int s = 0; s < 16; ++s) { asm volatile("s_waitcnt vmcnt(0) lgkmcnt(0)" ::: "memory"); __builtin_amdgcn_s_barrier(); asm volatile("" ::: "memory"); }
#endif

        u32x2 gp[2][2][4][2];
#pragma unroll
        for (int ai = 0; ai < 2; ++ai)
#pragma unroll
            for (int bj = 0; bj < 2; ++bj)
#pragma unroll
                for (int m = 0; m < 4; ++m)
#pragma unroll
                    for (int n = 0; n < 2; ++n) { const float r = rs[ai * 4 + m]; const f32x4 a = acc[ai][bj][m][n];
                        gp[ai][bj][m][n].x = cvt_pk_bf16_t(sigm(a[0] * r), sigm(a[1] * r)); gp[ai][bj][m][n].y = cvt_pk_bf16_t(sigm(a[2] * r), sigm(a[3] * r));
                        acc[ai][bj][m][n] = (f32x4){0.f, 0.f, 0.f, 0.f}; }
#pragma unroll
        for (int ai = 0; ai < 2; ++ai) {
            u32x2 pw[4][4];
#pragma unroll
            for (int m = 0; m < 4; ++m)
#pragma unroll
                for (int b = 0; b < 4; ++b) pw[m][b] = *(const u32x2*)(P + (size_t)EPI_ROW(ai, m) * 4096 + j0 + b * 1024);
#pragma unroll
            for (int m = 0; m < 4; ++m) {
                f32x4 s = (f32x4){0.f, 0.f, 0.f, 0.f};
#pragma unroll
                for (int bj = 0; bj < 2; ++bj)
#pragma unroll
                    for (int n = 0; n < 2; ++n) { const u32x2 pv = pw[m][2 * bj + n]; const u32x2 g = gp[ai][bj][m][n];
                        s[0] += bf_lo(g.x) * bf_lo(pv.x); s[1] += bf_hi(g.x) * bf_hi(pv.x); s[2] += bf_lo(g.y) * bf_lo(pv.y); s[3] += bf_hi(g.y) * bf_hi(pv.y); }
                u32x2 w; w.x = cvt_pk_bf16(s[0], s[1]); w.y = cvt_pk_bf16(s[2], s[3]); *(u32x2*)(merged + (size_t)EPI_ROW(ai, m) * 1024 + j0) = w; }
            asm volatile("" ::: "memory"); }
    }
};
struct EpiGLU {
    static constexpr bool PERM = true, AFTER_DRAIN = false; static constexpr int TAIL_OPS = 0;
    const bf16_t* yg; bf16_t* out; const float* bias;
    __device__ __forceinline__ void operator()(const f32x4 (&acc)[2][2][4][2], const Unit& u, int wr, int wc, int fr, int fq) const {
        const int row0 = u.pm * BM + wr * 64 + fr, col0 = u.pn * BM + wc * 32 + 8 * fq;
        f32x4 bb[2][2];
#pragma unroll
        for (int bj = 0; bj < 2; ++bj) { bb[bj][0] = *(const f32x4*)(bias + col0 + bj * HALF); bb[bj][1] = *(const f32x4*)(bias + col0 + bj * HALF + 4); }
#pragma unroll
        for (int ai = 0; ai < 2; ++ai) {
            u32x4 yw[4][2];
#pragma unroll
            for (int m = 0; m < 4; ++m)
#pragma unroll
                for (int bj = 0; bj < 2; ++bj) yw[m][bj] = *(const u32x4*)(yg + (size_t)EPI_ROW(ai, m) * 256 + col0 + bj * HALF);
#pragma unroll
            for (int m = 0; m < 4; ++m) { const size_t off = (size_t)EPI_ROW(ai, m) * 256 + col0;
#pragma unroll
                for (int bj = 0; bj < 2; ++bj) { f32x4 y0, y1; unpack8(yw[m][bj], y0, y1); const f32x4 a0 = acc[ai][bj][m][0] + bb[bj][0], a1 = acc[ai][bj][m][1] + bb[bj][1]; f32x4 o0, o1;
#pragma unroll
                    for (int e = 0; e < 4; ++e) { o0[e] = y0[e] * sigm(a0[e]); o1[e] = y1[e] * sigm(a1[e]); }
                    *(u32x4*)(out + off + bj * HALF) = pack8(o0, o1); } }
            asm volatile("" ::: "memory"); }
    }
};
struct EpiPle {
    static constexpr bool PERM = true, AFTER_DRAIN = false; static constexpr int TAIL_OPS = 0;
    const bf16_t* h; const bf16_t* T; bf16_t* hout; const rowss_t* rowss; rowss_t* rowss_next;
    __device__ __forceinline__ void operator()(const f32x4 (&acc)[2][2][4][2], const Unit& u, int wr, int wc, int fr, int fq) const {
        const int row0 = u.pm * BM + wr * 64 + fr, col0 = u.pn * BM + wc * 32 + 8 * fq;
        float rs[8]; load_scales(rowss, row0, rs);
#pragma unroll
        for (int ai = 0; ai < 2; ++ai)
#pragma unroll
          for (int mh = 0; mh < 2; ++mh) {
            u32x4 bw[2][2], tw[2][2];
#pragma unroll
            for (int mm = 0; mm < 2; ++mm)
#pragma unroll
                for (int bj = 0; bj < 2; ++bj) { const size_t off = (size_t)EPI_ROW(ai, 2 * mh + mm) * 1024 + col0 + bj * HALF; bw[mm][bj] = *(const u32x4*)(h + off); tw[mm][bj] = *(const u32x4*)(T + off); }
#pragma unroll
            for (int mm = 0; mm < 2; ++mm) { const int m = 2 * mh + mm; const int row = EPI_ROW(ai, m); const float r = rs[ai * 4 + m]; const size_t off = (size_t)row * 1024 + col0; float ss = 0.f;
#pragma unroll
                for (int bj = 0; bj < 2; ++bj) { f32x4 b0, b1, t0, t1; unpack8(bw[mm][bj], b0, b1); unpack8(tw[mm][bj], t0, t1);
                    const f32x4 a0 = acc[ai][bj][m][0] * r, a1 = acc[ai][bj][m][1] * r; f32x4 v0, v1;
#pragma unroll
                    for (int e = 0; e < 4; ++e) { v0[e] = b0[e] + t0[e] * sigm(a0[e]); v1[e] = b1[e] + t1[e] * sigm(a1[e]); }
                    *(u32x4*)(hout + off + bj * HALF) = pack8(v0, v1); ss += sumsq8(v0, v1); }
                ss += __shfl_xor(ss, 16); ss += __shfl_xor(ss, 32);
                if (fq == 0) rowss_add(rowss_next + row, ss); }
            asm volatile("" ::: "memory"); }
    }
};

__device__ __forceinline__ float dpp_row_xor(float v, int step) {
    const int x = __float_as_int(v); int r;
    switch (step) { case 0: r = __builtin_amdgcn_update_dpp(0, x, 0xB1, 0xF, 0xF, true); break; case 1: r = __builtin_amdgcn_update_dpp(0, x, 0x4E, 0xF, 0xF, true); break;
                    case 2: r = __builtin_amdgcn_update_dpp(0, x, 0x141, 0xF, 0xF, true); break; default: r = __builtin_amdgcn_update_dpp(0, x, 0x140, 0xF, 0xF, true); break; }
    return __int_as_float(r);
}
struct EpiMoba {
    static constexpr bool PERM = true, AFTER_DRAIN = false; static constexpr int TAIL_OPS = 0;
    bf16_t* proj; bf16_t* vt; float* kmean; const float* rope; const rowss_t* rowss;
    __device__ __forceinline__ void operator()(const f32x4 (&acc)[2][2][4][2], const Unit& u, int wr, int wc, int fr_in, int fq_in) const {
        int fr = fr_in, fq = fq_in; asm volatile("" : "+v"(fr), "+v"(fq));
        const int row0 = u.pm * BM + wr * 64 + fr;
        float rs[8]; load_scales(rowss, row0, rs);
        if (u.pn < 2) {
            const int pc = (u.pn == 0 ? 2304 : 2560) + wc * 64 + 8 * fq;
            f32x4 ks[4];
#pragma unroll
            for (int j = 0; j < 4; ++j) ks[j] = (f32x4){0.f, 0.f, 0.f, 0.f};
#pragma unroll
            for (int ai = 0; ai < 2; ++ai)
#pragma unroll
              for (int mh = 0; mh < 2; ++mh) {
                f32x4 cs[2][4];
#pragma unroll
                for (int mm = 0; mm < 2; ++mm) { const float* tp = rope + (size_t)EPI_ROW(ai, 2 * mh + mm) * 64 + 8 * fq; cs[mm][0] = *(const f32x4*)(tp); cs[mm][1] = *(const f32x4*)(tp + 4); cs[mm][2] = *(const f32x4*)(tp + 32); cs[mm][3] = *(const f32x4*)(tp + 36); }
#pragma unroll
                for (int mm = 0; mm < 2; ++mm) { const int m = 2 * mh + mm; const float r = rs[ai * 4 + m]; bf16_t* rowp = proj + (size_t)EPI_ROW(ai, m) * 3072 + pc;
                    const f32x4 a0 = acc[ai][0][m][0] * r, a1 = acc[ai][0][m][1] * r, b0 = acc[ai][1][m][0] * r, b1 = acc[ai][1][m][1] * r;
                    const f32x4 o10 = a0 * cs[mm][0] - b0 * cs[mm][2], o11 = a1 * cs[mm][1] - b1 * cs[mm][3], o20 = b0 * cs[mm][0] + a0 * cs[mm][2], o21 = b1 * cs[mm][1] + a1 * cs[mm][3];
                    *(u32x4*)(rowp) = pack8(o10, o11); *(u32x4*)(rowp + 32) = pack8(o20, o21);
                    ks[0] += o10; ks[1] += o11; ks[2] += o20; ks[3] += o21; }
                asm volatile("" ::: "memory"); }
            if (u.pn == 1) {
#pragma unroll
                for (int j = 0; j < 4; ++j)
#pragma unroll
                    for (int e = 0; e < 4; ++e) { float v = ks[j][e];
#pragma unroll
                        for (int st = 0; st < 4; ++st) v += dpp_row_xor(v, st);
                        ks[j][e] = v; }
                if (fr == 0) { const int b = u.pm >> 3, blk = u.pm & 7; float* kp = kmean + (size_t)((b * 4 + wc) * 8 + blk) * 64 + 8 * fq;
#pragma unroll
                    for (int e = 0; e < 4; ++e) { __hip_atomic_fetch_add(kp + e, ks[0][e] * (1.0f / 256.0f), __ATOMIC_RELAXED, __HIP_MEMORY_SCOPE_AGENT); __hip_atomic_fetch_add(kp + 4 + e, ks[1][e] * (1.0f / 256.0f), __ATOMIC_RELAXED, __HIP_MEMORY_SCOPE_AGENT);
                        __hip_atomic_fetch_add(kp + 32 + e, ks[2][e] * (1.0f / 256.0f), __ATOMIC_RELAXED, __HIP_MEMORY_SCOPE_AGENT); __hip_atomic_fetch_add(kp + 36 + e, ks[3][e] * (1.0f / 256.0f), __ATOMIC_RELAXED, __HIP_MEMORY_SCOPE_AGENT); } }
            }
        } else {
            const int b = u.pm >> 3, s0 = (u.pm & 7) * 256 + wr * 64 + fr;
#pragma unroll
            for (int ai = 0; ai < 2; ++ai)
#pragma unroll
                for (int m = 0; m < 4; ++m) { const float r = rs[ai * 4 + m]; const int s = s0 + ai * HALF + m * 16;
#pragma unroll
                    for (int bj = 0; bj < 2; ++bj) { const int hh = 2 * bj + (wc >> 1), d0 = 32 * (wc & 1) + 8 * fq; bf16_t* vp = vt + ((size_t)(b * 4 + hh) * 64 + d0) * 2048 + s;
                        const u32x4 w = pack8(acc[ai][bj][m][0] * r, acc[ai][bj][m][1] * r);
                        vp[0 * 2048] = (bf16_t)(w.x & 0xffffu); vp[1 * 2048] = (bf16_t)(w.x >> 16); vp[2 * 2048] = (bf16_t)(w.y & 0xffffu); vp[3 * 2048] = (bf16_t)(w.y >> 16);
                        vp[4 * 2048] = (bf16_t)(w.z & 0xffffu); vp[5 * 2048] = (bf16_t)(w.z >> 16); vp[6 * 2048] = (bf16_t)(w.w & 0xffffu); vp[7 * 2048] = (bf16_t)(w.w >> 16); } }
        }
    }
};


struct EpiGateP {
    static constexpr bool PERM = false, AFTER_DRAIN = true; static constexpr int TAIL_OPS = 0;
    const bf16_t* Y; const bf16_t* Wbr; bf16_t* merged; const rowss_t* rowss;
    size_t ybstride;
    __device__ __forceinline__ void fused(f32x4 (&acc)[2][2][4][2], const Unit& u, int wr, int wc, int fr, int fq, PG8_LAS unsigned char* lds, int wid, int lane) const {
        const int row0 = u.pm * BM + wr * 64 + fr;
        float rs[8]; load_scales(rowss, row0, rs);
        const int tid = wid * 64 + lane;
        unsigned voffA[2]; unsigned voffB;
#pragma unroll
        for (int i = 0; i < 2; ++i) { int R, C; stage_rc(tid * 16 + i * 8192, R, C); voffA[i] = (unsigned)(R * 256 + C) * 2u; }
        { int R, C; stage_rc(tid * 16, R, C); voffB = (unsigned)(R * 256 + C) * 2u; }
        const unsigned ldsw = (unsigned)wid * 1024u;
        const int aoff = lds_byte(wr * 64 + fr, fq * 8), boff = lds_byte(wc * 16 + fr, fq * 8);
        const char* ya = (const char*)Y + (size_t)u.pm * BM * 256 * 2;
        const char* wb = (const char*)Wbr + (size_t)u.pn * 64 * 256 * 2;
#define GP_STAGE(s_) do { const int b_ = (s_) >> 2, kt_ = (s_) & 3; const char* ga_ = ya + (size_t)b_ * ybstride * 2 + kt_ * 128; const char* gb_ = wb + (size_t)b_ * 1024 * 256 * 2 + kt_ * 128; PG8_LAS unsigned char* d_ = lds + ((s_) % 3) * 40960; \
            _Pragma("unroll") for (int h_ = 0; h_ < 2; ++h_) _Pragma("unroll") for (int i_ = 0; i_ < 2; ++i_) \
                __builtin_amdgcn_global_load_lds((const unsigned*)(ga_ + (size_t)h_ * HALF * 256 * 2 + voffA[i_]), (PG8_LAS unsigned*)(d_ + h_ * 16384 + ldsw + i_ * 8192), 16, 0, 0); \
            __builtin_amdgcn_global_load_lds((const unsigned*)(gb_ + voffB), (PG8_LAS unsigned*)(d_ + 32768 + ldsw), 16, 0, 0); } while (0)
        GP_STAGE(0); GP_STAGE(1);
        u32x2 gp[2][2][4][2];
#pragma unroll
        for (int ai = 0; ai < 2; ++ai)
#pragma unroll
            for (int bj = 0; bj < 2; ++bj)
#pragma unroll
                for (int m = 0; m < 4; ++m)
#pragma unroll
                    for (int n = 0; n < 2; ++n) { const float r = rs[ai * 4 + m]; const f32x4 a = acc[ai][bj][m][n];
                        gp[ai][bj][m][n].x = cvt_pk_bf16_t(sigm(a[0] * r), sigm(a[1] * r)); gp[ai][bj][m][n].y = cvt_pk_bf16_t(sigm(a[2] * r), sigm(a[3] * r));
                        acc[ai][bj][m][n] = (f32x4){0.f, 0.f, 0.f, 0.f}; }
#pragma unroll
        for (int s = 0; s < 16; ++s) {
            if (s < 15) asm volatile("s_waitcnt vmcnt(5)" ::: "memory"); else asm volatile("s_waitcnt vmcnt(0)" ::: "memory");
            __builtin_amdgcn_s_barrier(); asm volatile("" ::: "memory");
            if (s + 2 < 16) GP_STAGE(s + 2);
            const PG8_LAS unsigned char* bo = lds + (s % 3) * 40960; const int bj = (s >> 2) >> 1, n = (s >> 2) & 1;
            bf16x8 Bf[2];
#pragma unroll
            for (int k = 0; k < 2; ++k) Bf[k] = *(const PG8_LAS bf16x8*)(bo + 32768 + boff + k * 1024);
#pragma unroll
            for (int ai = 0; ai < 2; ++ai) { bf16x8 At[4][2];
#pragma unroll
                for (int m = 0; m < 4; ++m)
#pragma unroll
                    for (int k = 0; k < 2; ++k) At[m][k] = *(const PG8_LAS bf16x8*)(bo + ai * 16384 + aoff + m * 2048 + k * 1024);
#pragma unroll
                for (int m = 0; m < 4; ++m)
#pragma unroll
                    for (int k = 0; k < 2; ++k) acc[ai][bj][m][n] = __builtin_amdgcn_mfma_f32_16x16x32_bf16(Bf[k], At[m][k], acc[ai][bj][m][n], 0, 0, 0); }
            asm volatile("s_waitcnt lgkmcnt(0)" ::: "memory");
        }
#undef GP_STAGE
        const int j0 = u.pn * 64 + wc * 16 + 4 * fq;
#pragma unroll
        for (int ai = 0; ai < 2; ++ai)
#pragma unroll
            for (int m = 0; m < 4; ++m) { f32x4 s4 = (f32x4){0.f, 0.f, 0.f, 0.f};
#pragma unroll
                for (int bj = 0; bj < 2; ++bj)
#pragma unroll
                    for (int n = 0; n < 2; ++n) { const u32x2 g = gp[ai][bj][m][n]; const f32x4 p = acc[ai][bj][m][n];
                        s4[0] += bf_lo(g.x) * p[0]; s4[1] += bf_hi(g.x) * p[1]; s4[2] += bf_lo(g.y) * p[2]; s4[3] += bf_hi(g.y) * p[3]; }
                u32x2 w; w.x = cvt_pk_bf16(s4[0], s4[1]); w.y = cvt_pk_bf16(s4[2], s4[3]); *(u32x2*)(merged + (size_t)EPI_ROW(ai, m) * 1024 + j0) = w; }
    }
};
template <class Epi, class Sched, bool ALIGN_EPI = false, bool SP2 = false>
__device__ __forceinline__ void gemm_phase(PG8_LAS unsigned char* lds, const Gemm g, const Sched& S, const Epi& E) {
    int tid_ = threadIdx.x; asm volatile("" : "+v"(tid_));
    const int tid = tid_, wid = __builtin_amdgcn_readfirstlane(tid >> 6), lane = tid & 63, wr = wid >> 2, wc = wid & 3, fr = lane & 15, fq = lane >> 4;
    const int K = g.K, nt = K / BK;
    unsigned voffA[2], voffB[2];
#pragma unroll
    for (int i = 0; i < 2; ++i) { int R, C; stage_rc(tid * 16 + i * 8192, R, C); const int Rb = Epi::PERM ? ((R & ~31) + perm32(R & 31)) : R;
        voffA[i] = (unsigned)(R * K + C) * 2u; voffB[i] = (unsigned)(Rb * K + C) * 2u; }
    const size_t kstep = (size_t)(BK * 2);
    const size_t hstep = (size_t)HALF * K * 2;
    const size_t tstep = 2 * hstep;
    const unsigned ldsw = (unsigned)wid * 1024u;
    const int aoff = lds_byte(wr * 64 + fr, fq * 8), boff = lds_byte(wc * 32 + fr, fq * 8);
#define PG8_SA(b, h) (((b) * 2 + (h)) * HTB)
#define PG8_SB(b, h) ((4 + (b) * 2 + (h)) * HTB)
#define PG8_STAGE(bufoff, gbase, voff) do { _Pragma("unroll") for (int _i = 0; _i < 2; ++_i) \
        __builtin_amdgcn_global_load_lds((const unsigned*)((const char*)(gbase) + (voff)[_i]), (PG8_LAS unsigned*)(lds + (bufoff) + ldsw + _i * 8192), 16, 0, 0); } while (0)
#define PG8_LDA(dst, b, h) do { _Pragma("unroll") for (int m = 0; m < 4; ++m) _Pragma("unroll") for (int k = 0; k < 2; ++k) dst[m][k] = *(const PG8_LAS bf16x8*)(lds + PG8_SA(b, h) + aoff + m * 2048 + k * 1024); } while (0)
#define PG8_LDB(dst, b, h) do { _Pragma("unroll") for (int n = 0; n < 2; ++n) _Pragma("unroll") for (int k = 0; k < 2; ++k) dst[n][k] = *(const PG8_LAS bf16x8*)(lds + PG8_SB(b, h) + boff + n * 2048 + k * 1024); } while (0)
#define PG8_MMA(ai, bj, At, Bt) do { __builtin_amdgcn_s_setprio(1); _Pragma("unroll") for (int m = 0; m < 4; ++m) _Pragma("unroll") for (int n = 0; n < 2; ++n) _Pragma("unroll") for (int k = 0; k < 2; ++k) \
        acc[ai][bj][m][n] = __builtin_amdgcn_mfma_f32_16x16x32_bf16(Bt[n][k], At[m][k], acc[ai][bj][m][n], 0, 0, 0); __builtin_amdgcn_s_setprio(0); } while (0)
#define PG8_WAIT_V(n) asm volatile("s_waitcnt vmcnt(" #n ")" ::: "memory")
#define PG8_WAIT_L(n) asm volatile("s_waitcnt lgkmcnt(" #n ")" ::: "memory")
#define PG8_BAR __builtin_amdgcn_s_barrier()
#define PG8_SCHED __builtin_amdgcn_sched_barrier(0)
    Unit cur, nxt; int ui = 0;
    if (!S.next(0, cur)) return;
    f32x4 acc[2][2][4][2];
#pragma unroll
    for (int a = 0; a < 2; ++a)
#pragma unroll
        for (int b = 0; b < 2; ++b)
#pragma unroll
            for (int m = 0; m < 4; ++m)
#pragma unroll
                for (int n = 0; n < 2; ++n) acc[a][b][m][n] = (f32x4){0.f, 0.f, 0.f, 0.f};
    bf16x8 At[4][2], B0[2][2], B1[2][2];
    const char* cA = (const char*)g.A + (size_t)(cur.pn >> g.ashift) * g.astride + (size_t)cur.pm * tstep; const char* cB = (const char*)g.Bt + (size_t)cur.pn * tstep;
    S.a_ready(cur);
    if constexpr (SP2) {
        PG8_STAGE(PG8_SB(0, 0), cB, voffB); PG8_STAGE(PG8_SB(0, 1), cB + hstep, voffB); PG8_STAGE(PG8_SA(0, 0), cA, voffA); PG8_STAGE(PG8_SA(0, 1), cA + hstep, voffA);
        if (wr == 1) PG8_BAR;
        PG8_WAIT_V(2); PG8_BAR;
        PG8_STAGE(PG8_SB(1, 0), cB + kstep, voffB); PG8_STAGE(PG8_SA(1, 0), cA + kstep, voffA); PG8_STAGE(PG8_SB(1, 1), cB + hstep + kstep, voffB);
        PG8_WAIT_V(6); PG8_BAR;
    } else {
        PG8_STAGE(PG8_SB(0, 0), cB, voffB); PG8_STAGE(PG8_SA(0, 0), cA, voffA); PG8_STAGE(PG8_SB(0, 1), cB + hstep, voffB); PG8_STAGE(PG8_SA(0, 1), cA + hstep, voffA);
        if (wr == 1) PG8_BAR;
        PG8_WAIT_V(4); PG8_BAR;
        PG8_STAGE(PG8_SB(1, 0), cB + kstep, voffB); PG8_STAGE(PG8_SA(1, 0), cA + kstep, voffA); PG8_STAGE(PG8_SB(1, 1), cB + hstep + kstep, voffB);
        PG8_WAIT_V(6); PG8_BAR;
    }
    for (;;) {
        const bool has_next = S.next(ui + 1, nxt);
        const char* nA = has_next ? (const char*)g.A + (size_t)(nxt.pn >> g.ashift) * g.astride + (size_t)nxt.pm * tstep : cA; const char* nB = has_next ? (const char*)g.Bt + (size_t)nxt.pn * tstep : cB;
        for (int t = 0; t < nt; t += 2) {
            const bool last = (t == nt - 2);
            const char* a1 = cA + (size_t)(t + 1) * kstep;
            const char* a2 = last ? nA : cA + (size_t)(t + 2) * kstep; const char* b2 = last ? nB : cB + (size_t)(t + 2) * kstep;
            const char* a3 = a2 + kstep; const char* b3 = b2 + kstep;
            if (last && has_next) S.a_ready(nxt);
            if constexpr (SP2) {
            PG8_LDB(B0, 0, 0); PG8_LDB(B1, 0, 1); PG8_SCHED; PG8_LDA(At, 0, 0); PG8_STAGE(PG8_SA(1, 1), a1 + hstep, voffA);
            PG8_WAIT_V(8); PG8_WAIT_L(0); PG8_BAR; PG8_MMA(0, 0, At, B0); PG8_MMA(0, 1, At, B1); PG8_BAR; PG8_SCHED;
            PG8_LDA(At, 0, 1); PG8_STAGE(PG8_SB(0, 0), b2, voffB); PG8_STAGE(PG8_SB(0, 1), b2 + hstep, voffB); PG8_STAGE(PG8_SA(0, 0), a2, voffA);
            PG8_WAIT_V(8); PG8_WAIT_L(0); PG8_BAR; PG8_MMA(1, 0, At, B0); PG8_MMA(1, 1, At, B1); PG8_BAR; PG8_SCHED;
            PG8_LDB(B0, 1, 0); PG8_LDB(B1, 1, 1); PG8_SCHED; PG8_LDA(At, 1, 0); PG8_STAGE(PG8_SA(0, 1), a2 + hstep, voffA);
            PG8_WAIT_V(8); PG8_WAIT_L(0); PG8_BAR; PG8_MMA(0, 0, At, B0); PG8_MMA(0, 1, At, B1); PG8_BAR; PG8_SCHED;
            PG8_LDA(At, 1, 1); PG8_STAGE(PG8_SB(1, 0), b3, voffB); PG8_STAGE(PG8_SB(1, 1), b3 + hstep, voffB); PG8_STAGE(PG8_SA(1, 0), a3, voffA);
            PG8_WAIT_V(8); PG8_WAIT_L(0); PG8_BAR; PG8_MMA(1, 0, At, B0); PG8_MMA(1, 1, At, B1); PG8_BAR; PG8_SCHED;
            } else {
            PG8_LDB(B0, 0, 0); PG8_SCHED; PG8_LDA(At, 0, 0); PG8_STAGE(PG8_SA(1, 1), a1 + hstep, voffA);
            PG8_WAIT_L(8); PG8_BAR; PG8_WAIT_L(0); PG8_MMA(0, 0, At, B0); PG8_BAR; PG8_SCHED;
            PG8_LDB(B1, 0, 1); PG8_STAGE(PG8_SB(0, 0), b2, voffB);
            PG8_BAR; PG8_WAIT_L(0); PG8_MMA(0, 1, At, B1); PG8_BAR;
            PG8_LDA(At, 0, 1); PG8_STAGE(PG8_SA(0, 0), a2, voffA);
            PG8_BAR; PG8_WAIT_L(0); PG8_MMA(1, 0, At, B0); PG8_BAR; PG8_SCHED;
            PG8_STAGE(PG8_SB(0, 1), b2 + hstep, voffB);
            PG8_WAIT_V(6); PG8_BAR; PG8_MMA(1, 1, At, B1); PG8_BAR;
            PG8_LDB(B0, 1, 0); PG8_SCHED; PG8_LDA(At, 1, 0); PG8_STAGE(PG8_SA(0, 1), a2 + hstep, voffA);
            PG8_WAIT_L(8); PG8_BAR; PG8_WAIT_L(0); PG8_MMA(0, 0, At, B0); PG8_BAR; PG8_SCHED;
            PG8_LDB(B1, 1, 1); PG8_STAGE(PG8_SB(1, 0), b3, voffB);
            PG8_BAR; PG8_WAIT_L(0); PG8_MMA(0, 1, At, B1); PG8_BAR;
            PG8_LDA(At, 1, 1); PG8_STAGE(PG8_SA(1, 0), a3, voffA);
            PG8_BAR; PG8_WAIT_L(0); PG8_MMA(1, 0, At, B0); PG8_BAR; PG8_SCHED;
            PG8_STAGE(PG8_SB(1, 1), b3 + hstep, voffB);
            PG8_WAIT_V(6); PG8_BAR; PG8_MMA(1, 1, At, B1); PG8_BAR;
            }
        }
        if constexpr (ALIGN_EPI) { if (wr == 0) PG8_BAR; }
        if constexpr (!Epi::AFTER_DRAIN) { E(acc, cur, wr, wc, fr, fq); S.done(cur); }
        if (!has_next) break;
#pragma unroll
        for (int a = 0; a < 2; ++a)
#pragma unroll
            for (int b = 0; b < 2; ++b)
#pragma unroll
                for (int m = 0; m < 4; ++m)
#pragma unroll
                    for (int n = 0; n < 2; ++n) acc[a][b][m][n] = (f32x4){0.f, 0.f, 0.f, 0.f};
        cur = nxt; cA = nA; cB = nB; ++ui;
        if constexpr (ALIGN_EPI) { if (wr == 1) PG8_BAR; }
    }
    PG8_WAIT_V(0);
    if constexpr (!ALIGN_EPI) { if (wr == 0) PG8_BAR; }
    PG8_BAR;
    if constexpr (Epi::AFTER_DRAIN) { E.fused(acc, cur, wr, wc, fr, fq, lds, wid, lane); S.done(cur); }
#undef PG8_SA
#undef PG8_SB
#undef PG8_STAGE
#undef PG8_LDA
#undef PG8_LDB
#undef PG8_MMA
#undef PG8_WAIT_V
#undef PG8_WAIT_L
#undef PG8_BAR
#undef PG8_SCHED
}
}


constexpr int NWAVES = 8;
constexpr int BATCH = 16, SEQ = 2048, D = 1024, M = BATCH * SEQ, FF = 2816, NGU = 2 * FF, PLED = 256, DEPTH = 2;
constexpr int NIN_SRC = 3088, NIN = 3328, NPROJ = 3072, NGATE = 4096;
constexpr int PC_GQ = 0, PC_GZ = 768, PC_MQ = 1024, PC_MV = 1536, PC_MO = 1792, PC_S5 = 2048, PC_AQ = 2304, PC_AK = 2560, PC_AV = 2816;

constexpr size_t MiB = 1u << 20;
constexpr size_t WS_CTL = 0, CTL_ZERO_BYTES = 4 * MiB;
constexpr size_t WS_ROWSS = 1 * MiB;
constexpr size_t WS_KMEAN = 3 * MiB + 512 * 1024;
constexpr size_t WS_S5P = 6 * MiB + 512 * 1024;
constexpr size_t WS_SCAL = 4 * MiB;
constexpr size_t WS_W = 8 * MiB;
constexpr size_t W_GU1 = 0, W_D1 = W_GU1 + (size_t)NGU * D * 2, W_IN = W_D1 + (size_t)D * FF * 2, W_GATE = W_IN + (size_t)NIN * D * 2, W_BR = W_GATE + (size_t)NGATE * D * 2,
                 W_GLU = W_BR + (size_t)4096 * 256 * 2, W_OUT = W_GLU + (size_t)256 * 256 * 2, W_GU2 = W_OUT + (size_t)D * D * 2, W_D2 = W_GU2 + (size_t)NGU * D * 2,
                 W_PLE = W_D2 + (size_t)D * FF * 2, W_PG = W_PLE + (size_t)D * PLED * 2, W_END = W_PG + (size_t)D * D * 2;
static_assert(W_END <= 56 * MiB, "weights fit");
constexpr size_t WS_HB = 64 * MiB;
constexpr size_t WS_PB = 128 * MiB;
constexpr size_t WS_Y = 144 * MiB;
constexpr size_t WS_YG = 208 * MiB;
constexpr size_t WS_VT = 224 * MiB;
constexpr size_t WS_BIG = 256 * MiB;
constexpr size_t WS_END = 512 * MiB;
constexpr size_t OUT_W1 = 0, OUT_T = 56 * MiB, OUT_ROPE = 120 * MiB;
constexpr int CW_BAR = 4096, CW_QUEUE = 8192, CW_FLAG = 12288, CW_S5F = 16384, CW_GRP = 20480;

constexpr int RING_OFF = 0;
constexpr int LDS_BYTES = 147456;
constexpr int SC_OFF = 131072;
constexpr int LDSCTL_OFF = LDS_BYTES - 1024;
constexpr int WAVE_LDS = 17408;

#define GAS __attribute__((address_space(1)))
#define LAS __attribute__((address_space(3)))
typedef unsigned short bf16;
typedef unsigned v4u __attribute__((ext_vector_type(4)));
typedef float f32x4 __attribute__((ext_vector_type(4)));
typedef short bf16x8 __attribute__((ext_vector_type(8)));
typedef GAS unsigned gu32;
typedef GAS unsigned long long gu64;
#define RLX_AGENT __ATOMIC_RELAXED, __HIP_MEMORY_SCOPE_AGENT
#define LDS_WAIT() asm volatile("s_waitcnt lgkmcnt(0)" ::: "memory")
#define VM_WAIT() asm volatile("s_waitcnt vmcnt(0)" ::: "memory")
__device__ __forceinline__ unsigned long long rt() { return __builtin_amdgcn_s_memrealtime(); }
__device__ __forceinline__ unsigned f2bf(float f) { unsigned u = __builtin_bit_cast(unsigned, f); return (u + 0x7fffu + ((u >> 16) & 1u)) >> 16; }
typedef float pk2_f32x2 __attribute__((ext_vector_type(2)));
typedef __bf16 pk2_bf16x2 __attribute__((ext_vector_type(2)));
__device__ __forceinline__ unsigned pk2(float lo, float hi) { const pk2_f32x2 v = {lo, hi}; return __builtin_bit_cast(unsigned, __builtin_convertvector(v, pk2_bf16x2)); }

#define XB_TMO      128
#define XB_XCNT(j)  (256  + 64 * (j))
#define XB_XSUB(j)  (1280 + 64 * (j))
#define XB_XGEN(j)  (2304 + 64 * (j))
#define XB_TOP      3328
#define XB_TOPGEN   3392
#define XCD_BAR_WORDS 3456
#define XB_SPIN_CAP (1u << 21)

__device__ __forceinline__ unsigned xb_ld(unsigned* p)              { return __hip_atomic_load(p, __ATOMIC_RELAXED, __HIP_MEMORY_SCOPE_AGENT); }
__device__ __forceinline__ unsigned xb_add(unsigned* p, unsigned v) { return __hip_atomic_fetch_add(p, v, __ATOMIC_RELAXED, __HIP_MEMORY_SCOPE_AGENT); }
__device__ __forceinline__ unsigned xb_xcc_id() { return (unsigned)__builtin_amdgcn_s_getreg((3 << 11) | 20) & 0xFu; }
#define XB_SPIN(cond, bar) do { unsigned _sp = 0; while (cond) { __builtin_amdgcn_s_sleep(1); \
    if ((++_sp & 255u) == 0u) { if (xb_ld(&(bar)[XB_TMO])) break; if (_sp > XB_SPIN_CAP) { atomicAdd(&(bar)[XB_TMO], 1u); break; } } } } while (0)

struct XcdBarrier {
    unsigned* bar; unsigned x;
    volatile LAS unsigned* st;
};

__device__ __forceinline__ XcdBarrier xcd_barrier_post(unsigned* bar, volatile LAS unsigned* st) {
    XcdBarrier b; b.bar = bar; b.x = xb_xcc_id(); b.st = st;
    if (threadIdx.x == 0) (void)xb_add(&bar[XB_XCNT(b.x)], 1u);
    return b;
}
__device__ __forceinline__ void xcd_barrier_complete(unsigned* bar, unsigned x, unsigned& nloc, unsigned& nx) {
    const unsigned G = gridDim.x * gridDim.y * gridDim.z;
    unsigned sum, cnt, mine, sp = 0u;
    for (;;) {
        sum = 0u; cnt = 0u; mine = 0u;
#pragma unroll
        for (unsigned j = 0; j < 16; ++j) { const unsigned c = xb_ld(&bar[XB_XCNT(j)]); sum += c; cnt += (c > 0u) ? 1u : 0u; mine = (j == x) ? c : mine; }
        if (sum == G) break;
        __builtin_amdgcn_s_sleep(1);
        if ((++sp & 255u) == 0u) { if (xb_ld(&bar[XB_TMO])) break; if (sp > XB_SPIN_CAP) { atomicAdd(&bar[XB_TMO], 1u); break; } }
    }
    nloc = mine > 0u ? mine : 1u; nx = cnt > 0u ? cnt : 1u;
}

__device__ __forceinline__ void xcd_barrier(const XcdBarrier& b) {
    asm volatile("s_waitcnt vmcnt(0)" ::: "memory");
    __syncthreads();
    if (threadIdx.x == 0) {
        unsigned* bar = b.bar;
        __builtin_amdgcn_s_waitcnt(0);
        unsigned nloc = b.st[0], nx = b.st[1];
        if (nloc == 0u) { xcd_barrier_complete(bar, b.x, nloc, nx); b.st[0] = nloc; b.st[1] = nx; }
        const unsigned old = xb_add(&bar[XB_XSUB(b.x)], 1u);
        const unsigned gen = old / nloc;
        if (old + 1u == (gen + 1u) * nloc) {
            __builtin_amdgcn_fence(__ATOMIC_RELEASE, "agent");
            asm volatile("s_waitcnt vmcnt(0)" ::: "memory");
            const unsigned og = xb_add(&bar[XB_TOP], 1u);
            const unsigned tg = og / nx;
            if (og + 1u == (tg + 1u) * nx) xb_add(&bar[XB_TOPGEN], 1u);
            else XB_SPIN(xb_ld(&bar[XB_TOPGEN]) == tg, bar);
            __builtin_amdgcn_fence(__ATOMIC_ACQUIRE, "agent");
            xb_add(&bar[XB_XGEN(b.x)], 1u);
            asm volatile("s_waitcnt vmcnt(0)" ::: "memory");
        } else {
            XB_SPIN(xb_ld(&bar[XB_XGEN(b.x)]) == gen, bar);
            __builtin_amdgcn_fence(__ATOMIC_ACQUIRE, "agent");
            asm volatile("s_waitcnt vmcnt(0)" ::: "memory");
        }
    }
    __syncthreads();
}

__device__ __forceinline__ void group_barrier(unsigned* ctr, unsigned target) {
    asm volatile("s_waitcnt vmcnt(0)" ::: "memory");
    __syncthreads();
    if (threadIdx.x == 0) {
        __builtin_amdgcn_s_waitcnt(0);
        __builtin_amdgcn_fence(__ATOMIC_RELEASE, "agent");
        asm volatile("s_waitcnt vmcnt(0)" ::: "memory");
        (void)xb_add(ctr, 1u);
        unsigned sp = 0; while (xb_ld(ctr) < target) { __builtin_amdgcn_s_sleep(1); if (++sp > (1u << 22)) break; }
        __builtin_amdgcn_fence(__ATOMIC_ACQUIRE, "agent");
        asm volatile("s_waitcnt vmcnt(0)" ::: "memory");
    }
    __syncthreads();
}


__device__ __forceinline__ float wave_sum(float v) {
#pragma unroll
    for (int o = 1; o < 64; o <<= 1) v += __shfl_xor(v, o);
    return v;
}
__device__ __forceinline__ float wave_max(float v) {
#pragma unroll
    for (int o = 1; o < 64; o <<= 1) v = fmaxf(v, __shfl_xor(v, o));
    return v;
}
__device__ __forceinline__ float red8(float v) { v += __shfl_xor(v, 1); v += __shfl_xor(v, 2); v += __shfl_xor(v, 4); return v; }
__device__ __forceinline__ float bf2f(bf16 b) { return __uint_as_float(((unsigned)b) << 16); }
__device__ __forceinline__ float sigm(float x) { return __builtin_amdgcn_rcpf(1.0f + __expf(-x)); }
__device__ __forceinline__ float silu(float x) { return x * sigm(x); }

template <class Map>
__device__ __forceinline__ void cvt_item(const float* __restrict__ W, int ld, const float* __restrict__ gain, bf16* Bt, int K, int item, int nblk, LAS float* scr, int lane, Map map) {
    const int kb = item / nblk, nb = item % nblk, k0 = 64 * kb, n0 = 32 * nb;
    const int n4 = lane & 7, kr = lane >> 3; const long so = map(n0 + 4 * n4);
    f32x4 v[8]; float gn[8];
#pragma unroll
    for (int i = 0; i < 8; ++i) { v[i] = (f32x4){0.f, 0.f, 0.f, 0.f}; gn[i] = 1.0f;
        if (so >= 0) { v[i] = *(const GAS f32x4*)(W + so + (size_t)(k0 + 8 * i + kr) * ld); if (gain) gn[i] = gain[k0 + 8 * i + kr]; } }
#pragma unroll
    for (int i = 0; i < 8; ++i) { LAS float* d = scr + (8 * i + kr) * 33 + 4 * n4; const f32x4 w = v[i] * gn[i]; d[0] = w[0]; d[1] = w[1]; d[2] = w[2]; d[3] = w[3]; }
    LDS_WAIT(); asm volatile("" ::: "memory");
    const int c = lane & 7;
#pragma unroll
    for (int j = 0; j < 4; ++j) { const int n = (lane >> 3) + 8 * j; const LAS float* s = scr + (8 * c) * 33 + n;
        v4u o; o.x = pk2(s[0 * 33], s[1 * 33]); o.y = pk2(s[2 * 33], s[3 * 33]); o.z = pk2(s[4 * 33], s[5 * 33]); o.w = pk2(s[6 * 33], s[7 * 33]);
        *(GAS v4u*)(Bt + (size_t)(n0 + n) * K + k0 + 8 * c) = o; }
    LDS_WAIT(); asm volatile("" ::: "memory");
}
struct MapId { __device__ long operator()(int r) const { return r; } };
struct MapGU { __device__ long operator()(int r) const { const int pn = r >> 8, c = r & 255; return c < 128 ? 128 * pn + c : FF + 128 * pn + (c - 128); } };
struct MapIn { __device__ long operator()(int r) const { if (r < 1024) return r; if (r < 2048) return 1032 + (r - 1024); if (r < 2304) return 2064 + (r - 2048);
    if (r < 2560) { const int c = r - 2304; return c < 8 ? 1024 + c : c < 16 ? 2056 + (c - 8) : -1; }
    const int t = (r - 2560) >> 8, c = (r - 2560) & 255; if (t < 2) return 2320 + 256 * t + ((c >> 5) & 3) * 64 + (c >> 7) * 32 + (c & 31); return 2320 + 512 + c; } };
struct MapGate { __device__ long operator()(int r) const { const int pn = r >> 8, c = r & 255, b = 2 * (c >> 7) + ((c >> 4) & 1), jl = 16 * ((c >> 5) & 3) + 4 * ((c >> 2) & 3) + (c & 3); return (long)b * (D * D) + 64 * pn + jl; } };
struct MapBr { __device__ long operator()(int r) const { return (long)(r >> 10) * (256 * D) + (r & 1023); } };

struct LayerW {
    const float *ffn1_norm, *ffn1_w_gu, *ffn1_w_down, *mix_norm, *w_in, *gdn_conv, *gdn_a_log, *gdn_dt_bias, *gdn_norm, *mlstm_conv, *mlstm_i_bias, *mlstm_f_bias, *mlstm_norm,
                *s5_lre, *s5_lim, *s5_bre, *s5_bim, *s5_cre, *s5_cim, *s5_d, *s5_log_dt, *s5_w_glu, *s5_b_glu, *w_gate, *w_branch, *w_out, *ffn2_norm, *ffn2_w_gu, *ffn2_w_down, *ple_norm, *ple_w_proj, *ple_w_gate;
};

__device__ __forceinline__ void prologue_weights(const LayerW& L, unsigned char* wsw, LAS unsigned char* lds, int gw, int ngw, int wave, int lane) {
    LAS float* scr = (LAS float*)(lds + RING_OFF + wave * WAVE_LDS);
    constexpr int I_GU = (D / 64) * (NGU / 32), I_DN = (FF / 64) * (D / 32), I_IN = (D / 64) * (NIN / 32), I_GT = (D / 64) * (NGATE / 32), I_BR = (256 / 64) * (4096 / 32), I_GL = (256 / 64) * (256 / 32),
                  I_OUT = (D / 64) * (D / 32), I_PLE = (PLED / 64) * (D / 32), I_PG = I_OUT;
    constexpr int NITEMS = 2 * I_GU + 2 * I_DN + I_IN + I_GT + I_BR + I_GL + I_OUT + I_PLE + I_PG;
    for (int it = gw; it < NITEMS; it += ngw) {
        int r = it;
        if (r < I_GU) { cvt_item(L.ffn1_w_gu, NGU, L.ffn1_norm, (bf16*)(wsw + W_GU1), D, r, NGU / 32, scr, lane, MapGU()); continue; } r -= I_GU;
        if (r < I_GU) { cvt_item(L.ffn2_w_gu, NGU, L.ffn2_norm, (bf16*)(wsw + W_GU2), D, r, NGU / 32, scr, lane, MapGU()); continue; } r -= I_GU;
        if (r < I_DN) { cvt_item(L.ffn1_w_down, D, nullptr, (bf16*)(wsw + W_D1), FF, r, D / 32, scr, lane, MapId()); continue; } r -= I_DN;
        if (r < I_DN) { cvt_item(L.ffn2_w_down, D, nullptr, (bf16*)(wsw + W_D2), FF, r, D / 32, scr, lane, MapId()); continue; } r -= I_DN;
        if (r < I_IN) { cvt_item(L.w_in, NIN_SRC, L.mix_norm, (bf16*)(wsw + W_IN), D, r, NIN / 32, scr, lane, MapIn()); continue; } r -= I_IN;
        if (r < I_GT) { cvt_item(L.w_gate, D, L.mix_norm, (bf16*)(wsw + W_GATE), D, r, NGATE / 32, scr, lane, MapGate()); continue; } r -= I_GT;
        if (r < I_BR) { cvt_item(L.w_branch, D, nullptr, (bf16*)(wsw + W_BR), 256, r, 4096 / 32, scr, lane, MapBr()); continue; } r -= I_BR;
        if (r < I_GL) { cvt_item(L.s5_w_glu, 256, nullptr, (bf16*)(wsw + W_GLU), 256, r, 256 / 32, scr, lane, MapId()); continue; } r -= I_GL;
        if (r < I_OUT) { cvt_item(L.w_out, D, nullptr, (bf16*)(wsw + W_OUT), D, r, D / 32, scr, lane, MapId()); continue; } r -= I_OUT;
        if (r < I_PLE) { cvt_item(L.ple_w_proj, D, nullptr, (bf16*)(wsw + W_PLE), PLED, r, D / 32, scr, lane, MapId()); continue; } r -= I_PLE;
        cvt_item(L.ple_w_gate, D, L.ple_norm, (bf16*)(wsw + W_PG), D, r, D / 32, scr, lane, MapId());
    }
}
__device__ __forceinline__ void prologue_s5(const LayerW& L, float* s5p, int gtid, int ngt) {
    for (int i = gtid; i < 1024; i += ngt) { const int g = i >> 6;
        const float dt = expf(L.s5_log_dt[g]), lr = L.s5_lre[i], li = L.s5_lim[i];
        const float th = li * dt; float sn, cs; sincosf(th, &sn, &cs);
        const float em1 = expm1f(lr * dt), mag = em1 + 1.0f;
        const float are = mag * cs, aim = mag * sn;
        const float sh = sinf(0.5f * th); const float arem1 = em1 * cs - 2.0f * sh * sh;
        const float den = lr * lr + li * li;
        const float zre = (arem1 * lr + aim * li) / den, zim = (aim * lr - arem1 * li) / den;
        s5p[i] = are; s5p[1024 + i] = aim;
        for (int n = 0; n < 16; ++n) { const float br = L.s5_bre[i * 16 + n], bi = L.s5_bim[i * 16 + n];
            s5p[2048 + i * 16 + n] = zre * br - zim * bi; s5p[2048 + 16384 + i * 16 + n] = zre * bi + zim * br; } }
}
__device__ __forceinline__ void cvt_rows_bf16(const float* src, bf16* dst, size_t n, size_t gtid, size_t ngt) {
    size_t i = gtid * 8;
    for (; i + 3 * ngt * 8 < n; i += 4 * ngt * 8) {
        f32x4 a[4], b[4];
#pragma unroll
        for (int u = 0; u < 4; ++u) { a[u] = *(const GAS f32x4*)(src + i + u * ngt * 8); b[u] = *(const GAS f32x4*)(src + i + u * ngt * 8 + 4); }
#pragma unroll
        for (int u = 0; u < 4; ++u) { v4u o; o.x = pk2(a[u][0], a[u][1]); o.y = pk2(a[u][2], a[u][3]); o.z = pk2(b[u][0], b[u][1]); o.w = pk2(b[u][2], b[u][3]); *(GAS v4u*)(dst + i + u * ngt * 8) = o; } }
    for (; i < n; i += ngt * 8) { const f32x4 a = *(const GAS f32x4*)(src + i), b = *(const GAS f32x4*)(src + i + 4);
        v4u o; o.x = pk2(a[0], a[1]); o.y = pk2(a[2], a[3]); o.z = pk2(b[0], b[1]); o.w = pk2(b[2], b[3]); *(GAS v4u*)(dst + i) = o; }
}
__device__ __forceinline__ void prologue_rope(const int* positions, float* rope, size_t gtid, size_t ngt) {
    for (size_t i = gtid; i < (size_t)M * 32; i += ngt) { const size_t row = i >> 5; const int k = (int)(i & 31);
        const float invf = expf(-(float)k * (2.0f / 64.0f) * 9.210340371976184f); float sn, cs; sincosf((float)positions[row] * invf, &sn, &cs);
        rope[row * 64 + k] = cs; rope[row * 64 + 32 + k] = sn; }
}
__device__ __forceinline__ void x_to_hb(const float* x, bf16* hb, pg8::rowss_t* rowss, int gw, int ngw, int lane) {
    for (int m0 = gw; m0 < M; m0 += 2 * ngw) {
        f32x4 v[2][4]; float s[2];
#pragma unroll
        for (int u = 0; u < 2; ++u) { const int m = m0 + u * ngw; if (m < M) { const GAS f32x4* xr = (const GAS f32x4*)(x + (size_t)m * D) + lane;
#pragma unroll
            for (int j = 0; j < 4; ++j) v[u][j] = xr[64 * j]; } }
#pragma unroll
        for (int u = 0; u < 2; ++u) { const int m = m0 + u * ngw; if (m < M) { s[u] = 0.f;
#pragma unroll
            for (int j = 0; j < 4; ++j) s[u] += (v[u][j][0] * v[u][j][0] + v[u][j][1] * v[u][j][1]) + (v[u][j][2] * v[u][j][2] + v[u][j][3] * v[u][j][3]);
            s[u] = wave_sum(s[u]); if (lane == 0) rowss[m] = (pg8::rowss_t)(s[u] * pg8::RSS_SCALE);
            GAS unsigned long long* o8 = (GAS unsigned long long*)(hb + (size_t)m * D) + lane;
#pragma unroll
            for (int j = 0; j < 4; ++j) o8[64 * j] = (unsigned long long)pk2(v[u][j][0], v[u][j][1]) | ((unsigned long long)pk2(v[u][j][2], v[u][j][3]) << 32); } } }
}
__device__ __forceinline__ void final_norm(const bf16* h, float* out, const pg8::rowss_t* rowss, const float* w, int gw, int ngw, int lane) {
    const GAS f32x4* wp = (const GAS f32x4*)(w + 16 * lane); const f32x4 g0 = wp[0], g1 = wp[1], g2 = wp[2], g3 = wp[3];
    for (int m0 = gw; m0 < M; m0 += 4 * ngw) {
        v4u hw[4][2]; float r[4];
#pragma unroll
        for (int u = 0; u < 4; ++u) { const int m = m0 + u * ngw; if (m < M) { const GAS v4u* hp = (const GAS v4u*)(h + (size_t)m * D + 16 * lane); hw[u][0] = hp[0]; hw[u][1] = hp[1]; r[u] = pg8::rms_scale(rowss, m); } }
#pragma unroll
        for (int u = 0; u < 4; ++u) { const int m = m0 + u * ngw; if (m < M) { GAS f32x4* op = (GAS f32x4*)(out + (size_t)m * D + 16 * lane); const float rr = r[u];
            op[0] = (f32x4){__uint_as_float(hw[u][0].x << 16) * rr * g0[0], __uint_as_float(hw[u][0].x & 0xffff0000u) * rr * g0[1], __uint_as_float(hw[u][0].y << 16) * rr * g0[2], __uint_as_float(hw[u][0].y & 0xffff0000u) * rr * g0[3]};
            op[1] = (f32x4){__uint_as_float(hw[u][0].z << 16) * rr * g1[0], __uint_as_float(hw[u][0].z & 0xffff0000u) * rr * g1[1], __uint_as_float(hw[u][0].w << 16) * rr * g1[2], __uint_as_float(hw[u][0].w & 0xffff0000u) * rr * g1[3]};
            op[2] = (f32x4){__uint_as_float(hw[u][1].x << 16) * rr * g2[0], __uint_as_float(hw[u][1].x & 0xffff0000u) * rr * g2[1], __uint_as_float(hw[u][1].y << 16) * rr * g2[2], __uint_as_float(hw[u][1].y & 0xffff0000u) * rr * g2[3]};
            op[3] = (f32x4){__uint_as_float(hw[u][1].z << 16) * rr * g3[0], __uint_as_float(hw[u][1].z & 0xffff0000u) * rr * g3[1], __uint_as_float(hw[u][1].w << 16) * rr * g3[2], __uint_as_float(hw[u][1].w & 0xffff0000u) * rr * g3[3]}; } } }
}

__device__ __forceinline__ float softplusf(float x) { return fmaxf(x, 0.f) + __logf(1.0f + __expf(-fabsf(x))); }
__device__ __forceinline__ float gelu_tanh(float y) { const float z = 0.7978845608028654f * (y + 0.044715f * y * y * y); const float th = 1.0f - 2.0f * __builtin_amdgcn_rcpf(1.0f + __expf(2.0f * z)); return 0.5f * y * (1.0f + th); }
template <int NQG>
__device__ __forceinline__ void moba_mfma_item(const bf16* proj, const float* kmean, const bf16* vt, bf16* y3, int bh, int qb, int wsl, int lane) {
    constexpr int NQ = 16 * NQG;
    const int b = bh >> 2, h = bh & 3, fr = lane & 15, fq = lane >> 4;
    const int t0 = qb * 256 + wsl * NQ; const size_t rowb = (size_t)b * SEQ;
    unsigned selmask = 0;
    { const GAS v4u* qp = (const GAS v4u*)(proj + (rowb + t0 + (lane & (NQ - 1))) * NPROJ + PC_AQ + h * 64);
      float qv[64];
#pragma unroll
      for (int c = 0; c < 8; ++c) { const v4u w = qp[c]; qv[8 * c + 0] = __uint_as_float(w.x << 16); qv[8 * c + 1] = __uint_as_float(w.x & 0xffff0000u); qv[8 * c + 2] = __uint_as_float(w.y << 16); qv[8 * c + 3] = __uint_as_float(w.y & 0xffff0000u);
          qv[8 * c + 4] = __uint_as_float(w.z << 16); qv[8 * c + 5] = __uint_as_float(w.z & 0xffff0000u); qv[8 * c + 6] = __uint_as_float(w.w << 16); qv[8 * c + 7] = __uint_as_float(w.w & 0xffff0000u); }
      float gs[7];
#pragma unroll
      for (int n = 0; n < 7; ++n) { float a = -3.0e38f; if (n < qb) { const float* km = kmean + (size_t)(bh * 8 + n) * 64; a = 0.f;
#pragma unroll
              for (int d = 0; d < 64; ++d) a += qv[d] * km[d]; }
          gs[n] = a; }
#pragma unroll
      for (int r = 0; r < 3; ++r) { int best = -1; float bv = -3.0e38f;
#pragma unroll
          for (int n = 0; n < 7; ++n) if (n < qb && !((selmask >> n) & 1u) && gs[n] > bv) { bv = gs[n]; best = n; }
          if (best >= 0) selmask |= 1u << best; } }
    unsigned mskp = 0;
#pragma unroll
    for (int qg = 0; qg < NQG; ++qg) mskp |= ((unsigned)__shfl((int)selmask, 16 * qg + fr) & 0xffu) << (8 * qg);
    unsigned umask = 0;
#pragma unroll
    for (int n = 0; n < 7; ++n) if (__ballot((selmask >> n) & 1u) != 0ull) umask |= 1u << n;
    bf16x8 qf[NQG][2];
#pragma unroll
    for (int qg = 0; qg < NQG; ++qg)
#pragma unroll
        for (int ks = 0; ks < 2; ++ks) qf[qg][ks] = *(const GAS bf16x8*)(proj + (rowb + t0 + 16 * qg + fr) * NPROJ + PC_AQ + h * 64 + 32 * ks + 8 * fq);
    f32x4 o[4][NQG];
#pragma unroll
    for (int dt = 0; dt < 4; ++dt)
#pragma unroll
        for (int qg = 0; qg < NQG; ++qg) o[dt][qg] = (f32x4){0.f, 0.f, 0.f, 0.f};
    float mrun[NQG], lrun[NQG];
#pragma unroll
    for (int qg = 0; qg < NQG; ++qg) { mrun[qg] = -1.0e30f; lrun[qg] = 0.f; }
    const float cexp = 0.125f * 1.4426950408889634f;
    const int kperm = 8 * (fr >> 2) + (fr & 3);
    for (int it = 0; it <= qb; ++it) {
        const int nb = (it == 0) ? qb : it - 1;
        if (it > 0 && !((umask >> nb) & 1u)) continue;
        const int nsteps = (it == 0) ? (wsl * NQ + NQ - 1) / 32 + 1 : 8;
        bf16x8 kfn[2][2];
        { const size_t kb0 = rowb + nb * 256;
#pragma unroll
          for (int kt = 0; kt < 2; ++kt)
#pragma unroll
              for (int ks = 0; ks < 2; ++ks) kfn[kt][ks] = *(const GAS bf16x8*)(proj + (kb0 + kperm + 4 * kt) * NPROJ + PC_AK + h * 64 + 32 * ks + 8 * fq); }
        for (int st = 0; st < nsteps; ++st) {
            bf16x8 kf[2][2], vf[4];
#pragma unroll
            for (int kt = 0; kt < 2; ++kt) { kf[kt][0] = kfn[kt][0]; kf[kt][1] = kfn[kt][1]; }
#pragma unroll
            for (int dt = 0; dt < 4; ++dt) vf[dt] = *(const GAS bf16x8*)(vt + ((size_t)bh * 64 + 16 * dt + fr) * SEQ + nb * 256 + 32 * st + 8 * fq);
            if (st + 1 < nsteps) { const size_t kb = rowb + nb * 256 + 32 * (st + 1);
#pragma unroll
                for (int kt = 0; kt < 2; ++kt)
#pragma unroll
                    for (int ks = 0; ks < 2; ++ks) kfn[kt][ks] = *(const GAS bf16x8*)(proj + (kb + kperm + 4 * kt) * NPROJ + PC_AK + h * 64 + 32 * ks + 8 * fq); }
            f32x4 s[2][NQG];
#pragma unroll
            for (int kt = 0; kt < 2; ++kt)
#pragma unroll
                for (int qg = 0; qg < NQG; ++qg) { f32x4 a = (f32x4){0.f, 0.f, 0.f, 0.f};
                    a = __builtin_amdgcn_mfma_f32_16x16x32_bf16(kf[kt][0], qf[qg][0], a, 0, 0, 0); a = __builtin_amdgcn_mfma_f32_16x16x32_bf16(kf[kt][1], qf[qg][1], a, 0, 0, 0); s[kt][qg] = a; }
            bf16x8 pf[NQG];
#pragma unroll
            for (int qg = 0; qg < NQG; ++qg) {
                const int qloc = NQ * wsl + 16 * qg + fr; const bool sel = (mskp >> (8 * qg + nb)) & 1u;
                float mx = -1.0e30f;
#pragma unroll
                for (int kt = 0; kt < 2; ++kt)
#pragma unroll
                    for (int i = 0; i < 4; ++i) { const int kloc = 32 * st + 8 * fq + 4 * kt + i; const bool ok = (it == 0) ? (kloc <= qloc) : sel; const float v = ok ? s[kt][qg][i] : -1.0e30f; s[kt][qg][i] = v; mx = fmaxf(mx, v); }
                mx = fmaxf(mx, __shfl_xor(mx, 16)); mx = fmaxf(mx, __shfl_xor(mx, 32));
                const float mnew = fmaxf(mrun[qg], mx), alpha = __builtin_amdgcn_exp2f((mrun[qg] - mnew) * cexp); mrun[qg] = mnew;
                float ps = 0.f; float p[8];
#pragma unroll
                for (int kt = 0; kt < 2; ++kt)
#pragma unroll
                    for (int i = 0; i < 4; ++i) { const float e = __builtin_amdgcn_exp2f((s[kt][qg][i] - mnew) * cexp); p[4 * kt + i] = e; ps += e; }
                lrun[qg] = lrun[qg] * alpha + ps;
#pragma unroll
                for (int dt = 0; dt < 4; ++dt) o[dt][qg] *= alpha;
                v4u pw; pw.x = pk2(p[0], p[1]); pw.y = pk2(p[2], p[3]); pw.z = pk2(p[4], p[5]); pw.w = pk2(p[6], p[7]);
                pf[qg] = __builtin_bit_cast(bf16x8, pw);
            }
#pragma unroll
            for (int dt = 0; dt < 4; ++dt)
#pragma unroll
                for (int qg = 0; qg < NQG; ++qg) o[dt][qg] = __builtin_amdgcn_mfma_f32_16x16x32_bf16(vf[dt], pf[qg], o[dt][qg], 0, 0, 0);
        }
    }
#pragma unroll
    for (int qg = 0; qg < NQG; ++qg) { float l = lrun[qg]; l += __shfl_xor(l, 16); l += __shfl_xor(l, 32); const float inv = 1.0f / l;
        bf16* orow = y3 + (rowb + t0 + 16 * qg + fr) * 256 + h * 64 + 4 * fq;
#pragma unroll
        for (int dt = 0; dt < 4; ++dt) { const f32x4 v = o[dt][qg] * inv; *(GAS unsigned long long*)(orow + 16 * dt) = (unsigned long long)pk2(v[0], v[1]) | ((unsigned long long)pk2(v[2], v[3]) << 32); } }
}
typedef float f32x2 __attribute__((ext_vector_type(2)));
typedef unsigned u32x2_t __attribute__((ext_vector_type(2)));
constexpr int S2_XA = 0, S2_KN = 16384, S2_VV = 32768, S2_AB = 49152, S2_BUF = 50176, S2_OB = 2 * S2_BUF, S2_QD = S2_OB + 32768, S2_XT = S2_QD + 512, S2_CW = S2_XT + 32 * 68 * 4, S2_FA = S2_KN + 8960  ;
static_assert(S2_CW + 3 * 4 * 64 * 4 + 128 + 256 <= LDSCTL_OFF, "LDS map of the sequential mixers");
template <bool GDN>
__device__ __forceinline__ void seq_mixer2(const bf16* proj, const float* scal, const float* convw, const float* p0, const float* p1, const float* normw, bf16* yout, LAS unsigned char* lds, int bh, int tid) {
    const int wave = __builtin_amdgcn_readfirstlane(tid >> 6), lane = tid & 63;
    const int b = bh >> 2, h = bh & 3; const size_t rowb = (size_t)b * SEQ;
    constexpr int CIN = GDN ? 768 : 512, PCQ = GDN ? PC_GQ : PC_MQ;
    if (wave == 4) { LAS float* cwl = (LAS float*)(lds + S2_CW);
        for (int i = lane; i < 3 * 4 * 64; i += 64) { const int ty = i >> 8, j = (i >> 6) & 3, dd = i & 63; cwl[i] = (GDN || ty < 2) ? convw[j * CIN + ty * 256 + h * 64 + dd] : 0.f; }
        if (lane < 32) cwl[768 + lane] = 0.f; { unsigned no_ = (unsigned)(((GDN ? 0 : h * 64) + lane) * 4); asm volatile("" : "+v"(no_)); cwl[800 + lane] = *(const float*)((const char*)normw + no_); } }
    __syncthreads();
    if (wave < 4) {
        const int fr = lane & 15, fq = lane >> 4, e = 16 * wave + fr, sel = fr & 3;
        f32x4 ST[4];
#pragma unroll
        for (int T = 0; T < 4; ++T) ST[T] = (f32x4){0.f, 0.f, 0.f, 0.f};
        const unsigned wmask = (fq == 0) ? 0xffffffffu : 0u;
        v4u b0 = (v4u){0u, 0u, 0u, 0u}, b1 = b0, b2 = b0, b3 = b0;
        __builtin_amdgcn_s_setprio(3);
        for (int c = 0; c < SEQ / 64; ++c) {
            __syncthreads();
            const LAS bf16* XA = (const LAS bf16*)(lds + (c & 1) * S2_BUF + S2_XA) + (sel >> 1) * 128 + (sel & 1) * 64 + 8 * fq;
            const LAS unsigned char* KP = lds + (c & 1) * S2_BUF + S2_KN + fr * 16;
            const LAS float* VV = (const LAS float*)(lds + (c & 1) * S2_BUF + S2_VV) + e; const LAS float* AB = (const LAS float*)(lds + (c & 1) * S2_BUF + S2_AB);
            LAS float* OB = (LAS float*)(lds + S2_OB + (c & 1) * 16384) + e;
            bf16x8 a0n, a1n, kpn; f32x4 ab1n, ab2n; float v1n, v2n;
#define S2_LOAD(tp) do { a0n = *(const LAS bf16x8*)(XA + (tp) * 256); a1n = *(const LAS bf16x8*)(XA + (tp) * 256 + 32); kpn = *(const LAS bf16x8*)(KP + (tp) * 272); \
            v1n = VV[(tp) * 128]; v2n = VV[(tp) * 128 + 64]; ab1n = *(const LAS f32x4*)(AB + 8 * (tp)); ab2n = *(const LAS f32x4*)(AB + 8 * (tp) + 4); } while (0)
            S2_LOAD(0);
#pragma unroll 4
            for (int tp = 0; tp < 32; ++tp) {
                const bf16x8 a0 = a0n, a1 = a1n, kp = kpn; const f32x4 ab1 = ab1n, ab2 = ab2n; const float ve1 = v1n, ve2 = v2n;
                v4u bl, bhh; bl.x = pk2(ST[0][0], ST[0][1]); bl.y = pk2(ST[0][2], ST[0][3]); bl.z = pk2(ST[1][0], ST[1][1]); bl.w = pk2(ST[1][2], ST[1][3]);
                bhh.x = pk2(ST[2][0], ST[2][1]); bhh.y = pk2(ST[2][2], ST[2][3]); bhh.z = pk2(ST[3][0], ST[3][1]); bhh.w = pk2(ST[3][2], ST[3][3]);
                f32x4 d = (f32x4){0.f, 0.f, 0.f, 0.f};
                d = __builtin_amdgcn_mfma_f32_16x16x32_bf16(a0, __builtin_bit_cast(bf16x8, bl), d, 0, 0, 0);
                d = __builtin_amdgcn_mfma_f32_16x16x32_bf16(a1, __builtin_bit_cast(bf16x8, bhh), d, 0, 0, 0);
                __builtin_amdgcn_sched_barrier(0);
                S2_LOAD(tp + 1);
                __builtin_amdgcn_sched_barrier(0);
                float o1, o2, vn1, vn2;
                if (GDN) { vn1 = ve1 - ab1[1] * d[0]; o1 = ab1[0] * d[1] + vn1 * ab1[2];
                    const float sk2 = ab1[0] * d[2] + ab2[3] * vn1, sq2 = ab1[0] * d[3] + ab1[3] * vn1;
                    vn2 = ve2 - ab2[1] * sk2; o2 = ab2[0] * sq2 + vn2 * ab2[2]; }
                else { vn1 = ve1; o1 = ab1[0] * d[1] + ve1 * ab1[2]; const float sq2 = ab1[0] * d[3] + ab1[3] * ve1; vn2 = ve2; o2 = ab2[0] * sq2 + ve2 * ab2[2]; }
                const float aa = ab1[0] * ab2[0], c1 = ab2[0] * vn1;
#pragma unroll
                for (int T = 0; T < 4; ++T) ST[T] *= aa;
                const unsigned w = pk2(c1, vn2) & wmask;
                b0.x = w; b1.y = w; b2.z = w; b3.w = w;
                ST[0] = __builtin_amdgcn_mfma_f32_16x16x32_bf16(kp, __builtin_bit_cast(bf16x8, b0), ST[0], 0, 0, 0);
                ST[1] = __builtin_amdgcn_mfma_f32_16x16x32_bf16(kp, __builtin_bit_cast(bf16x8, b1), ST[1], 0, 0, 0);
                ST[2] = __builtin_amdgcn_mfma_f32_16x16x32_bf16(kp, __builtin_bit_cast(bf16x8, b2), ST[2], 0, 0, 0);
                ST[3] = __builtin_amdgcn_mfma_f32_16x16x32_bf16(kp, __builtin_bit_cast(bf16x8, b3), ST[3], 0, 0, 0);
                OB[tp * 128] = o1; OB[tp * 128 + 64] = o2;
            }
#undef S2_LOAD
        }
        __builtin_amdgcn_s_setprio(0);
        __syncthreads();
        __syncthreads();
    } else {
        const float s0 = GDN ? __expf(p0[h]) : p0[h], s1 = p1[h];
        const int ht = tid - 256, dgrp = ht & 7, d0 = 8 * dgrp, tg = ht >> 3;
        const int xpos = (dgrp >> 2) * 32 + (dgrp & 1) * 16 + ((dgrp >> 1) & 1) * 4;
        const LAS float* CW0 = (const LAS float*)(lds + S2_CW) + d0;
        const int e0 = (lane & 7) * 8;
        float nstate = 0.f;
#define S2_UNPK(W_, A_) do { const v4u w_ = (W_); A_[0] = __uint_as_float(w_.x << 16); A_[1] = __uint_as_float(w_.x & 0xffff0000u); A_[2] = __uint_as_float(w_.y << 16); A_[3] = __uint_as_float(w_.y & 0xffff0000u); \
                    A_[4] = __uint_as_float(w_.z << 16); A_[5] = __uint_as_float(w_.z & 0xffff0000u); A_[6] = __uint_as_float(w_.w << 16); A_[7] = __uint_as_float(w_.w & 0xffff0000u); } while (0)
        v4u rq[5], rk[5], rv[5]; float sg[2][2]; v4u zws[2];
        const int zh = 2 * (wave - 4);
#define S2_PREF(cn) do { const int s_ = (cn) * 64 + 2 * tg; \
            unsigned off_ = (unsigned)((((int)rowb + s_ - 3) * NPROJ + PCQ + h * 64 + d0) * 2); asm volatile("" : "+v"(off_));     \
            _Pragma("unroll") for (int r = 0; r < 5; ++r) { rq[r] = (v4u){0u, 0u, 0u, 0u}; rk[r] = rq[r]; \
                if (s_ - 3 + r >= 0) { const char* src_ = (const char*)proj + (off_ + (unsigned)(r * NPROJ * 2)); rq[r] = *(const GAS v4u*)src_; rk[r] = *(const GAS v4u*)(src_ + 512); } } } while (0)
#define S2_PREF_V(cn) do { const int s_ = (cn) * 64 + 2 * tg; \
            unsigned off_ = (unsigned)((((int)rowb + s_ - 3) * NPROJ + PCQ + h * 64 + d0) * 2); asm volatile("" : "+v"(off_)); \
            _Pragma("unroll") for (int r = 0; r < 5; ++r) { rv[r] = (v4u){0u, 0u, 0u, 0u}; \
                if (s_ - 3 + r >= 0) { const char* src_ = (const char*)proj + (off_ + (unsigned)(r * NPROJ * 2)); \
                    if (GDN) rv[r] = *(const GAS v4u*)(src_ + 1024); else if (r >= 3) rv[r] = *(const GAS v4u*)(src_ + (PC_MV - PCQ) * 2); } } \
            unsigned so_ = (unsigned)((((int)rowb + s_) * 16 + h) * 4); asm volatile("" : "+v"(so_)); const float* sb_ = (const float*)((const char*)scal + so_); \
            _Pragma("unroll") for (int i = 0; i < 2; ++i) { sg[i][0] = sb_[i * 16 + (GDN ? 0 : 8)]; sg[i][1] = sb_[i * 16 + (GDN ? 4 : 12)]; } } while (0)
#define S2_PREF_Z(cc_) do { unsigned zo_ = (unsigned)((((int)rowb + (cc_) * 64 + (lane >> 3) + zh * 8) * NPROJ + (GDN ? PC_GZ : PC_MO) + h * 64 + e0) * 2); asm volatile("" : "+v"(zo_)); \
            _Pragma("unroll") for (int i8 = 0; i8 < 2; ++i8) zws[i8] = *(const GAS v4u*)((const char*)proj + (zo_ + (unsigned)(i8 * 8 * NPROJ * 2))); } while (0)
        S2_PREF(0);
        for (int c = 0; c <= SEQ / 64 + 1; ++c) {
            if (c >= 2) {
                const int cc = c - 2; const LAS float* OB = (const LAS float*)(lds + S2_OB + (cc & 1) * 16384); const LAS float* QD = (const LAS float*)(lds + S2_QD) + (cc & 1) * 64;
#pragma unroll
                for (int i8 = 0; i8 < 2; ++i8) { const int t = (zh + i8) * 8 + (lane >> 3); const size_t row = rowb + cc * 64 + t;
                    f32x4 oa = *(const LAS f32x4*)(OB + t * 64 + e0), ob = *(const LAS f32x4*)(OB + t * 64 + e0 + 4);
                    if (!GDN) { const float inv = 1.0f / fmaxf(fabsf(QD[t]), 1.0f); oa *= inv; ob *= inv; }
                    float ss = (oa[0] * oa[0] + oa[1] * oa[1]) + (oa[2] * oa[2] + oa[3] * oa[3]) + (ob[0] * ob[0] + ob[1] * ob[1]) + (ob[2] * ob[2] + ob[3] * ob[3]);
                    ss += __shfl_xor(ss, 1); ss += __shfl_xor(ss, 2); ss += __shfl_xor(ss, 4);
                    const float r = rsqrtf(ss * (1.0f / 64.0f) + 1e-6f);
                    float z[8]; S2_UNPK(zws[i8], z);
                    float y[8]; const f32x4 nw0 = *(const LAS f32x4*)(lds + S2_CW + 3200 + 4 * e0), nw1 = *(const LAS f32x4*)(lds + S2_CW + 3200 + 4 * e0 + 16);
#pragma unroll
                    for (int i = 0; i < 8; ++i) { const float ov = (i < 4 ? oa[i] * nw0[i & 3] : ob[i - 4] * nw1[i & 3]) * r; y[i] = GDN ? ov * silu(z[i]) : ov * sigm(z[i]); }
                    v4u yo; yo.x = pk2(y[0], y[1]); yo.y = pk2(y[2], y[3]); yo.z = pk2(y[4], y[5]); yo.w = pk2(y[6], y[7]);
                    *(GAS v4u*)((char*)yout + (unsigned)(((int)row * 256 + h * 64 + e0) * 2)) = yo; }
            }
            if (c < SEQ / 64) {
                S2_PREF_V(c);
                LAS bf16* XA = (LAS bf16*)(lds + (c & 1) * S2_BUF + S2_XA); LAS unsigned char* KPb = lds + (c & 1) * S2_BUF + S2_KN; LAS float* VV = (LAS float*)(lds + (c & 1) * S2_BUF + S2_VV); LAS float* AB = (LAS float*)(lds + (c & 1) * S2_BUF + S2_AB);
#pragma unroll
                for (int i = 0; i < 2; ++i) { const int t = 2 * tg + i;
                    const LAS float* CW = CW0; asm volatile("" : "+v"(CW));
                    float q[8], k[8];
#pragma unroll
                    for (int ii = 0; ii < 8; ++ii) { q[ii] = 0.f; k[ii] = 0.f; }
#pragma unroll
                    for (int j = 0; j < 4; ++j) { const f32x4 wq0 = *(const LAS f32x4*)(CW + j * 64), wq1 = *(const LAS f32x4*)(CW + j * 64 + 4), wk0 = *(const LAS f32x4*)(CW + (4 + j) * 64), wk1 = *(const LAS f32x4*)(CW + (4 + j) * 64 + 4);
                        float x[8]; S2_UNPK(rq[i + j], x);
#pragma unroll
                        for (int ii = 0; ii < 4; ++ii) { q[ii] += wq0[ii] * x[ii]; q[4 + ii] += wq1[ii] * x[4 + ii]; }
                        S2_UNPK(rk[i + j], x);
#pragma unroll
                        for (int ii = 0; ii < 4; ++ii) { k[ii] += wk0[ii] * x[ii]; k[4 + ii] += wk1[ii] * x[4 + ii]; }
                        if (j & 1) asm volatile("" ::: "memory"); }
                    float ssq = 0.f, ssk = 0.f;
#pragma unroll
                    for (int ii = 0; ii < 8; ++ii) { q[ii] = silu(q[ii]); k[ii] = silu(k[ii]); ssq += q[ii] * q[ii]; ssk += k[ii] * k[ii]; }
                    float scq = 1.0f, sck = 1.0f;
                    if (GDN) { ssq += __shfl_xor(ssq, 1); ssk += __shfl_xor(ssk, 1); ssq += __shfl_xor(ssq, 2); ssk += __shfl_xor(ssk, 2); ssq += __shfl_xor(ssq, 4); ssk += __shfl_xor(ssk, 4);
                        scq = rsqrtf(ssq + 1e-6f) * 0.125f; sck = rsqrtf(ssk + 1e-6f); }
                    else sck = 0.125f * __expf(sg[i][0] + s0);
                    float kq = 0.f;
#pragma unroll
                    for (int ii = 0; ii < 8; ++ii) { q[ii] *= scq; k[ii] *= sck; kq += q[ii] * k[ii]; }
                    kq += __shfl_xor(kq, 1); kq += __shfl_xor(kq, 2); kq += __shfl_xor(kq, 4);
                    float k12 = 0.f, kq12 = 0.f;
                    float kp[8];
                    if (i == 1) { const u32x2_t w0 = *(const LAS u32x2_t*)(XA + (t - 1) * 128 + xpos), w1 = *(const LAS u32x2_t*)(XA + (t - 1) * 128 + xpos + 8);
                        kp[0] = __uint_as_float(w0.x << 16); kp[1] = __uint_as_float(w0.x & 0xffff0000u); kp[2] = __uint_as_float(w0.y << 16); kp[3] = __uint_as_float(w0.y & 0xffff0000u);
                        kp[4] = __uint_as_float(w1.x << 16); kp[5] = __uint_as_float(w1.x & 0xffff0000u); kp[6] = __uint_as_float(w1.y << 16); kp[7] = __uint_as_float(w1.y & 0xffff0000u);
#pragma unroll
                        for (int ii = 0; ii < 8; ++ii) { k12 += kp[ii] * k[ii]; kq12 += kp[ii] * q[ii]; }
                        k12 += __shfl_xor(k12, 1); kq12 += __shfl_xor(kq12, 1); k12 += __shfl_xor(k12, 2); kq12 += __shfl_xor(kq12, 2); k12 += __shfl_xor(k12, 4); kq12 += __shfl_xor(kq12, 4); }
                    v4u qb, kb; qb.x = pk2(q[0], q[1]); qb.y = pk2(q[2], q[3]); qb.z = pk2(q[4], q[5]); qb.w = pk2(q[6], q[7]); kb.x = pk2(k[0], k[1]); kb.y = pk2(k[2], k[3]); kb.z = pk2(k[4], k[5]); kb.w = pk2(k[6], k[7]);
                    *(LAS u32x2_t*)(XA + t * 128 + xpos) = (u32x2_t){kb.x, kb.y}; *(LAS u32x2_t*)(XA + t * 128 + xpos + 8) = (u32x2_t){kb.z, kb.w};
                    *(LAS u32x2_t*)(XA + t * 128 + 64 + xpos) = (u32x2_t){qb.x, qb.y}; *(LAS u32x2_t*)(XA + t * 128 + 64 + xpos + 8) = (u32x2_t){qb.z, qb.w};
                    if (i == 1) {
#pragma unroll
                        for (int ii = 0; ii < 8; ++ii) *(LAS unsigned*)(KPb + tg * 272 + (8 * (dgrp & 1) + ii) * 16 + (dgrp >> 1) * 4) = pk2(kp[ii], k[ii]); }
                    float be = 1.0f;
                    if (GDN) be = sigm(sg[i][0]);
                    if (dgrp == 0) { f32x4 abv;
                        if (GDN) { const float al = __expf(-s0 * softplusf(sg[i][1] + s1)); abv = (f32x4){al, al * be, kq, k12}; }
                        else { abv = (f32x4){sigm(sg[i][1] + s1), 0.f, kq, 0.f}; *(LAS float*)(lds + (c & 1) * S2_BUF + S2_FA + 4 * t) = abv[0]; }
                        *(LAS f32x4*)(AB + 4 * t) = abv; if (i == 1) AB[4 * (t - 1) + 3] = kq12; }
                    float v[8];
                    if (GDN) {
#pragma unroll
                        for (int ii = 0; ii < 8; ++ii) v[ii] = 0.f;
#pragma unroll
                        for (int j = 0; j < 4; ++j) { float x[8]; S2_UNPK(rv[i + j], x); const f32x4 wv0 = *(const LAS f32x4*)(CW + (8 + j) * 64), wv1 = *(const LAS f32x4*)(CW + (8 + j) * 64 + 4);
#pragma unroll
                            for (int ii = 0; ii < 4; ++ii) { v[ii] += wv0[ii] * x[ii]; v[4 + ii] += wv1[ii] * x[4 + ii]; } }
#pragma unroll
                        for (int ii = 0; ii < 8; ++ii) v[ii] = silu(v[ii]) * be;
                    } else S2_UNPK(rv[3 + i], v);
                    *(LAS f32x4*)(VV + t * 64 + d0) = (f32x4){v[0], v[1], v[2], v[3]}; *(LAS f32x4*)(VV + t * 64 + d0 + 4) = (f32x4){v[4], v[5], v[6], v[7]};
                    asm volatile("" ::: "memory"); }
                if (c + 1 < SEQ / 64) S2_PREF(c + 1);
            }
            if (c >= 1 && c <= SEQ / 64) S2_PREF_Z(c - 1);
            __syncthreads();
            if (!GDN && wave == 5 && c < SEQ / 64) {
                const int lpos = 32 * (lane >> 5) + 8 * ((lane & 15) >> 2) + 4 * ((lane >> 4) & 1) + (lane & 3); const LAS bf16* XQ = (const LAS bf16*)(lds + (c & 1) * S2_BUF + S2_XA) + 64 + lpos; const LAS bf16* XK = (const LAS bf16*)(lds + (c & 1) * S2_BUF + S2_XA) + lpos; const LAS float* AB = (const LAS float*)(lds + (c & 1) * S2_BUF + S2_AB);
                LAS float* QD = (LAS float*)(lds + S2_QD) + (c & 1) * 64; LAS float* XT = (LAS float*)(lds + S2_XT); const LAS float* FA = (const LAS float*)(lds + (c & 1) * S2_BUF + S2_FA);
                for (int hf = 0; hf < 2; ++hf) {
#pragma unroll 1
                    for (int g16 = 0; g16 < 2; ++g16) {
                        const int t0 = hf * 32 + g16 * 16; float fa[16], ka[16], qa[16], xo[16];
#pragma unroll
                        for (int j4 = 0; j4 < 4; ++j4) { const f32x4 f4 = *(const LAS f32x4*)(FA + t0 + 4 * j4); fa[4 * j4] = f4[0]; fa[4 * j4 + 1] = f4[1]; fa[4 * j4 + 2] = f4[2]; fa[4 * j4 + 3] = f4[3]; }
#pragma unroll
                        for (int j = 0; j < 16; ++j) { ka[j] = bf2f(XK[(t0 + j) * 128]); qa[j] = bf2f(XQ[(t0 + j) * 128]); }
#pragma unroll
                        for (int j = 0; j < 16; ++j) { nstate = nstate * fa[j] + ka[j]; xo[j] = nstate * qa[j]; }
#pragma unroll
                        for (int j = 0; j < 16; ++j) XT[(g16 * 16 + j) * 68 + lane] = xo[j];
                    }
                    LDS_WAIT(); asm volatile("" ::: "memory");
                    const LAS float* xr = XT + (lane & 31) * 68 + (lane >> 5) * 32; f32x4 s4 = (f32x4){0.f, 0.f, 0.f, 0.f};
#pragma unroll
                    for (int dd = 0; dd < 8; ++dd) s4 += *(const LAS f32x4*)(xr + 4 * dd);
                    float sm = (s4[0] + s4[1]) + (s4[2] + s4[3]);
                    sm += __shfl_xor(sm, 32);
                    if (lane < 32) QD[hf * 32 + lane] = sm;
                    LDS_WAIT(); asm volatile("" ::: "memory");
                }
            }
        }
#undef S2_UNPK
#undef S2_PREF
#undef S2_PREF_V
#undef S2_PREF_Z
    }
}
__device__ __forceinline__ void s5_wave_mfma(const bf16* proj, const float* s5p, const float* cre, const float* cim, const float* dsk_in, bf16* yg, LAS unsigned char* wl, int item, int lane) {
    const int b = item >> 4, g = item & 15, fr = lane & 15, fq = lane >> 4, p = lane;
    LAS float* bu = (LAS float*)wl;
    LAS bf16* xs = (LAS bf16*)(wl + 16 * 132 * 4);
    bf16x8 bfr[8];
#pragma unroll
    for (int tau = 0; tau < 8; ++tau) { const int pp = 16 * tau + fr, ps = pp >> 1, c = pp & 1; v4u w = (v4u){0u, 0u, 0u, 0u};
        if (fq < 2) { const float* src = s5p + 2048 + (c ? 16384 : 0) + (size_t)(g * 64 + ps) * 16 + 8 * fq; w.x = pk2(src[0], src[1]); w.y = pk2(src[2], src[3]); w.z = pk2(src[4], src[5]); w.w = pk2(src[6], src[7]); }
        bfr[tau] = __builtin_bit_cast(bf16x8, w); }
    bf16x8 cfr[4];
#pragma unroll
    for (int ks = 0; ks < 4; ++ks) { const int p0 = (32 * ks + 8 * fq) >> 1; const float* r = cre + (size_t)(g * 16 + fr) * 64 + p0; const float* im = cim + (size_t)(g * 16 + fr) * 64 + p0;
        v4u w; w.x = pk2(r[0], -im[0]); w.y = pk2(r[1], -im[1]); w.z = pk2(r[2], -im[2]); w.w = pk2(r[3], -im[3]); cfr[ks] = __builtin_bit_cast(bf16x8, w); }
    const float ar = s5p[g * 64 + p], ai = s5p[1024 + g * 64 + p];
    float dsk[4];
#pragma unroll
    for (int j = 0; j < 4; ++j) dsk[j] = dsk_in[g * 16 + 4 * fq + j];
    float xr = 0.f, xi = 0.f;
    const size_t rowb = (size_t)b * SEQ;
    const bf16* ubase = proj + (rowb + fr) * NPROJ + PC_S5 + g * 16;
    v4u unext = (v4u){0u, 0u, 0u, 0u}; unsigned long long usk_next = 0ull;
    if (fq < 2) unext = *(const GAS v4u*)(ubase + 8 * fq);
    usk_next = *(const GAS unsigned long long*)(ubase + 4 * fq);
    for (int c = 0; c < SEQ / 16; ++c) {
        const v4u ucur = unext; const unsigned long long usk = usk_next;
        if (c + 1 < SEQ / 16) { const bf16* un = ubase + (size_t)(c + 1) * 16 * NPROJ; if (fq < 2) unext = *(const GAS v4u*)(un + 8 * fq); usk_next = *(const GAS unsigned long long*)(un + 4 * fq); }
        const bf16x8 ufr = __builtin_bit_cast(bf16x8, ucur);
#pragma unroll
        for (int tau = 0; tau < 8; ++tau) { f32x4 d = (f32x4){0.f, 0.f, 0.f, 0.f}; d = __builtin_amdgcn_mfma_f32_16x16x32_bf16(bfr[tau], ufr, d, 0, 0, 0);
            *(LAS f32x4*)(bu + fr * 132 + 16 * tau + 4 * fq) = d; }
        LDS_WAIT(); asm volatile("" ::: "memory");
#pragma unroll 4
        for (int t = 0; t < 16; ++t) { const f32x2 bb = *(const LAS f32x2*)(bu + t * 132 + 2 * p);
            const float nr = ar * xr - ai * xi + bb.x, ni = ar * xi + ai * xr + bb.y; xr = nr; xi = ni;
            *(LAS unsigned*)(xs + t * 136 + 2 * p) = pk2(xr, xi); }
        LDS_WAIT(); asm volatile("" ::: "memory");
        f32x4 y = (f32x4){0.f, 0.f, 0.f, 0.f};
#pragma unroll
        for (int ks = 0; ks < 4; ++ks) { const bf16x8 xf = *(const LAS bf16x8*)(xs + fr * 136 + 32 * ks + 8 * fq); y = __builtin_amdgcn_mfma_f32_16x16x32_bf16(cfr[ks], xf, y, 0, 0, 0); }
        const float u4[4] = {__uint_as_float((unsigned)usk << 16), __uint_as_float((unsigned)usk & 0xffff0000u), __uint_as_float((unsigned)(usk >> 32) << 16), __uint_as_float((unsigned)(usk >> 32) & 0xffff0000u)};
        float o[4];
#pragma unroll
        for (int j = 0; j < 4; ++j) o[j] = gelu_tanh(y[j] + dsk[j] * u4[j]);
        *(GAS unsigned long long*)(yg + (rowb + c * 16 + fr) * 256 + g * 16 + 4 * fq) = (unsigned long long)pk2(o[0], o[1]) | ((unsigned long long)pk2(o[2], o[3]) << 32);
        LDS_WAIT(); asm volatile("" ::: "memory");
    }
}
#ifndef PHASE_MASK
#define PHASE_MASK 0xFFFFFFFFu
#endif
#define PH(k) ((PHASE_MASK >> (k)) & 1u)
#ifndef SEQ_REPS
#define SEQ_REPS 1
#endif
#ifndef DOWN_FLIP
#define DOWN_FLIP 0
#endif
#ifndef DOWN_SP2
#define DOWN_SP2 true
#endif
#ifndef DOWN_ALIGN
#define DOWN_ALIGN true
#endif
#ifndef MOBA_NQG
#define MOBA_NQG 4
#endif
struct Args { const float* in[36]; float* out; unsigned char* ws; };
typedef const Args __attribute__((address_space(4))) CArgs;
__device__ __forceinline__ LayerW layer_ptrs(CArgs& a, int l) {
    LayerW L;
    L.ffn1_norm = a.in[3] + (size_t)l * D; L.ffn1_w_gu = a.in[4] + (size_t)l * D * NGU; L.ffn1_w_down = a.in[5] + (size_t)l * FF * D; L.mix_norm = a.in[6] + (size_t)l * D; L.w_in = a.in[7] + (size_t)l * D * NIN_SRC;
    L.gdn_conv = a.in[8] + (size_t)l * 4 * 768; L.gdn_a_log = a.in[9] + l * 4; L.gdn_dt_bias = a.in[10] + l * 4; L.gdn_norm = a.in[11] + l * 64;
    L.mlstm_conv = a.in[12] + (size_t)l * 4 * 512; L.mlstm_i_bias = a.in[13] + l * 4; L.mlstm_f_bias = a.in[14] + l * 4; L.mlstm_norm = a.in[15] + l * 256;
    L.s5_lre = a.in[16] + l * 1024; L.s5_lim = a.in[17] + l * 1024; L.s5_bre = a.in[18] + l * 16384; L.s5_bim = a.in[19] + l * 16384; L.s5_cre = a.in[20] + l * 16384; L.s5_cim = a.in[21] + l * 16384;
    L.s5_d = a.in[22] + l * 256; L.s5_log_dt = a.in[23] + l * 16; L.s5_w_glu = a.in[24] + (size_t)l * 65536; L.s5_b_glu = a.in[25] + l * 256;
    L.w_gate = a.in[26] + (size_t)l * 4 * D * D; L.w_branch = a.in[27] + (size_t)l * 4 * 256 * D; L.w_out = a.in[28] + (size_t)l * D * D;
    L.ffn2_norm = a.in[29] + (size_t)l * D; L.ffn2_w_gu = a.in[30] + (size_t)l * D * NGU; L.ffn2_w_down = a.in[31] + (size_t)l * FF * D;
    L.ple_norm = a.in[32] + (size_t)l * D; L.ple_w_proj = a.in[33] + (size_t)l * PLED * D; L.ple_w_gate = a.in[34] + (size_t)l * D * D;
    return L;
}

__global__ void __launch_bounds__(NWAVES * 64, 2) mk_fwd(Args args_k) {
    (void)args_k;
#define KARGP() ((CArgs*)__builtin_amdgcn_kernarg_segment_ptr())
    extern __shared__ __attribute__((aligned(16))) unsigned char lds_raw[];
    LAS unsigned char* lds = (LAS unsigned char*)lds_raw;
    const int G = gridDim.x;
    for (int u = threadIdx.x; u < (LDS_BYTES - LDSCTL_OFF) / 4; u += NWAVES * 64) ((LAS unsigned*)(lds + LDSCTL_OFF))[u] = 0u;
    __syncthreads();
    (void)xcd_barrier_post((unsigned*)(KARGP()->ws + WS_CTL) + CW_BAR, (volatile LAS unsigned*)(lds + LDSCTL_OFF) + 8);
#define GRID_BAR() do { CArgs* gp_ = KARGP(); asm volatile("" : "+s"(gp_)); unsigned char* bw_ = gp_->ws; asm volatile("" : "+s"(bw_)); XcdBarrier bar_; bar_.bar = (unsigned*)(bw_ + WS_CTL) + CW_BAR; bar_.x = xb_xcc_id(); bar_.st = (volatile LAS unsigned*)(lds + LDSCTL_OFF) + 8; xcd_barrier(bar_); } while (0)
    unsigned gbn = 0;
#define GROUP_BAR() do { ++gbn; CArgs* gq_ = KARGP(); asm volatile("" : "+s"(gq_)); unsigned char* gw_ = gq_->ws; asm volatile("" : "+s"(gw_)); const unsigned gi_ = blockIdx.x & 7u; \
        group_barrier((unsigned*)(gw_ + WS_CTL) + CW_GRP + 64 * gi_, gbn * (((unsigned)G - gi_ + 7u) >> 3)); } while (0)
#define WSP(T, off) ((T*)(wsl + (off)))
#define LAUNDER() CArgs* ap_ = KARGP(); asm volatile("" : "+s"(ap_)); unsigned char* wsl = ap_->ws; asm volatile("" : "+s"(wsl)); int K256 = 256, K1024 = 1024, KFF = FF; asm volatile("" : "+s"(K256), "+s"(K1024), "+s"(KFF)); (void)K256; (void)K1024; (void)KFF; int tid = threadIdx.x; asm volatile("" : "+v"(tid)); const int lane = tid & 63, wave = __builtin_amdgcn_readfirstlane(tid >> 6); (void)lane; (void)wave; int bid = blockIdx.x; asm volatile("" : "+s"(bid)); (void)bid
#define SC_PTR ((LAS float*)(lds + SC_OFF))
#define SC_RESET() do { __syncthreads(); if (tid == 0) *(LAS int*)(lds + SC_OFF + 1024) = -1; __syncthreads(); } while (0)
#define GW (blockIdx.x * NWAVES + wave)
#define NGW (G * NWAVES)

#if PH(0)
#ifdef PROBE_REP0
#pragma nounroll
    for (int rep_ = 0; rep_ < PROBE_REP0; ++rep_)
#endif
    { LAUNDER(); const LayerW L = layer_ptrs(*ap_, 0); const LayerW L1 = layer_ptrs(*ap_, 1);
#ifndef PW_REPS
#define PW_REPS 1
#endif
      for (int rpw_ = 0; rpw_ < PW_REPS; ++rpw_)
      prologue_weights(L, ap_->ws + WS_W, lds, GW, NGW, wave, lane);
      prologue_s5(L, WSP(float, WS_S5P), blockIdx.x * 512 + tid, G * 512);
      prologue_s5(L1, WSP(float, WS_S5P) + 40960, blockIdx.x * 512 + tid, G * 512);
      prologue_rope((const int*)ap_->in[2], (float*)((unsigned char*)ap_->out + OUT_ROPE), (size_t)blockIdx.x * 512 + tid, (size_t)G * 512);
      x_to_hb(ap_->in[0], WSP(bf16, WS_HB), WSP(pg8::rowss_t, WS_ROWSS), GW, NGW, lane); }
    GRID_BAR();
#endif
    const int hb0 = (G >= 256) ? 128 : 0;
    for (int l = 0; l < DEPTH; ++l) {
#define WB(off) ((const pg8::bf16_t*)((l == 0 ? wsl + WS_W : (unsigned char*)ap_->out + OUT_W1) + (off)))
#define HCUR() ((const pg8::bf16_t*)(l == 0 ? wsl + WS_HB : (unsigned char*)ap_->out + OUT_T))
#if PH(1)
#ifndef GU_REPS
#define GU_REPS 1
#endif
        for (int repg_ = 0; repg_ < GU_REPS; ++repg_)
        { LAUNDER(); pg8::Gemm g{HCUR(), WB(W_GU1), M, NGU, K1024, 30, 0}; pg8::StaticOrder S; S.init(M, NGU, G, bid);
          SC_RESET(); pg8::EpiSwiGLU E{WSP(pg8::bf16_t, WS_BIG), WSP(pg8::rowss_t, WS_ROWSS) + (size_t)(4 * l) * M, FF, SC_PTR};
          pg8::gemm_phase<pg8::EpiSwiGLU, pg8::StaticOrder, true, true>(lds + RING_OFF, g, S, E);
          GROUP_BAR(); }
#endif
#if PH(2)
        { LAUNDER(); pg8::Gemm g{WSP(const pg8::bf16_t, WS_BIG), WB(W_D1), M, D, KFF, 30, 0}; pg8::StaticOrder S; S.init(M, D, G, bid);
          pg8::EpiRes E{HCUR(), WSP(pg8::bf16_t, WS_HB), WSP(pg8::rowss_t, WS_ROWSS) + (size_t)(4 * l + 1) * M, 0.5f};
          pg8::gemm_phase<pg8::EpiRes, pg8::StaticOrder, DOWN_ALIGN, DOWN_SP2>(lds + RING_OFF, g, S, E); }
        GRID_BAR();
#endif
#ifdef PROBE_BARS
        for (int pb_ = 0; pb_ < PROBE_BARS; ++pb_) GRID_BAR();
#endif
#if PH(3)
        { LAUNDER(); pg8::Gemm g{WSP(const pg8::bf16_t, WS_HB), WB(W_IN), M, 2560, K1024, 30, 0}; pg8::StaticOrder S; S.init(M, 2560, G, bid);
          SC_RESET(); pg8::EpiMixIn E{WSP(pg8::bf16_t, WS_BIG), WSP(float, WS_SCAL), WSP(pg8::rowss_t, WS_ROWSS) + (size_t)(4 * l + 1) * M, SC_PTR};
          pg8::gemm_phase<pg8::EpiMixIn, pg8::StaticOrder, true, true>(lds + RING_OFF, g, S, E); }
        GRID_BAR();
#endif
#ifdef PROBE_IDLE_US
        { const unsigned long long t0_ = __builtin_amdgcn_s_memrealtime(); while (__builtin_amdgcn_s_memrealtime() - t0_ < (unsigned long long)PROBE_IDLE_US * 100ull) __builtin_amdgcn_s_sleep(32); __syncthreads(); }
#endif
#if PH(5)
        { LAUNDER(); const LayerW L = layer_ptrs(*ap_, l);
          for (int rep_ = 0; rep_ < SEQ_REPS; ++rep_)
          for (int it = blockIdx.x; it < 64; it += G) seq_mixer2<true>(WSP(const bf16, WS_BIG), WSP(const float, WS_SCAL), L.gdn_conv, L.gdn_a_log, L.gdn_dt_bias, L.gdn_norm, WSP(bf16, WS_Y), lds, it, tid); }
#endif
#if PH(6)
        { LAUNDER(); const LayerW L = layer_ptrs(*ap_, l);
          for (int rep_ = 0; rep_ < SEQ_REPS; ++rep_)
          for (int it = blockIdx.x; it < 64 + 64; it += G) if (it >= 64) seq_mixer2<false>(WSP(const bf16, WS_BIG), WSP(const float, WS_SCAL), L.mlstm_conv, L.mlstm_i_bias, L.mlstm_f_bias, L.mlstm_norm, WSP(bf16, WS_Y) + (size_t)M * 256, lds, it - 64, tid); }
#endif
#if PH(15)
        const int gb0 = (G >= 256) ? hb0 + 32 : hb0;
        if ((int)blockIdx.x >= gb0) {
          { LAUNDER(); pg8::Gemm g{WSP(const pg8::bf16_t, WS_HB), WB(W_IN + (size_t)2560 * D * 2), M, 768, K1024, 30, 0}; pg8::StaticOrder S; S.init(M, 768, G - gb0, bid - gb0);
            pg8::EpiMoba E{WSP(pg8::bf16_t, WS_BIG), WSP(pg8::bf16_t, WS_VT), WSP(float, WS_KMEAN) + (size_t)l * 32768, (const float*)((unsigned char*)ap_->out + OUT_ROPE), WSP(pg8::rowss_t, WS_ROWSS) + (size_t)(4 * l + 1) * M};
            pg8::gemm_phase<pg8::EpiMoba, pg8::StaticOrder, true, true>(lds + RING_OFF, g, S, E);
            asm volatile("s_waitcnt vmcnt(0)" ::: "memory"); __syncthreads();
            if (tid == 0) { __builtin_amdgcn_fence(__ATOMIC_RELEASE, "agent"); asm volatile("s_waitcnt vmcnt(0)" ::: "memory"); __hip_atomic_fetch_add(WSP(unsigned, WS_CTL) + CW_FLAG + 64 * l, 1u, RLX_AGENT); } }
          { LAUNDER(); const int nh = G - gb0, c0 = (int)blockIdx.x - gb0;
            for (int pm = c0; pm < M / 256; pm += nh) cvt_rows_bf16(ap_->in[1] + ((size_t)l * M + (size_t)pm * 256) * PLED, WSP(bf16, WS_PB) + (size_t)pm * 256 * PLED, (size_t)256 * PLED, (size_t)tid, (size_t)512);
            asm volatile("s_waitcnt vmcnt(0)" ::: "memory"); __syncthreads();
            pg8::Gemm g{WSP(const pg8::bf16_t, WS_PB), WB(W_PLE), M, D, K256, 30, 0}; pg8::PanelOrder S{c0, nh, M / 256, 4};
            pg8::EpiBf16P E{(pg8::bf16_t*)((unsigned char*)ap_->out + OUT_T), D};
            pg8::gemm_phase<pg8::EpiBf16P, pg8::PanelOrder, true, true>(lds + RING_OFF, g, S, E); }
          __syncthreads();
          const int wb0 = gb0;
          if (l == 0 && (int)blockIdx.x >= wb0) { LAUNDER(); const LayerW L1 = layer_ptrs(*ap_, 1);
            prologue_weights(L1, (unsigned char*)ap_->out + OUT_W1, lds, ((int)blockIdx.x - wb0) * NWAVES + wave, (G - wb0) * NWAVES, wave, lane); }
        }
#endif
#if PH(7)
        { LAUNDER(); const LayerW L = layer_ptrs(*ap_, l); const int c0 = (int)blockIdx.x - hb0;
#ifndef S5_REPS
#define S5_REPS 1
#endif
          for (int rep5_ = 0; rep5_ < S5_REPS; ++rep5_)
          if (c0 >= 0) for (int it = c0; it < 32; it += G - hb0)
              s5_wave_mfma(WSP(const bf16, WS_BIG), WSP(const float, WS_S5P) + 40960 * l, L.s5_cre, L.s5_cim, L.s5_d, WSP(bf16, WS_YG), lds + wave * WAVE_LDS, it * 8 + wave, lane); }
        if (G >= 256 && (int)blockIdx.x >= hb0 && (int)blockIdx.x < hb0 + 32) {
          LAUNDER(); const int c0 = (int)blockIdx.x - hb0; unsigned* f5 = WSP(unsigned, WS_CTL) + CW_S5F + (l * 16 + (c0 >> 1)) * 64;
          asm volatile("s_waitcnt vmcnt(0)" ::: "memory"); __syncthreads();
          if (tid == 0) { __builtin_amdgcn_fence(__ATOMIC_RELEASE, "agent"); asm volatile("s_waitcnt vmcnt(0)" ::: "memory"); __hip_atomic_fetch_add(f5, 1u, RLX_AGENT);
              unsigned sp = 0; while (__hip_atomic_load(f5, RLX_AGENT) < 2u) { __builtin_amdgcn_s_sleep(2); if (++sp > (1u << 22)) break; } }
          __syncthreads();
          __builtin_amdgcn_fence(__ATOMIC_ACQUIRE, "agent"); asm volatile("s_waitcnt vmcnt(0)" ::: "memory");
          const int p0 = 8 * (c0 >> 1) + 4 * (c0 & 1);
          pg8::Gemm g{WSP(const pg8::bf16_t, WS_YG), WB(W_GLU), M, 256, K256, 30, 0}; pg8::PanelOrder S{p0, 1, p0 + 4, 1};
          pg8::EpiGLU E{WSP(const pg8::bf16_t, WS_YG), WSP(pg8::bf16_t, WS_Y) + (size_t)2 * M * 256, ap_->in[25] + l * 256};
          pg8::gemm_phase<pg8::EpiGLU, pg8::PanelOrder, true, true>(lds + RING_OFF, g, S, E); }
#endif
#if PH(8)
        { LAUNDER(); unsigned* flag = WSP(unsigned, WS_CTL) + CW_FLAG + 64 * l; const unsigned need = (unsigned)(G - gb0);
          __syncthreads();
          if (tid == 0) { unsigned sp = 0; while (__hip_atomic_load(flag, RLX_AGENT) < need) { __builtin_amdgcn_s_sleep(2); if (++sp > (1u << 22)) break; } }
          __syncthreads();
          __builtin_amdgcn_fence(__ATOMIC_ACQUIRE, "agent"); asm volatile("s_waitcnt vmcnt(0)" ::: "memory");
          unsigned* qctr = WSP(unsigned, WS_CTL) + CW_QUEUE + 64 * l;
          for (;;) { unsigned idx = 0; if (lane == 0) idx = __hip_atomic_fetch_add(qctr, 1u, RLX_AGENT); idx = __builtin_amdgcn_readfirstlane(idx);
              if (idx >= 8192u / MOBA_NQG) break;
              const int qsl = idx & (16 / MOBA_NQG - 1), bh = (idx / (16 / MOBA_NQG)) & 63, qb = 7 - (int)(idx / (1024 / MOBA_NQG));
              moba_mfma_item<MOBA_NQG>(WSP(const bf16, WS_BIG), WSP(const float, WS_KMEAN) + (size_t)l * 32768, WSP(const bf16, WS_VT), WSP(bf16, WS_Y) + (size_t)3 * M * 256, bh, qb, qsl, lane); } }
#endif
        GRID_BAR();
#if PH(11)
#ifndef G11_REPS
#define G11_REPS 1
#endif
        for (int rep11_ = 0; rep11_ < G11_REPS; ++rep11_)
        { LAUNDER(); pg8::StaticOrder S0; S0.init(M, NGATE, G, bid);
          pg8::Gemm g{WSP(const pg8::bf16_t, WS_HB), WB(W_GATE), M, NGATE, K1024, 30, 0};
          pg8::EpiGateP E{WSP(const pg8::bf16_t, WS_Y), WB(W_BR), WSP(pg8::bf16_t, WS_BIG + 184 * MiB), WSP(pg8::rowss_t, WS_ROWSS) + (size_t)(4 * l + 1) * M, (size_t)M * 256};
#pragma nounroll
          for (int r = 0; ; ++r) { pg8::OneUnit S1; if (!S0.next(r, S1.u)) break;
              pg8::gemm_phase<pg8::EpiGateP, pg8::OneUnit, false, true>(lds + RING_OFF, g, S1, E);
              __syncthreads(); }
          GROUP_BAR(); }
#endif
#if PH(12)
#ifndef OUT_REPS
#define OUT_REPS 1
#endif
        for (int rep12_ = 0; rep12_ < OUT_REPS; ++rep12_)
        { LAUNDER(); pg8::Gemm g{WSP(const pg8::bf16_t, WS_BIG + 184 * MiB), WB(W_OUT), M, D, K1024, 30, 0}; pg8::StaticOrder S; S.init(M, D, G, bid);
          const bool real_ = (rep12_ + 1 == OUT_REPS);
          pg8::EpiRes E{WSP(const pg8::bf16_t, WS_HB), real_ ? WSP(pg8::bf16_t, WS_HB) : WSP(pg8::bf16_t, WS_BIG + 128 * MiB), real_ ? WSP(pg8::rowss_t, WS_ROWSS) + (size_t)(4 * l + 2) * M : WSP(pg8::rowss_t, WS_BIG + 200 * MiB), 1.0f};
          pg8::gemm_phase<pg8::EpiRes, pg8::StaticOrder, true, true>(lds + RING_OFF, g, S, E);
          GROUP_BAR(); }
#endif
#if PH(13)
#ifndef GU_REPS
#define GU_REPS 1
#endif
        for (int repg_ = 0; repg_ < GU_REPS; ++repg_)
        { LAUNDER(); pg8::Gemm g{WSP(const pg8::bf16_t, WS_HB), WB(W_GU2), M, NGU, K1024, 30, 0}; pg8::StaticOrder S; S.init(M, NGU, G, bid);
          SC_RESET(); pg8::EpiSwiGLU E{WSP(pg8::bf16_t, WS_BIG), WSP(pg8::rowss_t, WS_ROWSS) + (size_t)(4 * l + 2) * M, FF, SC_PTR};
          pg8::gemm_phase<pg8::EpiSwiGLU, pg8::StaticOrder, true, true>(lds + RING_OFF, g, S, E);
          GROUP_BAR(); }
#endif
#if PH(14)
#ifndef DOWN_REPS
#define DOWN_REPS 1
#endif
        for (int rep14_ = 0; rep14_ < DOWN_REPS; ++rep14_)
        { LAUNDER(); pg8::Gemm g{WSP(const pg8::bf16_t, WS_BIG), WB(W_D2), M, D, KFF, 30, 0}; pg8::StaticOrder S; S.init(M, D, G, bid);
          const bool real_ = (rep14_ + 1 == DOWN_REPS);
          pg8::EpiRes E{WSP(const pg8::bf16_t, WS_HB), real_ ? WSP(pg8::bf16_t, WS_HB) : WSP(pg8::bf16_t, WS_BIG + 184 * MiB), real_ ? WSP(pg8::rowss_t, WS_ROWSS) + (size_t)(4 * l + 3) * M : WSP(pg8::rowss_t, WS_BIG + 250 * MiB), 0.5f};
          pg8::gemm_phase<pg8::EpiRes, pg8::StaticOrder, DOWN_ALIGN, DOWN_SP2>(lds + RING_OFF, g, S, E);
          GROUP_BAR(); }
#endif
#if PH(16)
#ifndef PLE_REPS
#define PLE_REPS 1
#endif
        for (int rep16_ = 0; rep16_ < PLE_REPS; ++rep16_)
        { LAUNDER(); pg8::Gemm g{WSP(const pg8::bf16_t, WS_HB), WB(W_PG), M, D, K1024, 30, 0}; pg8::StaticOrder S; S.init(M, D, G, bid);
          const bool real_ = (rep16_ + 1 == PLE_REPS);
          pg8::EpiPle E{WSP(const pg8::bf16_t, WS_HB), (const pg8::bf16_t*)((unsigned char*)ap_->out + OUT_T), !real_ ? WSP(pg8::bf16_t, WS_BIG + 128 * MiB) : l == 0 ? (pg8::bf16_t*)((unsigned char*)ap_->out + OUT_T) : WSP(pg8::bf16_t, WS_BIG + 184 * MiB),
                        WSP(pg8::rowss_t, WS_ROWSS) + (size_t)(4 * l + 3) * M, real_ ? WSP(pg8::rowss_t, WS_ROWSS) + (size_t)(4 * l + 4) * M : WSP(pg8::rowss_t, WS_BIG + 200 * MiB)};
          pg8::gemm_phase<pg8::EpiPle, pg8::StaticOrder, true, true>(lds + RING_OFF, g, S, E);
          if (l + 1 < DEPTH) GROUP_BAR(); else GRID_BAR(); }
#endif
    }
#if PH(17)
#ifdef PROBE_REP0
#pragma nounroll
    for (int rep_ = 0; rep_ < PROBE_REP0; ++rep_)
#endif
    { LAUNDER(); final_norm(WSP(const bf16, WS_BIG + 184 * MiB), ap_->out, WSP(pg8::rowss_t, WS_ROWSS) + (size_t)8 * M, ap_->in[35], GW, NGW, lane); }
#endif
}

extern "C" void kernel_launch(void* const* d_in, const int* in_sizes, int n_in, void* d_out, int out_size, void* d_ws, size_t ws_size, hipStream_t stream) {
    static int grid = 0;
    if (grid == 0) {
        if (n_in != 36 || out_size != M * D || ws_size < WS_END) { fprintf(stderr, "kernel_launch: unexpected shapes (n_in %d, out %d, ws %zu); nothing launched\n", n_in, out_size, ws_size); grid = -1; return; }
        int dev = 0, cus = 0, per_cu = 0;
        if (hipGetDevice(&dev) != hipSuccess || hipDeviceGetAttribute(&cus, hipDeviceAttributeMultiprocessorCount, dev) != hipSuccess) { grid = -1; return; }
        if (hipFuncSetAttribute((const void*)mk_fwd, hipFuncAttributeMaxDynamicSharedMemorySize, LDS_BYTES) != hipSuccess) { fprintf(stderr, "kernel_launch: hipFuncSetAttribute failed\n"); grid = -1; return; }
        if (hipOccupancyMaxActiveBlocksPerMultiprocessor(&per_cu, (const void*)mk_fwd, NWAVES * 64, LDS_BYTES) != hipSuccess || per_cu < 1) { fprintf(stderr, "kernel_launch: occupancy query says %d\n", per_cu); per_cu = 1; }
        (void)hipGetLastError();
        if (cus < 256) { fprintf(stderr, "kernel_launch: %d CUs; the mixer phase's workgroup roles need 256; nothing launched\n", cus); grid = -1; return; }
        grid = 256;
    }
    if (grid < 0) return;
    if (hipMemsetAsync((char*)d_ws + WS_CTL, 0, CTL_ZERO_BYTES, stream) != hipSuccess) return;
    Args a{};
    for (int i = 0; i < 36; ++i) a.in[i] = (const float*)d_in[i];
    a.out = (float*)d_out; a.ws = (unsigned char*)d_ws;
    hipLaunchKernelGGL(mk_fwd, dim3(grid), dim3(NWAVES * 64), LDS_BYTES, stream, a);
}
```

```cpp
#include <hip/hip_runtime.h>
#include <cstdio>
#include <cstdint>
namespace pg8 {
#define PG8_LAS __attribute__((address_space(3)))
typedef unsigned short bf16_t;
typedef short bf16x8 __attribute__((ext_vector_type(8)));
typedef float f32x4 __attribute__((ext_vector_type(4)));
typedef unsigned u32x4 __attribute__((ext_vector_type(4)));
constexpr int BM = 256, BK = 64, HALF = 128, HTB = HALF * BK * 2  , STAGE_BYTES = 8 * HTB, NXCD = 8, WGM = 8;

__host__ __device__ __forceinline__ int lds_byte(int r, int c) { const int st = (r >> 4) * 2 + (c >> 5), rr = r & 15, cc = c & 31, ob = rr * 64 + cc * 2; return st * 1024 + (ob ^ (((ob >> 9) & 1) << 5)); }
__host__ __device__ __forceinline__ void stage_rc(int b, int& R, int& C) { const int st = b / 1024, sb = b % 1024, swz = sb ^ (((sb >> 9) & 1) << 5); R = (st >> 1) * 16 + swz / 64; C = (st & 1) * 32 + (swz % 64) / 2; }
__host__ __device__ __forceinline__ int perm32(int rho) { const int n = rho >> 4, i = rho & 15; return 8 * (i >> 2) + 4 * n + (i & 3); }

struct Unit { int pm, pn; };
struct Gemm { const bf16_t* A; const bf16_t* Bt; int M, N, K; int ashift; size_t astride; };

struct StaticOrder {
    int nM, nN, nwg, G, c;
    __host__ __device__ __forceinline__ void init(int M, int N, int G_, int c_) { nM = M / BM; nN = N / BM; nwg = nM * nN; G = G_; c = c_; }
    __host__ __device__ __forceinline__ bool next(int i, Unit& u) const {
        const long L = (long)i * G + c; if (L >= nwg) return false;
        int wgid = (int)L; { const int q = nwg / NXCD, r = nwg % NXCD, xcd = wgid % NXCD, off = wgid / NXCD; wgid = (xcd < r ? xcd * (q + 1) : r * (q + 1) + (xcd - r) * q) + off; }
        const int nig = WGM * nN, gid = wgid / nig, fm = gid * WGM, gsz = (nM - fm) < WGM ? (nM - fm) : WGM;
        u.pm = fm + ((wgid % nig) % gsz); u.pn = (wgid % nig) / gsz; return true;
    }
    __device__ __forceinline__ void a_ready(const Unit&) const {}
    __device__ __forceinline__ void done(const Unit&) const {}
};
struct PanelOrder {
    int pm0, stride, nM, nN;
    __host__ __device__ __forceinline__ bool next(int i, Unit& u) const { const int p = pm0 + (i / nN) * stride; if (p >= nM) return false; u.pm = p; u.pn = i % nN; return true; }
    __device__ __forceinline__ void a_ready(const Unit&) const {}
    __device__ __forceinline__ void done(const Unit&) const {}
};
struct OneUnit {
    Unit u;
    __host__ __device__ __forceinline__ bool next(int i, Unit& o) const { if (i != 0) return false; o = u; return true; }
    __device__ __forceinline__ void a_ready(const Unit&) const {}
    __device__ __forceinline__ void done(const Unit&) const {}
};

typedef unsigned u32x2 __attribute__((ext_vector_type(2)));
__device__ __forceinline__ unsigned cvt_pk_bf16(float lo, float hi) { unsigned r; asm volatile("v_cvt_pk_bf16_f32 %0, %1, %2" : "=v"(r) : "v"(lo), "v"(hi)); return r; }
__device__ __forceinline__ unsigned cvt_pk_bf16_t(float lo, float hi) { unsigned r; asm volatile("s_nop 1\n\tv_cvt_pk_bf16_f32 %0, %1, %2" : "=v"(r) : "v"(lo), "v"(hi)); return r; }
__device__ __forceinline__ float bf_lo(unsigned w) { return __uint_as_float(w << 16); }
__device__ __forceinline__ float bf_hi(unsigned w) { return __uint_as_float(w & 0xffff0000u); }
__device__ __forceinline__ float sigm(float x) { return __builtin_amdgcn_rcpf(1.0f + __expf(-x)); }
__device__ __forceinline__ float silu(float x) { return x * sigm(x); }
constexpr float RMS_EPS = 1e-6f;
typedef unsigned long long rowss_t;
constexpr float RSS_SCALE = 16777216.0f;
__device__ __forceinline__ float rms_scale(const rowss_t* rowss, int row) { return rsqrtf((float)rowss[row] * (1.0f / (1024.0f * RSS_SCALE)) + RMS_EPS); }
__device__ __forceinline__ void rowss_add(rowss_t* p, float ss) { __hip_atomic_fetch_add(p, (rowss_t)(ss * RSS_SCALE), __ATOMIC_RELAXED, __HIP_MEMORY_SCOPE_AGENT); }
__device__ __forceinline__ u32x4 pack8(const f32x4 a, const f32x4 b) { u32x4 w; w.x = cvt_pk_bf16(a[0], a[1]); w.y = cvt_pk_bf16(a[2], a[3]); w.z = cvt_pk_bf16(b[0], b[1]); w.w = cvt_pk_bf16(b[2], b[3]); return w; }

#define EPI_ROW(ai, m) (row0 + (ai) * HALF + (m) * 16)
__device__ __forceinline__ void load_scales(const rowss_t* rowss, int row0, float (&r)[8]) {
    rowss_t v[8];
#pragma unroll
    for (int g = 0; g < 8; ++g) v[g] = rowss[EPI_ROW(g >> 2, g & 3)];
#pragma unroll
    for (int g = 0; g < 8; ++g) r[g] = rsqrtf((float)v[g] * (1.0f / (1024.0f * RSS_SCALE)) + RMS_EPS);
}
struct EpiSwiGLU {
    static constexpr bool PERM = true, AFTER_DRAIN = false;
    bf16_t* act; const rowss_t* rowss; int ldc;
    __device__ __forceinline__ void operator()(const f32x4 (&acc)[2][2][4][2], const Unit& u, int wr, int wc, int fr, int fq) const {
        const int row0 = u.pm * BM + wr * 64 + fr, col0 = u.pn * 128 + wc * 32 + 8 * fq;
        float rs[8]; load_scales(rowss, row0, rs);
#pragma unroll
        for (int ai = 0; ai < 2; ++ai)
#pragma unroll
            for (int m = 0; m < 4; ++m) { const int row = EPI_ROW(ai, m); const float r = rs[ai * 4 + m];
                f32x4 o0, o1;
#pragma unroll
                for (int e = 0; e < 4; ++e) { o0[e] = silu(acc[ai][0][m][0][e] * r) * (acc[ai][1][m][0][e] * r); o1[e] = silu(acc[ai][0][m][1][e] * r) * (acc[ai][1][m][1][e] * r); }
                *(u32x4*)(act + (size_t)row * ldc + col0) = pack8(o0, o1); }
    }
};
struct EpiBf16P {
    static constexpr bool PERM = true, AFTER_DRAIN = false;
    bf16_t* O; int ldc;
    __device__ __forceinline__ void operator()(const f32x4 (&acc)[2][2][4][2], const Unit& u, int wr, int wc, int fr, int fq) const {
        const int row0 = u.pm * BM + wr * 64 + fr, col0 = u.pn * BM + wc * 32 + 8 * fq;
#pragma unroll
        for (int ai = 0; ai < 2; ++ai)
#pragma unroll
            for (int m = 0; m < 4; ++m) { bf16_t* rowp = O + (size_t)EPI_ROW(ai, m) * ldc + col0;
#pragma unroll
                for (int bj = 0; bj < 2; ++bj) *(u32x4*)(rowp + bj * HALF) = pack8(acc[ai][bj][m][0], acc[ai][bj][m][1]); }
    }
};
__device__ __forceinline__ void unpack8(const u32x4 w, f32x4& a, f32x4& b) { a[0] = bf_lo(w.x); a[1] = bf_hi(w.x); a[2] = bf_lo(w.y); a[3] = bf_hi(w.y); b[0] = bf_lo(w.z); b[1] = bf_hi(w.z); b[2] = bf_lo(w.w); b[3] = bf_hi(w.w); }
__device__ __forceinline__ float sumsq8(const f32x4 v0, const f32x4 v1) { return (v0[0] * v0[0] + v0[1] * v0[1]) + (v0[2] * v0[2] + v0[3] * v0[3]) + (v1[0] * v1[0] + v1[1] * v1[1]) + (v1[2] * v1[2] + v1[3] * v1[3]); }
struct EpiRes {
    static constexpr bool PERM = true, AFTER_DRAIN = false;
    const bf16_t* base; bf16_t* hb; rowss_t* rowss_next; float scale;
    __device__ __forceinline__ void operator()(const f32x4 (&acc)[2][2][4][2], const Unit& u, int wr, int wc, int fr, int fq) const {
        const int row0 = u.pm * BM + wr * 64 + fr, col0 = u.pn * BM + wc * 32 + 8 * fq;
#pragma unroll
        for (int ai = 0; ai < 2; ++ai) {
            u32x4 bw[4][2];
#pragma unroll
            for (int m = 0; m < 4; ++m)
#pragma unroll
                for (int bj = 0; bj < 2; ++bj) bw[m][bj] = *(const u32x4*)(base + (size_t)EPI_ROW(ai, m) * 1024 + col0 + bj * HALF);
#pragma unroll
            for (int m = 0; m < 4; ++m) { const int row = EPI_ROW(ai, m); const size_t off = (size_t)row * 1024 + col0; float ss = 0.f;
#pragma unroll
                for (int bj = 0; bj < 2; ++bj) { f32x4 b0, b1; unpack8(bw[m][bj], b0, b1);
                    const f32x4 v0 = b0 + acc[ai][bj][m][0] * scale, v1 = b1 + acc[ai][bj][m][1] * scale;
                    *(u32x4*)(hb + off + bj * HALF) = pack8(v0, v1); ss += sumsq8(v0, v1); }
                ss += __shfl_xor(ss, 16); ss += __shfl_xor(ss, 32);
                if (fq == 0) rowss_add(rowss_next + row, ss); }
            asm volatile("" ::: "memory"); }
    }
};
struct EpiMixIn {
    static constexpr bool PERM = true, AFTER_DRAIN = false;
    bf16_t* proj; float* scal; const rowss_t* rowss;
    __device__ __forceinline__ void operator()(const f32x4 (&acc)[2][2][4][2], const Unit& u, int wr, int wc, int fr, int fq) const {
        const int row0 = u.pm * BM + wr * 64 + fr;
        float rs[8]; load_scales(rowss, row0, rs);
        if (u.pn < 9) { const int col0 = u.pn * BM + wc * 32 + 8 * fq;
#pragma unroll
            for (int ai = 0; ai < 2; ++ai)
#pragma unroll
                for (int m = 0; m < 4; ++m) { const float r = rs[ai * 4 + m]; bf16_t* rowp = proj + (size_t)EPI_ROW(ai, m) * 3072 + col0;
#pragma unroll
                    for (int bj = 0; bj < 2; ++bj) *(u32x4*)(rowp + bj * HALF) = pack8(acc[ai][bj][m][0] * r, acc[ai][bj][m][1] * r); }
        } else if (wc == 0 && fq < 2) {
#pragma unroll
            for (int ai = 0; ai < 2; ++ai)
#pragma unroll
                for (int m = 0; m < 4; ++m) { const float r = rs[ai * 4 + m]; float* rowp = scal + (size_t)EPI_ROW(ai, m) * 16 + 8 * fq;
                    *(f32x4*)(rowp) = acc[ai][0][m][0] * r; *(f32x4*)(rowp + 4) = acc[ai][0][m][1] * r; }
        }
    }
};
struct EpiGateMerge {
    static constexpr bool PERM = false, AFTER_DRAIN = false;
    const bf16_t* P; bf16_t* merged; const rowss_t* rowss;
    __device__ __forceinline__ void operator()(const f32x4 (&acc)[2][2][4][2], const Unit& u, int wr, int wc, int fr, int fq) const {
        const int row0 = u.pm * BM + wr * 64 + fr, j0 = u.pn * 64 + wc * 16 + 4 * fq;
        float rs[8]; load_scales(rowss, row0, rs);
#pragma unroll
        for (int ai = 0; ai < 2; ++ai) {
            u32x2 pw[4][4];
#pragma unroll
            for (int m = 0; m < 4; ++m)
#pragma unroll
                for (int b = 0; b < 4; ++b) pw[m][b] = *(const u32x2*)(P + (size_t)EPI_ROW(ai, m) * 4096 + j0 + b * 1024);
#pragma unroll
            for (int m = 0; m < 4; ++m) { const float r = rs[ai * 4 + m];
                f32x4 s = (f32x4){0.f, 0.f, 0.f, 0.f};
#pragma unroll
                for (int bj = 0; bj < 2; ++bj)
#pragma unroll
                    for (int n = 0; n < 2; ++n) { const u32x2 pv = pw[m][2 * bj + n]; const f32x4 a = acc[ai][bj][m][n];
                        s[0] += sigm(a[0] * r) * bf_lo(pv.x); s[1] += sigm(a[1] * r) * bf_hi(pv.x); s[2] += sigm(a[2] * r) * bf_lo(pv.y); s[3] += sigm(a[3] * r) * bf_hi(pv.y); }
                u32x2 w; w.x = cvt_pk_bf16(s[0], s[1]); w.y = cvt_pk_bf16(s[2], s[3]); *(u32x2*)(merged + (size_t)EPI_ROW(ai, m) * 1024 + j0) = w; }
            asm volatile("" ::: "memory"); }
    }
};
struct EpiGateMergeAD {
    static constexpr bool PERM = false, AFTER_DRAIN = true;
    const bf16_t* P; bf16_t* merged; const rowss_t* rowss;
    __device__ __forceinline__ void fused(f32x4 (&acc)[2][2][4][2], const Unit& u, int wr, int wc, int fr, int fq, PG8_LAS unsigned char* lds, int wid, int lane) const {
        const int row0 = u.pm * BM + wr * 64 + fr, j0 = u.pn * 64 + wc * 16 + 4 * fq;
        float rs[8]; load_scales(rowss, row0, rs);
#ifdef AD_BARS
#pragma unroll
        for (int s = 0; s < 16; ++s) { asm volatile("s_waitcnt vmcnt(0) lgkmcnt(0)" ::: "memory"); __builtin_amdgcn_s_barrier(); asm volatile("" ::: "memory"); }
#endif

        u32x2 gp[2][2][4][2];
#pragma unroll
        for (int ai = 0; ai < 2; ++ai)
#pragma unroll
            for (int bj = 0; bj < 2; ++bj)
#pragma unroll
                for (int m = 0; m < 4; ++m)
#pragma unroll
                    for (int n = 0; n < 2; ++n) { const float r = rs[ai * 4 + m]; const f32x4 a = acc[ai][bj][m][n];
                        gp[ai][bj][m][n].x = cvt_pk_bf16_t(sigm(a[0] * r), sigm(a[1] * r)); gp[ai][bj][m][n].y = cvt_pk_bf16_t(sigm(a[2] * r), sigm(a[3] * r));
                        acc[ai][bj][m][n] = (f32x4){0.f, 0.f, 0.f, 0.f}; }
#pragma unroll
        for (int ai = 0; ai < 2; ++ai) {
            u32x2 pw[4][4];
#pragma unroll
            for (int m = 0; m < 4; ++m)
#pragma unroll
                for (int b = 0; b < 4; ++b) pw[m][b] = *(const u32x2*)(P + (size_t)EPI_ROW(ai, m) * 4096 + j0 + b * 1024);
#pragma unroll
            for (int m = 0; m < 4; ++m) {
                f32x4 s = (f32x4){0.f, 0.f, 0.f, 0.f};
#pragma unroll
                for (int bj = 0; bj < 2; ++bj)
#pragma unroll
                    for (int n = 0; n < 2; ++n) { const u32x2 pv = pw[m][2 * bj + n]; const u32x2 g = gp[ai][bj][m][n];
                        s[0] += bf_lo(g.x) * bf_lo(pv.x); s[1] += bf_hi(g.x) * bf_hi(pv.x); s[2] += bf_lo(g.y) * bf_lo(pv.y); s[3] += bf_hi(g.y) * bf_hi(pv.y); }
                u32x2 w; w.x = cvt_pk_bf16(s[0], s[1]); w.y = cvt_pk_bf16(s[2], s[3]); *(u32x2*)(merged + (size_t)EPI_ROW(ai, m) * 1024 + j0) = w; }
            asm volatile("" ::: "memory"); }
    }
};
struct EpiGLU {
    static constexpr bool PERM = true, AFTER_DRAIN = false;
    const bf16_t* yg; bf16_t* out; const float* bias;
    __device__ __forceinline__ void operator()(const f32x4 (&acc)[2][2][4][2], const Unit& u, int wr, int wc, int fr, int fq) const {
        const int row0 = u.pm * BM + wr * 64 + fr, col0 = u.pn * BM + wc * 32 + 8 * fq;
        f32x4 bb[2][2];
#pragma unroll
        for (int bj = 0; bj < 2; ++bj) { bb[bj][0] = *(const f32x4*)(bias + col0 + bj * HALF); bb[bj][1] = *(const f32x4*)(bias + col0 + bj * HALF + 4); }
#pragma unroll
        for (int ai = 0; ai < 2; ++ai) {
            u32x4 yw[4][2];
#pragma unroll
            for (int m = 0; m < 4; ++m)
#pragma unroll
                for (int bj = 0; bj < 2; ++bj) yw[m][bj] = *(const u32x4*)(yg + (size_t)EPI_ROW(ai, m) * 256 + col0 + bj * HALF);
#pragma unroll
            for (int m = 0; m < 4; ++m) { const size_t off = (size_t)EPI_ROW(ai, m) * 256 + col0;
#pragma unroll
                for (int bj = 0; bj < 2; ++bj) { f32x4 y0, y1; unpack8(yw[m][bj], y0, y1); const f32x4 a0 = acc[ai][bj][m][0] + bb[bj][0], a1 = acc[ai][bj][m][1] + bb[bj][1]; f32x4 o0, o1;
#pragma unroll
                    for (int e = 0; e < 4; ++e) { o0[e] = y0[e] * sigm(a0[e]); o1[e] = y1[e] * sigm(a1[e]); }
                    *(u32x4*)(out + off + bj * HALF) = pack8(o0, o1); } }
            asm volatile("" ::: "memory"); }
    }
};
struct EpiPle {
    static constexpr bool PERM = true, AFTER_DRAIN = false;
    const bf16_t* h; const bf16_t* T; bf16_t* hout; const rowss_t* rowss; rowss_t* rowss_next;
    __device__ __forceinline__ void operator()(const f32x4 (&acc)[2][2][4][2], const Unit& u, int wr, int wc, int fr, int fq) const {
        const int row0 = u.pm * BM + wr * 64 + fr, col0 = u.pn * BM + wc * 32 + 8 * fq;
        float rs[8]; load_scales(rowss, row0, rs);
#pragma unroll
        for (int ai = 0; ai < 2; ++ai)
#pragma unroll
          for (int mh = 0; mh < 2; ++mh) {
            u32x4 bw[2][2], tw[2][2];
#pragma unroll
            for (int mm = 0; mm < 2; ++mm)
#pragma unroll
                for (int bj = 0; bj < 2; ++bj) { const size_t off = (size_t)EPI_ROW(ai, 2 * mh + mm) * 1024 + col0 + bj * HALF; bw[mm][bj] = *(const u32x4*)(h + off); tw[mm][bj] = *(const u32x4*)(T + off); }
#pragma unroll
            for (int mm = 0; mm < 2; ++mm) { const int m = 2 * mh + mm; const int row = EPI_ROW(ai, m); const float r = rs[ai * 4 + m]; const size_t off = (size_t)row * 1024 + col0; float ss = 0.f;
#pragma unroll
                for (int bj = 0; bj < 2; ++bj) { f32x4 b0, b1, t0, t1; unpack8(bw[mm][bj], b0, b1); unpack8(tw[mm][bj], t0, t1);
                    const f32x4 a0 = acc[ai][bj][m][0] * r, a1 = acc[ai][bj][m][1] * r; f32x4 v0, v1;
#pragma unroll
                    for (int e = 0; e < 4; ++e) { v0[e] = b0[e] + t0[e] * sigm(a0[e]); v1[e] = b1[e] + t1[e] * sigm(a1[e]); }
                    *(u32x4*)(hout + off + bj * HALF) = pack8(v0, v1); ss += sumsq8(v0, v1); }
                ss += __shfl_xor(ss, 16); ss += __shfl_xor(ss, 32);
                if (fq == 0) rowss_add(rowss_next + row, ss); }
            asm volatile("" ::: "memory"); }
    }
};

__device__ __forceinline__ float dpp_row_xor(float v, int step) {
    const int x = __float_as_int(v); int r;
    switch (step) { case 0: r = __builtin_amdgcn_update_dpp(0, x, 0xB1, 0xF, 0xF, true); break; case 1: r = __builtin_amdgcn_update_dpp(0, x, 0x4E, 0xF, 0xF, true); break;
                    case 2: r = __builtin_amdgcn_update_dpp(0, x, 0x141, 0xF, 0xF, true); break; default: r = __builtin_amdgcn_update_dpp(0, x, 0x140, 0xF, 0xF, true); break; }
    return __int_as_float(r);
}
struct EpiMoba {
    static constexpr bool PERM = true, AFTER_DRAIN = false;
    bf16_t* proj; bf16_t* vt; float* kmean; const float* rope; const rowss_t* rowss;
    __device__ __forceinline__ void operator()(const f32x4 (&acc)[2][2][4][2], const Unit& u, int wr, int wc, int fr_in, int fq_in) const {
        int fr = fr_in, fq = fq_in; asm volatile("" : "+v"(fr), "+v"(fq));
        const int row0 = u.pm * BM + wr * 64 + fr;
        float rs[8]; load_scales(rowss, row0, rs);
        if (u.pn < 2) {
            const int pc = (u.pn == 0 ? 2304 : 2560) + wc * 64 + 8 * fq;
            f32x4 ks[4];
#pragma unroll
            for (int j = 0; j < 4; ++j) ks[j] = (f32x4){0.f, 0.f, 0.f, 0.f};
#pragma unroll
            for (int ai = 0; ai < 2; ++ai)
#pragma unroll
              for (int mh = 0; mh < 2; ++mh) {
                f32x4 cs[2][4];
#pragma unroll
                for (int mm = 0; mm < 2; ++mm) { const float* tp = rope + (size_t)EPI_ROW(ai, 2 * mh + mm) * 64 + 8 * fq; cs[mm][0] = *(const f32x4*)(tp); cs[mm][1] = *(const f32x4*)(tp + 4); cs[mm][2] = *(const f32x4*)(tp + 32); cs[mm][3] = *(const f32x4*)(tp + 36); }
#pragma unroll
                for (int mm = 0; mm < 2; ++mm) { const int m = 2 * mh + mm; const float r = rs[ai * 4 + m]; bf16_t* rowp = proj + (size_t)EPI_ROW(ai, m) * 3072 + pc;
                    const f32x4 a0 = acc[ai][0][m][0] * r, a1 = acc[ai][0][m][1] * r, b0 = acc[ai][1][m][0] * r, b1 = acc[ai][1][m][1] * r;
                    const f32x4 o10 = a0 * cs[mm][0] - b0 * cs[mm][2], o11 = a1 * cs[mm][1] - b1 * cs[mm][3], o20 = b0 * cs[mm][0] + a0 * cs[mm][2], o21 = b1 * cs[mm][1] + a1 * cs[mm][3];
                    *(u32x4*)(rowp) = pack8(o10, o11); *(u32x4*)(rowp + 32) = pack8(o20, o21);
                    ks[0] += o10; ks[1] += o11; ks[2] += o20; ks[3] += o21; }
                asm volatile("" ::: "memory"); }
            if (u.pn == 1) {
#pragma unroll
                for (int j = 0; j < 4; ++j)
#pragma unroll
                    for (int e = 0; e < 4; ++e) { float v = ks[j][e];
#pragma unroll
                        for (int st = 0; st < 4; ++st) v += dpp_row_xor(v, st);
                        ks[j][e] = v; }
                if (fr == 0) { const int b = u.pm >> 3, blk = u.pm & 7; float* kp = kmean + (size_t)((b * 4 + wc) * 8 + blk) * 64 + 8 * fq;
#pragma unroll
                    for (int e = 0; e < 4; ++e) { __hip_atomic_fetch_add(kp + e, ks[0][e] * (1.0f / 256.0f), __ATOMIC_RELAXED, __HIP_MEMORY_SCOPE_AGENT); __hip_atomic_fetch_add(kp + 4 + e, ks[1][e] * (1.0f / 256.0f), __ATOMIC_RELAXED, __HIP_MEMORY_SCOPE_AGENT);
                        __hip_atomic_fetch_add(kp + 32 + e, ks[2][e] * (1.0f / 256.0f), __ATOMIC_RELAXED, __HIP_MEMORY_SCOPE_AGENT); __hip_atomic_fetch_add(kp + 36 + e, ks[3][e] * (1.0f / 256.0f), __ATOMIC_RELAXED, __HIP_MEMORY_SCOPE_AGENT); } }
            }
        } else {
            const int b = u.pm >> 3, s0 = (u.pm & 7) * 256 + wr * 64 + fr;
#pragma unroll
            for (int ai = 0; ai < 2; ++ai)
#pragma unroll
                for (int m = 0; m < 4; ++m) { const float r = rs[ai * 4 + m]; const int s = s0 + ai * HALF + m * 16;
#pragma unroll
                    for (int bj = 0; bj < 2; ++bj) { const int hh = 2 * bj + (wc >> 1), d0 = 32 * (wc & 1) + 8 * fq; bf16_t* vp = vt + ((size_t)(b * 4 + hh) * 64 + d0) * 2048 + s;
                        const u32x4 w = pack8(acc[ai][bj][m][0] * r, acc[ai][bj][m][1] * r);
                        vp[0 * 2048] = (bf16_t)(w.x & 0xffffu); vp[1 * 2048] = (bf16_t)(w.x >> 16); vp[2 * 2048] = (bf16_t)(w.y & 0xffffu); vp[3 * 2048] = (bf16_t)(w.y >> 16);
                        vp[4 * 2048] = (bf16_t)(w.z & 0xffffu); vp[5 * 2048] = (bf16_t)(w.z >> 16); vp[6 * 2048] = (bf16_t)(w.w & 0xffffu); vp[7 * 2048] = (bf16_t)(w.w >> 16); } }
        }
    }
};


struct EpiGateP {
    static constexpr bool PERM = false, AFTER_DRAIN = true;
    const bf16_t* Y; const bf16_t* Wbr; bf16_t* merged; const rowss_t* rowss;
    size_t ybstride;
    __device__ __forceinline__ void fused(f32x4 (&acc)[2][2][4][2], const Unit& u, int wr, int wc, int fr, int fq, PG8_LAS unsigned char* lds, int wid, int lane) const {
        const int row0 = u.pm * BM + wr * 64 + fr;
        float rs[8]; load_scales(rowss, row0, rs);
        const int tid = wid * 64 + lane;
        unsigned voffA[2]; unsigned voffB;
#pragma unroll
        for (int i = 0; i < 2; ++i) { int R, C; stage_rc(tid * 16 + i * 8192, R, C); voffA[i] = (unsigned)(R * 256 + C) * 2u; }
        { int R, C; stage_rc(tid * 16, R, C); voffB = (unsigned)(R * 256 + C) * 2u; }
        const unsigned ldsw = (unsigned)wid * 1024u;
        const int aoff = lds_byte(wr * 64 + fr, fq * 8), boff = lds_byte(wc * 16 + fr, fq * 8);
        const char* ya = (const char*)Y + (size_t)u.pm * BM * 256 * 2;
        const char* wb = (const char*)Wbr + (size_t)u.pn * 64 * 256 * 2;
#define GP_STAGE(s_) do { const int b_ = (s_) >> 2, kt_ = (s_) & 3; const char* ga_ = ya + (size_t)b_ * ybstride * 2 + kt_ * 128; const char* gb_ = wb + (size_t)b_ * 1024 * 256 * 2 + kt_ * 128; PG8_LAS unsigned char* d_ = lds + ((s_) % 3) * 40960; \
            _Pragma("unroll") for (int h_ = 0; h_ < 2; ++h_) _Pragma("unroll") for (int i_ = 0; i_ < 2; ++i_) \
                __builtin_amdgcn_global_load_lds((const unsigned*)(ga_ + (size_t)h_ * HALF * 256 * 2 + voffA[i_]), (PG8_LAS unsigned*)(d_ + h_ * 16384 + ldsw + i_ * 8192), 16, 0, 0); \
            __builtin_amdgcn_global_load_lds((const unsigned*)(gb_ + voffB), (PG8_LAS unsigned*)(d_ + 32768 + ldsw), 16, 0, 0); } while (0)
        GP_STAGE(0); GP_STAGE(1);
        u32x2 gp[2][2][4][2];
#pragma unroll
        for (int ai = 0; ai < 2; ++ai)
#pragma unroll
            for (int bj = 0; bj < 2; ++bj)
#pragma unroll
                for (int m = 0; m < 4; ++m)
#pragma unroll
                    for (int n = 0; n < 2; ++n) { const float r = rs[ai * 4 + m]; const f32x4 a = acc[ai][bj][m][n];
                        gp[ai][bj][m][n].x = cvt_pk_bf16_t(sigm(a[0] * r), sigm(a[1] * r)); gp[ai][bj][m][n].y = cvt_pk_bf16_t(sigm(a[2] * r), sigm(a[3] * r));
                        acc[ai][bj][m][n] = (f32x4){0.f, 0.f, 0.f, 0.f}; }
#pragma unroll
        for (int s = 0; s < 16; ++s) {
            if (s < 15) asm volatile("s_waitcnt vmcnt(5)" ::: "memory"); else asm volatile("s_waitcnt vmcnt(0)" ::: "memory");
            __builtin_amdgcn_s_barrier(); asm volatile("" ::: "memory");
            if (s + 2 < 16) GP_STAGE(s + 2);
            const PG8_LAS unsigned char* bo = lds + (s % 3) * 40960; const int bj = (s >> 2) >> 1, n = (s >> 2) & 1;
            bf16x8 Bf[2];
#pragma unroll
            for (int k = 0; k < 2; ++k) Bf[k] = *(const PG8_LAS bf16x8*)(bo + 32768 + boff + k * 1024);
#pragma unroll
            for (int ai = 0; ai < 2; ++ai) { bf16x8 At[4][2];
#pragma unroll
                for (int m = 0; m < 4; ++m)
#pragma unroll
                    for (int k = 0; k < 2; ++k) At[m][k] = *(const PG8_LAS bf16x8*)(bo + ai * 16384 + aoff + m * 2048 + k * 1024);
#pragma unroll
                for (int m = 0; m < 4; ++m)
#pragma unroll
                    for (int k = 0; k < 2; ++k) acc[ai][bj][m][n] = __builtin_amdgcn_mfma_f32_16x16x32_bf16(Bf[k], At[m][k], acc[ai][bj][m][n], 0, 0, 0); }
            asm volatile("s_waitcnt lgkmcnt(0)" ::: "memory");
        }
#undef GP_STAGE
        const int j0 = u.pn * 64 + wc * 16 + 4 * fq;
#pragma unroll
        for (int ai = 0; ai < 2; ++ai)
#pragma unroll
            for (int m = 0; m < 4; ++m) { f32x4 s4 = (f32x4){0.f, 0.f, 0.f, 0.f};
#pragma unroll
                for (int bj = 0; bj < 2; ++bj)
#pragma unroll
                    for (int n = 0; n < 2; ++n) { const u32x2 g = gp[ai][bj][m][n]; const f32x4 p = acc[ai][bj][m][n];
                        s4[0] += bf_lo(g.x) * p[0]; s4[1] += bf_hi(g.x) * p[1]; s4[2] += bf_lo(g.y) * p[2]; s4[3] += bf_hi(g.y) * p[3]; }
                u32x2 w; w.x = cvt_pk_bf16(s4[0], s4[1]); w.y = cvt_pk_bf16(s4[2], s4[3]); *(u32x2*)(merged + (size_t)EPI_ROW(ai, m) * 1024 + j0) = w; }
    }
};
template <class Epi, class Sched, bool ALIGN_EPI = false, bool SP2 = false>
__device__ __forceinline__ void gemm_phase(PG8_LAS unsigned char* lds, const Gemm g, const Sched& S, const Epi& E) {
    int tid_ = threadIdx.x; asm volatile("" : "+v"(tid_));
    const int tid = tid_, wid = __builtin_amdgcn_readfirstlane(tid >> 6), lane = tid & 63, wr = wid >> 2, wc = wid & 3, fr = lane & 15, fq = lane >> 4;
    const int K = g.K, nt = K / BK;
    unsigned voffA[2], voffB[2];
#pragma unroll
    for (int i = 0; i < 2; ++i) { int R, C; stage_rc(tid * 16 + i * 8192, R, C); const int Rb = Epi::PERM ? ((R & ~31) + perm32(R & 31)) : R;
        voffA[i] = (unsigned)(R * K + C) * 2u; voffB[i] = (unsigned)(Rb * K + C) * 2u; }
    const size_t kstep = (size_t)(BK * 2);
    const size_t hstep = (size_t)HALF * K * 2;
    const size_t tstep = 2 * hstep;
    const unsigned ldsw = (unsigned)wid * 1024u;
    const int aoff = lds_byte(wr * 64 + fr, fq * 8), boff = lds_byte(wc * 32 + fr, fq * 8);
#define PG8_SA(b, h) (((b) * 2 + (h)) * HTB)
#define PG8_SB(b, h) ((4 + (b) * 2 + (h)) * HTB)
#define PG8_STAGE(bufoff, gbase, voff) do { _Pragma("unroll") for (int _i = 0; _i < 2; ++_i) \
        __builtin_amdgcn_global_load_lds((const unsigned*)((const char*)(gbase) + (voff)[_i]), (PG8_LAS unsigned*)(lds + (bufoff) + ldsw + _i * 8192), 16, 0, 0); } while (0)
#define PG8_LDA(dst, b, h) do { _Pragma("unroll") for (int m = 0; m < 4; ++m) _Pragma("unroll") for (int k = 0; k < 2; ++k) dst[m][k] = *(const PG8_LAS bf16x8*)(lds + PG8_SA(b, h) + aoff + m * 2048 + k * 1024); } while (0)
#define PG8_LDB(dst, b, h) do { _Pragma("unroll") for (int n = 0; n < 2; ++n) _Pragma("unroll") for (int k = 0; k < 2; ++k) dst[n][k] = *(const PG8_LAS bf16x8*)(lds + PG8_SB(b, h) + boff + n * 2048 + k * 1024); } while (0)
#define PG8_MMA(ai, bj, At, Bt) do { __builtin_amdgcn_s_setprio(1); _Pragma("unroll") for (int m = 0; m < 4; ++m) _Pragma("unroll") for (int n = 0; n < 2; ++n) _Pragma("unroll") for (int k = 0; k < 2; ++k) \
        acc[ai][bj][m][n] = __builtin_amdgcn_mfma_f32_16x16x32_bf16(Bt[n][k], At[m][k], acc[ai][bj][m][n], 0, 0, 0); __builtin_amdgcn_s_setprio(0); } while (0)
#define PG8_WAIT_V(n) asm volatile("s_waitcnt vmcnt(" #n ")" ::: "memory")
#define PG8_WAIT_L(n) asm volatile("s_waitcnt lgkmcnt(" #n ")" ::: "memory")
#define PG8_BAR __builtin_amdgcn_s_barrier()
#define PG8_SCHED __builtin_amdgcn_sched_barrier(0)
    Unit cur, nxt; int ui = 0;
    if (!S.next(0, cur)) return;
    f32x4 acc[2][2][4][2];
#pragma unroll
    for (int a = 0; a < 2; ++a)
#pragma unroll
        for (int b = 0; b < 2; ++b)
#pragma unroll
            for (int m = 0; m < 4; ++m)
#pragma unroll
                for (int n = 0; n < 2; ++n) acc[a][b][m][n] = (f32x4){0.f, 0.f, 0.f, 0.f};
    bf16x8 At[4][2], B0[2][2], B1[2][2];
    const char* cA = (const char*)g.A + (size_t)(cur.pn >> g.ashift) * g.astride + (size_t)cur.pm * tstep; const char* cB = (const char*)g.Bt + (size_t)cur.pn * tstep;
    S.a_ready(cur);
    if constexpr (SP2) {
        PG8_STAGE(PG8_SB(0, 0), cB, voffB); PG8_STAGE(PG8_SB(0, 1), cB + hstep, voffB); PG8_STAGE(PG8_SA(0, 0), cA, voffA); PG8_STAGE(PG8_SA(0, 1), cA + hstep, voffA);
        if (wr == 1) PG8_BAR;
        PG8_WAIT_V(2); PG8_BAR;
        PG8_STAGE(PG8_SB(1, 0), cB + kstep, voffB); PG8_STAGE(PG8_SA(1, 0), cA + kstep, voffA); PG8_STAGE(PG8_SB(1, 1), cB + hstep + kstep, voffB);
        PG8_WAIT_V(6); PG8_BAR;
    } else {
        PG8_STAGE(PG8_SB(0, 0), cB, voffB); PG8_STAGE(PG8_SA(0, 0), cA, voffA); PG8_STAGE(PG8_SB(0, 1), cB + hstep, voffB); PG8_STAGE(PG8_SA(0, 1), cA + hstep, voffA);
        if (wr == 1) PG8_BAR;
        PG8_WAIT_V(4); PG8_BAR;
        PG8_STAGE(PG8_SB(1, 0), cB + kstep, voffB); PG8_STAGE(PG8_SA(1, 0), cA + kstep, voffA); PG8_STAGE(PG8_SB(1, 1), cB + hstep + kstep, voffB);
        PG8_WAIT_V(6); PG8_BAR;
    }
    for (;;) {
        const bool has_next = S.next(ui + 1, nxt);
        const char* nA = has_next ? (const char*)g.A + (size_t)(nxt.pn >> g.ashift) * g.astride + (size_t)nxt.pm * tstep : cA; const char* nB = has_next ? (const char*)g.Bt + (size_t)nxt.pn * tstep : cB;
        for (int t = 0; t < nt; t += 2) {
            const bool last = (t == nt - 2);
            const char* a1 = cA + (size_t)(t + 1) * kstep;
            const char* a2 = last ? nA : cA + (size_t)(t + 2) * kstep; const char* b2 = last ? nB : cB + (size_t)(t + 2) * kstep;
            const char* a3 = a2 + kstep; const char* b3 = b2 + kstep;
            if (last && has_next) S.a_ready(nxt);
            if constexpr (SP2) {
            PG8_LDB(B0, 0, 0); PG8_LDB(B1, 0, 1); PG8_SCHED; PG8_LDA(At, 0, 0); PG8_STAGE(PG8_SA(1, 1), a1 + hstep, voffA);
            PG8_WAIT_V(8); PG8_WAIT_L(0); PG8_BAR; PG8_MMA(0, 0, At, B0); PG8_MMA(0, 1, At, B1); PG8_BAR; PG8_SCHED;
            PG8_LDA(At, 0, 1); PG8_STAGE(PG8_SB(0, 0), b2, voffB); PG8_STAGE(PG8_SB(0, 1), b2 + hstep, voffB); PG8_STAGE(PG8_SA(0, 0), a2, voffA);
            PG8_WAIT_V(8); PG8_WAIT_L(0); PG8_BAR; PG8_MMA(1, 0, At, B0); PG8_MMA(1, 1, At, B1); PG8_BAR; PG8_SCHED;
            PG8_LDB(B0, 1, 0); PG8_LDB(B1, 1, 1); PG8_SCHED; PG8_LDA(At, 1, 0); PG8_STAGE(PG8_SA(0, 1), a2 + hstep, voffA);
            PG8_WAIT_V(8); PG8_WAIT_L(0); PG8_BAR; PG8_MMA(0, 0, At, B0); PG8_MMA(0, 1, At, B1); PG8_BAR; PG8_SCHED;
            PG8_LDA(At, 1, 1); PG8_STAGE(PG8_SB(1, 0), b3, voffB); PG8_STAGE(PG8_SB(1, 1), b3 + hstep, voffB); PG8_STAGE(PG8_SA(1, 0), a3, voffA);
            PG8_WAIT_V(8); PG8_WAIT_L(0); PG8_BAR; PG8_MMA(1, 0, At, B0); PG8_MMA(1, 1, At, B1); PG8_BAR; PG8_SCHED;
            } else {
            PG8_LDB(B0, 0, 0); PG8_SCHED; PG8_LDA(At, 0, 0); PG8_STAGE(PG8_SA(1, 1), a1 + hstep, voffA);
            PG8_WAIT_L(8); PG8_BAR; PG8_WAIT_L(0); PG8_MMA(0, 0, At, B0); PG8_BAR; PG8_SCHED;
            PG8_LDB(B1, 0, 1); PG8_STAGE(PG8_SB(0, 0), b2, voffB);
            PG8_BAR; PG8_WAIT_L(0); PG8_MMA(0, 1, At, B1); PG8_BAR;
            PG8_LDA(At, 0, 1); PG8_STAGE(PG8_SA(0, 0), a2, voffA);
            PG8_BAR; PG8_WAIT_L(0); PG8_MMA(1, 0, At, B0); PG8_BAR; PG8_SCHED;
            PG8_STAGE(PG8_SB(0, 1), b2 + hstep, voffB);
            PG8_WAIT_V(6); PG8_BAR; PG8_MMA(1, 1, At, B1); PG8_BAR;
            PG8_LDB(B0, 1, 0); PG8_SCHED; PG8_LDA(At, 1, 0); PG8_STAGE(PG8_SA(0, 1), a2 + hstep, voffA);
            PG8_WAIT_L(8); PG8_BAR; PG8_WAIT_L(0); PG8_MMA(0, 0, At, B0); PG8_BAR; PG8_SCHED;
            PG8_LDB(B1, 1, 1); PG8_STAGE(PG8_SB(1, 0), b3, voffB);
            PG8_BAR; PG8_WAIT_L(0); PG8_MMA(0, 1, At, B1); PG8_BAR;
            PG8_LDA(At, 1, 1); PG8_STAGE(PG8_SA(1, 0), a3, voffA);
            PG8_BAR; PG8_WAIT_L(0); PG8_MMA(1, 0, At, B0); PG8_BAR; PG8_SCHED;
            PG8_STAGE(PG8_SB(1, 1), b3 + hstep, voffB);
            PG8_WAIT_V(6); PG8_BAR; PG8_MMA(1, 1, At, B1); PG8_BAR;
            }
        }
        if constexpr (ALIGN_EPI) { if (wr == 0) PG8_BAR; }
        if constexpr (!Epi::AFTER_DRAIN) { E(acc, cur, wr, wc, fr, fq); S.done(cur); }
        if (!has_next) break;
#pragma unroll
        for (int a = 0; a < 2; ++a)
#pragma unroll
            for (int b = 0; b < 2; ++b)
#pragma unroll
                for (int m = 0; m < 4; ++m)
#pragma unroll
                    for (int n = 0; n < 2; ++n) acc[a][b][m][n] = (f32x4){0.f, 0.f, 0.f, 0.f};
        cur = nxt; cA = nA; cB = nB; ++ui;
        if constexpr (ALIGN_EPI) { if (wr == 1) PG8_BAR; }
    }
    PG8_WAIT_V(0);
    if constexpr (!ALIGN_EPI) { if (wr == 0) PG8_BAR; }
    PG8_BAR;
    if constexpr (Epi::AFTER_DRAIN) { E.fused(acc, cur, wr, wc, fr, fq, lds, wid, lane); S.done(cur); }
#undef PG8_SA
#undef PG8_SB
#undef PG8_STAGE
#undef PG8_LDA
#undef PG8_LDB
#undef PG8_MMA
#undef PG8_WAIT_V
#undef PG8_WAIT_L
#undef PG8_BAR
#undef PG8_SCHED
}
}


constexpr int NWAVES = 8;
constexpr int BATCH = 16, SEQ = 2048, D = 1024, M = BATCH * SEQ, FF = 2816, NGU = 2 * FF, PLED = 256, DEPTH = 2;
constexpr int NIN_SRC = 3088, NIN = 3328, NPROJ = 3072, NGATE = 4096;
constexpr int PC_GQ = 0, PC_GZ = 768, PC_MQ = 1024, PC_MV = 1536, PC_MO = 1792, PC_S5 = 2048, PC_AQ = 2304, PC_AK = 2560, PC_AV = 2816;

constexpr size_t MiB = 1u << 20;
constexpr size_t WS_CTL = 0, CTL_ZERO_BYTES = 4 * MiB;
constexpr size_t WS_ROWSS = 1 * MiB;
constexpr size_t WS_KMEAN = 3 * MiB + 512 * 1024;
constexpr size_t WS_S5P = 6 * MiB + 512 * 1024;
constexpr size_t WS_SCAL = 4 * MiB;
constexpr size_t WS_W = 8 * MiB;
constexpr size_t W_GU1 = 0, W_D1 = W_GU1 + (size_t)NGU * D * 2, W_IN = W_D1 + (size_t)D * FF * 2, W_GATE = W_IN + (size_t)NIN * D * 2, W_BR = W_GATE + (size_t)NGATE * D * 2,
                 W_GLU = W_BR + (size_t)4096 * 256 * 2, W_OUT = W_GLU + (size_t)256 * 256 * 2, W_GU2 = W_OUT + (size_t)D * D * 2, W_D2 = W_GU2 + (size_t)NGU * D * 2,
                 W_PLE = W_D2 + (size_t)D * FF * 2, W_PG = W_PLE + (size_t)D * PLED * 2, W_END = W_PG + (size_t)D * D * 2;
static_assert(W_END <= 56 * MiB, "weights fit");
constexpr size_t WS_HB = 64 * MiB;
constexpr size_t WS_PB = 128 * MiB;
constexpr size_t WS_Y = 144 * MiB;
constexpr size_t WS_YG = 208 * MiB;
constexpr size_t WS_VT = 224 * MiB;
constexpr size_t WS_BIG = 256 * MiB;
constexpr size_t WS_END = 512 * MiB;
constexpr size_t OUT_W1 = 0, OUT_T = 56 * MiB, OUT_ROPE = 120 * MiB;
constexpr int CW_BAR = 4096, CW_QUEUE = 8192, CW_FLAG = 12288, CW_S5F = 16384, CW_GRP = 20480;

constexpr int RING_OFF = 0;
constexpr int LDS_BYTES = 147456;
constexpr int LDSCTL_OFF = LDS_BYTES - 1024;
constexpr int WAVE_LDS = 17408;

#define GAS __attribute__((address_space(1)))
#define LAS __attribute__((address_space(3)))
typedef unsigned short bf16;
typedef unsigned v4u __attribute__((ext_vector_type(4)));
typedef float f32x4 __attribute__((ext_vector_type(4)));
typedef short bf16x8 __attribute__((ext_vector_type(8)));
typedef GAS unsigned gu32;
typedef GAS unsigned long long gu64;
#define RLX_AGENT __ATOMIC_RELAXED, __HIP_MEMORY_SCOPE_AGENT
#define LDS_WAIT() asm volatile("s_waitcnt lgkmcnt(0)" ::: "memory")
#define VM_WAIT() asm volatile("s_waitcnt vmcnt(0)" ::: "memory")
__device__ __forceinline__ unsigned long long rt() { return __builtin_amdgcn_s_memrealtime(); }
__device__ __forceinline__ unsigned f2bf(float f) { unsigned u = __builtin_bit_cast(unsigned, f); return (u + 0x7fffu + ((u >> 16) & 1u)) >> 16; }
typedef float pk2_f32x2 __attribute__((ext_vector_type(2)));
typedef __bf16 pk2_bf16x2 __attribute__((ext_vector_type(2)));
__device__ __forceinline__ unsigned pk2(float lo, float hi) { const pk2_f32x2 v = {lo, hi}; return __builtin_bit_cast(unsigned, __builtin_convertvector(v, pk2_bf16x2)); }

#define XB_TMO      128
#define XB_XCNT(j)  (256  + 64 * (j))
#define XB_XSUB(j)  (1280 + 64 * (j))
#define XB_XGEN(j)  (2304 + 64 * (j))
#define XB_TOP      3328
#define XB_TOPGEN   3392
#define XCD_BAR_WORDS 3456
#define XB_SPIN_CAP (1u << 21)

__device__ __forceinline__ unsigned xb_ld(unsigned* p)              { return __hip_atomic_load(p, __ATOMIC_RELAXED, __HIP_MEMORY_SCOPE_AGENT); }
__device__ __forceinline__ unsigned xb_add(unsigned* p, unsigned v) { return __hip_atomic_fetch_add(p, v, __ATOMIC_RELAXED, __HIP_MEMORY_SCOPE_AGENT); }
__device__ __forceinline__ unsigned xb_xcc_id() { return (unsigned)__builtin_amdgcn_s_getreg((3 << 11) | 20) & 0xFu; }
#define XB_SPIN(cond, bar) do { unsigned _sp = 0; while (cond) { __builtin_amdgcn_s_sleep(1); \
    if ((++_sp & 255u) == 0u) { if (xb_ld(&(bar)[XB_TMO])) break; if (_sp > XB_SPIN_CAP) { atomicAdd(&(bar)[XB_TMO], 1u); break; } } } } while (0)

struct XcdBarrier {
    unsigned* bar; unsigned x;
    volatile LAS unsigned* st;
};

__device__ __forceinline__ XcdBarrier xcd_barrier_post(unsigned* bar, volatile LAS unsigned* st) {
    XcdBarrier b; b.bar = bar; b.x = xb_xcc_id(); b.st = st;
    if (threadIdx.x == 0) (void)xb_add(&bar[XB_XCNT(b.x)], 1u);
    return b;
}
__device__ __forceinline__ void xcd_barrier_complete(unsigned* bar, unsigned x, unsigned& nloc, unsigned& nx) {
    const unsigned G = gridDim.x * gridDim.y * gridDim.z;
    unsigned sum, cnt, mine, sp = 0u;
    for (;;) {
        sum = 0u; cnt = 0u; mine = 0u;
#pragma unroll
        for (unsigned j = 0; j < 16; ++j) { const unsigned c = xb_ld(&bar[XB_XCNT(j)]); sum += c; cnt += (c > 0u) ? 1u : 0u; mine = (j == x) ? c : mine; }
        if (sum == G) break;
        __builtin_amdgcn_s_sleep(1);
        if ((++sp & 255u) == 0u) { if (xb_ld(&bar[XB_TMO])) break; if (sp > XB_SPIN_CAP) { atomicAdd(&bar[XB_TMO], 1u); break; } }
    }
    nloc = mine > 0u ? mine : 1u; nx = cnt > 0u ? cnt : 1u;
}

__device__ __forceinline__ void xcd_barrier(const XcdBarrier& b) {
    asm volatile("s_waitcnt vmcnt(0)" ::: "memory");
    __syncthreads();
    if (threadIdx.x == 0) {
        unsigned* bar = b.bar;
        __builtin_amdgcn_s_waitcnt(0);
        unsigned nloc = b.st[0], nx = b.st[1];
        if (nloc == 0u) { xcd_barrier_complete(bar, b.x, nloc, nx); b.st[0] = nloc; b.st[1] = nx; }
        const unsigned old = xb_add(&bar[XB_XSUB(b.x)], 1u);
        const unsigned gen = old / nloc;
        if (old + 1u == (gen + 1u) * nloc) {
            __builtin_amdgcn_fence(__ATOMIC_RELEASE, "agent");
            asm volatile("s_waitcnt vmcnt(0)" ::: "memory");
            const unsigned og = xb_add(&bar[XB_TOP], 1u);
            const unsigned tg = og / nx;
            if (og + 1u == (tg + 1u) * nx) xb_add(&bar[XB_TOPGEN], 1u);
            else XB_SPIN(xb_ld(&bar[XB_TOPGEN]) == tg, bar);
            __builtin_amdgcn_fence(__ATOMIC_ACQUIRE, "agent");
            xb_add(&bar[XB_XGEN(b.x)], 1u);
            asm volatile("s_waitcnt vmcnt(0)" ::: "memory");
        } else {
            XB_SPIN(xb_ld(&bar[XB_XGEN(b.x)]) == gen, bar);
            __builtin_amdgcn_fence(__ATOMIC_ACQUIRE, "agent");
            asm volatile("s_waitcnt vmcnt(0)" ::: "memory");
        }
    }
    __syncthreads();
}

__device__ __forceinline__ void group_barrier(unsigned* ctr, unsigned target) {
    asm volatile("s_waitcnt vmcnt(0)" ::: "memory");
    __syncthreads();
    if (threadIdx.x == 0) {
        __builtin_amdgcn_s_waitcnt(0);
        __builtin_amdgcn_fence(__ATOMIC_RELEASE, "agent");
        asm volatile("s_waitcnt vmcnt(0)" ::: "memory");
        (void)xb_add(ctr, 1u);
        unsigned sp = 0; while (xb_ld(ctr) < target) { __builtin_amdgcn_s_sleep(1); if (++sp > (1u << 22)) break; }
        __builtin_amdgcn_fence(__ATOMIC_ACQUIRE, "agent");
        asm volatile("s_waitcnt vmcnt(0)" ::: "memory");
    }
    __syncthreads();
}


template <int CTRL> __device__ __forceinline__ float dppx(float x) { return __int_as_float(__builtin_amdgcn_update_dpp(0, __float_as_int(x), CTRL, 0xF, 0xF, true)); }
constexpr int DPP_XOR1 = 0xB1, DPP_XOR2 = 0x4E, DPP_HMIRROR = 0x141, DPP_MIRROR = 0x140;
__device__ __forceinline__ float xrow16_sum(float x) {
    auto s = __builtin_amdgcn_permlane16_swap(__float_as_uint(x), __float_as_uint(x), false, false);
    x = __uint_as_float(s[0]) + __uint_as_float(s[1]);
    auto t = __builtin_amdgcn_permlane32_swap(__float_as_uint(x), __float_as_uint(x), false, false);
    return __uint_as_float(t[0]) + __uint_as_float(t[1]);
}
__device__ __forceinline__ float xrow16_max(float x) {
    auto s = __builtin_amdgcn_permlane16_swap(__float_as_uint(x), __float_as_uint(x), false, false);
    x = fmaxf(__uint_as_float(s[0]), __uint_as_float(s[1]));
    auto t = __builtin_amdgcn_permlane32_swap(__float_as_uint(x), __float_as_uint(x), false, false);
    return fmaxf(__uint_as_float(t[0]), __uint_as_float(t[1]));
}
__device__ __forceinline__ float xhalf_sum(float x) {
    auto t = __builtin_amdgcn_permlane32_swap(__float_as_uint(x), __float_as_uint(x), false, false);
    return __uint_as_float(t[0]) + __uint_as_float(t[1]);
}
__device__ __forceinline__ float red8(float v) { v += dppx<DPP_XOR1>(v); v += dppx<DPP_XOR2>(v); v += dppx<DPP_HMIRROR>(v); return v; }
__device__ __forceinline__ float wave_sum(float v) { v = red8(v); v += dppx<DPP_MIRROR>(v); return xrow16_sum(v); }
__device__ __forceinline__ float wave_max(float v) { v = fmaxf(v, dppx<DPP_XOR1>(v)); v = fmaxf(v, dppx<DPP_XOR2>(v)); v = fmaxf(v, dppx<DPP_HMIRROR>(v)); v = fmaxf(v, dppx<DPP_MIRROR>(v)); return xrow16_max(v); }
__device__ __forceinline__ float bf2f(bf16 b) { return __uint_as_float(((unsigned)b) << 16); }
__device__ __forceinline__ float sigm(float x) { return __builtin_amdgcn_rcpf(1.0f + __expf(-x)); }
__device__ __forceinline__ float silu(float x) { return x * sigm(x); }

template <class Map>
__device__ __forceinline__ void cvt_item(const float* __restrict__ W, int ld, const float* __restrict__ gain, bf16* Bt, int K, int item, int nblk, LAS float* scr, int lane, Map map) {
    const int kb = item / nblk, nb = item % nblk, k0 = 64 * kb, n0 = 32 * nb;
    const int n4 = lane & 7, kr = lane >> 3; const long so = map(n0 + 4 * n4);
    const long sx = so >= 0 ? so : 0; const float keep = so >= 0 ? 1.0f : 0.0f;
    f32x4 v[8]; float gn[8];
#pragma unroll
    for (int i = 0; i < 8; ++i) { v[i] = *(const GAS f32x4*)(W + sx + (size_t)(k0 + 8 * i + kr) * ld); gn[i] = keep; }
    if (gain) {
#pragma unroll
        for (int i = 0; i < 8; ++i) gn[i] = keep * gain[k0 + 8 * i + kr]; }
#pragma unroll
    for (int i = 0; i < 8; ++i) { LAS float* d = scr + (8 * i + kr) * 33 + 4 * n4; const f32x4 w = v[i] * gn[i]; d[0] = w[0]; d[1] = w[1]; d[2] = w[2]; d[3] = w[3]; }
    LDS_WAIT(); asm volatile("" ::: "memory");
    const int c = lane & 7;
#pragma unroll
    for (int j = 0; j < 4; ++j) { const int n = (lane >> 3) + 8 * j; const LAS float* s = scr + (8 * c) * 33 + n;
        v4u o; o.x = pk2(s[0 * 33], s[1 * 33]); o.y = pk2(s[2 * 33], s[3 * 33]); o.z = pk2(s[4 * 33], s[5 * 33]); o.w = pk2(s[6 * 33], s[7 * 33]);
        *(GAS v4u*)(Bt + (size_t)(n0 + n) * K + k0 + 8 * c) = o; }
    LDS_WAIT(); asm volatile("" ::: "memory");
}
struct MapId { __device__ long operator()(int r) const { return r; } };
struct MapGU { __device__ long operator()(int r) const { const int pn = r >> 8, c = r & 255; return c < 128 ? 128 * pn + c : FF + 128 * pn + (c - 128); } };
struct MapIn { __device__ long operator()(int r) const { if (r < 1024) return r; if (r < 2048) return 1032 + (r - 1024); if (r < 2304) return 2064 + (r - 2048);
    if (r < 2560) { const int c = r - 2304; return c < 8 ? 1024 + c : c < 16 ? 2056 + (c - 8) : -1; }
    const int t = (r - 2560) >> 8, c = (r - 2560) & 255; if (t < 2) return 2320 + 256 * t + ((c >> 5) & 3) * 64 + (c >> 7) * 32 + (c & 31); return 2320 + 512 + c; } };
struct MapGate { __device__ long operator()(int r) const { const int pn = r >> 8, c = r & 255, b = 2 * (c >> 7) + ((c >> 4) & 1), jl = 16 * ((c >> 5) & 3) + 4 * ((c >> 2) & 3) + (c & 3); return (long)b * (D * D) + 64 * pn + jl; } };
struct MapBr { __device__ long operator()(int r) const { return (long)(r >> 10) * (256 * D) + (r & 1023); } };

struct LayerW {
    const float *ffn1_norm, *ffn1_w_gu, *ffn1_w_down, *mix_norm, *w_in, *gdn_conv, *gdn_a_log, *gdn_dt_bias, *gdn_norm, *mlstm_conv, *mlstm_i_bias, *mlstm_f_bias, *mlstm_norm,
                *s5_lre, *s5_lim, *s5_bre, *s5_bim, *s5_cre, *s5_cim, *s5_d, *s5_log_dt, *s5_w_glu, *s5_b_glu, *w_gate, *w_branch, *w_out, *ffn2_norm, *ffn2_w_gu, *ffn2_w_down, *ple_norm, *ple_w_proj, *ple_w_gate;
};

__device__ __forceinline__ void prologue_weights(const LayerW& L, unsigned char* wsw, LAS unsigned char* lds, int gw, int ngw, int wave, int lane) {
    LAS float* scr = (LAS float*)(lds + RING_OFF + wave * WAVE_LDS);
    constexpr int I_GU = (D / 64) * (NGU / 32), I_DN = (FF / 64) * (D / 32), I_IN = (D / 64) * (NIN / 32), I_GT = (D / 64) * (NGATE / 32), I_BR = (256 / 64) * (4096 / 32), I_GL = (256 / 64) * (256 / 32),
                  I_OUT = (D / 64) * (D / 32), I_PLE = (PLED / 64) * (D / 32), I_PG = I_OUT;
    constexpr int NITEMS = 2 * I_GU + 2 * I_DN + I_IN + I_GT + I_BR + I_GL + I_OUT + I_PLE + I_PG;
    for (int it = gw; it < NITEMS; it += ngw) {
        int r = it;
        if (r < I_GU) { cvt_item(L.ffn1_w_gu, NGU, L.ffn1_norm, (bf16*)(wsw + W_GU1), D, r, NGU / 32, scr, lane, MapGU()); continue; } r -= I_GU;
        if (r < I_GU) { cvt_item(L.ffn2_w_gu, NGU, L.ffn2_norm, (bf16*)(wsw + W_GU2), D, r, NGU / 32, scr, lane, MapGU()); continue; } r -= I_GU;
        if (r < I_DN) { cvt_item(L.ffn1_w_down, D, nullptr, (bf16*)(wsw + W_D1), FF, r, D / 32, scr, lane, MapId()); continue; } r -= I_DN;
        if (r < I_DN) { cvt_item(L.ffn2_w_down, D, nullptr, (bf16*)(wsw + W_D2), FF, r, D / 32, scr, lane, MapId()); continue; } r -= I_DN;
        if (r < I_IN) { cvt_item(L.w_in, NIN_SRC, L.mix_norm, (bf16*)(wsw + W_IN), D, r, NIN / 32, scr, lane, MapIn()); continue; } r -= I_IN;
        if (r < I_GT) { cvt_item(L.w_gate, D, L.mix_norm, (bf16*)(wsw + W_GATE), D, r, NGATE / 32, scr, lane, MapGate()); continue; } r -= I_GT;
        if (r < I_BR) { cvt_item(L.w_branch, D, nullptr, (bf16*)(wsw + W_BR), 256, r, 4096 / 32, scr, lane, MapBr()); continue; } r -= I_BR;
        if (r < I_GL) { cvt_item(L.s5_w_glu, 256, nullptr, (bf16*)(wsw + W_GLU), 256, r, 256 / 32, scr, lane, MapId()); continue; } r -= I_GL;
        if (r < I_OUT) { cvt_item(L.w_out, D, nullptr, (bf16*)(wsw + W_OUT), D, r, D / 32, scr, lane, MapId()); continue; } r -= I_OUT;
        if (r < I_PLE) { cvt_item(L.ple_w_proj, D, nullptr, (bf16*)(wsw + W_PLE), PLED, r, D / 32, scr, lane, MapId()); continue; } r -= I_PLE;
        cvt_item(L.ple_w_gate, D, L.ple_norm, (bf16*)(wsw + W_PG), D, r, D / 32, scr, lane, MapId());
    }
}
__device__ __forceinline__ void prologue_s5(const LayerW& L, float* s5p, int gtid, int ngt) {
    for (int i = gtid; i < 1024; i += ngt) { const int g = i >> 6;
        const float dt = expf(L.s5_log_dt[g]), lr = L.s5_lre[i], li = L.s5_lim[i];
        const float th = li * dt; float sn, cs; sincosf(th, &sn, &cs);
        const float em1 = expm1f(lr * dt), mag = em1 + 1.0f;
        const float are = mag * cs, aim = mag * sn;
        const float sh = sinf(0.5f * th); const float arem1 = em1 * cs - 2.0f * sh * sh;
        const float den = lr * lr + li * li;
        const float zre = (arem1 * lr + aim * li) / den, zim = (aim * lr - arem1 * li) / den;
        s5p[i] = are; s5p[1024 + i] = aim;
        for (int n = 0; n < 16; ++n) { const float br = L.s5_bre[i * 16 + n], bi = L.s5_bim[i * 16 + n];
            s5p[2048 + i * 16 + n] = zre * br - zim * bi; s5p[2048 + 16384 + i * 16 + n] = zre * bi + zim * br; } }
}
__device__ __forceinline__ void cvt_rows_bf16(const float* src, bf16* dst, size_t n, size_t gtid, size_t ngt) {
    size_t i = gtid * 8;
    for (; i + 3 * ngt * 8 < n; i += 4 * ngt * 8) {
        f32x4 a[4], b[4];
#pragma unroll
        for (int u = 0; u < 4; ++u) { a[u] = *(const GAS f32x4*)(src + i + u * ngt * 8); b[u] = *(const GAS f32x4*)(src + i + u * ngt * 8 + 4); }
#pragma unroll
        for (int u = 0; u < 4; ++u) { v4u o; o.x = pk2(a[u][0], a[u][1]); o.y = pk2(a[u][2], a[u][3]); o.z = pk2(b[u][0], b[u][1]); o.w = pk2(b[u][2], b[u][3]); *(GAS v4u*)(dst + i + u * ngt * 8) = o; } }
    for (; i < n; i += ngt * 8) { const f32x4 a = *(const GAS f32x4*)(src + i), b = *(const GAS f32x4*)(src + i + 4);
        v4u o; o.x = pk2(a[0], a[1]); o.y = pk2(a[2], a[3]); o.z = pk2(b[0], b[1]); o.w = pk2(b[2], b[3]); *(GAS v4u*)(dst + i) = o; }
}
__device__ __forceinline__ void prologue_rope(const int* positions, float* rope, size_t gtid, size_t ngt) {
    for (size_t i = gtid; i < (size_t)M * 32; i += ngt) { const size_t row = i >> 5; const int k = (int)(i & 31);
        const float invf = expf(-(float)k * (2.0f / 64.0f) * 9.210340371976184f); float sn, cs; sincosf((float)positions[row] * invf, &sn, &cs);
        rope[row * 64 + k] = cs; rope[row * 64 + 32 + k] = sn; }
}
__device__ __forceinline__ void x_to_hb(const float* x, bf16* hb, pg8::rowss_t* rowss, int gw, int ngw, int lane) {
    for (int m0 = gw; m0 < M; m0 += 2 * ngw) {
        f32x4 v[2][4]; float s[2];
#pragma unroll
        for (int u = 0; u < 2; ++u) { const int m = m0 + u * ngw; if (m < M) { const GAS f32x4* xr = (const GAS f32x4*)(x + (size_t)m * D) + lane;
#pragma unroll
            for (int j = 0; j < 4; ++j) v[u][j] = xr[64 * j]; } }
#pragma unroll
        for (int u = 0; u < 2; ++u) { const int m = m0 + u * ngw; if (m < M) { s[u] = 0.f;
#pragma unroll
            for (int j = 0; j < 4; ++j) s[u] += (v[u][j][0] * v[u][j][0] + v[u][j][1] * v[u][j][1]) + (v[u][j][2] * v[u][j][2] + v[u][j][3] * v[u][j][3]);
            s[u] = wave_sum(s[u]); if (lane == 0) rowss[m] = (pg8::rowss_t)(s[u] * pg8::RSS_SCALE);
            GAS unsigned long long* o8 = (GAS unsigned long long*)(hb + (size_t)m * D) + lane;
#pragma unroll
            for (int j = 0; j < 4; ++j) o8[64 * j] = (unsigned long long)pk2(v[u][j][0], v[u][j][1]) | ((unsigned long long)pk2(v[u][j][2], v[u][j][3]) << 32); } } }
}
__device__ __forceinline__ void final_norm(const bf16* h, float* out, const pg8::rowss_t* rowss, const float* w, int gw, int ngw, int lane) {
    const GAS f32x4* wp = (const GAS f32x4*)(w + 16 * lane); const f32x4 g0 = wp[0], g1 = wp[1], g2 = wp[2], g3 = wp[3];
    for (int m0 = gw; m0 < M; m0 += 4 * ngw) {
        v4u hw[4][2]; float r[4];
#pragma unroll
        for (int u = 0; u < 4; ++u) { const int m = m0 + u * ngw; if (m < M) { const GAS v4u* hp = (const GAS v4u*)(h + (size_t)m * D + 16 * lane); hw[u][0] = hp[0]; hw[u][1] = hp[1]; r[u] = pg8::rms_scale(rowss, m); } }
#pragma unroll
        for (int u = 0; u < 4; ++u) { const int m = m0 + u * ngw; if (m < M) { GAS f32x4* op = (GAS f32x4*)(out + (size_t)m * D + 16 * lane); const float rr = r[u];
            op[0] = (f32x4){__uint_as_float(hw[u][0].x << 16) * rr * g0[0], __uint_as_float(hw[u][0].x & 0xffff0000u) * rr * g0[1], __uint_as_float(hw[u][0].y << 16) * rr * g0[2], __uint_as_float(hw[u][0].y & 0xffff0000u) * rr * g0[3]};
            op[1] = (f32x4){__uint_as_float(hw[u][0].z << 16) * rr * g1[0], __uint_as_float(hw[u][0].z & 0xffff0000u) * rr * g1[1], __uint_as_float(hw[u][0].w << 16) * rr * g1[2], __uint_as_float(hw[u][0].w & 0xffff0000u) * rr * g1[3]};
            op[2] = (f32x4){__uint_as_float(hw[u][1].x << 16) * rr * g2[0], __uint_as_float(hw[u][1].x & 0xffff0000u) * rr * g2[1], __uint_as_float(hw[u][1].y << 16) * rr * g2[2], __uint_as_float(hw[u][1].y & 0xffff0000u) * rr * g2[3]};
            op[3] = (f32x4){__uint_as_float(hw[u][1].z << 16) * rr * g3[0], __uint_as_float(hw[u][1].z & 0xffff0000u) * rr * g3[1], __uint_as_float(hw[u][1].w << 16) * rr * g3[2], __uint_as_float(hw[u][1].w & 0xffff0000u) * rr * g3[3]}; } } }
}

__device__ __forceinline__ float softplusf(float x) { return fmaxf(x, 0.f) + __logf(1.0f + __expf(-fabsf(x))); }
__device__ __forceinline__ float gelu_tanh(float y) { const float z = 0.7978845608028654f * (y + 0.044715f * y * y * y); const float th = 1.0f - 2.0f * __builtin_amdgcn_rcpf(1.0f + __expf(2.0f * z)); return 0.5f * y * (1.0f + th); }
template <int NQG>
__device__ __forceinline__ void moba_mfma_item(const bf16* proj, const float* kmean, const bf16* vt, bf16* y3, int bh, int qb, int wsl, int lane) {
    constexpr int NQ = 16 * NQG;
    const int b = bh >> 2, h = bh & 3, fr = lane & 15, fq = lane >> 4;
    const int t0 = qb * 256 + wsl * NQ; const size_t rowb = (size_t)b * SEQ;
    unsigned selmask = 0;
    { const GAS v4u* qp = (const GAS v4u*)(proj + (rowb + t0 + (lane & (NQ - 1))) * NPROJ + PC_AQ + h * 64);
      float qv[64];
#pragma unroll
      for (int c = 0; c < 8; ++c) { const v4u w = qp[c]; qv[8 * c + 0] = __uint_as_float(w.x << 16); qv[8 * c + 1] = __uint_as_float(w.x & 0xffff0000u); qv[8 * c + 2] = __uint_as_float(w.y << 16); qv[8 * c + 3] = __uint_as_float(w.y & 0xffff0000u);
          qv[8 * c + 4] = __uint_as_float(w.z << 16); qv[8 * c + 5] = __uint_as_float(w.z & 0xffff0000u); qv[8 * c + 6] = __uint_as_float(w.w << 16); qv[8 * c + 7] = __uint_as_float(w.w & 0xffff0000u); }
      float gs[7];
#pragma unroll
      for (int n = 0; n < 7; ++n) { float a = -3.0e38f; if (n < qb) { const float* km = kmean + (size_t)(bh * 8 + n) * 64; a = 0.f;
#pragma unroll
              for (int d = 0; d < 64; ++d) a += qv[d] * km[d]; }
          gs[n] = a; }
#pragma unroll
      for (int r = 0; r < 3; ++r) { int best = -1; float bv = -3.0e38f;
#pragma unroll
          for (int n = 0; n < 7; ++n) if (n < qb && !((selmask >> n) & 1u) && gs[n] > bv) { bv = gs[n]; best = n; }
          if (best >= 0) selmask |= 1u << best; } }
    unsigned mskp = 0;
#pragma unroll
    for (int qg = 0; qg < NQG; ++qg) mskp |= ((unsigned)__shfl((int)selmask, 16 * qg + fr) & 0xffu) << (8 * qg);
    unsigned umask = 0;
#pragma unroll
    for (int n = 0; n < 7; ++n) if (__ballot((selmask >> n) & 1u) != 0ull) umask |= 1u << n;
    bf16x8 qf[NQG][2];
#pragma unroll
    for (int qg = 0; qg < NQG; ++qg)
#pragma unroll
        for (int ks = 0; ks < 2; ++ks) qf[qg][ks] = *(const GAS bf16x8*)(proj + (rowb + t0 + 16 * qg + fr) * NPROJ + PC_AQ + h * 64 + 32 * ks + 8 * fq);
    f32x4 o[4][NQG];
#pragma unroll
    for (int dt = 0; dt < 4; ++dt)
#pragma unroll
        for (int qg = 0; qg < NQG; ++qg) o[dt][qg] = (f32x4){0.f, 0.f, 0.f, 0.f};
    float mrun[NQG], lrun[NQG];
#pragma unroll
    for (int qg = 0; qg < NQG; ++qg) { mrun[qg] = -1.0e30f; lrun[qg] = 0.f; }
    const float cexp = 0.125f * 1.4426950408889634f;
    const int kperm = 8 * (fr >> 2) + (fr & 3);
    for (int it = 0; it <= qb; ++it) {
        const int nb = (it == 0) ? qb : it - 1;
        if (it > 0 && !((umask >> nb) & 1u)) continue;
        const int nsteps = (it == 0) ? (wsl * NQ + NQ - 1) / 32 + 1 : 8;
        bf16x8 kfn[2][2];
        { const size_t kb0 = rowb + nb * 256;
#pragma unroll
          for (int kt = 0; kt < 2; ++kt)
#pragma unroll
              for (int ks = 0; ks < 2; ++ks) kfn[kt][ks] = *(const GAS bf16x8*)(proj + (kb0 + kperm + 4 * kt) * NPROJ + PC_AK + h * 64 + 32 * ks + 8 * fq); }
        for (int st = 0; st < nsteps; ++st) {
            bf16x8 kf[2][2], vf[4];
#pragma unroll
            for (int kt = 0; kt < 2; ++kt) { kf[kt][0] = kfn[kt][0]; kf[kt][1] = kfn[kt][1]; }
#pragma unroll
            for (int dt = 0; dt < 4; ++dt) vf[dt] = *(const GAS bf16x8*)(vt + ((size_t)bh * 64 + 16 * dt + fr) * SEQ + nb * 256 + 32 * st + 8 * fq);
            if (st + 1 < nsteps) { const size_t kb = rowb + nb * 256 + 32 * (st + 1);
#pragma unroll
                for (int kt = 0; kt < 2; ++kt)
#pragma unroll
                    for (int ks = 0; ks < 2; ++ks) kfn[kt][ks] = *(const GAS bf16x8*)(proj + (kb + kperm + 4 * kt) * NPROJ + PC_AK + h * 64 + 32 * ks + 8 * fq); }
            f32x4 s[2][NQG];
#pragma unroll
            for (int kt = 0; kt < 2; ++kt)
#pragma unroll
                for (int qg = 0; qg < NQG; ++qg) { f32x4 a = (f32x4){0.f, 0.f, 0.f, 0.f};
                    a = __builtin_amdgcn_mfma_f32_16x16x32_bf16(kf[kt][0], qf[qg][0], a, 0, 0, 0); a = __builtin_amdgcn_mfma_f32_16x16x32_bf16(kf[kt][1], qf[qg][1], a, 0, 0, 0); s[kt][qg] = a; }
            bf16x8 pf[NQG];
#pragma unroll
            for (int qg = 0; qg < NQG; ++qg) {
                const int qloc = NQ * wsl + 16 * qg + fr; const bool sel = (mskp >> (8 * qg + nb)) & 1u;
                float mx = -1.0e30f;
#pragma unroll
                for (int kt = 0; kt < 2; ++kt)
#pragma unroll
                    for (int i = 0; i < 4; ++i) { const int kloc = 32 * st + 8 * fq + 4 * kt + i; const bool ok = (it == 0) ? (kloc <= qloc) : sel; const float v = ok ? s[kt][qg][i] : -1.0e30f; s[kt][qg][i] = v; mx = fmaxf(mx, v); }
                mx = xrow16_max(mx);
                const float mnew = fmaxf(mrun[qg], mx), alpha = __builtin_amdgcn_exp2f((mrun[qg] - mnew) * cexp); mrun[qg] = mnew;
                float ps = 0.f; float p[8];
#pragma unroll
                for (int kt = 0; kt < 2; ++kt)
#pragma unroll
                    for (int i = 0; i < 4; ++i) { const float e = __builtin_amdgcn_exp2f((s[kt][qg][i] - mnew) * cexp); p[4 * kt + i] = e; ps += e; }
                lrun[qg] = lrun[qg] * alpha + ps;
#pragma unroll
                for (int dt = 0; dt < 4; ++dt) o[dt][qg] *= alpha;
                v4u pw; pw.x = pk2(p[0], p[1]); pw.y = pk2(p[2], p[3]); pw.z = pk2(p[4], p[5]); pw.w = pk2(p[6], p[7]);
                pf[qg] = __builtin_bit_cast(bf16x8, pw);
            }
#pragma unroll
            for (int dt = 0; dt < 4; ++dt)
#pragma unroll
                for (int qg = 0; qg < NQG; ++qg) o[dt][qg] = __builtin_amdgcn_mfma_f32_16x16x32_bf16(vf[dt], pf[qg], o[dt][qg], 0, 0, 0);
        }
    }
#pragma unroll
    for (int qg = 0; qg < NQG; ++qg) { float l = xrow16_sum(lrun[qg]); const float inv = 1.0f / l;
        bf16* orow = y3 + (rowb + t0 + 16 * qg + fr) * 256 + h * 64 + 4 * fq;
#pragma unroll
        for (int dt = 0; dt < 4; ++dt) { const f32x4 v = o[dt][qg] * inv; *(GAS unsigned long long*)(orow + 16 * dt) = (unsigned long long)pk2(v[0], v[1]) | ((unsigned long long)pk2(v[2], v[3]) << 32); } }
}
typedef float f32x2 __attribute__((ext_vector_type(2)));
typedef unsigned u32x2_t __attribute__((ext_vector_type(2)));
constexpr int S2_XA = 0, S2_KN = 16384, S2_VV = 32768, S2_AB = 49152, S2_BUF = 50176, S2_OB = 2 * S2_BUF, S2_QD = S2_OB + 32768, S2_XT = S2_QD + 512, S2_CW = S2_XT + 32 * 68 * 4, S2_FA = S2_KN + 8960  ;
static_assert(S2_CW + 3 * 4 * 64 * 4 + 128 + 256 <= LDSCTL_OFF, "LDS map of the sequential mixers");
template <bool GDN>
__device__ __forceinline__ void seq_mixer2(const bf16* proj, const float* scal, const float* convw, const float* p0, const float* p1, const float* normw, bf16* yout, LAS unsigned char* lds, int bh, int tid) {
    const int wave = __builtin_amdgcn_readfirstlane(tid >> 6), lane = tid & 63;
    const int b = bh >> 2, h = bh & 3; const size_t rowb = (size_t)b * SEQ;
    constexpr int CIN = GDN ? 768 : 512, PCQ = GDN ? PC_GQ : PC_MQ;
    if (wave == 4) { LAS float* cwl = (LAS float*)(lds + S2_CW);
        for (int i = lane; i < 3 * 4 * 64; i += 64) { const int ty = i >> 8, j = (i >> 6) & 3, dd = i & 63; cwl[i] = (GDN || ty < 2) ? convw[j * CIN + ty * 256 + h * 64 + dd] : 0.f; }
        if (lane < 32) cwl[768 + lane] = 0.f; { unsigned no_ = (unsigned)(((GDN ? 0 : h * 64) + lane) * 4); asm volatile("" : "+v"(no_)); cwl[800 + lane] = *(const float*)((const char*)normw + no_); } }
    __syncthreads();
    if (wave < 4) {
        const int fr = lane & 15, fq = lane >> 4, e = 16 * wave + fr, sel = fr & 3;
        f32x4 ST[4];
#pragma unroll
        for (int T = 0; T < 4; ++T) ST[T] = (f32x4){0.f, 0.f, 0.f, 0.f};
        const unsigned wmask = (fq == 0) ? 0xffffffffu : 0u;
        v4u b0 = (v4u){0u, 0u, 0u, 0u}, b1 = b0, b2 = b0, b3 = b0;
        __builtin_amdgcn_s_setprio(3);
        for (int c = 0; c < SEQ / 64; ++c) {
            __syncthreads();
            const LAS bf16* XA = (const LAS bf16*)(lds + (c & 1) * S2_BUF + S2_XA) + (sel >> 1) * 128 + (sel & 1) * 64 + 8 * fq;
            const LAS unsigned char* KP = lds + (c & 1) * S2_BUF + S2_KN + fr * 16;
            const LAS float* VV = (const LAS float*)(lds + (c & 1) * S2_BUF + S2_VV) + e; const LAS float* AB = (const LAS float*)(lds + (c & 1) * S2_BUF + S2_AB);
            LAS float* OB = (LAS float*)(lds + S2_OB + (c & 1) * 16384) + e;
            bf16x8 a0n, a1n, kpn; f32x4 ab1n, ab2n; float v1n, v2n;
#define S2_LOAD(tp) do { a0n = *(const LAS bf16x8*)(XA + (tp) * 256); a1n = *(const LAS bf16x8*)(XA + (tp) * 256 + 32); kpn = *(const LAS bf16x8*)(KP + (tp) * 272); \
            v1n = VV[(tp) * 128]; v2n = VV[(tp) * 128 + 64]; ab1n = *(const LAS f32x4*)(AB + 8 * (tp)); ab2n = *(const LAS f32x4*)(AB + 8 * (tp) + 4); } while (0)
            S2_LOAD(0);
#pragma unroll 4
            for (int tp = 0; tp < 32; ++tp) {
                const bf16x8 a0 = a0n, a1 = a1n, kp = kpn; const f32x4 ab1 = ab1n, ab2 = ab2n; const float ve1 = v1n, ve2 = v2n;
                v4u bl, bhh; bl.x = pk2(ST[0][0], ST[0][1]); bl.y = pk2(ST[0][2], ST[0][3]); bl.z = pk2(ST[1][0], ST[1][1]); bl.w = pk2(ST[1][2], ST[1][3]);
                bhh.x = pk2(ST[2][0], ST[2][1]); bhh.y = pk2(ST[2][2], ST[2][3]); bhh.z = pk2(ST[3][0], ST[3][1]); bhh.w = pk2(ST[3][2], ST[3][3]);
                f32x4 d = (f32x4){0.f, 0.f, 0.f, 0.f};
                d = __builtin_amdgcn_mfma_f32_16x16x32_bf16(a0, __builtin_bit_cast(bf16x8, bl), d, 0, 0, 0);
                d = __builtin_amdgcn_mfma_f32_16x16x32_bf16(a1, __builtin_bit_cast(bf16x8, bhh), d, 0, 0, 0);
                __builtin_amdgcn_sched_barrier(0);
                S2_LOAD(tp + 1);
                __builtin_amdgcn_sched_barrier(0);
                float o1, o2, vn1, vn2;
                if (GDN) { vn1 = ve1 - ab1[1] * d[0]; o1 = ab1[0] * d[1] + vn1 * ab1[2];
                    const float sk2 = ab1[0] * d[2] + ab2[3] * vn1, sq2 = ab1[0] * d[3] + ab1[3] * vn1;
                    vn2 = ve2 - ab2[1] * sk2; o2 = ab2[0] * sq2 + vn2 * ab2[2]; }
                else { vn1 = ve1; o1 = ab1[0] * d[1] + ve1 * ab1[2]; const float sq2 = ab1[0] * d[3] + ab1[3] * ve1; vn2 = ve2; o2 = ab2[0] * sq2 + ve2 * ab2[2]; }
                const float aa = ab1[0] * ab2[0], c1 = ab2[0] * vn1;
#pragma unroll
                for (int T = 0; T < 4; ++T) ST[T] *= aa;
                const unsigned w = pk2(c1, vn2) & wmask;
                b0.x = w; b1.y = w; b2.z = w; b3.w = w;
                ST[0] = __builtin_amdgcn_mfma_f32_16x16x32_bf16(kp, __builtin_bit_cast(bf16x8, b0), ST[0], 0, 0, 0);
                ST[1] = __builtin_amdgcn_mfma_f32_16x16x32_bf16(kp, __builtin_bit_cast(bf16x8, b1), ST[1], 0, 0, 0);
                ST[2] = __builtin_amdgcn_mfma_f32_16x16x32_bf16(kp, __builtin_bit_cast(bf16x8, b2), ST[2], 0, 0, 0);
                ST[3] = __builtin_amdgcn_mfma_f32_16x16x32_bf16(kp, __builtin_bit_cast(bf16x8, b3), ST[3], 0, 0, 0);
                OB[tp * 128] = o1; OB[tp * 128 + 64] = o2;
            }
#undef S2_LOAD
        }
        __builtin_amdgcn_s_setprio(0);
        __syncthreads();
        __syncthreads();
    } else {
        const float s0 = GDN ? __expf(p0[h]) : p0[h], s1 = p1[h];
        const int ht = tid - 256, dgrp = ht & 7, d0 = 8 * dgrp, tg = ht >> 3;
        const int xpos = (dgrp >> 2) * 32 + (dgrp & 1) * 16 + ((dgrp >> 1) & 1) * 4;
        const LAS float* CW0 = (const LAS float*)(lds + S2_CW) + d0;
        const int e0 = (lane & 7) * 8;
        float nstate = 0.f;
#define S2_UNPK(W_, A_) do { const v4u w_ = (W_); A_[0] = __uint_as_float(w_.x << 16); A_[1] = __uint_as_float(w_.x & 0xffff0000u); A_[2] = __uint_as_float(w_.y << 16); A_[3] = __uint_as_float(w_.y & 0xffff0000u); \
                    A_[4] = __uint_as_float(w_.z << 16); A_[5] = __uint_as_float(w_.z & 0xffff0000u); A_[6] = __uint_as_float(w_.w << 16); A_[7] = __uint_as_float(w_.w & 0xffff0000u); } while (0)
        v4u rq[5], rk[5], rv[5]; float sg[2][2]; v4u zws[2];
        const int zh = 2 * (wave - 4);
#define S2_PREF(cn) do { const int s_ = (cn) * 64 + 2 * tg; \
            unsigned off_ = (unsigned)((((int)rowb + s_ - 3) * NPROJ + PCQ + h * 64 + d0) * 2); asm volatile("" : "+v"(off_));     \
            _Pragma("unroll") for (int r = 0; r < 5; ++r) { rq[r] = (v4u){0u, 0u, 0u, 0u}; rk[r] = rq[r]; \
                if (s_ - 3 + r >= 0) { const char* src_ = (const char*)proj + (off_ + (unsigned)(r * NPROJ * 2)); rq[r] = *(const GAS v4u*)src_; rk[r] = *(const GAS v4u*)(src_ + 512); } } } while (0)
#define S2_PREF_V(cn) do { const int s_ = (cn) * 64 + 2 * tg; \
            unsigned off_ = (unsigned)((((int)rowb + s_ - 3) * NPROJ + PCQ + h * 64 + d0) * 2); asm volatile("" : "+v"(off_)); \
            _Pragma("unroll") for (int r = 0; r < 5; ++r) { rv[r] = (v4u){0u, 0u, 0u, 0u}; \
                if (s_ - 3 + r >= 0) { const char* src_ = (const char*)proj + (off_ + (unsigned)(r * NPROJ * 2)); \
                    if (GDN) rv[r] = *(const GAS v4u*)(src_ + 1024); else if (r >= 3) rv[r] = *(const GAS v4u*)(src_ + (PC_MV - PCQ) * 2); } } \
            unsigned so_ = (unsigned)((((int)rowb + s_) * 16 + h) * 4); asm volatile("" : "+v"(so_)); const float* sb_ = (const float*)((const char*)scal + so_); \
            _Pragma("unroll") for (int i = 0; i < 2; ++i) { sg[i][0] = sb_[i * 16 + (GDN ? 0 : 8)]; sg[i][1] = sb_[i * 16 + (GDN ? 4 : 12)]; } } while (0)
#define S2_PREF_Z(cc_) do { unsigned zo_ = (unsigned)((((int)rowb + (cc_) * 64 + (lane >> 3) + zh * 8) * NPROJ + (GDN ? PC_GZ : PC_MO) + h * 64 + e0) * 2); asm volatile("" : "+v"(zo_)); \
            _Pragma("unroll") for (int i8 = 0; i8 < 2; ++i8) zws[i8] = *(const GAS v4u*)((const char*)proj + (zo_ + (unsigned)(i8 * 8 * NPROJ * 2))); } while (0)
        S2_PREF(0);
        for (int c = 0; c <= SEQ / 64 + 1; ++c) {
            if (c >= 2) {
                const int cc = c - 2; const LAS float* OB = (const LAS float*)(lds + S2_OB + (cc & 1) * 16384); const LAS float* QD = (const LAS float*)(lds + S2_QD) + (cc & 1) * 64;
#pragma unroll
                for (int i8 = 0; i8 < 2; ++i8) { const int t = (zh + i8) * 8 + (lane >> 3); const size_t row = rowb + cc * 64 + t;
                    f32x4 oa = *(const LAS f32x4*)(OB + t * 64 + e0), ob = *(const LAS f32x4*)(OB + t * 64 + e0 + 4);
                    if (!GDN) { const float inv = 1.0f / fmaxf(fabsf(QD[t]), 1.0f); oa *= inv; ob *= inv; }
                    float ss = (oa[0] * oa[0] + oa[1] * oa[1]) + (oa[2] * oa[2] + oa[3] * oa[3]) + (ob[0] * ob[0] + ob[1] * ob[1]) + (ob[2] * ob[2] + ob[3] * ob[3]);
                    ss = red8(ss);
                    const float r = rsqrtf(ss * (1.0f / 64.0f) + 1e-6f);
                    float z[8]; S2_UNPK(zws[i8], z);
                    float y[8]; const f32x4 nw0 = *(const LAS f32x4*)(lds + S2_CW + 3200 + 4 * e0), nw1 = *(const LAS f32x4*)(lds + S2_CW + 3200 + 4 * e0 + 16);
#pragma unroll
                    for (int i = 0; i < 8; ++i) { const float ov = (i < 4 ? oa[i] * nw0[i & 3] : ob[i - 4] * nw1[i & 3]) * r; y[i] = GDN ? ov * silu(z[i]) : ov * sigm(z[i]); }
                    v4u yo; yo.x = pk2(y[0], y[1]); yo.y = pk2(y[2], y[3]); yo.z = pk2(y[4], y[5]); yo.w = pk2(y[6], y[7]);
                    *(GAS v4u*)((char*)yout + (unsigned)(((int)row * 256 + h * 64 + e0) * 2)) = yo; }
            }
            if (c < SEQ / 64) {
                S2_PREF_V(c);
                LAS bf16* XA = (LAS bf16*)(lds + (c & 1) * S2_BUF + S2_XA); LAS unsigned char* KPb = lds + (c & 1) * S2_BUF + S2_KN; LAS float* VV = (LAS float*)(lds + (c & 1) * S2_BUF + S2_VV); LAS float* AB = (LAS float*)(lds + (c & 1) * S2_BUF + S2_AB);
#pragma unroll
                for (int i = 0; i < 2; ++i) { const int t = 2 * tg + i;
                    const LAS float* CW = CW0; asm volatile("" : "+v"(CW));
                    float q[8], k[8];
#pragma unroll
                    for (int ii = 0; ii < 8; ++ii) { q[ii] = 0.f; k[ii] = 0.f; }
#pragma unroll
                    for (int j = 0; j < 4; ++j) { const f32x4 wq0 = *(const LAS f32x4*)(CW + j * 64), wq1 = *(const LAS f32x4*)(CW + j * 64 + 4), wk0 = *(const LAS f32x4*)(CW + (4 + j) * 64), wk1 = *(const LAS f32x4*)(CW + (4 + j) * 64 + 4);
                        float x[8]; S2_UNPK(rq[i + j], x);
#pragma unroll
                        for (int ii = 0; ii < 4; ++ii) { q[ii] += wq0[ii] * x[ii]; q[4 + ii] += wq1[ii] * x[4 + ii]; }
                        S2_UNPK(rk[i + j], x);
#pragma unroll
                        for (int ii = 0; ii < 4; ++ii) { k[ii] += wk0[ii] * x[ii]; k[4 + ii] += wk1[ii] * x[4 + ii]; }
                        if (j & 1) asm volatile("" ::: "memory"); }
                    float ssq = 0.f, ssk = 0.f;
#pragma unroll
                    for (int ii = 0; ii < 8; ++ii) { q[ii] = silu(q[ii]); k[ii] = silu(k[ii]); ssq += q[ii] * q[ii]; ssk += k[ii] * k[ii]; }
                    float scq = 1.0f, sck = 1.0f;
                    if (GDN) { ssq = red8(ssq); ssk = red8(ssk);
                        scq = rsqrtf(ssq + 1e-6f) * 0.125f; sck = rsqrtf(ssk + 1e-6f); }
                    else sck = 0.125f * __expf(sg[i][0] + s0);
                    float kq = 0.f;
#pragma unroll
                    for (int ii = 0; ii < 8; ++ii) { q[ii] *= scq; k[ii] *= sck; kq += q[ii] * k[ii]; }
                    kq = red8(kq);
                    float k12 = 0.f, kq12 = 0.f;
                    float kp[8];
                    if (i == 1) { const u32x2_t w0 = *(const LAS u32x2_t*)(XA + (t - 1) * 128 + xpos), w1 = *(const LAS u32x2_t*)(XA + (t - 1) * 128 + xpos + 8);
                        kp[0] = __uint_as_float(w0.x << 16); kp[1] = __uint_as_float(w0.x & 0xffff0000u); kp[2] = __uint_as_float(w0.y << 16); kp[3] = __uint_as_float(w0.y & 0xffff0000u);
                        kp[4] = __uint_as_float(w1.x << 16); kp[5] = __uint_as_float(w1.x & 0xffff0000u); kp[6] = __uint_as_float(w1.y << 16); kp[7] = __uint_as_float(w1.y & 0xffff0000u);
#pragma unroll
                        for (int ii = 0; ii < 8; ++ii) { k12 += kp[ii] * k[ii]; kq12 += kp[ii] * q[ii]; }
                        k12 = red8(k12); kq12 = red8(kq12); }
                    v4u qb, kb; qb.x = pk2(q[0], q[1]); qb.y = pk2(q[2], q[3]); qb.z = pk2(q[4], q[5]); qb.w = pk2(q[6], q[7]); kb.x = pk2(k[0], k[1]); kb.y = pk2(k[2], k[3]); kb.z = pk2(k[4], k[5]); kb.w = pk2(k[6], k[7]);
                    *(LAS u32x2_t*)(XA + t * 128 + xpos) = (u32x2_t){kb.x, kb.y}; *(LAS u32x2_t*)(XA + t * 128 + xpos + 8) = (u32x2_t){kb.z, kb.w};
                    *(LAS u32x2_t*)(XA + t * 128 + 64 + xpos) = (u32x2_t){qb.x, qb.y}; *(LAS u32x2_t*)(XA + t * 128 + 64 + xpos + 8) = (u32x2_t){qb.z, qb.w};
                    if (i == 1) {
#pragma unroll
                        for (int ii = 0; ii < 8; ++ii) *(LAS unsigned*)(KPb + tg * 272 + (8 * (dgrp & 1) + ii) * 16 + (dgrp >> 1) * 4) = pk2(kp[ii], k[ii]); }
                    float be = 1.0f;
                    if (GDN) be = sigm(sg[i][0]);
                    if (dgrp == 0) { f32x4 abv;
                        if (GDN) { const float al = __expf(-s0 * softplusf(sg[i][1] + s1)); abv = (f32x4){al, al * be, kq, k12}; }
                        else { abv = (f32x4){sigm(sg[i][1] + s1), 0.f, kq, 0.f}; *(LAS float*)(lds + (c & 1) * S2_BUF + S2_FA + 4 * t) = abv[0]; }
                        *(LAS f32x4*)(AB + 4 * t) = abv; if (i == 1) AB[4 * (t - 1) + 3] = kq12; }
                    float v[8];
                    if (GDN) {
#pragma unroll
                        for (int ii = 0; ii < 8; ++ii) v[ii] = 0.f;
#pragma unroll
                        for (int j = 0; j < 4; ++j) { float x[8]; S2_UNPK(rv[i + j], x); const f32x4 wv0 = *(const LAS f32x4*)(CW + (8 + j) * 64), wv1 = *(const LAS f32x4*)(CW + (8 + j) * 64 + 4);
#pragma unroll
                            for (int ii = 0; ii < 4; ++ii) { v[ii] += wv0[ii] * x[ii]; v[4 + ii] += wv1[ii] * x[4 + ii]; } }
#pragma unroll
                        for (int ii = 0; ii < 8; ++ii) v[ii] = silu(v[ii]) * be;
                    } else S2_UNPK(rv[3 + i], v);
                    *(LAS f32x4*)(VV + t * 64 + d0) = (f32x4){v[0], v[1], v[2], v[3]}; *(LAS f32x4*)(VV + t * 64 + d0 + 4) = (f32x4){v[4], v[5], v[6], v[7]};
                    asm volatile("" ::: "memory"); }
                if (c + 1 < SEQ / 64) S2_PREF(c + 1);
            }
            if (c >= 1 && c <= SEQ / 64) S2_PREF_Z(c - 1);
            __syncthreads();
            if (!GDN && wave == 5 && c < SEQ / 64) {
                const int lpos = 32 * (lane >> 5) + 8 * ((lane & 15) >> 2) + 4 * ((lane >> 4) & 1) + (lane & 3); const LAS bf16* XQ = (const LAS bf16*)(lds + (c & 1) * S2_BUF + S2_XA) + 64 + lpos; const LAS bf16* XK = (const LAS bf16*)(lds + (c & 1) * S2_BUF + S2_XA) + lpos; const LAS float* AB = (const LAS float*)(lds + (c & 1) * S2_BUF + S2_AB);
                LAS float* QD = (LAS float*)(lds + S2_QD) + (c & 1) * 64; LAS float* XT = (LAS float*)(lds + S2_XT); const LAS float* FA = (const LAS float*)(lds + (c & 1) * S2_BUF + S2_FA);
                for (int hf = 0; hf < 2; ++hf) {
#pragma unroll 1
                    for (int g16 = 0; g16 < 2; ++g16) {
                        const int t0 = hf * 32 + g16 * 16; float fa[16], ka[16], qa[16], xo[16];
#pragma unroll
                        for (int j4 = 0; j4 < 4; ++j4) { const f32x4 f4 = *(const LAS f32x4*)(FA + t0 + 4 * j4); fa[4 * j4] = f4[0]; fa[4 * j4 + 1] = f4[1]; fa[4 * j4 + 2] = f4[2]; fa[4 * j4 + 3] = f4[3]; }
#pragma unroll
                        for (int j = 0; j < 16; ++j) { ka[j] = bf2f(XK[(t0 + j) * 128]); qa[j] = bf2f(XQ[(t0 + j) * 128]); }
#pragma unroll
                        for (int j = 0; j < 16; ++j) { nstate = nstate * fa[j] + ka[j]; xo[j] = nstate * qa[j]; }
#pragma unroll
                        for (int j = 0; j < 16; ++j) XT[(g16 * 16 + j) * 68 + lane] = xo[j];
                    }
                    LDS_WAIT(); asm volatile("" ::: "memory");
                    const LAS float* xr = XT + (lane & 31) * 68 + (lane >> 5) * 32; f32x4 s4 = (f32x4){0.f, 0.f, 0.f, 0.f};
#pragma unroll
                    for (int dd = 0; dd < 8; ++dd) s4 += *(const LAS f32x4*)(xr + 4 * dd);
                    float sm = (s4[0] + s4[1]) + (s4[2] + s4[3]);
                    sm = xhalf_sum(sm);
                    if (lane < 32) QD[hf * 32 + lane] = sm;
                    LDS_WAIT(); asm volatile("" ::: "memory");
                }
            }
        }
#undef S2_UNPK
#undef S2_PREF
#undef S2_PREF_V
#undef S2_PREF_Z
    }
}
__device__ __forceinline__ void s5_wave_mfma(const bf16* proj, const float* s5p, const float* cre, const float* cim, const float* dsk_in, bf16* yg, LAS unsigned char* wl, int item, int lane) {
    const int b = item >> 4, g = item & 15, fr = lane & 15, fq = lane >> 4, p = lane;
    LAS float* bu = (LAS float*)wl;
    LAS bf16* xs = (LAS bf16*)(wl + 16 * 132 * 4);
    bf16x8 bfr[8];
#pragma unroll
    for (int tau = 0; tau < 8; ++tau) { const int pp = 16 * tau + fr, ps = pp >> 1, c = pp & 1; v4u w = (v4u){0u, 0u, 0u, 0u};
        if (fq < 2) { const float* src = s5p + 2048 + (c ? 16384 : 0) + (size_t)(g * 64 + ps) * 16 + 8 * fq; w.x = pk2(src[0], src[1]); w.y = pk2(src[2], src[3]); w.z = pk2(src[4], src[5]); w.w = pk2(src[6], src[7]); }
        bfr[tau] = __builtin_bit_cast(bf16x8, w); }
    bf16x8 cfr[4];
#pragma unroll
    for (int ks = 0; ks < 4; ++ks) { const int p0 = (32 * ks + 8 * fq) >> 1; const float* r = cre + (size_t)(g * 16 + fr) * 64 + p0; const float* im = cim + (size_t)(g * 16 + fr) * 64 + p0;
        v4u w; w.x = pk2(r[0], -im[0]); w.y = pk2(r[1], -im[1]); w.z = pk2(r[2], -im[2]); w.w = pk2(r[3], -im[3]); cfr[ks] = __builtin_bit_cast(bf16x8, w); }
    const float ar = s5p[g * 64 + p], ai = s5p[1024 + g * 64 + p];
    float dsk[4];
#pragma unroll
    for (int j = 0; j < 4; ++j) dsk[j] = dsk_in[g * 16 + 4 * fq + j];
    float xr = 0.f, xi = 0.f;
    const size_t rowb = (size_t)b * SEQ;
    const bf16* ubase = proj + (rowb + fr) * NPROJ + PC_S5 + g * 16;
    v4u unext = (v4u){0u, 0u, 0u, 0u}; unsigned long long usk_next = 0ull;
    if (fq < 2) unext = *(const GAS v4u*)(ubase + 8 * fq);
    usk_next = *(const GAS unsigned long long*)(ubase + 4 * fq);
    for (int c = 0; c < SEQ / 16; ++c) {
        const v4u ucur = unext; const unsigned long long usk = usk_next;
        if (c + 1 < SEQ / 16) { const bf16* un = ubase + (size_t)(c + 1) * 16 * NPROJ; if (fq < 2) unext = *(const GAS v4u*)(un + 8 * fq); usk_next = *(const GAS unsigned long long*)(un + 4 * fq); }
        const bf16x8 ufr = __builtin_bit_cast(bf16x8, ucur);
#pragma unroll
        for (int tau = 0; tau < 8; ++tau) { f32x4 d = (f32x4){0.f, 0.f, 0.f, 0.f}; d = __builtin_amdgcn_mfma_f32_16x16x32_bf16(bfr[tau], ufr, d, 0, 0, 0);
            *(LAS f32x4*)(bu + fr * 132 + 16 * tau + 4 * fq) = d; }
        LDS_WAIT(); asm volatile("" ::: "memory");
#pragma unroll 4
        for (int t = 0; t < 16; ++t) { const f32x2 bb = *(const LAS f32x2*)(bu + t * 132 + 2 * p);
            const float nr = ar * xr - ai * xi + bb.x, ni = ar * xi + ai * xr + bb.y; xr = nr; xi = ni;
            *(LAS unsigned*)(xs + t * 136 + 2 * p) = pk2(xr, xi); }
        LDS_WAIT(); asm volatile("" ::: "memory");
        f32x4 y = (f32x4){0.f, 0.f, 0.f, 0.f};
#pragma unroll
        for (int ks = 0; ks < 4; ++ks) { const bf16x8 xf = *(const LAS bf16x8*)(xs + fr * 136 + 32 * ks + 8 * fq); y = __builtin_amdgcn_mfma_f32_16x16x32_bf16(cfr[ks], xf, y, 0, 0, 0); }
        const float u4[4] = {__uint_as_float((unsigned)usk << 16), __uint_as_float((unsigned)usk & 0xffff0000u), __uint_as_float((unsigned)(usk >> 32) << 16), __uint_as_float((unsigned)(usk >> 32) & 0xffff0000u)};
        float o[4];
#pragma unroll
        for (int j = 0; j < 4; ++j) o[j] = gelu_tanh(y[j] + dsk[j] * u4[j]);
        *(GAS unsigned long long*)(yg + (rowb + c * 16 + fr) * 256 + g * 16 + 4 * fq) = (unsigned long long)pk2(o[0], o[1]) | ((unsigned long long)pk2(o[2], o[3]) << 32);
        LDS_WAIT(); asm volatile("" ::: "memory");
    }
}
#ifndef PHASE_MASK
#define PHASE_MASK 0xFFFFFFFFu
#endif
#define PH(k) ((PHASE_MASK >> (k)) & 1u)
#ifndef SEQ_REPS
#define SEQ_REPS 1
#endif
#ifndef DOWN_FLIP
#define DOWN_FLIP 0
#endif
#ifndef DOWN_SP2
#define DOWN_SP2 true
#endif
#ifndef DOWN_ALIGN
#define DOWN_ALIGN true
#endif
#ifndef MOBA_NQG
#define MOBA_NQG 4
#endif
struct Args { const float* in[36]; float* out; unsigned char* ws; };
typedef const Args __attribute__((address_space(4))) CArgs;
__device__ __forceinline__ LayerW layer_ptrs(CArgs& a, int l) {
    LayerW L;
    L.ffn1_norm = a.in[3] + (size_t)l * D; L.ffn1_w_gu = a.in[4] + (size_t)l * D * NGU; L.ffn1_w_down = a.in[5] + (size_t)l * FF * D; L.mix_norm = a.in[6] + (size_t)l * D; L.w_in = a.in[7] + (size_t)l * D * NIN_SRC;
    L.gdn_conv = a.in[8] + (size_t)l * 4 * 768; L.gdn_a_log = a.in[9] + l * 4; L.gdn_dt_bias = a.in[10] + l * 4; L.gdn_norm = a.in[11] + l * 64;
    L.mlstm_conv = a.in[12] + (size_t)l * 4 * 512; L.mlstm_i_bias = a.in[13] + l * 4; L.mlstm_f_bias = a.in[14] + l * 4; L.mlstm_norm = a.in[15] + l * 256;
    L.s5_lre = a.in[16] + l * 1024; L.s5_lim = a.in[17] + l * 1024; L.s5_bre = a.in[18] + l * 16384; L.s5_bim = a.in[19] + l * 16384; L.s5_cre = a.in[20] + l * 16384; L.s5_cim = a.in[21] + l * 16384;
    L.s5_d = a.in[22] + l * 256; L.s5_log_dt = a.in[23] + l * 16; L.s5_w_glu = a.in[24] + (size_t)l * 65536; L.s5_b_glu = a.in[25] + l * 256;
    L.w_gate = a.in[26] + (size_t)l * 4 * D * D; L.w_branch = a.in[27] + (size_t)l * 4 * 256 * D; L.w_out = a.in[28] + (size_t)l * D * D;
    L.ffn2_norm = a.in[29] + (size_t)l * D; L.ffn2_w_gu = a.in[30] + (size_t)l * D * NGU; L.ffn2_w_down = a.in[31] + (size_t)l * FF * D;
    L.ple_norm = a.in[32] + (size_t)l * D; L.ple_w_proj = a.in[33] + (size_t)l * PLED * D; L.ple_w_gate = a.in[34] + (size_t)l * D * D;
    return L;
}

__global__ void __launch_bounds__(NWAVES * 64, 2) mk_fwd(Args args_k) {
    (void)args_k;
#define KARGP() ((CArgs*)__builtin_amdgcn_kernarg_segment_ptr())
    extern __shared__ __attribute__((aligned(16))) unsigned char lds_raw[];
    LAS unsigned char* lds = (LAS unsigned char*)lds_raw;
    const int G = gridDim.x;
    for (int u = threadIdx.x; u < (LDS_BYTES - LDSCTL_OFF) / 4; u += NWAVES * 64) ((LAS unsigned*)(lds + LDSCTL_OFF))[u] = 0u;
    __syncthreads();
    (void)xcd_barrier_post((unsigned*)(KARGP()->ws + WS_CTL) + CW_BAR, (volatile LAS unsigned*)(lds + LDSCTL_OFF) + 8);
#define GRID_BAR() do { CArgs* gp_ = KARGP(); asm volatile("" : "+s"(gp_)); unsigned char* bw_ = gp_->ws; asm volatile("" : "+s"(bw_)); XcdBarrier bar_; bar_.bar = (unsigned*)(bw_ + WS_CTL) + CW_BAR; bar_.x = xb_xcc_id(); bar_.st = (volatile LAS unsigned*)(lds + LDSCTL_OFF) + 8; xcd_barrier(bar_); } while (0)
    unsigned gbn = 0;
#define GROUP_BAR() do { ++gbn; CArgs* gq_ = KARGP(); asm volatile("" : "+s"(gq_)); unsigned char* gw_ = gq_->ws; asm volatile("" : "+s"(gw_)); const unsigned gi_ = blockIdx.x & 7u; \
        group_barrier((unsigned*)(gw_ + WS_CTL) + CW_GRP + 64 * gi_, gbn * (((unsigned)G - gi_ + 7u) >> 3)); } while (0)
#define WSP(T, off) ((T*)(wsl + (off)))
#define LAUNDER() CArgs* ap_ = KARGP(); asm volatile("" : "+s"(ap_)); unsigned char* wsl = ap_->ws; asm volatile("" : "+s"(wsl)); int K256 = 256, K1024 = 1024, KFF = FF; asm volatile("" : "+s"(K256), "+s"(K1024), "+s"(KFF)); (void)K256; (void)K1024; (void)KFF; int tid = threadIdx.x; asm volatile("" : "+v"(tid)); const int lane = tid & 63, wave = __builtin_amdgcn_readfirstlane(tid >> 6); (void)lane; (void)wave; int bid = blockIdx.x; asm volatile("" : "+s"(bid)); (void)bid
#define GW (blockIdx.x * NWAVES + wave)
#define NGW (G * NWAVES)

#if PH(0)
#ifdef PROBE_REP0
#pragma nounroll
    for (int rep_ = 0; rep_ < PROBE_REP0; ++rep_)
#endif
    { LAUNDER(); const LayerW L = layer_ptrs(*ap_, 0); const LayerW L1 = layer_ptrs(*ap_, 1);
#ifndef PW_REPS
#define PW_REPS 1
#endif
      for (int rpw_ = 0; rpw_ < PW_REPS; ++rpw_)
      prologue_weights(L, ap_->ws + WS_W, lds, GW, NGW, wave, lane);
      prologue_s5(L, WSP(float, WS_S5P), blockIdx.x * 512 + tid, G * 512);
      prologue_s5(L1, WSP(float, WS_S5P) + 40960, blockIdx.x * 512 + tid, G * 512);
      prologue_rope((const int*)ap_->in[2], (float*)((unsigned char*)ap_->out + OUT_ROPE), (size_t)blockIdx.x * 512 + tid, (size_t)G * 512);
      x_to_hb(ap_->in[0], WSP(bf16, WS_HB), WSP(pg8::rowss_t, WS_ROWSS), GW, NGW, lane); }
    GRID_BAR();
#endif
    const int hb0 = (G >= 256) ? 128 : 0;
    for (int l = 0; l < DEPTH; ++l) {
#define WB(off) ((const pg8::bf16_t*)((l == 0 ? wsl + WS_W : (unsigned char*)ap_->out + OUT_W1) + (off)))
#define HCUR() ((const pg8::bf16_t*)(l == 0 ? wsl + WS_HB : (unsigned char*)ap_->out + OUT_T))
#if PH(1)
#ifndef GU_REPS
#define GU_REPS 1
#endif
        for (int repg_ = 0; repg_ < GU_REPS; ++repg_)
        { LAUNDER(); pg8::Gemm g{HCUR(), WB(W_GU1), M, NGU, K1024, 30, 0}; pg8::StaticOrder S; S.init(M, NGU, G, bid);
          pg8::EpiSwiGLU E{WSP(pg8::bf16_t, WS_BIG), WSP(pg8::rowss_t, WS_ROWSS) + (size_t)(4 * l) * M, FF};
          pg8::gemm_phase<pg8::EpiSwiGLU, pg8::StaticOrder, true, true>(lds + RING_OFF, g, S, E);
          GROUP_BAR(); }
#endif
#if PH(2)
        { LAUNDER(); pg8::Gemm g{WSP(const pg8::bf16_t, WS_BIG), WB(W_D1), M, D, KFF, 30, 0}; pg8::StaticOrder S; S.init(M, D, G, bid);
          pg8::EpiRes E{HCUR(), WSP(pg8::bf16_t, WS_HB), WSP(pg8::rowss_t, WS_ROWSS) + (size_t)(4 * l + 1) * M, 0.5f};
          pg8::gemm_phase<pg8::EpiRes, pg8::StaticOrder, DOWN_ALIGN, DOWN_SP2>(lds + RING_OFF, g, S, E); }
        GRID_BAR();
#endif
#ifdef PROBE_BARS
        for (int pb_ = 0; pb_ < PROBE_BARS; ++pb_) GRID_BAR();
#endif
#if PH(3)
        { LAUNDER(); pg8::Gemm g{WSP(const pg8::bf16_t, WS_HB), WB(W_IN), M, 2560, K1024, 30, 0}; pg8::StaticOrder S; S.init(M, 2560, G, bid);
          pg8::EpiMixIn E{WSP(pg8::bf16_t, WS_BIG), WSP(float, WS_SCAL), WSP(pg8::rowss_t, WS_ROWSS) + (size_t)(4 * l + 1) * M};
          pg8::gemm_phase<pg8::EpiMixIn, pg8::StaticOrder, true, true>(lds + RING_OFF, g, S, E); }
        GRID_BAR();
#endif
#ifdef PROBE_IDLE_US
        { const unsigned long long t0_ = __builtin_amdgcn_s_memrealtime(); while (__builtin_amdgcn_s_memrealtime() - t0_ < (unsigned long long)PROBE_IDLE_US * 100ull) __builtin_amdgcn_s_sleep(32); __syncthreads(); }
#endif
#if PH(5)
        { LAUNDER(); const LayerW L = layer_ptrs(*ap_, l);
          for (int rep_ = 0; rep_ < SEQ_REPS; ++rep_)
          for (int it = blockIdx.x; it < 64; it += G) seq_mixer2<true>(WSP(const bf16, WS_BIG), WSP(const float, WS_SCAL), L.gdn_conv, L.gdn_a_log, L.gdn_dt_bias, L.gdn_norm, WSP(bf16, WS_Y), lds, it, tid); }
#endif
#if PH(6)
        { LAUNDER(); const LayerW L = layer_ptrs(*ap_, l);
          for (int rep_ = 0; rep_ < SEQ_REPS; ++rep_)
          for (int it = blockIdx.x; it < 64 + 64; it += G) if (it >= 64) seq_mixer2<false>(WSP(const bf16, WS_BIG), WSP(const float, WS_SCAL), L.mlstm_conv, L.mlstm_i_bias, L.mlstm_f_bias, L.mlstm_norm, WSP(bf16, WS_Y) + (size_t)M * 256, lds, it - 64, tid); }
#endif
#if PH(15)
        const int gb0 = (G >= 256) ? hb0 + 32 : hb0;
        if ((int)blockIdx.x >= gb0) {
          { LAUNDER(); pg8::Gemm g{WSP(const pg8::bf16_t, WS_HB), WB(W_IN + (size_t)2560 * D * 2), M, 768, K1024, 30, 0}; pg8::StaticOrder S; S.init(M, 768, G - gb0, bid - gb0);
            pg8::EpiMoba E{WSP(pg8::bf16_t, WS_BIG), WSP(pg8::bf16_t, WS_VT), WSP(float, WS_KMEAN) + (size_t)l * 32768, (const float*)((unsigned char*)ap_->out + OUT_ROPE), WSP(pg8::rowss_t, WS_ROWSS) + (size_t)(4 * l + 1) * M};
            pg8::gemm_phase<pg8::EpiMoba, pg8::StaticOrder, true, true>(lds + RING_OFF, g, S, E);
            asm volatile("s_waitcnt vmcnt(0)" ::: "memory"); __syncthreads();
            if (tid == 0) { __builtin_amdgcn_fence(__ATOMIC_RELEASE, "agent"); asm volatile("s_waitcnt vmcnt(0)" ::: "memory"); __hip_atomic_fetch_add(WSP(unsigned, WS_CTL) + CW_FLAG + 64 * l, 1u, RLX_AGENT); } }
          { LAUNDER(); const int nh = G - gb0, c0 = (int)blockIdx.x - gb0;
            for (int pm = c0; pm < M / 256; pm += nh) cvt_rows_bf16(ap_->in[1] + ((size_t)l * M + (size_t)pm * 256) * PLED, WSP(bf16, WS_PB) + (size_t)pm * 256 * PLED, (size_t)256 * PLED, (size_t)tid, (size_t)512);
            asm volatile("s_waitcnt vmcnt(0)" ::: "memory"); __syncthreads();
            pg8::Gemm g{WSP(const pg8::bf16_t, WS_PB), WB(W_PLE), M, D, K256, 30, 0}; pg8::PanelOrder S{c0, nh, M / 256, 4};
            pg8::EpiBf16P E{(pg8::bf16_t*)((unsigned char*)ap_->out + OUT_T), D};
            pg8::gemm_phase<pg8::EpiBf16P, pg8::PanelOrder, true, true>(lds + RING_OFF, g, S, E); }
          __syncthreads();
          const int wb0 = gb0;
          if (l == 0 && (int)blockIdx.x >= wb0) { LAUNDER(); const LayerW L1 = layer_ptrs(*ap_, 1);
            prologue_weights(L1, (unsigned char*)ap_->out + OUT_W1, lds, ((int)blockIdx.x - wb0) * NWAVES + wave, (G - wb0) * NWAVES, wave, lane); }
        }
#endif
#if PH(7)
        { LAUNDER(); const LayerW L = layer_ptrs(*ap_, l); const int c0 = (int)blockIdx.x - hb0;
#ifndef S5_REPS
#define S5_REPS 1
#endif
          for (int rep5_ = 0; rep5_ < S5_REPS; ++rep5_)
          if (c0 >= 0) for (int it = c0; it < 32; it += G - hb0)
              s5_wave_mfma(WSP(const bf16, WS_BIG), WSP(const float, WS_S5P) + 40960 * l, L.s5_cre, L.s5_cim, L.s5_d, WSP(bf16, WS_YG), lds + wave * WAVE_LDS, it * 8 + wave, lane); }
        if (G >= 256 && (int)blockIdx.x >= hb0 && (int)blockIdx.x < hb0 + 32) {
          LAUNDER(); const int c0 = (int)blockIdx.x - hb0; unsigned* f5 = WSP(unsigned, WS_CTL) + CW_S5F + (l * 16 + (c0 >> 1)) * 64;
          asm volatile("s_waitcnt vmcnt(0)" ::: "memory"); __syncthreads();
          if (tid == 0) { __builtin_amdgcn_fence(__ATOMIC_RELEASE, "agent"); asm volatile("s_waitcnt vmcnt(0)" ::: "memory"); __hip_atomic_fetch_add(f5, 1u, RLX_AGENT);
              unsigned sp = 0; while (__hip_atomic_load(f5, RLX_AGENT) < 2u) { __builtin_amdgcn_s_sleep(2); if (++sp > (1u << 22)) break; } }
          __syncthreads();
          __builtin_amdgcn_fence(__ATOMIC_ACQUIRE, "agent"); asm volatile("s_waitcnt vmcnt(0)" ::: "memory");
          const int p0 = 8 * (c0 >> 1) + 4 * (c0 & 1);
          pg8::Gemm g{WSP(const pg8::bf16_t, WS_YG), WB(W_GLU), M, 256, K256, 30, 0}; pg8::PanelOrder S{p0, 1, p0 + 4, 1};
          pg8::EpiGLU E{WSP(const pg8::bf16_t, WS_YG), WSP(pg8::bf16_t, WS_Y) + (size_t)2 * M * 256, ap_->in[25] + l * 256};
          pg8::gemm_phase<pg8::EpiGLU, pg8::PanelOrder, true, true>(lds + RING_OFF, g, S, E); }
#endif
#if PH(8)
        { LAUNDER(); unsigned* flag = WSP(unsigned, WS_CTL) + CW_FLAG + 64 * l; const unsigned need = (unsigned)(G - gb0);
          __syncthreads();
          if (tid == 0) { unsigned sp = 0; while (__hip_atomic_load(flag, RLX_AGENT) < need) { __builtin_amdgcn_s_sleep(2); if (++sp > (1u << 22)) break; } }
          __syncthreads();
          __builtin_amdgcn_fence(__ATOMIC_ACQUIRE, "agent"); asm volatile("s_waitcnt vmcnt(0)" ::: "memory");
          unsigned* qctr = WSP(unsigned, WS_CTL) + CW_QUEUE + 64 * l;
          for (;;) { unsigned idx = 0; if (lane == 0) idx = __hip_atomic_fetch_add(qctr, 1u, RLX_AGENT); idx = __builtin_amdgcn_readfirstlane(idx);
              if (idx >= 8192u / MOBA_NQG) break;
              const int qsl = idx & (16 / MOBA_NQG - 1), bh = (idx / (16 / MOBA_NQG)) & 63, qb = 7 - (int)(idx / (1024 / MOBA_NQG));
              moba_mfma_item<MOBA_NQG>(WSP(const bf16, WS_BIG), WSP(const float, WS_KMEAN) + (size_t)l * 32768, WSP(const bf16, WS_VT), WSP(bf16, WS_Y) + (size_t)3 * M * 256, bh, qb, qsl, lane); } }
#endif
        GRID_BAR();
#if PH(11)
#ifndef G11_REPS
#define G11_REPS 1
#endif
        for (int rep11_ = 0; rep11_ < G11_REPS; ++rep11_)
        { LAUNDER(); pg8::StaticOrder S0; S0.init(M, NGATE, G, bid);
          pg8::Gemm g{WSP(const pg8::bf16_t, WS_HB), WB(W_GATE), M, NGATE, K1024, 30, 0};
          pg8::EpiGateP E{WSP(const pg8::bf16_t, WS_Y), WB(W_BR), WSP(pg8::bf16_t, WS_BIG + 184 * MiB), WSP(pg8::rowss_t, WS_ROWSS) + (size_t)(4 * l + 1) * M, (size_t)M * 256};
#pragma nounroll
          for (int r = 0; ; ++r) { pg8::OneUnit S1; if (!S0.next(r, S1.u)) break;
              pg8::gemm_phase<pg8::EpiGateP, pg8::OneUnit, false, true>(lds + RING_OFF, g, S1, E);
              __syncthreads(); }
          GROUP_BAR(); }
#endif
#if PH(12)
#ifndef OUT_REPS
#define OUT_REPS 1
#endif
        for (int rep12_ = 0; rep12_ < OUT_REPS; ++rep12_)
        { LAUNDER(); pg8::Gemm g{WSP(const pg8::bf16_t, WS_BIG + 184 * MiB), WB(W_OUT), M, D, K1024, 30, 0}; pg8::StaticOrder S; S.init(M, D, G, bid);
          const bool real_ = (rep12_ + 1 == OUT_REPS);
          pg8::EpiRes E{WSP(const pg8::bf16_t, WS_HB), real_ ? WSP(pg8::bf16_t, WS_HB) : WSP(pg8::bf16_t, WS_BIG + 128 * MiB), real_ ? WSP(pg8::rowss_t, WS_ROWSS) + (size_t)(4 * l + 2) * M : WSP(pg8::rowss_t, WS_BIG + 200 * MiB), 1.0f};
          pg8::gemm_phase<pg8::EpiRes, pg8::StaticOrder, true, true>(lds + RING_OFF, g, S, E);
          GROUP_BAR(); }
#endif
#if PH(13)
#ifndef GU_REPS
#define GU_REPS 1
#endif
        for (int repg_ = 0; repg_ < GU_REPS; ++repg_)
        { LAUNDER(); pg8::Gemm g{WSP(const pg8::bf16_t, WS_HB), WB(W_GU2), M, NGU, K1024, 30, 0}; pg8::StaticOrder S; S.init(M, NGU, G, bid);
          pg8::EpiSwiGLU E{WSP(pg8::bf16_t, WS_BIG), WSP(pg8::rowss_t, WS_ROWSS) + (size_t)(4 * l + 2) * M, FF};
          pg8::gemm_phase<pg8::EpiSwiGLU, pg8::StaticOrder, true, true>(lds + RING_OFF, g, S, E);
          GROUP_BAR(); }
#endif
#if PH(14)
#ifndef DOWN_REPS
#define DOWN_REPS 1
#endif
        for (int rep14_ = 0; rep14_ < DOWN_REPS; ++rep14_)
        { LAUNDER(); pg8::Gemm g{WSP(const pg8::bf16_t, WS_BIG), WB(W_D2), M, D, KFF, 30, 0}; pg8::StaticOrder S; S.init(M, D, G, bid);
          const bool real_ = (rep14_ + 1 == DOWN_REPS);
          pg8::EpiRes E{WSP(const pg8::bf16_t, WS_HB), real_ ? WSP(pg8::bf16_t, WS_HB) : WSP(pg8::bf16_t, WS_BIG + 184 * MiB), real_ ? WSP(pg8::rowss_t, WS_ROWSS) + (size_t)(4 * l + 3) * M : WSP(pg8::rowss_t, WS_BIG + 250 * MiB), 0.5f};
          pg8::gemm_phase<pg8::EpiRes, pg8::StaticOrder, DOWN_ALIGN, DOWN_SP2>(lds + RING_OFF, g, S, E);
          GROUP_BAR(); }
#endif
#if PH(16)
#ifndef PLE_REPS
#define PLE_REPS 1
#endif
        for (int rep16_ = 0; rep16_ < PLE_REPS; ++rep16_)
        { LAUNDER(); pg8::Gemm g{WSP(const pg8::bf16_t, WS_HB), WB(W_PG), M, D, K1024, 30, 0}; pg8::StaticOrder S; S.init(M, D, G, bid);
          const bool real_ = (rep16_ + 1 == PLE_REPS);
          pg8::EpiPle E{WSP(const pg8::bf16_t, WS_HB), (const pg8::bf16_t*)((unsigned char*)ap_->out + OUT_T), !real_ ? WSP(pg8::bf16_t, WS_BIG + 128 * MiB) : l == 0 ? (pg8::bf16_t*)((unsigned char*)ap_->out + OUT_T) : WSP(pg8::bf16_t, WS_BIG + 184 * MiB),
                        WSP(pg8::rowss_t, WS_ROWSS) + (size_t)(4 * l + 3) * M, real_ ? WSP(pg8::rowss_t, WS_ROWSS) + (size_t)(4 * l + 4) * M : WSP(pg8::rowss_t, WS_BIG + 200 * MiB)};
          pg8::gemm_phase<pg8::EpiPle, pg8::StaticOrder, true, true>(lds + RING_OFF, g, S, E);
          if (l + 1 < DEPTH) GROUP_BAR(); else GRID_BAR(); }
#endif
    }
#if PH(17)
#ifdef PROBE_REP0
#pragma nounroll
    for (int rep_ = 0; rep_ < PROBE_REP0; ++rep_)
#endif
    { LAUNDER(); final_norm(WSP(const bf16, WS_BIG + 184 * MiB), ap_->out, WSP(pg8::rowss_t, WS_ROWSS) + (size_t)8 * M, ap_->in[35], GW, NGW, lane); }
#endif
}

extern "C" void kernel_launch(void* const* d_in, const int* in_sizes, int n_in, void* d_out, int out_size, void* d_ws, size_t ws_size, hipStream_t stream) {
    static int grid = 0;
    if (grid == 0) {
        if (n_in != 36 || out_size != M * D || ws_size < WS_END) { fprintf(stderr, "kernel_launch: unexpected shapes (n_in %d, out %d, ws %zu); nothing launched\n", n_in, out_size, ws_size); grid = -1; return; }
        int dev = 0, cus = 0, per_cu = 0;
        if (hipGetDevice(&dev) != hipSuccess || hipDeviceGetAttribute(&cus, hipDeviceAttributeMultiprocessorCount, dev) != hipSuccess) { grid = -1; return; }
        if (hipFuncSetAttribute((const void*)mk_fwd, hipFuncAttributeMaxDynamicSharedMemorySize, LDS_BYTES) != hipSuccess) { fprintf(stderr, "kernel_launch: hipFuncSetAttribute failed\n"); grid = -1; return; }
        if (hipOccupancyMaxActiveBlocksPerMultiprocessor(&per_cu, (const void*)mk_fwd, NWAVES * 64, LDS_BYTES) != hipSuccess || per_cu < 1) { fprintf(stderr, "kernel_launch: occupancy query says %d\n", per_cu); per_cu = 1; }
        (void)hipGetLastError();
        if (cus < 256) { fprintf(stderr, "kernel_launch: %d CUs; the mixer phase's workgroup roles need 256; nothing launched\n", cus); grid = -1; return; }
        grid = 256;
    }
    if (grid < 0) return;
    if (hipMemsetAsync((char*)d_ws + WS_CTL, 0, CTL_ZERO_BYTES, stream) != hipSuccess) return;
    Args a{};
    for (int i = 0; i < 36; ++i) a.in[i] = (const float*)d_in[i];
    a.out = (float*)d_out; a.ws = (unsigned char*)d_ws;
    hipLaunchKernelGGL(mk_fwd, dim3(grid), dim3(NWAVES * 64), LDS_BYTES, stream, a);
}
```

```cpp
#include <hip/hip_runtime.h>
#include <cstdio>
#include <cstdint>
namespace pg8 {
#define PG8_LAS __attribute__((address_space(3)))
typedef unsigned short bf16_t;
typedef short bf16x8 __attribute__((ext_vector_type(8)));
typedef float f32x4 __attribute__((ext_vector_type(4)));
typedef unsigned u32x4 __attribute__((ext_vector_type(4)));
constexpr int BM = 256, BK = 64, HALF = 128, HTB = HALF * BK * 2  , STAGE_BYTES = 8 * HTB, NXCD = 8, WGM = 8;

__host__ __device__ __forceinline__ int lds_byte(int r, int c) { const int st = (r >> 4) * 2 + (c >> 5), rr = r & 15, cc = c & 31, ob = rr * 64 + cc * 2; return st * 1024 + (ob ^ (((ob >> 9) & 1) << 5)); }
__host__ __device__ __forceinline__ void stage_rc(int b, int& R, int& C) { const int st = b / 1024, sb = b % 1024, swz = sb ^ (((sb >> 9) & 1) << 5); R = (st >> 1) * 16 + swz / 64; C = (st & 1) * 32 + (swz % 64) / 2; }
__host__ __device__ __forceinline__ int perm32(int rho) { const int n = rho >> 4, i = rho & 15; return 8 * (i >> 2) + 4 * n + (i & 3); }

struct Unit { int pm, pn; };
struct Gemm { const bf16_t* A; const bf16_t* Bt; int M, N, K; int ashift; size_t astride; };

struct StaticOrder {
    int nM, nN, nwg, G, c;
    __host__ __device__ __forceinline__ void init(int M, int N, int G_, int c_) { nM = M / BM; nN = N / BM; nwg = nM * nN; G = G_; c = c_; }
    __host__ __device__ __forceinline__ bool next(int i, Unit& u) const {
        const long L = (long)i * G + c; if (L >= nwg) return false;
        int wgid = (int)L; { const int q = nwg / NXCD, r = nwg % NXCD, xcd = wgid % NXCD, off = wgid / NXCD; wgid = (xcd < r ? xcd * (q + 1) : r * (q + 1) + (xcd - r) * q) + off; }
        const int nig = WGM * nN, gid = wgid / nig, fm = gid * WGM, gsz = (nM - fm) < WGM ? (nM - fm) : WGM;
        u.pm = fm + ((wgid % nig) % gsz); u.pn = (wgid % nig) / gsz; return true;
    }
    __device__ __forceinline__ void a_ready(const Unit&) const {}
    __device__ __forceinline__ void done(const Unit&) const {}
};
struct PanelOrder {
    int pm0, stride, nM, nN;
    __host__ __device__ __forceinline__ bool next(int i, Unit& u) const { const int p = pm0 + (i / nN) * stride; if (p >= nM) return false; u.pm = p; u.pn = i % nN; return true; }
    __device__ __forceinline__ void a_ready(const Unit&) const {}
    __device__ __forceinline__ void done(const Unit&) const {}
};
struct OneUnit {
    Unit u;
    __host__ __device__ __forceinline__ bool next(int i, Unit& o) const { if (i != 0) return false; o = u; return true; }
    __device__ __forceinline__ void a_ready(const Unit&) const {}
    __device__ __forceinline__ void done(const Unit&) const {}
};

typedef unsigned u32x2 __attribute__((ext_vector_type(2)));
__device__ __forceinline__ unsigned cvt_pk_bf16(float lo, float hi) { unsigned r; asm volatile("v_cvt_pk_bf16_f32 %0, %1, %2" : "=v"(r) : "v"(lo), "v"(hi)); return r; }
__device__ __forceinline__ unsigned cvt_pk_bf16_t(float lo, float hi) { unsigned r; asm volatile("s_nop 1\n\tv_cvt_pk_bf16_f32 %0, %1, %2" : "=v"(r) : "v"(lo), "v"(hi)); return r; }
__device__ __forceinline__ float bf_lo(unsigned w) { return __uint_as_float(w << 16); }
__device__ __forceinline__ float bf_hi(unsigned w) { return __uint_as_float(w & 0xffff0000u); }
__device__ __forceinline__ float sigm(float x) { return __builtin_amdgcn_rcpf(1.0f + __expf(-x)); }
__device__ __forceinline__ float silu(float x) { return x * sigm(x); }
constexpr float RMS_EPS = 1e-6f;
typedef unsigned long long rowss_t;
constexpr float RSS_SCALE = 16777216.0f;
__device__ __forceinline__ float rms_scale(const rowss_t* rowss, int row) { return rsqrtf((float)rowss[row] * (1.0f / (1024.0f * RSS_SCALE)) + RMS_EPS); }
__device__ __forceinline__ void rowss_add(rowss_t* p, float ss) { __hip_atomic_fetch_add(p, (rowss_t)(ss * RSS_SCALE), __ATOMIC_RELAXED, __HIP_MEMORY_SCOPE_AGENT); }
__device__ __forceinline__ u32x4 pack8(const f32x4 a, const f32x4 b) { u32x4 w; w.x = cvt_pk_bf16(a[0], a[1]); w.y = cvt_pk_bf16(a[2], a[3]); w.z = cvt_pk_bf16(b[0], b[1]); w.w = cvt_pk_bf16(b[2], b[3]); return w; }

#define EPI_ROW(ai, m) (row0 + (ai) * HALF + (m) * 16)
__device__ __forceinline__ void load_scales(const rowss_t* rowss, int row0, float (&r)[8]) {
    rowss_t v[8];
#pragma unroll
    for (int g = 0; g < 8; ++g) v[g] = rowss[EPI_ROW(g >> 2, g & 3)];
#pragma unroll
    for (int g = 0; g < 8; ++g) r[g] = rsqrtf((float)v[g] * (1.0f / (1024.0f * RSS_SCALE)) + RMS_EPS);
}
__device__ __forceinline__ void cached_scales(const rowss_t* rowss, PG8_LAS float* sc, int pm, int wr, int wc, int fr, int fq, float (&r)[8]) {
    const int tag = *(const PG8_LAS int*)(sc + 256);
    if (tag != pm) {
        const int tid = (wr * 4 + wc) * 64 + fq * 16 + fr;
        if (tid < 256) { const rowss_t v = *(const __attribute__((address_space(1))) rowss_t*)(rowss + (size_t)pm * BM + tid); sc[tid] = rsqrtf((float)v * (1.0f / (1024.0f * RSS_SCALE)) + RMS_EPS); }
        asm volatile("s_waitcnt lgkmcnt(0)" ::: "memory");
        __builtin_amdgcn_s_barrier();
        if (tid == 0) *(PG8_LAS int*)(sc + 256) = pm;
    }
    asm volatile("" ::: "memory");
#pragma unroll
    for (int g = 0; g < 8; ++g) r[g] = sc[wr * 64 + fr + (g >> 2) * HALF + (g & 3) * 16];
}
struct EpiSwiGLU {
    static constexpr bool PERM = true, AFTER_DRAIN = false; static constexpr int TAIL_OPS = 8;
    bf16_t* act; const rowss_t* rowss; int ldc; PG8_LAS float* sc;
    __device__ __forceinline__ void operator()(const f32x4 (&acc)[2][2][4][2], const Unit& u, int wr, int wc, int fr, int fq) const {
        const int row0 = u.pm * BM + wr * 64 + fr, col0 = u.pn * 128 + wc * 32 + 8 * fq;
        float rs[8]; cached_scales(rowss, sc, u.pm, wr, wc, fr, fq, rs);
#pragma unroll
        for (int ai = 0; ai < 2; ++ai)
#pragma unroll
            for (int m = 0; m < 4; ++m) { const int row = EPI_ROW(ai, m); const float r = rs[ai * 4 + m];
                f32x4 o0, o1;
#pragma unroll
                for (int e = 0; e < 4; ++e) { o0[e] = silu(acc[ai][0][m][0][e] * r) * (acc[ai][1][m][0][e] * r); o1[e] = silu(acc[ai][0][m][1][e] * r) * (acc[ai][1][m][1][e] * r); }
                *(u32x4*)(act + (size_t)row * ldc + col0) = pack8(o0, o1); }
    }
};
struct EpiBf16P {
    static constexpr bool PERM = true, AFTER_DRAIN = false; static constexpr int TAIL_OPS = 0;
    bf16_t* O; int ldc;
    __device__ __forceinline__ void operator()(const f32x4 (&acc)[2][2][4][2], const Unit& u, int wr, int wc, int fr, int fq) const {
        const int row0 = u.pm * BM + wr * 64 + fr, col0 = u.pn * BM + wc * 32 + 8 * fq;
#pragma unroll
        for (int ai = 0; ai < 2; ++ai)
#pragma unroll
            for (int m = 0; m < 4; ++m) { bf16_t* rowp = O + (size_t)EPI_ROW(ai, m) * ldc + col0;
#pragma unroll
                for (int bj = 0; bj < 2; ++bj) *(u32x4*)(rowp + bj * HALF) = pack8(acc[ai][bj][m][0], acc[ai][bj][m][1]); }
    }
};
__device__ __forceinline__ void unpack8(const u32x4 w, f32x4& a, f32x4& b) { a[0] = bf_lo(w.x); a[1] = bf_hi(w.x); a[2] = bf_lo(w.y); a[3] = bf_hi(w.y); b[0] = bf_lo(w.z); b[1] = bf_hi(w.z); b[2] = bf_lo(w.w); b[3] = bf_hi(w.w); }
__device__ __forceinline__ float sumsq8(const f32x4 v0, const f32x4 v1) { return (v0[0] * v0[0] + v0[1] * v0[1]) + (v0[2] * v0[2] + v0[3] * v0[3]) + (v1[0] * v1[0] + v1[1] * v1[1]) + (v1[2] * v1[2] + v1[3] * v1[3]); }
struct EpiRes {
    static constexpr bool PERM = true, AFTER_DRAIN = false; static constexpr int TAIL_OPS = 0;
    const bf16_t* base; bf16_t* hb; rowss_t* rowss_next; float scale;
    __device__ __forceinline__ void operator()(const f32x4 (&acc)[2][2][4][2], const Unit& u, int wr, int wc, int fr, int fq) const {
        const int row0 = u.pm * BM + wr * 64 + fr, col0 = u.pn * BM + wc * 32 + 8 * fq;
#pragma unroll
        for (int ai = 0; ai < 2; ++ai) {
            u32x4 bw[4][2];
#pragma unroll
            for (int m = 0; m < 4; ++m)
#pragma unroll
                for (int bj = 0; bj < 2; ++bj) bw[m][bj] = *(const u32x4*)(base + (size_t)EPI_ROW(ai, m) * 1024 + col0 + bj * HALF);
#pragma unroll
            for (int m = 0; m < 4; ++m) { const int row = EPI_ROW(ai, m); const size_t off = (size_t)row * 1024 + col0; float ss = 0.f;
#pragma unroll
                for (int bj = 0; bj < 2; ++bj) { f32x4 b0, b1; unpack8(bw[m][bj], b0, b1);
                    const f32x4 v0 = b0 + acc[ai][bj][m][0] * scale, v1 = b1 + acc[ai][bj][m][1] * scale;
                    *(u32x4*)(hb + off + bj * HALF) = pack8(v0, v1); ss += sumsq8(v0, v1); }
                ss += __shfl_xor(ss, 16); ss += __shfl_xor(ss, 32);
                if (fq == 0) rowss_add(rowss_next + row, ss); }
            asm volatile("" ::: "memory"); }
    }
};
struct EpiMixIn {
    static constexpr bool PERM = true, AFTER_DRAIN = false; static constexpr int TAIL_OPS = 0;
    bf16_t* proj; float* scal; const rowss_t* rowss; PG8_LAS float* sc;
    __device__ __forceinline__ void operator()(const f32x4 (&acc)[2][2][4][2], const Unit& u, int wr, int wc, int fr, int fq) const {
        const int row0 = u.pm * BM + wr * 64 + fr;
        float rs[8]; cached_scales(rowss, sc, u.pm, wr, wc, fr, fq, rs);
        if (u.pn < 9) { const int col0 = u.pn * BM + wc * 32 + 8 * fq;
#pragma unroll
            for (int ai = 0; ai < 2; ++ai)
#pragma unroll
                for (int m = 0; m < 4; ++m) { const float r = rs[ai * 4 + m]; bf16_t* rowp = proj + (size_t)EPI_ROW(ai, m) * 3072 + col0;
#pragma unroll
                    for (int bj = 0; bj < 2; ++bj) *(u32x4*)(rowp + bj * HALF) = pack8(acc[ai][bj][m][0] * r, acc[ai][bj][m][1] * r); }
        } else if (wc == 0 && fq < 2) {
#pragma unroll
            for (int ai = 0; ai < 2; ++ai)
#pragma unroll
                for (int m = 0; m < 4; ++m) { const float r = rs[ai * 4 + m]; float* rowp = scal + (size_t)EPI_ROW(ai, m) * 16 + 8 * fq;
                    *(f32x4*)(rowp) = acc[ai][0][m][0] * r; *(f32x4*)(rowp + 4) = acc[ai][0][m][1] * r; }
        }
    }
};
struct EpiGateMerge {
    static constexpr bool PERM = false, AFTER_DRAIN = false; static constexpr int TAIL_OPS = 0;
    const bf16_t* P; bf16_t* merged; const rowss_t* rowss;
    __device__ __forceinline__ void operator()(const f32x4 (&acc)[2][2][4][2], const Unit& u, int wr, int wc, int fr, int fq) const {
        const int row0 = u.pm * BM + wr * 64 + fr, j0 = u.pn * 64 + wc * 16 + 4 * fq;
        float rs[8]; load_scales(rowss, row0, rs);
#pragma unroll
        for (int ai = 0; ai < 2; ++ai) {
            u32x2 pw[4][4];
#pragma unroll
            for (int m = 0; m < 4; ++m)
#pragma unroll
                for (int b = 0; b < 4; ++b) pw[m][b] = *(const u32x2*)(P + (size_t)EPI_ROW(ai, m) * 4096 + j0 + b * 1024);
#pragma unroll
            for (int m = 0; m < 4; ++m) { const float r = rs[ai * 4 + m];
                f32x4 s = (f32x4){0.f, 0.f, 0.f, 0.f};
#pragma unroll
                for (int bj = 0; bj < 2; ++bj)
#pragma unroll
                    for (int n = 0; n < 2; ++n) { const u32x2 pv = pw[m][2 * bj + n]; const f32x4 a = acc[ai][bj][m][n];
                        s[0] += sigm(a[0] * r) * bf_lo(pv.x); s[1] += sigm(a[1] * r) * bf_hi(pv.x); s[2] += sigm(a[2] * r) * bf_lo(pv.y); s[3] += sigm(a[3] * r) * bf_hi(pv.y); }
                u32x2 w; w.x = cvt_pk_bf16(s[0], s[1]); w.y = cvt_pk_bf16(s[2], s[3]); *(u32x2*)(merged + (size_t)EPI_ROW(ai, m) * 1024 + j0) = w; }
            asm volatile("" ::: "memory"); }
    }
};
struct EpiGateMergeAD {
    static constexpr bool PERM = false, AFTER_DRAIN = true; static constexpr int TAIL_OPS = 0;
    const bf16_t* P; bf16_t* merged; const rowss_t* rowss;
    __device__ __forceinline__ void fused(f32x4 (&acc)[2][2][4][2], const Unit& u, int wr, int wc, int fr, int fq, PG8_LAS unsigned char* lds, int wid, int lane) const {
        const int row0 = u.pm * BM + wr * 64 + fr, j0 = u.pn * 64 + wc * 16 + 4 * fq;
        float rs[8]; load_scales(rowss, row0, rs);
#ifdef AD_BARS
#pragma unroll
        for (int s = 0; s < 16; ++s) { asm volatile("s_waitcnt vmcnt(0) lgkmcnt(0)" ::: "memory"); __builtin_amdgcn_s_barrier(); asm volatile("" ::: "memory"); }
#endif

        u32x2 gp[2][2][4][2];
#pragma unroll
        for (int ai = 0; ai < 2; ++ai)
#pragma unroll
            for (int bj = 0; bj < 2; ++bj)
#pragma unroll
                for (int m = 0; m < 4; ++m)
#pragma unroll
                    for (int n = 0; n < 2; ++n) { const float r = rs[ai * 4 + m]; const f32x4 a = acc[ai][bj][m][n];
                        gp[ai][bj][m][n].x = cvt_pk_bf16_t(sigm(a[0] * r), sigm(a[1] * r)); gp[ai][bj][m][n].y = cvt_pk_bf16_t(sigm(a[2] * r), sigm(a[3] * r));
                        acc[ai][bj][m][n] = (f32x4){0.f, 0.f, 0.f, 0.f}; }
#pragma unroll
        for (int ai = 0; ai < 2; ++ai) {
            u32x2 pw[4][4];
#pragma unroll
            for (int m = 0; m < 4; ++m)
#pragma unroll
                for (int b = 0; b < 4; ++b) pw[m][b] = *(const u32x2*)(P + (size_t)EPI_ROW(ai, m) * 4096 + j0 + b * 1024);
#pragma unroll
            for (int m = 0; m < 4; ++m) {
                f32x4 s = (f32x4){0.f, 0.f, 0.f, 0.f};
#pragma unroll
                for (int bj = 0; bj < 2; ++bj)
#pragma unroll
                    for (int n = 0; n < 2; ++n) { const u32x2 pv = pw[m][2 * bj + n]; const u32x2 g = gp[ai][bj][m][n];
                        s[0] += bf_lo(g.x) * bf_lo(pv.x); s[1] += bf_hi(g.x) * bf_hi(pv.x); s[2] += bf_lo(g.y) * bf_lo(pv.y); s[3] += bf_hi(g.y) * bf_hi(pv.y); }
                u32x2 w; w.x = cvt_pk_bf16(s[0], s[1]); w.y = cvt_pk_bf16(s[2], s[3]); *(u32x2*)(merged + (size_t)EPI_ROW(ai, m) * 1024 + j0) = w; }
            asm volatile("" ::: "memory"); }
    }
};
struct EpiGLU {
    static constexpr bool PERM = true, AFTER_DRAIN = false; static constexpr int TAIL_OPS = 0;
    const bf16_t* yg; bf16_t* out; const float* bias;
    __device__ __forceinline__ void operator()(const f32x4 (&acc)[2][2][4][2], const Unit& u, int wr, int wc, int fr, int fq) const {
        const int row0 = u.pm * BM + wr * 64 + fr, col0 = u.pn * BM + wc * 32 + 8 * fq;
        f32x4 bb[2][2];
#pragma unroll
        for (int bj = 0; bj < 2; ++bj) { bb[bj][0] = *(const f32x4*)(bias + col0 + bj * HALF); bb[bj][1] = *(const f32x4*)(bias + col0 + bj * HALF + 4); }
#pragma unroll
        for (int ai = 0; ai < 2; ++ai) {
            u32x4 yw[4][2];
#pragma unroll
            for (int m = 0; m < 4; ++m)
#pragma unroll
                for (int bj = 0; bj < 2; ++bj) yw[m][bj] = *(const u32x4*)(yg + (size_t)EPI_ROW(ai, m) * 256 + col0 + bj * HALF);
#pragma unroll
            for (int m = 0; m < 4; ++m) { const size_t off = (size_t)EPI_ROW(ai, m) * 256 + col0;
#pragma unroll
                for (int bj = 0; bj < 2; ++bj) { f32x4 y0, y1; unpack8(yw[m][bj], y0, y1); const f32x4 a0 = acc[ai][bj][m][0] + bb[bj][0], a1 = acc[ai][bj][m][1] + bb[bj][1]; f32x4 o0, o1;
#pragma unroll
                    for (int e = 0; e < 4; ++e) { o0[e] = y0[e] * sigm(a0[e]); o1[e] = y1[e] * sigm(a1[e]); }
                    *(u32x4*)(out + off + bj * HALF) = pack8(o0, o1); } }
            asm volatile("" ::: "memory"); }
    }
};
struct EpiPle {
    static constexpr bool PERM = true, AFTER_DRAIN = false; static constexpr int TAIL_OPS = 0;
    const bf16_t* h; const bf16_t* T; bf16_t* hout; const rowss_t* rowss; rowss_t* rowss_next;
    __device__ __forceinline__ void operator()(const f32x4 (&acc)[2][2][4][2], const Unit& u, int wr, int wc, int fr, int fq) const {
        const int row0 = u.pm * BM + wr * 64 + fr, col0 = u.pn * BM + wc * 32 + 8 * fq;
        float rs[8]; load_scales(rowss, row0, rs);
#pragma unroll
        for (int ai = 0; ai < 2; ++ai)
#pragma unroll
          for (int mh = 0; mh < 2; ++mh) {
            u32x4 bw[2][2], tw[2][2];
#pragma unroll
            for (int mm = 0; mm < 2; ++mm)
#pragma unroll
                for (int bj = 0; bj < 2; ++bj) { const size_t off = (size_t)EPI_ROW(ai, 2 * mh + mm) * 1024 + col0 + bj * HALF; bw[mm][bj] = *(const u32x4*)(h + off); tw[mm][bj] = *(const u32x4*)(T + off); }
#pragma unroll
            for (int mm = 0; mm < 2; ++mm) { const int m = 2 * mh + mm; const int row = EPI_ROW(ai, m); const float r = rs[ai * 4 + m]; const size_t off = (size_t)row * 1024 + col0; float ss = 0.f;
#pragma unroll
                for (int bj = 0; bj < 2; ++bj) { f32x4 b0, b1, t0, t1; unpack8(bw[mm][bj], b0, b1); unpack8(tw[mm][bj], t0, t1);
                    const f32x4 a0 = acc[ai][bj][m][0] * r, a1 = acc[ai][bj][m][1] * r; f32x4 v0, v1;
#pragma unroll
                    for (int e = 0; e < 4; ++e) { v0[e] = b0[e] + t0[e] * sigm(a0[e]); v1[e] = b1[e] + t1[e] * sigm(a1[e]); }
                    *(u32x4*)(hout + off + bj * HALF) = pack8(v0, v1); ss += sumsq8(v0, v1); }
                ss += __shfl_xor(ss, 16); ss += __shfl_xor(ss, 32);
                if (fq == 0) rowss_add(rowss_next + row, ss); }
            asm volatile("" ::: "memory"); }
    }
};

__device__ __forceinline__ float dpp_row_xor(float v, int step) {
    const int x = __float_as_int(v); int r;
    switch (step) { case 0: r = __builtin_amdgcn_update_dpp(0, x, 0xB1, 0xF, 0xF, true); break; case 1: r = __builtin_amdgcn_update_dpp(0, x, 0x4E, 0xF, 0xF, true); break;
                    case 2: r = __builtin_amdgcn_update_dpp(0, x, 0x141, 0xF, 0xF, true); break; default: r = __builtin_amdgcn_update_dpp(0, x, 0x140, 0xF, 0xF, true); break; }
    return __int_as_float(r);
}
struct EpiMoba {
    static constexpr bool PERM = true, AFTER_DRAIN = false; static constexpr int TAIL_OPS = 0;
    bf16_t* proj; bf16_t* vt; float* kmean; const float* rope; const rowss_t* rowss;
    __device__ __forceinline__ void operator()(const f32x4 (&acc)[2][2][4][2], const Unit& u, int wr, int wc, int fr_in, int fq_in) const {
        int fr = fr_in, fq = fq_in; asm volatile("" : "+v"(fr), "+v"(fq));
        const int row0 = u.pm * BM + wr * 64 + fr;
        float rs[8]; load_scales(rowss, row0, rs);
        if (u.pn < 2) {
            const int pc = (u.pn == 0 ? 2304 : 2560) + wc * 64 + 8 * fq;
            f32x4 ks[4];
#pragma unroll
            for (int j = 0; j < 4; ++j) ks[j] = (f32x4){0.f, 0.f, 0.f, 0.f};
#pragma unroll
            for (int ai = 0; ai < 2; ++ai)
#pragma unroll
              for (int mh = 0; mh < 2; ++mh) {
                f32x4 cs[2][4];
#pragma unroll
                for (int mm = 0; mm < 2; ++mm) { const float* tp = rope + (size_t)EPI_ROW(ai, 2 * mh + mm) * 64 + 8 * fq; cs[mm][0] = *(const f32x4*)(tp); cs[mm][1] = *(const f32x4*)(tp + 4); cs[mm][2] = *(const f32x4*)(tp + 32); cs[mm][3] = *(const f32x4*)(tp + 36); }
#pragma unroll
                for (int mm = 0; mm < 2; ++mm) { const int m = 2 * mh + mm; const float r = rs[ai * 4 + m]; bf16_t* rowp = proj + (size_t)EPI_ROW(ai, m) * 3072 + pc;
                    const f32x4 a0 = acc[ai][0][m][0] * r, a1 = acc[ai][0][m][1] * r, b0 = acc[ai][1][m][0] * r, b1 = acc[ai][1][m][1] * r;
                    const f32x4 o10 = a0 * cs[mm][0] - b0 * cs[mm][2], o11 = a1 * cs[mm][1] - b1 * cs[mm][3], o20 = b0 * cs[mm][0] + a0 * cs[mm][2], o21 = b1 * cs[mm][1] + a1 * cs[mm][3];
                    *(u32x4*)(rowp) = pack8(o10, o11); *(u32x4*)(rowp + 32) = pack8(o20, o21);
                    ks[0] += o10; ks[1] += o11; ks[2] += o20; ks[3] += o21; }
                asm volatile("" ::: "memory"); }
            if (u.pn == 1) {
#pragma unroll
                for (int j = 0; j < 4; ++j)
#pragma unroll
                    for (int e = 0; e < 4; ++e) { float v = ks[j][e];
#pragma unroll
                        for (int st = 0; st < 4; ++st) v += dpp_row_xor(v, st);
                        ks[j][e] = v; }
                if (fr == 0) { const int b = u.pm >> 3, blk = u.pm & 7; float* kp = kmean + (size_t)((b * 4 + wc) * 8 + blk) * 64 + 8 * fq;
#pragma unroll
                    for (int e = 0; e < 4; ++e) { __hip_atomic_fetch_add(kp + e, ks[0][e] * (1.0f / 256.0f), __ATOMIC_RELAXED, __HIP_MEMORY_SCOPE_AGENT); __hip_atomic_fetch_add(kp + 4 + e, ks[1][e] * (1.0f / 256.0f), __ATOMIC_RELAXED, __HIP_MEMORY_SCOPE_AGENT);
                        __hip_atomic_fetch_add(kp + 32 + e, ks[2][e] * (1.0f / 256.0f), __ATOMIC_RELAXED, __HIP_MEMORY_SCOPE_AGENT); __hip_atomic_fetch_add(kp + 36 + e, ks[3][e] * (1.0f / 256.0f), __ATOMIC_RELAXED, __HIP_MEMORY_SCOPE_AGENT); } }
            }
        } else {
            const int b = u.pm >> 3, s0 = (u.pm & 7) * 256 + wr * 64 + fr;
#pragma unroll
            for (int ai = 0; ai < 2; ++ai)
#pragma unroll
                for (int m = 0; m < 4; ++m) { const float r = rs[ai * 4 + m]; const int s = s0 + ai * HALF + m * 16;
#pragma unroll
                    for (int bj = 0; bj < 2; ++bj) { const int hh = 2 * bj + (wc >> 1), d0 = 32 * (wc & 1) + 8 * fq; bf16_t* vp = vt + ((size_t)(b * 4 + hh) * 64 + d0) * 2048 + s;
                        const u32x4 w = pack8(acc[ai][bj][m][0] * r, acc[ai][bj][m][1] * r);
                        vp[0 * 2048] = (bf16_t)(w.x & 0xffffu); vp[1 * 2048] = (bf16_t)(w.x >> 16); vp[2 * 2048] = (bf16_t)(w.y & 0xffffu); vp[3 * 2048] = (bf16_t)(w.y >> 16);
                        vp[4 * 2048] = (bf16_t)(w.z & 0xffffu); vp[5 * 2048] = (bf16_t)(w.z >> 16); vp[6 * 2048] = (bf16_t)(w.w & 0xffffu); vp[7 * 2048] = (bf16_t)(w.w >> 16); } }
        }
    }
};


struct EpiGateP {
    static constexpr bool PERM = false, AFTER_DRAIN = true; static constexpr int TAIL_OPS = 0;
    const bf16_t* Y; const bf16_t* Wbr; bf16_t* merged; const rowss_t* rowss;
    size_t ybstride;
    __device__ __forceinline__ void fused(f32x4 (&acc)[2][2][4][2], const Unit& u, int wr, int wc, int fr, int fq, PG8_LAS unsigned char* lds, int wid, int lane) const {
        const int row0 = u.pm * BM + wr * 64 + fr;
        float rs[8]; load_scales(rowss, row0, rs);
        const int tid = wid * 64 + lane;
        unsigned voffA[2]; unsigned voffB;
#pragma unroll
        for (int i = 0; i < 2; ++i) { int R, C; stage_rc(tid * 16 + i * 8192, R, C); voffA[i] = (unsigned)(R * 256 + C) * 2u; }
        { int R, C; stage_rc(tid * 16, R, C); voffB = (unsigned)(R * 256 + C) * 2u; }
        const unsigned ldsw = (unsigned)wid * 1024u;
        const int aoff = lds_byte(wr * 64 + fr, fq * 8), boff = lds_byte(wc * 16 + fr, fq * 8);
        const char* ya = (const char*)Y + (size_t)u.pm * BM * 256 * 2;
        const char* wb = (const char*)Wbr + (size_t)u.pn * 64 * 256 * 2;
#define GP_STAGE(s_) do { const int b_ = (s_) >> 2, kt_ = (s_) & 3; const char* ga_ = ya + (size_t)b_ * ybstride * 2 + kt_ * 128; const char* gb_ = wb + (size_t)b_ * 1024 * 256 * 2 + kt_ * 128; PG8_LAS unsigned char* d_ = lds + ((s_) % 3) * 40960; \
            _Pragma("unroll") for (int h_ = 0; h_ < 2; ++h_) _Pragma("unroll") for (int i_ = 0; i_ < 2; ++i_) \
                __builtin_amdgcn_global_load_lds((const unsigned*)(ga_ + (size_t)h_ * HALF * 256 * 2 + voffA[i_]), (PG8_LAS unsigned*)(d_ + h_ * 16384 + ldsw + i_ * 8192), 16, 0, 0); \
            __builtin_amdgcn_global_load_lds((const unsigned*)(gb_ + voffB), (PG8_LAS unsigned*)(d_ + 32768 + ldsw), 16, 0, 0); } while (0)
        GP_STAGE(0); GP_STAGE(1);
        u32x2 gp[2][2][4][2];
#pragma unroll
        for (int ai = 0; ai < 2; ++ai)
#pragma unroll
            for (int bj = 0; bj < 2; ++bj)
#pragma unroll
                for (int m = 0; m < 4; ++m)
#pragma unroll
                    for (int n = 0; n < 2; ++n) { const float r = rs[ai * 4 + m]; const f32x4 a = acc[ai][bj][m][n];
                        gp[ai][bj][m][n].x = cvt_pk_bf16_t(sigm(a[0] * r), sigm(a[1] * r)); gp[ai][bj][m][n].y = cvt_pk_bf16_t(sigm(a[2] * r), sigm(a[3] * r));
                        acc[ai][bj][m][n] = (f32x4){0.f, 0.f, 0.f, 0.f}; }
#pragma unroll
        for (int s = 0; s < 16; ++s) {
            if (s < 15) asm volatile("s_waitcnt vmcnt(5)" ::: "memory"); else asm volatile("s_waitcnt vmcnt(0)" ::: "memory");
            __builtin_amdgcn_s_barrier(); asm volatile("" ::: "memory");
            if (s + 2 < 16) GP_STAGE(s + 2);
            const PG8_LAS unsigned char* bo = lds + (s % 3) * 40960; const int bj = (s >> 2) >> 1, n = (s >> 2) & 1;
            bf16x8 Bf[2];
#pragma unroll
            for (int k = 0; k < 2; ++k) Bf[k] = *(const PG8_LAS bf16x8*)(bo + 32768 + boff + k * 1024);
#pragma unroll
            for (int ai = 0; ai < 2; ++ai) { bf16x8 At[4][2];
#pragma unroll
                for (int m = 0; m < 4; ++m)
#pragma unroll
                    for (int k = 0; k < 2; ++k) At[m][k] = *(const PG8_LAS bf16x8*)(bo + ai * 16384 + aoff + m * 2048 + k * 1024);
#pragma unroll
                for (int m = 0; m < 4; ++m)
#pragma unroll
                    for (int k = 0; k < 2; ++k) acc[ai][bj][m][n] = __builtin_amdgcn_mfma_f32_16x16x32_bf16(Bf[k], At[m][k], acc[ai][bj][m][n], 0, 0, 0); }
            asm volatile("s_waitcnt lgkmcnt(0)" ::: "memory");
        }
#undef GP_STAGE
        const int j0 = u.pn * 64 + wc * 16 + 4 * fq;
#pragma unroll
        for (int ai = 0; ai < 2; ++ai)
#pragma unroll
            for (int m = 0; m < 4; ++m) { f32x4 s4 = (f32x4){0.f, 0.f, 0.f, 0.f};
#pragma unroll
                for (int bj = 0; bj < 2; ++bj)
#pragma unroll
                    for (int n = 0; n < 2; ++n) { const u32x2 g = gp[ai][bj][m][n]; const f32x4 p = acc[ai][bj][m][n];
                        s4[0] += bf_lo(g.x) * p[0]; s4[1] += bf_hi(g.x) * p[1]; s4[2] += bf_lo(g.y) * p[2]; s4[3] += bf_hi(g.y) * p[3]; }
                u32x2 w; w.x = cvt_pk_bf16(s4[0], s4[1]); w.y = cvt_pk_bf16(s4[2], s4[3]); *(u32x2*)(merged + (size_t)EPI_ROW(ai, m) * 1024 + j0) = w; }
    }
};
template <class Epi, class Sched, bool ALIGN_EPI = false, bool SP2 = false>
__device__ __forceinline__ void gemm_phase(PG8_LAS unsigned char* lds, const Gemm g, const Sched& S, const Epi& E) {
    int tid_ = threadIdx.x; asm volatile("" : "+v"(tid_));
    const int tid = tid_, wid = __builtin_amdgcn_readfirstlane(tid >> 6), lane = tid & 63, wr = wid >> 2, wc = wid & 3, fr = lane & 15, fq = lane >> 4;
    const int K = g.K, nt = K / BK;
    unsigned voffA[2], voffB[2];
#pragma unroll
    for (int i = 0; i < 2; ++i) { int R, C; stage_rc(tid * 16 + i * 8192, R, C); const int Rb = Epi::PERM ? ((R & ~31) + perm32(R & 31)) : R;
        voffA[i] = (unsigned)(R * K + C) * 2u; voffB[i] = (unsigned)(Rb * K + C) * 2u; }
    const size_t kstep = (size_t)(BK * 2);
    const size_t hstep = (size_t)HALF * K * 2;
    const size_t tstep = 2 * hstep;
    const unsigned ldsw = (unsigned)wid * 1024u;
    const int aoff = lds_byte(wr * 64 + fr, fq * 8), boff = lds_byte(wc * 32 + fr, fq * 8);
#define PG8_SA(b, h) (((b) * 2 + (h)) * HTB)
#define PG8_SB(b, h) ((4 + (b) * 2 + (h)) * HTB)
#define PG8_STAGE(bufoff, gbase, voff) do { _Pragma("unroll") for (int _i = 0; _i < 2; ++_i) \
        __builtin_amdgcn_global_load_lds((const unsigned*)((const char*)(gbase) + (voff)[_i]), (PG8_LAS unsigned*)(lds + (bufoff) + ldsw + _i * 8192), 16, 0, 0); } while (0)
#define PG8_LDA(dst, b, h) do { _Pragma("unroll") for (int m = 0; m < 4; ++m) _Pragma("unroll") for (int k = 0; k < 2; ++k) dst[m][k] = *(const PG8_LAS bf16x8*)(lds + PG8_SA(b, h) + aoff + m * 2048 + k * 1024); } while (0)
#define PG8_LDB(dst, b, h) do { _Pragma("unroll") for (int n = 0; n < 2; ++n) _Pragma("unroll") for (int k = 0; k < 2; ++k) dst[n][k] = *(const PG8_LAS bf16x8*)(lds + PG8_SB(b, h) + boff + n * 2048 + k * 1024); } while (0)
#define PG8_MMA(ai, bj, At, Bt) do { __builtin_amdgcn_s_setprio(1); _Pragma("unroll") for (int m = 0; m < 4; ++m) _Pragma("unroll") for (int n = 0; n < 2; ++n) _Pragma("unroll") for (int k = 0; k < 2; ++k) \
        acc[ai][bj][m][n] = __builtin_amdgcn_mfma_f32_16x16x32_bf16(Bt[n][k], At[m][k], acc[ai][bj][m][n], 0, 0, 0); __builtin_amdgcn_s_setprio(0); } while (0)
#define PG8_WAIT_V(n) asm volatile("s_waitcnt vmcnt(" #n ")" ::: "memory")
#define PG8_WAIT_L(n) asm volatile("s_waitcnt lgkmcnt(" #n ")" ::: "memory")
#define PG8_BAR __builtin_amdgcn_s_barrier()
#define PG8_SCHED __builtin_amdgcn_sched_barrier(0)
    Unit cur, nxt; int ui = 0;
    if (!S.next(0, cur)) return;
    f32x4 acc[2][2][4][2];
#pragma unroll
    for (int a = 0; a < 2; ++a)
#pragma unroll
        for (int b = 0; b < 2; ++b)
#pragma unroll
            for (int m = 0; m < 4; ++m)
#pragma unroll
                for (int n = 0; n < 2; ++n) acc[a][b][m][n] = (f32x4){0.f, 0.f, 0.f, 0.f};
    bf16x8 At[4][2], B0[2][2], B1[2][2];
    const char* cA = (const char*)g.A + (size_t)(cur.pn >> g.ashift) * g.astride + (size_t)cur.pm * tstep; const char* cB = (const char*)g.Bt + (size_t)cur.pn * tstep;
    S.a_ready(cur);
    if constexpr (SP2) {
        PG8_STAGE(PG8_SB(0, 0), cB, voffB); PG8_STAGE(PG8_SB(0, 1), cB + hstep, voffB); PG8_STAGE(PG8_SA(0, 0), cA, voffA); PG8_STAGE(PG8_SA(0, 1), cA + hstep, voffA);
        if (wr == 1) PG8_BAR;
        PG8_WAIT_V(2); PG8_BAR;
        PG8_STAGE(PG8_SB(1, 0), cB + kstep, voffB); PG8_STAGE(PG8_SA(1, 0), cA + kstep, voffA); PG8_STAGE(PG8_SB(1, 1), cB + hstep + kstep, voffB);
        PG8_WAIT_V(6); PG8_BAR;
    } else {
        PG8_STAGE(PG8_SB(0, 0), cB, voffB); PG8_STAGE(PG8_SA(0, 0), cA, voffA); PG8_STAGE(PG8_SB(0, 1), cB + hstep, voffB); PG8_STAGE(PG8_SA(0, 1), cA + hstep, voffA);
        if (wr == 1) PG8_BAR;
        PG8_WAIT_V(4); PG8_BAR;
        PG8_STAGE(PG8_SB(1, 0), cB + kstep, voffB); PG8_STAGE(PG8_SA(1, 0), cA + kstep, voffA); PG8_STAGE(PG8_SB(1, 1), cB + hstep + kstep, voffB);
        PG8_WAIT_V(6); PG8_BAR;
    }
    for (;;) {
        const bool has_next = S.next(ui + 1, nxt);
        const char* nA = has_next ? (const char*)g.A + (size_t)(nxt.pn >> g.ashift) * g.astride + (size_t)nxt.pm * tstep : cA; const char* nB = has_next ? (const char*)g.Bt + (size_t)nxt.pn * tstep : cB;
        for (int t = 0; t < nt; t += 2) {
            const bool last = (t == nt - 2);
            const char* a1 = cA + (size_t)(t + 1) * kstep;
            const char* a2 = last ? nA : cA + (size_t)(t + 2) * kstep; const char* b2 = last ? nB : cB + (size_t)(t + 2) * kstep;
            const char* a3 = a2 + kstep; const char* b3 = b2 + kstep;
            if (last && has_next) S.a_ready(nxt);
            if constexpr (SP2) {
            PG8_LDB(B0, 0, 0); PG8_LDB(B1, 0, 1); PG8_SCHED; PG8_LDA(At, 0, 0); PG8_STAGE(PG8_SA(1, 1), a1 + hstep, voffA);
            PG8_WAIT_V(8); PG8_WAIT_L(0); PG8_BAR; PG8_MMA(0, 0, At, B0); PG8_MMA(0, 1, At, B1); PG8_BAR; PG8_SCHED;
            PG8_LDA(At, 0, 1); PG8_STAGE(PG8_SB(0, 0), b2, voffB); PG8_STAGE(PG8_SB(0, 1), b2 + hstep, voffB); PG8_STAGE(PG8_SA(0, 0), a2, voffA);
            PG8_WAIT_V(8); PG8_WAIT_L(0); PG8_BAR; PG8_MMA(1, 0, At, B0); PG8_MMA(1, 1, At, B1); PG8_BAR; PG8_SCHED;
            PG8_LDB(B0, 1, 0); PG8_LDB(B1, 1, 1); PG8_SCHED; PG8_LDA(At, 1, 0); PG8_STAGE(PG8_SA(0, 1), a2 + hstep, voffA);
            PG8_WAIT_V(8); PG8_WAIT_L(0); PG8_BAR; PG8_MMA(0, 0, At, B0); PG8_MMA(0, 1, At, B1); PG8_BAR; PG8_SCHED;
            PG8_LDA(At, 1, 1); PG8_STAGE(PG8_SB(1, 0), b3, voffB); PG8_STAGE(PG8_SB(1, 1), b3 + hstep, voffB); PG8_STAGE(PG8_SA(1, 0), a3, voffA);
            PG8_WAIT_V(8); PG8_WAIT_L(0); PG8_BAR; PG8_MMA(1, 0, At, B0); PG8_MMA(1, 1, At, B1); PG8_BAR; PG8_SCHED;
            } else {
            PG8_LDB(B0, 0, 0); PG8_SCHED; PG8_LDA(At, 0, 0); PG8_STAGE(PG8_SA(1, 1), a1 + hstep, voffA);
            PG8_WAIT_L(8); PG8_BAR; PG8_WAIT_L(0); PG8_MMA(0, 0, At, B0); PG8_BAR; PG8_SCHED;
            PG8_LDB(B1, 0, 1); PG8_STAGE(PG8_SB(0, 0), b2, voffB);
            PG8_BAR; PG8_WAIT_L(0); PG8_MMA(0, 1, At, B1); PG8_BAR;
            PG8_LDA(At, 0, 1); PG8_STAGE(PG8_SA(0, 0), a2, voffA);
            PG8_BAR; PG8_WAIT_L(0); PG8_MMA(1, 0, At, B0); PG8_BAR; PG8_SCHED;
            PG8_STAGE(PG8_SB(0, 1), b2 + hstep, voffB);
            PG8_WAIT_V(6); PG8_BAR; PG8_MMA(1, 1, At, B1); PG8_BAR;
            PG8_LDB(B0, 1, 0); PG8_SCHED; PG8_LDA(At, 1, 0); PG8_STAGE(PG8_SA(0, 1), a2 + hstep, voffA);
            PG8_WAIT_L(8); PG8_BAR; PG8_WAIT_L(0); PG8_MMA(0, 0, At, B0); PG8_BAR; PG8_SCHED;
            PG8_LDB(B1, 1, 1); PG8_STAGE(PG8_SB(1, 0), b3, voffB);
            PG8_BAR; PG8_WAIT_L(0); PG8_MMA(0, 1, At, B1); PG8_BAR;
            PG8_LDA(At, 1, 1); PG8_STAGE(PG8_SA(1, 0), a3, voffA);
            PG8_BAR; PG8_WAIT_L(0); PG8_MMA(1, 0, At, B0); PG8_BAR; PG8_SCHED;
            PG8_STAGE(PG8_SB(1, 1), b3 + hstep, voffB);
            PG8_WAIT_V(6); PG8_BAR; PG8_MMA(1, 1, At, B1); PG8_BAR;
            }
        }
        if constexpr (ALIGN_EPI) { if (wr == 0) PG8_BAR; }
        if constexpr (!Epi::AFTER_DRAIN) { E(acc, cur, wr, wc, fr, fq); S.done(cur); }
        if (!has_next) break;
#pragma unroll
        for (int a = 0; a < 2; ++a)
#pragma unroll
            for (int b = 0; b < 2; ++b)
#pragma unroll
                for (int m = 0; m < 4; ++m)
#pragma unroll
                    for (int n = 0; n < 2; ++n) acc[a][b][m][n] = (f32x4){0.f, 0.f, 0.f, 0.f};
        cur = nxt; cA = nA; cB = nB; ++ui;
        if constexpr (ALIGN_EPI) { if (wr == 1) PG8_BAR; }
    }
    PG8_WAIT_V(0);
    if constexpr (!ALIGN_EPI) { if (wr == 0) PG8_BAR; }
    PG8_BAR;
    if constexpr (Epi::AFTER_DRAIN) { E.fused(acc, cur, wr, wc, fr, fq, lds, wid, lane); S.done(cur); }
#undef PG8_SA
#undef PG8_SB
#undef PG8_STAGE
#undef PG8_LDA
#undef PG8_LDB
#undef PG8_MMA
#undef PG8_WAIT_V
#undef PG8_WAIT_L
#undef PG8_BAR
#undef PG8_SCHED
}
}


constexpr int NWAVES = 8;
constexpr int BATCH = 16, SEQ = 2048, D = 1024, M = BATCH * SEQ, FF = 2816, NGU = 2 * FF, PLED = 256, DEPTH = 2;
constexpr int NIN_SRC = 3088, NIN = 3328, NPROJ = 3072, NGATE = 4096;
constexpr int PC_GQ = 0, PC_GZ = 768, PC_MQ = 1024, PC_MV = 1536, PC_MO = 1792, PC_S5 = 2048, PC_AQ = 2304, PC_AK = 2560, PC_AV = 2816;

constexpr size_t MiB = 1u << 20;
constexpr size_t WS_CTL = 0, CTL_ZERO_BYTES = 4 * MiB;
constexpr size_t WS_ROWSS = 1 * MiB;
constexpr size_t WS_KMEAN = 3 * MiB + 512 * 1024;
constexpr size_t WS_S5P = 6 * MiB + 512 * 1024;
constexpr size_t WS_SCAL = 4 * MiB;
constexpr size_t WS_W = 8 * MiB;
constexpr size_t W_GU1 = 0, W_D1 = W_GU1 + (size_t)NGU * D * 2, W_IN = W_D1 + (size_t)D * FF * 2, W_GATE = W_IN + (size_t)NIN * D * 2, W_BR = W_GATE + (size_t)NGATE * D * 2,
                 W_GLU = W_BR + (size_t)4096 * 256 * 2, W_OUT = W_GLU + (size_t)256 * 256 * 2, W_GU2 = W_OUT + (size_t)D * D * 2, W_D2 = W_GU2 + (size_t)NGU * D * 2,
                 W_PLE = W_D2 + (size_t)D * FF * 2, W_PG = W_PLE + (size_t)D * PLED * 2, W_END = W_PG + (size_t)D * D * 2;
static_assert(W_END <= 56 * MiB, "weights fit");
constexpr size_t WS_HB = 64 * MiB;
constexpr size_t WS_PB = 128 * MiB;
constexpr size_t WS_Y = 144 * MiB;
constexpr size_t WS_YG = 208 * MiB;
constexpr size_t WS_VT = 224 * MiB;
constexpr size_t WS_BIG = 256 * MiB;
constexpr size_t WS_END = 512 * MiB;
constexpr size_t OUT_W1 = 0, OUT_T = 56 * MiB, OUT_ROPE = 120 * MiB;
constexpr int CW_BAR = 4096, CW_QUEUE = 8192, CW_FLAG = 12288, CW_S5F = 16384, CW_GRP = 20480;

constexpr int RING_OFF = 0;
constexpr int LDS_BYTES = 147456;
constexpr int SC_OFF = 131072;
constexpr int LDSCTL_OFF = LDS_BYTES - 1024;
constexpr int WAVE_LDS = 17408;

#define GAS __attribute__((address_space(1)))
#define LAS __attribute__((address_space(3)))
typedef unsigned short bf16;
typedef unsigned v4u __attribute__((ext_vector_type(4)));
typedef float f32x4 __attribute__((ext_vector_type(4)));
typedef short bf16x8 __attribute__((ext_vector_type(8)));
typedef GAS unsigned gu32;
typedef GAS unsigned long long gu64;
#define RLX_AGENT __ATOMIC_RELAXED, __HIP_MEMORY_SCOPE_AGENT
#define LDS_WAIT() asm volatile("s_waitcnt lgkmcnt(0)" ::: "memory")
#define VM_WAIT() asm volatile("s_waitcnt vmcnt(0)" ::: "memory")
__device__ __forceinline__ unsigned long long rt() { return __builtin_amdgcn_s_memrealtime(); }
__device__ __forceinline__ unsigned f2bf(float f) { unsigned u = __builtin_bit_cast(unsigned, f); return (u + 0x7fffu + ((u >> 16) & 1u)) >> 16; }
typedef float pk2_f32x2 __attribute__((ext_vector_type(2)));
typedef __bf16 pk2_bf16x2 __attribute__((ext_vector_type(2)));
__device__ __forceinline__ unsigned pk2(float lo, float hi) { const pk2_f32x2 v = {lo, hi}; return __builtin_bit_cast(unsigned, __builtin_convertvector(v, pk2_bf16x2)); }

#define XB_TMO      128
#define XB_XCNT(j)  (256  + 64 * (j))
#define XB_XSUB(j)  (1280 + 64 * (j))
#define XB_XGEN(j)  (2304 + 64 * (j))
#define XB_TOP      3328
#define XB_TOPGEN   3392
#define XCD_BAR_WORDS 3456
#define XB_SPIN_CAP (1u << 21)

__device__ __forceinline__ unsigned xb_ld(unsigned* p)              { return __hip_atomic_load(p, __ATOMIC_RELAXED, __HIP_MEMORY_SCOPE_AGENT); }
__device__ __forceinline__ unsigned xb_add(unsigned* p, unsigned v) { return __hip_atomic_fetch_add(p, v, __ATOMIC_RELAXED, __HIP_MEMORY_SCOPE_AGENT); }
__device__ __forceinline__ unsigned xb_xcc_id() { return (unsigned)__builtin_amdgcn_s_getreg((3 << 11) | 20) & 0xFu; }
#define XB_SPIN(cond, bar) do { unsigned _sp = 0; while (cond) { __builtin_amdgcn_s_sleep(1); \
    if ((++_sp & 255u) == 0u) { if (xb_ld(&(bar)[XB_TMO])) break; if (_sp > XB_SPIN_CAP) { atomicAdd(&(bar)[XB_TMO], 1u); break; } } } } while (0)

struct XcdBarrier {
    unsigned* bar; unsigned x;
    volatile LAS unsigned* st;
};

__device__ __forceinline__ XcdBarrier xcd_barrier_post(unsigned* bar, volatile LAS unsigned* st) {
    XcdBarrier b; b.bar = bar; b.x = xb_xcc_id(); b.st = st;
    if (threadIdx.x == 0) (void)xb_add(&bar[XB_XCNT(b.x)], 1u);
    return b;
}
__device__ __forceinline__ void xcd_barrier_complete(unsigned* bar, unsigned x, unsigned& nloc, unsigned& nx) {
    const unsigned G = gridDim.x * gridDim.y * gridDim.z;
    unsigned sum, cnt, mine, sp = 0u;
    for (;;) {
        sum = 0u; cnt = 0u; mine = 0u;
#pragma unroll
        for (unsigned j = 0; j < 16; ++j) { const unsigned c = xb_ld(&bar[XB_XCNT(j)]); sum += c; cnt += (c > 0u) ? 1u : 0u; mine = (j == x) ? c : mine; }
        if (sum == G) break;
        __builtin_amdgcn_s_sleep(1);
        if ((++sp & 255u) == 0u) { if (xb_ld(&bar[XB_TMO])) break; if (sp > XB_SPIN_CAP) { atomicAdd(&bar[XB_TMO], 1u); break; } }
    }
    nloc = mine > 0u ? mine : 1u; nx = cnt > 0u ? cnt : 1u;
}

__device__ __forceinline__ void xcd_barrier(const XcdBarrier& b) {
    asm volatile("s_waitcnt vmcnt(0)" ::: "memory");
    __syncthreads();
    if (threadIdx.x == 0) {
        unsigned* bar = b.bar;
        __builtin_amdgcn_s_waitcnt(0);
        unsigned nloc = b.st[0], nx = b.st[1];
        if (nloc == 0u) { xcd_barrier_complete(bar, b.x, nloc, nx); b.st[0] = nloc; b.st[1] = nx; }
        const unsigned old = xb_add(&bar[XB_XSUB(b.x)], 1u);
        const unsigned gen = old / nloc;
        if (old + 1u == (gen + 1u) * nloc) {
            __builtin_amdgcn_fence(__ATOMIC_RELEASE, "agent");
            asm volatile("s_waitcnt vmcnt(0)" ::: "memory");
            const unsigned og = xb_add(&bar[XB_TOP], 1u);
            const unsigned tg = og / nx;
            if (og + 1u == (tg + 1u) * nx) xb_add(&bar[XB_TOPGEN], 1u);
            else XB_SPIN(xb_ld(&bar[XB_TOPGEN]) == tg, bar);
            __builtin_amdgcn_fence(__ATOMIC_ACQUIRE, "agent");
            xb_add(&bar[XB_XGEN(b.x)], 1u);
            asm volatile("s_waitcnt vmcnt(0)" ::: "memory");
        } else {
            XB_SPIN(xb_ld(&bar[XB_XGEN(b.x)]) == gen, bar);
            __builtin_amdgcn_fence(__ATOMIC_ACQUIRE, "agent");
            asm volatile("s_waitcnt vmcnt(0)" ::: "memory");
        }
    }
    __syncthreads();
}

__device__ __forceinline__ void group_barrier(unsigned* ctr, unsigned target) {
    asm volatile("s_waitcnt vmcnt(0)" ::: "memory");
    __syncthreads();
    if (threadIdx.x == 0) {
        __builtin_amdgcn_s_waitcnt(0);
        __builtin_amdgcn_fence(__ATOMIC_RELEASE, "agent");
        asm volatile("s_waitcnt vmcnt(0)" ::: "memory");
        (void)xb_add(ctr, 1u);
        unsigned sp = 0; while (xb_ld(ctr) < target) { __builtin_amdgcn_s_sleep(1); if (++sp > (1u << 22)) break; }
        __builtin_amdgcn_fence(__ATOMIC_ACQUIRE, "agent");
        asm volatile("s_waitcnt vmcnt(0)" ::: "memory");
    }
    __syncthreads();
}


template <int CTRL> __device__ __forceinline__ float dppx(float x) { return __int_as_float(__builtin_amdgcn_update_dpp(0, __float_as_int(x), CTRL, 0xF, 0xF, true)); }
constexpr int DPP_XOR1 = 0xB1, DPP_XOR2 = 0x4E, DPP_HMIRROR = 0x141, DPP_MIRROR = 0x140;
__device__ __forceinline__ float xrow16_sum(float x) {
    auto s = __builtin_amdgcn_permlane16_swap(__float_as_uint(x), __float_as_uint(x), false, false);
    x = __uint_as_float(s[0]) + __uint_as_float(s[1]);
    auto t = __builtin_amdgcn_permlane32_swap(__float_as_uint(x), __float_as_uint(x), false, false);
    return __uint_as_float(t[0]) + __uint_as_float(t[1]);
}
__device__ __forceinline__ float xrow16_max(float x) {
    auto s = __builtin_amdgcn_permlane16_swap(__float_as_uint(x), __float_as_uint(x), false, false);
    x = fmaxf(__uint_as_float(s[0]), __uint_as_float(s[1]));
    auto t = __builtin_amdgcn_permlane32_swap(__float_as_uint(x), __float_as_uint(x), false, false);
    return fmaxf(__uint_as_float(t[0]), __uint_as_float(t[1]));
}
__device__ __forceinline__ float xhalf_sum(float x) {
    auto t = __builtin_amdgcn_permlane32_swap(__float_as_uint(x), __float_as_uint(x), false, false);
    return __uint_as_float(t[0]) + __uint_as_float(t[1]);
}
__device__ __forceinline__ float red8(float v) { v += dppx<DPP_XOR1>(v); v += dppx<DPP_XOR2>(v); v += dppx<DPP_HMIRROR>(v); return v; }
__device__ __forceinline__ float wave_sum(float v) { v = red8(v); v += dppx<DPP_MIRROR>(v); return xrow16_sum(v); }
__device__ __forceinline__ float wave_max(float v) { v = fmaxf(v, dppx<DPP_XOR1>(v)); v = fmaxf(v, dppx<DPP_XOR2>(v)); v = fmaxf(v, dppx<DPP_HMIRROR>(v)); v = fmaxf(v, dppx<DPP_MIRROR>(v)); return xrow16_max(v); }
__device__ __forceinline__ float bf2f(bf16 b) { return __uint_as_float(((unsigned)b) << 16); }
__device__ __forceinline__ float sigm(float x) { return __builtin_amdgcn_rcpf(1.0f + __expf(-x)); }
__device__ __forceinline__ float silu(float x) { return x * sigm(x); }

template <class Map>
__device__ __forceinline__ void cvt_item(const float* __restrict__ W, int ld, const float* __restrict__ gain, bf16* Bt, int K, int item, int nblk, LAS float* scr, int lane, Map map) {
    const int kb = item / nblk, nb = item % nblk, k0 = 64 * kb, n0 = 32 * nb;
    const int n4 = lane & 7, kr = lane >> 3; const long so = map(n0 + 4 * n4);
    const long sx = so >= 0 ? so : 0; const float keep = so >= 0 ? 1.0f : 0.0f;
    f32x4 v[8]; float gn[8];
#pragma unroll
    for (int i = 0; i < 8; ++i) { v[i] = *(const GAS f32x4*)(W + sx + (size_t)(k0 + 8 * i + kr) * ld); gn[i] = keep; }
    if (gain) {
#pragma unroll
        for (int i = 0; i < 8; ++i) gn[i] = keep * gain[k0 + 8 * i + kr]; }
#pragma unroll
    for (int i = 0; i < 8; ++i) { LAS float* d = scr + (8 * i + kr) * 33 + 4 * n4; const f32x4 w = v[i] * gn[i]; d[0] = w[0]; d[1] = w[1]; d[2] = w[2]; d[3] = w[3]; }
    LDS_WAIT(); asm volatile("" ::: "memory");
    const int c = lane & 7;
#pragma unroll
    for (int j = 0; j < 4; ++j) { const int n = (lane >> 3) + 8 * j; const LAS float* s = scr + (8 * c) * 33 + n;
        v4u o; o.x = pk2(s[0 * 33], s[1 * 33]); o.y = pk2(s[2 * 33], s[3 * 33]); o.z = pk2(s[4 * 33], s[5 * 33]); o.w = pk2(s[6 * 33], s[7 * 33]);
        *(GAS v4u*)(Bt + (size_t)(n0 + n) * K + k0 + 8 * c) = o; }
    LDS_WAIT(); asm volatile("" ::: "memory");
}
struct MapId { __device__ long operator()(int r) const { return r; } };
struct MapGU { __device__ long operator()(int r) const { const int pn = r >> 8, c = r & 255; return c < 128 ? 128 * pn + c : FF + 128 * pn + (c - 128); } };
struct MapIn { __device__ long operator()(int r) const { if (r < 1024) return r; if (r < 2048) return 1032 + (r - 1024); if (r < 2304) return 2064 + (r - 2048);
    if (r < 2560) { const int c = r - 2304; return c < 8 ? 1024 + c : c < 16 ? 2056 + (c - 8) : -1; }
    const int t = (r - 2560) >> 8, c = (r - 2560) & 255; if (t < 2) return 2320 + 256 * t + ((c >> 5) & 3) * 64 + (c >> 7) * 32 + (c & 31); return 2320 + 512 + c; } };
struct MapGate { __device__ long operator()(int r) const { const int pn = r >> 8, c = r & 255, b = 2 * (c >> 7) + ((c >> 4) & 1), jl = 16 * ((c >> 5) & 3) + 4 * ((c >> 2) & 3) + (c & 3); return (long)b * (D * D) + 64 * pn + jl; } };
struct MapBr { __device__ long operator()(int r) const { return (long)(r >> 10) * (256 * D) + (r & 1023); } };

struct LayerW {
    const float *ffn1_norm, *ffn1_w_gu, *ffn1_w_down, *mix_norm, *w_in, *gdn_conv, *gdn_a_log, *gdn_dt_bias, *gdn_norm, *mlstm_conv, *mlstm_i_bias, *mlstm_f_bias, *mlstm_norm,
                *s5_lre, *s5_lim, *s5_bre, *s5_bim, *s5_cre, *s5_cim, *s5_d, *s5_log_dt, *s5_w_glu, *s5_b_glu, *w_gate, *w_branch, *w_out, *ffn2_norm, *ffn2_w_gu, *ffn2_w_down, *ple_norm, *ple_w_proj, *ple_w_gate;
};

__device__ __forceinline__ void prologue_weights(const LayerW& L, unsigned char* wsw, LAS unsigned char* lds, int gw, int ngw, int wave, int lane) {
    LAS float* scr = (LAS float*)(lds + RING_OFF + wave * WAVE_LDS);
    constexpr int I_GU = (D / 64) * (NGU / 32), I_DN = (FF / 64) * (D / 32), I_IN = (D / 64) * (NIN / 32), I_GT = (D / 64) * (NGATE / 32), I_BR = (256 / 64) * (4096 / 32), I_GL = (256 / 64) * (256 / 32),
                  I_OUT = (D / 64) * (D / 32), I_PLE = (PLED / 64) * (D / 32), I_PG = I_OUT;
    constexpr int NITEMS = 2 * I_GU + 2 * I_DN + I_IN + I_GT + I_BR + I_GL + I_OUT + I_PLE + I_PG;
    for (int it = gw; it < NITEMS; it += ngw) {
        int r = it;
        if (r < I_GU) { cvt_item(L.ffn1_w_gu, NGU, L.ffn1_norm, (bf16*)(wsw + W_GU1), D, r, NGU / 32, scr, lane, MapGU()); continue; } r -= I_GU;
        if (r < I_GU) { cvt_item(L.ffn2_w_gu, NGU, L.ffn2_norm, (bf16*)(wsw + W_GU2), D, r, NGU / 32, scr, lane, MapGU()); continue; } r -= I_GU;
        if (r < I_DN) { cvt_item(L.ffn1_w_down, D, nullptr, (bf16*)(wsw + W_D1), FF, r, D / 32, scr, lane, MapId()); continue; } r -= I_DN;
        if (r < I_DN) { cvt_item(L.ffn2_w_down, D, nullptr, (bf16*)(wsw + W_D2), FF, r, D / 32, scr, lane, MapId()); continue; } r -= I_DN;
        if (r < I_IN) { cvt_item(L.w_in, NIN_SRC, L.mix_norm, (bf16*)(wsw + W_IN), D, r, NIN / 32, scr, lane, MapIn()); continue; } r -= I_IN;
        if (r < I_GT) { cvt_item(L.w_gate, D, L.mix_norm, (bf16*)(wsw + W_GATE), D, r, NGATE / 32, scr, lane, MapGate()); continue; } r -= I_GT;
        if (r < I_BR) { cvt_item(L.w_branch, D, nullptr, (bf16*)(wsw + W_BR), 256, r, 4096 / 32, scr, lane, MapBr()); continue; } r -= I_BR;
        if (r < I_GL) { cvt_item(L.s5_w_glu, 256, nullptr, (bf16*)(wsw + W_GLU), 256, r, 256 / 32, scr, lane, MapId()); continue; } r -= I_GL;
        if (r < I_OUT) { cvt_item(L.w_out, D, nullptr, (bf16*)(wsw + W_OUT), D, r, D / 32, scr, lane, MapId()); continue; } r -= I_OUT;
        if (r < I_PLE) { cvt_item(L.ple_w_proj, D, nullptr, (bf16*)(wsw + W_PLE), PLED, r, D / 32, scr, lane, MapId()); continue; } r -= I_PLE;
        cvt_item(L.ple_w_gate, D, L.ple_norm, (bf16*)(wsw + W_PG), D, r, D / 32, scr, lane, MapId());
    }
}
__device__ __forceinline__ void prologue_s5(const LayerW& L, float* s5p, int gtid, int ngt) {
    for (int i = gtid; i < 1024; i += ngt) { const int g = i >> 6;
        const float dt = expf(L.s5_log_dt[g]), lr = L.s5_lre[i], li = L.s5_lim[i];
        const float th = li * dt; float sn, cs; sincosf(th, &sn, &cs);
        const float em1 = expm1f(lr * dt), mag = em1 + 1.0f;
        const float are = mag * cs, aim = mag * sn;
        const float sh = sinf(0.5f * th); const float arem1 = em1 * cs - 2.0f * sh * sh;
        const float den = lr * lr + li * li;
        const float zre = (arem1 * lr + aim * li) / den, zim = (aim * lr - arem1 * li) / den;
        s5p[i] = are; s5p[1024 + i] = aim;
        for (int n = 0; n < 16; ++n) { const float br = L.s5_bre[i * 16 + n], bi = L.s5_bim[i * 16 + n];
            s5p[2048 + i * 16 + n] = zre * br - zim * bi; s5p[2048 + 16384 + i * 16 + n] = zre * bi + zim * br; } }
}
__device__ __forceinline__ void cvt_rows_bf16(const float* src, bf16* dst, size_t n, size_t gtid, size_t ngt) {
    size_t i = gtid * 8;
    for (; i + 3 * ngt * 8 < n; i += 4 * ngt * 8) {
        f32x4 a[4], b[4];
#pragma unroll
        for (int u = 0; u < 4; ++u) { a[u] = *(const GAS f32x4*)(src + i + u * ngt * 8); b[u] = *(const GAS f32x4*)(src + i + u * ngt * 8 + 4); }
#pragma unroll
        for (int u = 0; u < 4; ++u) { v4u o; o.x = pk2(a[u][0], a[u][1]); o.y = pk2(a[u][2], a[u][3]); o.z = pk2(b[u][0], b[u][1]); o.w = pk2(b[u][2], b[u][3]); *(GAS v4u*)(dst + i + u * ngt * 8) = o; } }
    for (; i < n; i += ngt * 8) { const f32x4 a = *(const GAS f32x4*)(src + i), b = *(const GAS f32x4*)(src + i + 4);
        v4u o; o.x = pk2(a[0], a[1]); o.y = pk2(a[2], a[3]); o.z = pk2(b[0], b[1]); o.w = pk2(b[2], b[3]); *(GAS v4u*)(dst + i) = o; }
}
__device__ __forceinline__ void prologue_rope(const int* positions, float* rope, size_t gtid, size_t ngt) {
    for (size_t i = gtid; i < (size_t)M * 32; i += ngt) { const size_t row = i >> 5; const int k = (int)(i & 31);
        const float invf = expf(-(float)k * (2.0f / 64.0f) * 9.210340371976184f); float sn, cs; sincosf((float)positions[row] * invf, &sn, &cs);
        rope[row * 64 + k] = cs; rope[row * 64 + 32 + k] = sn; }
}
__device__ __forceinline__ void x_to_hb(const float* x, bf16* hb, pg8::rowss_t* rowss, int gw, int ngw, int lane) {
    for (int m0 = gw; m0 < M; m0 += 2 * ngw) {
        f32x4 v[2][4]; float s[2];
#pragma unroll
        for (int u = 0; u < 2; ++u) { const int m = m0 + u * ngw; if (m < M) { const GAS f32x4* xr = (const GAS f32x4*)(x + (size_t)m * D) + lane;
#pragma unroll
            for (int j = 0; j < 4; ++j) v[u][j] = xr[64 * j]; } }
#pragma unroll
        for (int u = 0; u < 2; ++u) { const int m = m0 + u * ngw; if (m < M) { s[u] = 0.f;
#pragma unroll
            for (int j = 0; j < 4; ++j) s[u] += (v[u][j][0] * v[u][j][0] + v[u][j][1] * v[u][j][1]) + (v[u][j][2] * v[u][j][2] + v[u][j][3] * v[u][j][3]);
            s[u] = wave_sum(s[u]); if (lane == 0) rowss[m] = (pg8::rowss_t)(s[u] * pg8::RSS_SCALE);
            GAS unsigned long long* o8 = (GAS unsigned long long*)(hb + (size_t)m * D) + lane;
#pragma unroll
            for (int j = 0; j < 4; ++j) o8[64 * j] = (unsigned long long)pk2(v[u][j][0], v[u][j][1]) | ((unsigned long long)pk2(v[u][j][2], v[u][j][3]) << 32); } } }
}
__device__ __forceinline__ void final_norm(const bf16* h, float* out, const pg8::rowss_t* rowss, const float* w, int gw, int ngw, int lane) {
    const GAS f32x4* wp = (const GAS f32x4*)(w + 16 * lane); const f32x4 g0 = wp[0], g1 = wp[1], g2 = wp[2], g3 = wp[3];
    for (int m0 = gw; m0 < M; m0 += 4 * ngw) {
        v4u hw[4][2]; float r[4];
#pragma unroll
        for (int u = 0; u < 4; ++u) { const int m = m0 + u * ngw; if (m < M) { const GAS v4u* hp = (const GAS v4u*)(h + (size_t)m * D + 16 * lane); hw[u][0] = hp[0]; hw[u][1] = hp[1]; r[u] = pg8::rms_scale(rowss, m); } }
#pragma unroll
        for (int u = 0; u < 4; ++u) { const int m = m0 + u * ngw; if (m < M) { GAS f32x4* op = (GAS f32x4*)(out + (size_t)m * D + 16 * lane); const float rr = r[u];
            op[0] = (f32x4){__uint_as_float(hw[u][0].x << 16) * rr * g0[0], __uint_as_float(hw[u][0].x & 0xffff0000u) * rr * g0[1], __uint_as_float(hw[u][0].y << 16) * rr * g0[2], __uint_as_float(hw[u][0].y & 0xffff0000u) * rr * g0[3]};
            op[1] = (f32x4){__uint_as_float(hw[u][0].z << 16) * rr * g1[0], __uint_as_float(hw[u][0].z & 0xffff0000u) * rr * g1[1], __uint_as_float(hw[u][0].w << 16) * rr * g1[2], __uint_as_float(hw[u][0].w & 0xffff0000u) * rr * g1[3]};
            op[2] = (f32x4){__uint_as_float(hw[u][1].x << 16) * rr * g2[0], __uint_as_float(hw[u][1].x & 0xffff0000u) * rr * g2[1], __uint_as_float(hw[u][1].y << 16) * rr * g2[2], __uint_as_float(hw[u][1].y & 0xffff0000u) * rr * g2[3]};
            op[3] = (f32x4){__uint_as_float(hw[u][1].z << 16) * rr * g3[0], __uint_as_float(hw[u][1].z & 0xffff0000u) * rr * g3[1], __uint_as_float(hw[u][1].w << 16) * rr * g3[2], __uint_as_float(hw[u][1].w & 0xffff0000u) * rr * g3[3]}; } } }
}

__device__ __forceinline__ float softplusf(float x) { return fmaxf(x, 0.f) + __logf(1.0f + __expf(-fabsf(x))); }
__device__ __forceinline__ float gelu_tanh(float y) { const float z = 0.7978845608028654f * (y + 0.044715f * y * y * y); const float th = 1.0f - 2.0f * __builtin_amdgcn_rcpf(1.0f + __expf(2.0f * z)); return 0.5f * y * (1.0f + th); }
template <int NQG>
__device__ __forceinline__ void moba_mfma_item(const bf16* proj, const float* kmean, const bf16* vt, bf16* y3, int bh, int qb, int wsl, int lane) {
    constexpr int NQ = 16 * NQG;
    const int b = bh >> 2, h = bh & 3, fr = lane & 15, fq = lane >> 4;
    const int t0 = qb * 256 + wsl * NQ; const size_t rowb = (size_t)b * SEQ;
    unsigned selmask = 0;
    { const GAS v4u* qp = (const GAS v4u*)(proj + (rowb + t0 + (lane & (NQ - 1))) * NPROJ + PC_AQ + h * 64);
      float qv[64];
#pragma unroll
      for (int c = 0; c < 8; ++c) { const v4u w = qp[c]; qv[8 * c + 0] = __uint_as_float(w.x << 16); qv[8 * c + 1] = __uint_as_float(w.x & 0xffff0000u); qv[8 * c + 2] = __uint_as_float(w.y << 16); qv[8 * c + 3] = __uint_as_float(w.y & 0xffff0000u);
          qv[8 * c + 4] = __uint_as_float(w.z << 16); qv[8 * c + 5] = __uint_as_float(w.z & 0xffff0000u); qv[8 * c + 6] = __uint_as_float(w.w << 16); qv[8 * c + 7] = __uint_as_float(w.w & 0xffff0000u); }
      float gs[7];
#pragma unroll
      for (int n = 0; n < 7; ++n) { float a = -3.0e38f; if (n < qb) { const float* km = kmean + (size_t)(bh * 8 + n) * 64; a = 0.f;
#pragma unroll
              for (int d = 0; d < 64; ++d) a += qv[d] * km[d]; }
          gs[n] = a; }
#pragma unroll
      for (int r = 0; r < 3; ++r) { int best = -1; float bv = -3.0e38f;
#pragma unroll
          for (int n = 0; n < 7; ++n) if (n < qb && !((selmask >> n) & 1u) && gs[n] > bv) { bv = gs[n]; best = n; }
          if (best >= 0) selmask |= 1u << best; } }
    unsigned mskp = 0;
#pragma unroll
    for (int qg = 0; qg < NQG; ++qg) mskp |= ((unsigned)__shfl((int)selmask, 16 * qg + fr) & 0xffu) << (8 * qg);
    unsigned umask = 0;
#pragma unroll
    for (int n = 0; n < 7; ++n) if (__ballot((selmask >> n) & 1u) != 0ull) umask |= 1u << n;
    bf16x8 qf[NQG][2];
#pragma unroll
    for (int qg = 0; qg < NQG; ++qg)
#pragma unroll
        for (int ks = 0; ks < 2; ++ks) qf[qg][ks] = *(const GAS bf16x8*)(proj + (rowb + t0 + 16 * qg + fr) * NPROJ + PC_AQ + h * 64 + 32 * ks + 8 * fq);
    f32x4 o[4][NQG];
#pragma unroll
    for (int dt = 0; dt < 4; ++dt)
#pragma unroll
        for (int qg = 0; qg < NQG; ++qg) o[dt][qg] = (f32x4){0.f, 0.f, 0.f, 0.f};
    float mrun[NQG], lrun[NQG];
#pragma unroll
    for (int qg = 0; qg < NQG; ++qg) { mrun[qg] = -1.0e30f; lrun[qg] = 0.f; }
    const float cexp = 0.125f * 1.4426950408889634f;
    const int kperm = 8 * (fr >> 2) + (fr & 3);
    for (int it = 0; it <= qb; ++it) {
        const int nb = (it == 0) ? qb : it - 1;
        if (it > 0 && !((umask >> nb) & 1u)) continue;
        const int nsteps = (it == 0) ? (wsl * NQ + NQ - 1) / 32 + 1 : 8;
        bf16x8 kfn[2][2];
        { const size_t kb0 = rowb + nb * 256;
#pragma unroll
          for (int kt = 0; kt < 2; ++kt)
#pragma unroll
              for (int ks = 0; ks < 2; ++ks) kfn[kt][ks] = *(const GAS bf16x8*)(proj + (kb0 + kperm + 4 * kt) * NPROJ + PC_AK + h * 64 + 32 * ks + 8 * fq); }
        for (int st = 0; st < nsteps; ++st) {
            bf16x8 kf[2][2], vf[4];
#pragma unroll
            for (int kt = 0; kt < 2; ++kt) { kf[kt][0] = kfn[kt][0]; kf[kt][1] = kfn[kt][1]; }
#pragma unroll
            for (int dt = 0; dt < 4; ++dt) vf[dt] = *(const GAS bf16x8*)(vt + ((size_t)bh * 64 + 16 * dt + fr) * SEQ + nb * 256 + 32 * st + 8 * fq);
            if (st + 1 < nsteps) { const size_t kb = rowb + nb * 256 + 32 * (st + 1);
#pragma unroll
                for (int kt = 0; kt < 2; ++kt)
#pragma unroll
                    for (int ks = 0; ks < 2; ++ks) kfn[kt][ks] = *(const GAS bf16x8*)(proj + (kb + kperm + 4 * kt) * NPROJ + PC_AK + h * 64 + 32 * ks + 8 * fq); }
            f32x4 s[2][NQG];
#pragma unroll
            for (int kt = 0; kt < 2; ++kt)
#pragma unroll
                for (int qg = 0; qg < NQG; ++qg) { f32x4 a = (f32x4){0.f, 0.f, 0.f, 0.f};
                    a = __builtin_amdgcn_mfma_f32_16x16x32_bf16(kf[kt][0], qf[qg][0], a, 0, 0, 0); a = __builtin_amdgcn_mfma_f32_16x16x32_bf16(kf[kt][1], qf[qg][1], a, 0, 0, 0); s[kt][qg] = a; }
            bf16x8 pf[NQG];
#pragma unroll
            for (int qg = 0; qg < NQG; ++qg) {
                const int qloc = NQ * wsl + 16 * qg + fr; const bool sel = (mskp >> (8 * qg + nb)) & 1u;
                float mx = -1.0e30f;
#pragma unroll
                for (int kt = 0; kt < 2; ++kt)
#pragma unroll
                    for (int i = 0; i < 4; ++i) { const int kloc = 32 * st + 8 * fq + 4 * kt + i; const bool ok = (it == 0) ? (kloc <= qloc) : sel; const float v = ok ? s[kt][qg][i] : -1.0e30f; s[kt][qg][i] = v; mx = fmaxf(mx, v); }
                mx = xrow16_max(mx);
                const float mnew = fmaxf(mrun[qg], mx), alpha = __builtin_amdgcn_exp2f((mrun[qg] - mnew) * cexp); mrun[qg] = mnew;
                float ps = 0.f; float p[8];
#pragma unroll
                for (int kt = 0; kt < 2; ++kt)
#pragma unroll
                    for (int i = 0; i < 4; ++i) { const float e = __builtin_amdgcn_exp2f((s[kt][qg][i] - mnew) * cexp); p[4 * kt + i] = e; ps += e; }
                lrun[qg] = lrun[qg] * alpha + ps;
#pragma unroll
                for (int dt = 0; dt < 4; ++dt) o[dt][qg] *= alpha;
                v4u pw; pw.x = pk2(p[0], p[1]); pw.y = pk2(p[2], p[3]); pw.z = pk2(p[4], p[5]); pw.w = pk2(p[6], p[7]);
                pf[qg] = __builtin_bit_cast(bf16x8, pw);
            }
#pragma unroll
            for (int dt = 0; dt < 4; ++dt)
#pragma unroll
                for (int qg = 0; qg < NQG; ++qg) o[dt][qg] = __builtin_amdgcn_mfma_f32_16x16x32_bf16(vf[dt], pf[qg], o[dt][qg], 0, 0, 0);
        }
    }
#pragma unroll
    for (int qg = 0; qg < NQG; ++qg) { float l = xrow16_sum(lrun[qg]); const float inv = 1.0f / l;
        bf16* orow = y3 + (rowb + t0 + 16 * qg + fr) * 256 + h * 64 + 4 * fq;
#pragma unroll
        for (int dt = 0; dt < 4; ++dt) { const f32x4 v = o[dt][qg] * inv; *(GAS unsigned long long*)(orow + 16 * dt) = (unsigned long long)pk2(v[0], v[1]) | ((unsigned long long)pk2(v[2], v[3]) << 32); } }
}
typedef float f32x2 __attribute__((ext_vector_type(2)));
typedef unsigned u32x2_t __attribute__((ext_vector_type(2)));
constexpr int S2_XA = 0, S2_KN = 16384, S2_VV = 32768, S2_AB = 49152, S2_BUF = 50176, S2_OB = 2 * S2_BUF, S2_QD = S2_OB + 32768, S2_XT = S2_QD + 512, S2_CW = S2_XT + 32 * 68 * 4, S2_FA = S2_KN + 8960  ;
static_assert(S2_CW + 3 * 4 * 64 * 4 + 128 + 256 <= LDSCTL_OFF, "LDS map of the sequential mixers");
template <bool GDN>
__device__ __forceinline__ void seq_mixer2(const bf16* proj, const float* scal, const float* convw, const float* p0, const float* p1, const float* normw, bf16* yout, LAS unsigned char* lds, int bh, int tid) {
    const int wave = __builtin_amdgcn_readfirstlane(tid >> 6), lane = tid & 63;
    const int b = bh >> 2, h = bh & 3; const size_t rowb = (size_t)b * SEQ;
    constexpr int CIN = GDN ? 768 : 512, PCQ = GDN ? PC_GQ : PC_MQ;
    if (wave == 4) { LAS float* cwl = (LAS float*)(lds + S2_CW);
        for (int i = lane; i < 3 * 4 * 64; i += 64) { const int ty = i >> 8, j = (i >> 6) & 3, dd = i & 63; cwl[i] = (GDN || ty < 2) ? convw[j * CIN + ty * 256 + h * 64 + dd] : 0.f; }
        if (lane < 32) cwl[768 + lane] = 0.f; { unsigned no_ = (unsigned)(((GDN ? 0 : h * 64) + lane) * 4); asm volatile("" : "+v"(no_)); cwl[800 + lane] = *(const float*)((const char*)normw + no_); } }
    __syncthreads();
    if (wave < 4) {
        const int fr = lane & 15, fq = lane >> 4, e = 16 * wave + fr, sel = fr & 3;
        f32x4 ST[4];
#pragma unroll
        for (int T = 0; T < 4; ++T) ST[T] = (f32x4){0.f, 0.f, 0.f, 0.f};
        const unsigned wmask = (fq == 0) ? 0xffffffffu : 0u;
        v4u b0 = (v4u){0u, 0u, 0u, 0u}, b1 = b0, b2 = b0, b3 = b0;
        __builtin_amdgcn_s_setprio(3);
        for (int c = 0; c < SEQ / 64; ++c) {
            __syncthreads();
            const LAS bf16* XA = (const LAS bf16*)(lds + (c & 1) * S2_BUF + S2_XA) + (sel >> 1) * 128 + (sel & 1) * 64 + 8 * fq;
            const LAS unsigned char* KP = lds + (c & 1) * S2_BUF + S2_KN + fr * 16;
            const LAS float* VV = (const LAS float*)(lds + (c & 1) * S2_BUF + S2_VV) + e; const LAS float* AB = (const LAS float*)(lds + (c & 1) * S2_BUF + S2_AB);
            LAS float* OB = (LAS float*)(lds + S2_OB + (c & 1) * 16384) + e;
            bf16x8 a0n, a1n, kpn; f32x4 ab1n, ab2n; float v1n, v2n;
#define S2_LOAD(tp) do { a0n = *(const LAS bf16x8*)(XA + (tp) * 256); a1n = *(const LAS bf16x8*)(XA + (tp) * 256 + 32); kpn = *(const LAS bf16x8*)(KP + (tp) * 272); \
            v1n = VV[(tp) * 128]; v2n = VV[(tp) * 128 + 64]; ab1n = *(const LAS f32x4*)(AB + 8 * (tp)); ab2n = *(const LAS f32x4*)(AB + 8 * (tp) + 4); } while (0)
            S2_LOAD(0);
#pragma unroll 4
            for (int tp = 0; tp < 32; ++tp) {
                const bf16x8 a0 = a0n, a1 = a1n, kp = kpn; const f32x4 ab1 = ab1n, ab2 = ab2n; const float ve1 = v1n, ve2 = v2n;
                v4u bl, bhh; bl.x = pk2(ST[0][0], ST[0][1]); bl.y = pk2(ST[0][2], ST[0][3]); bl.z = pk2(ST[1][0], ST[1][1]); bl.w = pk2(ST[1][2], ST[1][3]);
                bhh.x = pk2(ST[2][0], ST[2][1]); bhh.y = pk2(ST[2][2], ST[2][3]); bhh.z = pk2(ST[3][0], ST[3][1]); bhh.w = pk2(ST[3][2], ST[3][3]);
                f32x4 d = (f32x4){0.f, 0.f, 0.f, 0.f};
                d = __builtin_amdgcn_mfma_f32_16x16x32_bf16(a0, __builtin_bit_cast(bf16x8, bl), d, 0, 0, 0);
                d = __builtin_amdgcn_mfma_f32_16x16x32_bf16(a1, __builtin_bit_cast(bf16x8, bhh), d, 0, 0, 0);
                __builtin_amdgcn_sched_barrier(0);
                S2_LOAD(tp + 1);
                __builtin_amdgcn_sched_barrier(0);
                float o1, o2, vn1, vn2;
                if (GDN) { vn1 = ve1 - ab1[1] * d[0]; o1 = ab1[0] * d[1] + vn1 * ab1[2];
                    const float sk2 = ab1[0] * d[2] + ab2[3] * vn1, sq2 = ab1[0] * d[3] + ab1[3] * vn1;
                    vn2 = ve2 - ab2[1] * sk2; o2 = ab2[0] * sq2 + vn2 * ab2[2]; }
                else { vn1 = ve1; o1 = ab1[0] * d[1] + ve1 * ab1[2]; const float sq2 = ab1[0] * d[3] + ab1[3] * ve1; vn2 = ve2; o2 = ab2[0] * sq2 + ve2 * ab2[2]; }
                const float aa = ab1[0] * ab2[0], c1 = ab2[0] * vn1;
#pragma unroll
                for (int T = 0; T < 4; ++T) ST[T] *= aa;
                const unsigned w = pk2(c1, vn2) & wmask;
                b0.x = w; b1.y = w; b2.z = w; b3.w = w;
                ST[0] = __builtin_amdgcn_mfma_f32_16x16x32_bf16(kp, __builtin_bit_cast(bf16x8, b0), ST[0], 0, 0, 0);
                ST[1] = __builtin_amdgcn_mfma_f32_16x16x32_bf16(kp, __builtin_bit_cast(bf16x8, b1), ST[1], 0, 0, 0);
                ST[2] = __builtin_amdgcn_mfma_f32_16x16x32_bf16(kp, __builtin_bit_cast(bf16x8, b2), ST[2], 0, 0, 0);
                ST[3] = __builtin_amdgcn_mfma_f32_16x16x32_bf16(kp, __builtin_bit_cast(bf16x8, b3), ST[3], 0, 0, 0);
                OB[tp * 128] = o1; OB[tp * 128 + 64] = o2;
            }
#undef S2_LOAD
        }
        __builtin_amdgcn_s_setprio(0);
        __syncthreads();
        __syncthreads();
    } else {
        const float s0 = GDN ? __expf(p0[h]) : p0[h], s1 = p1[h];
        const int ht = tid - 256, dgrp = ht & 7, d0 = 8 * dgrp, tg = ht >> 3;
        const int xpos = (dgrp >> 2) * 32 + (dgrp & 1) * 16 + ((dgrp >> 1) & 1) * 4;
        const LAS float* CW0 = (const LAS float*)(lds + S2_CW) + d0;
        const int e0 = (lane & 7) * 8;
        float nstate = 0.f;
#define S2_UNPK(W_, A_) do { const v4u w_ = (W_); A_[0] = __uint_as_float(w_.x << 16); A_[1] = __uint_as_float(w_.x & 0xffff0000u); A_[2] = __uint_as_float(w_.y << 16); A_[3] = __uint_as_float(w_.y & 0xffff0000u); \
                    A_[4] = __uint_as_float(w_.z << 16); A_[5] = __uint_as_float(w_.z & 0xffff0000u); A_[6] = __uint_as_float(w_.w << 16); A_[7] = __uint_as_float(w_.w & 0xffff0000u); } while (0)
        v4u rq[5], rk[5], rv[5]; float sg[2][2]; v4u zws[2];
        const int zh = 2 * (wave - 4);
#define S2_PREF(cn) do { const int s_ = (cn) * 64 + 2 * tg; \
            unsigned off_ = (unsigned)((((int)rowb + s_ - 3) * NPROJ + PCQ + h * 64 + d0) * 2); asm volatile("" : "+v"(off_));     \
            _Pragma("unroll") for (int r = 0; r < 5; ++r) { rq[r] = (v4u){0u, 0u, 0u, 0u}; rk[r] = rq[r]; \
                if (s_ - 3 + r >= 0) { const char* src_ = (const char*)proj + (off_ + (unsigned)(r * NPROJ * 2)); rq[r] = *(const GAS v4u*)src_; rk[r] = *(const GAS v4u*)(src_ + 512); } } } while (0)
#define S2_PREF_V(cn) do { const int s_ = (cn) * 64 + 2 * tg; \
            unsigned off_ = (unsigned)((((int)rowb + s_ - 3) * NPROJ + PCQ + h * 64 + d0) * 2); asm volatile("" : "+v"(off_)); \
            _Pragma("unroll") for (int r = 0; r < 5; ++r) { rv[r] = (v4u){0u, 0u, 0u, 0u}; \
                if (s_ - 3 + r >= 0) { const char* src_ = (const char*)proj + (off_ + (unsigned)(r * NPROJ * 2)); \
                    if (GDN) rv[r] = *(const GAS v4u*)(src_ + 1024); else if (r >= 3) rv[r] = *(const GAS v4u*)(src_ + (PC_MV - PCQ) * 2); } } \
            unsigned so_ = (unsigned)((((int)rowb + s_) * 16 + h) * 4); asm volatile("" : "+v"(so_)); const float* sb_ = (const float*)((const char*)scal + so_); \
            _Pragma("unroll") for (int i = 0; i < 2; ++i) { sg[i][0] = sb_[i * 16 + (GDN ? 0 : 8)]; sg[i][1] = sb_[i * 16 + (GDN ? 4 : 12)]; } } while (0)
#define S2_PREF_Z(cc_) do { unsigned zo_ = (unsigned)((((int)rowb + (cc_) * 64 + (lane >> 3) + zh * 8) * NPROJ + (GDN ? PC_GZ : PC_MO) + h * 64 + e0) * 2); asm volatile("" : "+v"(zo_)); \
            _Pragma("unroll") for (int i8 = 0; i8 < 2; ++i8) zws[i8] = *(const GAS v4u*)((const char*)proj + (zo_ + (unsigned)(i8 * 8 * NPROJ * 2))); } while (0)
        S2_PREF(0);
        for (int c = 0; c <= SEQ / 64 + 1; ++c) {
            if (c >= 2) {
                const int cc = c - 2; const LAS float* OB = (const LAS float*)(lds + S2_OB + (cc & 1) * 16384); const LAS float* QD = (const LAS float*)(lds + S2_QD) + (cc & 1) * 64;
#pragma unroll
                for (int i8 = 0; i8 < 2; ++i8) { const int t = (zh + i8) * 8 + (lane >> 3); const size_t row = rowb + cc * 64 + t;
                    f32x4 oa = *(const LAS f32x4*)(OB + t * 64 + e0), ob = *(const LAS f32x4*)(OB + t * 64 + e0 + 4);
                    if (!GDN) { const float inv = 1.0f / fmaxf(fabsf(QD[t]), 1.0f); oa *= inv; ob *= inv; }
                    float ss = (oa[0] * oa[0] + oa[1] * oa[1]) + (oa[2] * oa[2] + oa[3] * oa[3]) + (ob[0] * ob[0] + ob[1] * ob[1]) + (ob[2] * ob[2] + ob[3] * ob[3]);
                    ss = red8(ss);
                    const float r = rsqrtf(ss * (1.0f / 64.0f) + 1e-6f);
                    float z[8]; S2_UNPK(zws[i8], z);
                    float y[8]; const f32x4 nw0 = *(const LAS f32x4*)(lds + S2_CW + 3200 + 4 * e0), nw1 = *(const LAS f32x4*)(lds + S2_CW + 3200 + 4 * e0 + 16);
#pragma unroll
                    for (int i = 0; i < 8; ++i) { const float ov = (i < 4 ? oa[i] * nw0[i & 3] : ob[i - 4] * nw1[i & 3]) * r; y[i] = GDN ? ov * silu(z[i]) : ov * sigm(z[i]); }
                    v4u yo; yo.x = pk2(y[0], y[1]); yo.y = pk2(y[2], y[3]); yo.z = pk2(y[4], y[5]); yo.w = pk2(y[6], y[7]);
                    *(GAS v4u*)((char*)yout + (unsigned)(((int)row * 256 + h * 64 + e0) * 2)) = yo; }
            }
            if (c < SEQ / 64) {
                S2_PREF_V(c);
                LAS bf16* XA = (LAS bf16*)(lds + (c & 1) * S2_BUF + S2_XA); LAS unsigned char* KPb = lds + (c & 1) * S2_BUF + S2_KN; LAS float* VV = (LAS float*)(lds + (c & 1) * S2_BUF + S2_VV); LAS float* AB = (LAS float*)(lds + (c & 1) * S2_BUF + S2_AB);
#pragma unroll
                for (int i = 0; i < 2; ++i) { const int t = 2 * tg + i;
                    const LAS float* CW = CW0; asm volatile("" : "+v"(CW));
                    float q[8], k[8];
#pragma unroll
                    for (int ii = 0; ii < 8; ++ii) { q[ii] = 0.f; k[ii] = 0.f; }
#pragma unroll
                    for (int j = 0; j < 4; ++j) { const f32x4 wq0 = *(const LAS f32x4*)(CW + j * 64), wq1 = *(const LAS f32x4*)(CW + j * 64 + 4), wk0 = *(const LAS f32x4*)(CW + (4 + j) * 64), wk1 = *(const LAS f32x4*)(CW + (4 + j) * 64 + 4);
                        float x[8]; S2_UNPK(rq[i + j], x);
#pragma unroll
                        for (int ii = 0; ii < 4; ++ii) { q[ii] += wq0[ii] * x[ii]; q[4 + ii] += wq1[ii] * x[4 + ii]; }
                        S2_UNPK(rk[i + j], x);
#pragma unroll
                        for (int ii = 0; ii < 4; ++ii) { k[ii] += wk0[ii] * x[ii]; k[4 + ii] += wk1[ii] * x[4 + ii]; }
                        if (j & 1) asm volatile("" ::: "memory"); }
                    float ssq = 0.f, ssk = 0.f;
#pragma unroll
                    for (int ii = 0; ii < 8; ++ii) { q[ii] = silu(q[ii]); k[ii] = silu(k[ii]); ssq += q[ii] * q[ii]; ssk += k[ii] * k[ii]; }
                    float scq = 1.0f, sck = 1.0f;
                    if (GDN) { ssq = red8(ssq); ssk = red8(ssk);
                        scq = rsqrtf(ssq + 1e-6f) * 0.125f; sck = rsqrtf(ssk + 1e-6f); }
                    else sck = 0.125f * __expf(sg[i][0] + s0);
                    float kq = 0.f;
#pragma unroll
                    for (int ii = 0; ii < 8; ++ii) { q[ii] *= scq; k[ii] *= sck; kq += q[ii] * k[ii]; }
                    kq = red8(kq);
                    float k12 = 0.f, kq12 = 0.f;
                    float kp[8];
                    if (i == 1) { const u32x2_t w0 = *(const LAS u32x2_t*)(XA + (t - 1) * 128 + xpos), w1 = *(const LAS u32x2_t*)(XA + (t - 1) * 128 + xpos + 8);
                        kp[0] = __uint_as_float(w0.x << 16); kp[1] = __uint_as_float(w0.x & 0xffff0000u); kp[2] = __uint_as_float(w0.y << 16); kp[3] = __uint_as_float(w0.y & 0xffff0000u);
                        kp[4] = __uint_as_float(w1.x << 16); kp[5] = __uint_as_float(w1.x & 0xffff0000u); kp[6] = __uint_as_float(w1.y << 16); kp[7] = __uint_as_float(w1.y & 0xffff0000u);
#pragma unroll
                        for (int ii = 0; ii < 8; ++ii) { k12 += kp[ii] * k[ii]; kq12 += kp[ii] * q[ii]; }
                        k12 = red8(k12); kq12 = red8(kq12); }
                    v4u qb, kb; qb.x = pk2(q[0], q[1]); qb.y = pk2(q[2], q[3]); qb.z = pk2(q[4], q[5]); qb.w = pk2(q[6], q[7]); kb.x = pk2(k[0], k[1]); kb.y = pk2(k[2], k[3]); kb.z = pk2(k[4], k[5]); kb.w = pk2(k[6], k[7]);
                    *(LAS u32x2_t*)(XA + t * 128 + xpos) = (u32x2_t){kb.x, kb.y}; *(LAS u32x2_t*)(XA + t * 128 + xpos + 8) = (u32x2_t){kb.z, kb.w};
                    *(LAS u32x2_t*)(XA + t * 128 + 64 + xpos) = (u32x2_t){qb.x, qb.y}; *(LAS u32x2_t*)(XA + t * 128 + 64 + xpos + 8) = (u32x2_t){qb.z, qb.w};
                    if (i == 1) {
#pragma unroll
                        for (int ii = 0; ii < 8; ++ii) *(LAS unsigned*)(KPb + tg * 272 + (8 * (dgrp & 1) + ii) * 16 + (dgrp >> 1) * 4) = pk2(kp[ii], k[ii]); }
                    float be = 1.0f;
                    if (GDN) be = sigm(sg[i][0]);
                    if (dgrp == 0) { f32x4 abv;
                        if (GDN) { const float al = __expf(-s0 * softplusf(sg[i][1] + s1)); abv = (f32x4){al, al * be, kq, k12}; }
                        else { abv = (f32x4){sigm(sg[i][1] + s1), 0.f, kq, 0.f}; *(LAS float*)(lds + (c & 1) * S2_BUF + S2_FA + 4 * t) = abv[0]; }
                        *(LAS f32x4*)(AB + 4 * t) = abv; if (i == 1) AB[4 * (t - 1) + 3] = kq12; }
                    float v[8];
                    if (GDN) {
#pragma unroll
                        for (int ii = 0; ii < 8; ++ii) v[ii] = 0.f;
#pragma unroll
                        for (int j = 0; j < 4; ++j) { float x[8]; S2_UNPK(rv[i + j], x); const f32x4 wv0 = *(const LAS f32x4*)(CW + (8 + j) * 64), wv1 = *(const LAS f32x4*)(CW + (8 + j) * 64 + 4);
#pragma unroll
                            for (int ii = 0; ii < 4; ++ii) { v[ii] += wv0[ii] * x[ii]; v[4 + ii] += wv1[ii] * x[4 + ii]; } }
#pragma unroll
                        for (int ii = 0; ii < 8; ++ii) v[ii] = silu(v[ii]) * be;
                    } else S2_UNPK(rv[3 + i], v);
                    *(LAS f32x4*)(VV + t * 64 + d0) = (f32x4){v[0], v[1], v[2], v[3]}; *(LAS f32x4*)(VV + t * 64 + d0 + 4) = (f32x4){v[4], v[5], v[6], v[7]};
                    asm volatile("" ::: "memory"); }
                if (c + 1 < SEQ / 64) S2_PREF(c + 1);
            }
            if (c >= 1 && c <= SEQ / 64) S2_PREF_Z(c - 1);
            __syncthreads();
            if (!GDN && wave == 5 && c < SEQ / 64) {
                const int lpos = 32 * (lane >> 5) + 8 * ((lane & 15) >> 2) + 4 * ((lane >> 4) & 1) + (lane & 3); const LAS bf16* XQ = (const LAS bf16*)(lds + (c & 1) * S2_BUF + S2_XA) + 64 + lpos; const LAS bf16* XK = (const LAS bf16*)(lds + (c & 1) * S2_BUF + S2_XA) + lpos; const LAS float* AB = (const LAS float*)(lds + (c & 1) * S2_BUF + S2_AB);
                LAS float* QD = (LAS float*)(lds + S2_QD) + (c & 1) * 64; LAS float* XT = (LAS float*)(lds + S2_XT); const LAS float* FA = (const LAS float*)(lds + (c & 1) * S2_BUF + S2_FA);
                for (int hf = 0; hf < 2; ++hf) {
#pragma unroll 1
                    for (int g16 = 0; g16 < 2; ++g16) {
                        const int t0 = hf * 32 + g16 * 16; float fa[16], ka[16], qa[16], xo[16];
#pragma unroll
                        for (int j4 = 0; j4 < 4; ++j4) { const f32x4 f4 = *(const LAS f32x4*)(FA + t0 + 4 * j4); fa[4 * j4] = f4[0]; fa[4 * j4 + 1] = f4[1]; fa[4 * j4 + 2] = f4[2]; fa[4 * j4 + 3] = f4[3]; }
#pragma unroll
                        for (int j = 0; j < 16; ++j) { ka[j] = bf2f(XK[(t0 + j) * 128]); qa[j] = bf2f(XQ[(t0 + j) * 128]); }
#pragma unroll
                        for (int j = 0; j < 16; ++j) { nstate = nstate * fa[j] + ka[j]; xo[j] = nstate * qa[j]; }
#pragma unroll
                        for (int j = 0; j < 16; ++j) XT[(g16 * 16 + j) * 68 + lane] = xo[j];
                    }
                    LDS_WAIT(); asm volatile("" ::: "memory");
                    const LAS float* xr = XT + (lane & 31) * 68 + (lane >> 5) * 32; f32x4 s4 = (f32x4){0.f, 0.f, 0.f, 0.f};
#pragma unroll
                    for (int dd = 0; dd < 8; ++dd) s4 += *(const LAS f32x4*)(xr + 4 * dd);
                    float sm = (s4[0] + s4[1]) + (s4[2] + s4[3]);
                    sm = xhalf_sum(sm);
                    if (lane < 32) QD[hf * 32 + lane] = sm;
                    LDS_WAIT(); asm volatile("" ::: "memory");
                }
            }
        }
#undef S2_UNPK
#undef S2_PREF
#undef S2_PREF_V
#undef S2_PREF_Z
    }
}
__device__ __forceinline__ void s5_wave_mfma(const bf16* proj, const float* s5p, const float* cre, const float* cim, const float* dsk_in, bf16* yg, LAS unsigned char* wl, int item, int lane) {
    const int b = item >> 4, g = item & 15, fr = lane & 15, fq = lane >> 4, p = lane;
    LAS float* bu = (LAS float*)wl;
    LAS bf16* xs = (LAS bf16*)(wl + 16 * 132 * 4);
    bf16x8 bfr[8];
#pragma unroll
    for (int tau = 0; tau < 8; ++tau) { const int pp = 16 * tau + fr, ps = pp >> 1, c = pp & 1; v4u w = (v4u){0u, 0u, 0u, 0u};
        if (fq < 2) { const float* src = s5p + 2048 + (c ? 16384 : 0) + (size_t)(g * 64 + ps) * 16 + 8 * fq; w.x = pk2(src[0], src[1]); w.y = pk2(src[2], src[3]); w.z = pk2(src[4], src[5]); w.w = pk2(src[6], src[7]); }
        bfr[tau] = __builtin_bit_cast(bf16x8, w); }
    bf16x8 cfr[4];
#pragma unroll
    for (int ks = 0; ks < 4; ++ks) { const int p0 = (32 * ks + 8 * fq) >> 1; const float* r = cre + (size_t)(g * 16 + fr) * 64 + p0; const float* im = cim + (size_t)(g * 16 + fr) * 64 + p0;
        v4u w; w.x = pk2(r[0], -im[0]); w.y = pk2(r[1], -im[1]); w.z = pk2(r[2], -im[2]); w.w = pk2(r[3], -im[3]); cfr[ks] = __builtin_bit_cast(bf16x8, w); }
    const float ar = s5p[g * 64 + p], ai = s5p[1024 + g * 64 + p];
    float dsk[4];
#pragma unroll
    for (int j = 0; j < 4; ++j) dsk[j] = dsk_in[g * 16 + 4 * fq + j];
    float xr = 0.f, xi = 0.f;
    const size_t rowb = (size_t)b * SEQ;
    const bf16* ubase = proj + (rowb + fr) * NPROJ + PC_S5 + g * 16;
    v4u unext = (v4u){0u, 0u, 0u, 0u}; unsigned long long usk_next = 0ull;
    if (fq < 2) unext = *(const GAS v4u*)(ubase + 8 * fq);
    usk_next = *(const GAS unsigned long long*)(ubase + 4 * fq);
    for (int c = 0; c < SEQ / 16; ++c) {
        const v4u ucur = unext; const unsigned long long usk = usk_next;
        if (c + 1 < SEQ / 16) { const bf16* un = ubase + (size_t)(c + 1) * 16 * NPROJ; if (fq < 2) unext = *(const GAS v4u*)(un + 8 * fq); usk_next = *(const GAS unsigned long long*)(un + 4 * fq); }
        const bf16x8 ufr = __builtin_bit_cast(bf16x8, ucur);
#pragma unroll
        for (int tau = 0; tau < 8; ++tau) { f32x4 d = (f32x4){0.f, 0.f, 0.f, 0.f}; d = __builtin_amdgcn_mfma_f32_16x16x32_bf16(bfr[tau], ufr, d, 0, 0, 0);
            *(LAS f32x4*)(bu + fr * 132 + 16 * tau + 4 * fq) = d; }
        LDS_WAIT(); asm volatile("" ::: "memory");
#pragma unroll 4
        for (int t = 0; t < 16; ++t) { const f32x2 bb = *(const LAS f32x2*)(bu + t * 132 + 2 * p);
            const float nr = ar * xr - ai * xi + bb.x, ni = ar * xi + ai * xr + bb.y; xr = nr; xi = ni;
            *(LAS unsigned*)(xs + t * 136 + 2 * p) = pk2(xr, xi); }
        LDS_WAIT(); asm volatile("" ::: "memory");
        f32x4 y = (f32x4){0.f, 0.f, 0.f, 0.f};
#pragma unroll
        for (int ks = 0; ks < 4; ++ks) { const bf16x8 xf = *(const LAS bf16x8*)(xs + fr * 136 + 32 * ks + 8 * fq); y = __builtin_amdgcn_mfma_f32_16x16x32_bf16(cfr[ks], xf, y, 0, 0, 0); }
        const float u4[4] = {__uint_as_float((unsigned)usk << 16), __uint_as_float((unsigned)usk & 0xffff0000u), __uint_as_float((unsigned)(usk >> 32) << 16), __uint_as_float((unsigned)(usk >> 32) & 0xffff0000u)};
        float o[4];
#pragma unroll
        for (int j = 0; j < 4; ++j) o[j] = gelu_tanh(y[j] + dsk[j] * u4[j]);
        *(GAS unsigned long long*)(yg + (rowb + c * 16 + fr) * 256 + g * 16 + 4 * fq) = (unsigned long long)pk2(o[0], o[1]) | ((unsigned long long)pk2(o[2], o[3]) << 32);
        LDS_WAIT(); asm volatile("" ::: "memory");
    }
}
#ifndef PHASE_MASK
#define PHASE_MASK 0xFFFFFFFFu
#endif
#define PH(k) ((PHASE_MASK >> (k)) & 1u)
#ifndef SEQ_REPS
#define SEQ_REPS 1
#endif
#ifndef DOWN_FLIP
#define DOWN_FLIP 0
#endif
#ifndef DOWN_SP2
#define DOWN_SP2 true
#endif
#ifndef DOWN_ALIGN
#define DOWN_ALIGN true
#endif
#ifndef MOBA_NQG
#define MOBA_NQG 4
#endif
struct Args { const float* in[36]; float* out; unsigned char* ws; };
typedef const Args __attribute__((address_space(4))) CArgs;
__device__ __forceinline__ LayerW layer_ptrs(CArgs& a, int l) {
    LayerW L;
    L.ffn1_norm = a.in[3] + (size_t)l * D; L.ffn1_w_gu = a.in[4] + (size_t)l * D * NGU; L.ffn1_w_down = a.in[5] + (size_t)l * FF * D; L.mix_norm = a.in[6] + (size_t)l * D; L.w_in = a.in[7] + (size_t)l * D * NIN_SRC;
    L.gdn_conv = a.in[8] + (size_t)l * 4 * 768; L.gdn_a_log = a.in[9] + l * 4; L.gdn_dt_bias = a.in[10] + l * 4; L.gdn_norm = a.in[11] + l * 64;
    L.mlstm_conv = a.in[12] + (size_t)l * 4 * 512; L.mlstm_i_bias = a.in[13] + l * 4; L.mlstm_f_bias = a.in[14] + l * 4; L.mlstm_norm = a.in[15] + l * 256;
    L.s5_lre = a.in[16] + l * 1024; L.s5_lim = a.in[17] + l * 1024; L.s5_bre = a.in[18] + l * 16384; L.s5_bim = a.in[19] + l * 16384; L.s5_cre = a.in[20] + l * 16384; L.s5_cim = a.in[21] + l * 16384;
    L.s5_d = a.in[22] + l * 256; L.s5_log_dt = a.in[23] + l * 16; L.s5_w_glu = a.in[24] + (size_t)l * 65536; L.s5_b_glu = a.in[25] + l * 256;
    L.w_gate = a.in[26] + (size_t)l * 4 * D * D; L.w_branch = a.in[27] + (size_t)l * 4 * 256 * D; L.w_out = a.in[28] + (size_t)l * D * D;
    L.ffn2_norm = a.in[29] + (size_t)l * D; L.ffn2_w_gu = a.in[30] + (size_t)l * D * NGU; L.ffn2_w_down = a.in[31] + (size_t)l * FF * D;
    L.ple_norm = a.in[32] + (size_t)l * D; L.ple_w_proj = a.in[33] + (size_t)l * PLED * D; L.ple_w_gate = a.in[34] + (size_t)l * D * D;
    return L;
}

__global__ void __launch_bounds__(NWAVES * 64, 2) mk_fwd(Args args_k) {
    (void)args_k;
#define KARGP() ((CArgs*)__builtin_amdgcn_kernarg_segment_ptr())
    extern __shared__ __attribute__((aligned(16))) unsigned char lds_raw[];
    LAS unsigned char* lds = (LAS unsigned char*)lds_raw;
    const int G = gridDim.x;
    for (int u = threadIdx.x; u < (LDS_BYTES - LDSCTL_OFF) / 4; u += NWAVES * 64) ((LAS unsigned*)(lds + LDSCTL_OFF))[u] = 0u;
    __syncthreads();
    (void)xcd_barrier_post((unsigned*)(KARGP()->ws + WS_CTL) + CW_BAR, (volatile LAS unsigned*)(lds + LDSCTL_OFF) + 8);
#define GRID_BAR() do { CArgs* gp_ = KARGP(); asm volatile("" : "+s"(gp_)); unsigned char* bw_ = gp_->ws; asm volatile("" : "+s"(bw_)); XcdBarrier bar_; bar_.bar = (unsigned*)(bw_ + WS_CTL) + CW_BAR; bar_.x = xb_xcc_id(); bar_.st = (volatile LAS unsigned*)(lds + LDSCTL_OFF) + 8; xcd_barrier(bar_); } while (0)
    unsigned gbn = 0;
#define GROUP_BAR() do { ++gbn; CArgs* gq_ = KARGP(); asm volatile("" : "+s"(gq_)); unsigned char* gw_ = gq_->ws; asm volatile("" : "+s"(gw_)); const unsigned gi_ = blockIdx.x & 7u; \
        group_barrier((unsigned*)(gw_ + WS_CTL) + CW_GRP + 64 * gi_, gbn * (((unsigned)G - gi_ + 7u) >> 3)); } while (0)
#define WSP(T, off) ((T*)(wsl + (off)))
#define LAUNDER() CArgs* ap_ = KARGP(); asm volatile("" : "+s"(ap_)); unsigned char* wsl = ap_->ws; asm volatile("" : "+s"(wsl)); int K256 = 256, K1024 = 1024, KFF = FF; asm volatile("" : "+s"(K256), "+s"(K1024), "+s"(KFF)); (void)K256; (void)K1024; (void)KFF; int tid = threadIdx.x; asm volatile("" : "+v"(tid)); const int lane = tid & 63, wave = __builtin_amdgcn_readfirstlane(tid >> 6); (void)lane; (void)wave; int bid = blockIdx.x; asm volatile("" : "+s"(bid)); (void)bid
#define SC_PTR ((LAS float*)(lds + SC_OFF))
#define SC_RESET() do { __syncthreads(); if (tid == 0) *(LAS int*)(lds + SC_OFF + 1024) = -1; __syncthreads(); } while (0)
#define GW (blockIdx.x * NWAVES + wave)
#define NGW (G * NWAVES)

#if PH(0)
#ifdef PROBE_REP0
#pragma nounroll
    for (int rep_ = 0; rep_ < PROBE_REP0; ++rep_)
#endif
    { LAUNDER(); const LayerW L = layer_ptrs(*ap_, 0); const LayerW L1 = layer_ptrs(*ap_, 1);
#ifndef PW_REPS
#define PW_REPS 1
#endif
      for (int rpw_ = 0; rpw_ < PW_REPS; ++rpw_)
      prologue_weights(L, ap_->ws + WS_W, lds, GW, NGW, wave, lane);
      prologue_s5(L, WSP(float, WS_S5P), blockIdx.x * 512 + tid, G * 512);
      prologue_s5(L1, WSP(float, WS_S5P) + 40960, blockIdx.x * 512 + tid, G * 512);
      prologue_rope((const int*)ap_->in[2], (float*)((unsigned char*)ap_->out + OUT_ROPE), (size_t)blockIdx.x * 512 + tid, (size_t)G * 512);
      x_to_hb(ap_->in[0], WSP(bf16, WS_HB), WSP(pg8::rowss_t, WS_ROWSS), GW, NGW, lane); }
    GRID_BAR();
#endif
    const int hb0 = (G >= 256) ? 128 : 0;
    for (int l = 0; l < DEPTH; ++l) {
#define WB(off) ((const pg8::bf16_t*)((l == 0 ? wsl + WS_W : (unsigned char*)ap_->out + OUT_W1) + (off)))
#define HCUR() ((const pg8::bf16_t*)(l == 0 ? wsl + WS_HB : (unsigned char*)ap_->out + OUT_T))
#if PH(1)
#ifndef GU_REPS
#define GU_REPS 1
#endif
        for (int repg_ = 0; repg_ < GU_REPS; ++repg_)
        { LAUNDER(); pg8::Gemm g{HCUR(), WB(W_GU1), M, NGU, K1024, 30, 0}; pg8::StaticOrder S; S.init(M, NGU, G, bid);
          SC_RESET(); pg8::EpiSwiGLU E{WSP(pg8::bf16_t, WS_BIG), WSP(pg8::rowss_t, WS_ROWSS) + (size_t)(4 * l) * M, FF, SC_PTR};
          pg8::gemm_phase<pg8::EpiSwiGLU, pg8::StaticOrder, true, true>(lds + RING_OFF, g, S, E);
          GROUP_BAR(); }
#endif
#if PH(2)
        { LAUNDER(); pg8::Gemm g{WSP(const pg8::bf16_t, WS_BIG), WB(W_D1), M, D, KFF, 30, 0}; pg8::StaticOrder S; S.init(M, D, G, bid);
          pg8::EpiRes E{HCUR(), WSP(pg8::bf16_t, WS_HB), WSP(pg8::rowss_t, WS_ROWSS) + (size_t)(4 * l + 1) * M, 0.5f};
          pg8::gemm_phase<pg8::EpiRes, pg8::StaticOrder, DOWN_ALIGN, DOWN_SP2>(lds + RING_OFF, g, S, E); }
        GRID_BAR();
#endif
#ifdef PROBE_BARS
        for (int pb_ = 0; pb_ < PROBE_BARS; ++pb_) GRID_BAR();
#endif
#if PH(3)
        { LAUNDER(); pg8::Gemm g{WSP(const pg8::bf16_t, WS_HB), WB(W_IN), M, 2560, K1024, 30, 0}; pg8::StaticOrder S; S.init(M, 2560, G, bid);
          SC_RESET(); pg8::EpiMixIn E{WSP(pg8::bf16_t, WS_BIG), WSP(float, WS_SCAL), WSP(pg8::rowss_t, WS_ROWSS) + (size_t)(4 * l + 1) * M, SC_PTR};
          pg8::gemm_phase<pg8::EpiMixIn, pg8::StaticOrder, true, true>(lds + RING_OFF, g, S, E); }
        GRID_BAR();
#endif
#ifdef PROBE_IDLE_US
        { const unsigned long long t0_ = __builtin_amdgcn_s_memrealtime(); while (__builtin_amdgcn_s_memrealtime() - t0_ < (unsigned long long)PROBE_IDLE_US * 100ull) __builtin_amdgcn_s_sleep(32); __syncthreads(); }
#endif
#if PH(5)
        { LAUNDER(); const LayerW L = layer_ptrs(*ap_, l);
          for (int rep_ = 0; rep_ < SEQ_REPS; ++rep_)
          for (int it = blockIdx.x; it < 64; it += G) seq_mixer2<true>(WSP(const bf16, WS_BIG), WSP(const float, WS_SCAL), L.gdn_conv, L.gdn_a_log, L.gdn_dt_bias, L.gdn_norm, WSP(bf16, WS_Y), lds, it, tid); }
#endif
#if PH(6)
        { LAUNDER(); const LayerW L = layer_ptrs(*ap_, l);
          for (int rep_ = 0; rep_ < SEQ_REPS; ++rep_)
          for (int it = blockIdx.x; it < 64 + 64; it += G) if (it >= 64) seq_mixer2<false>(WSP(const bf16, WS_BIG), WSP(const float, WS_SCAL), L.mlstm_conv, L.mlstm_i_bias, L.mlstm_f_bias, L.mlstm_norm, WSP(bf16, WS_Y) + (size_t)M * 256, lds, it - 64, tid); }
#endif
#if PH(15)
        const int gb0 = (G >= 256) ? hb0 + 32 : hb0;
        if ((int)blockIdx.x >= gb0) {
          { LAUNDER(); pg8::Gemm g{WSP(const pg8::bf16_t, WS_HB), WB(W_IN + (size_t)2560 * D * 2), M, 768, K1024, 30, 0}; pg8::StaticOrder S; S.init(M, 768, G - gb0, bid - gb0);
            pg8::EpiMoba E{WSP(pg8::bf16_t, WS_BIG), WSP(pg8::bf16_t, WS_VT), WSP(float, WS_KMEAN) + (size_t)l * 32768, (const float*)((unsigned char*)ap_->out + OUT_ROPE), WSP(pg8::rowss_t, WS_ROWSS) + (size_t)(4 * l + 1) * M};
            pg8::gemm_phase<pg8::EpiMoba, pg8::StaticOrder, true, true>(lds + RING_OFF, g, S, E);
            asm volatile("s_waitcnt vmcnt(0)" ::: "memory"); __syncthreads();
            if (tid == 0) { __builtin_amdgcn_fence(__ATOMIC_RELEASE, "agent"); asm volatile("s_waitcnt vmcnt(0)" ::: "memory"); __hip_atomic_fetch_add(WSP(unsigned, WS_CTL) + CW_FLAG + 64 * l, 1u, RLX_AGENT); } }
          { LAUNDER(); const int nh = G - gb0, c0 = (int)blockIdx.x - gb0;
            for (int pm = c0; pm < M / 256; pm += nh) cvt_rows_bf16(ap_->in[1] + ((size_t)l * M + (size_t)pm * 256) * PLED, WSP(bf16, WS_PB) + (size_t)pm * 256 * PLED, (size_t)256 * PLED, (size_t)tid, (size_t)512);
            asm volatile("s_waitcnt vmcnt(0)" ::: "memory"); __syncthreads();
            pg8::Gemm g{WSP(const pg8::bf16_t, WS_PB), WB(W_PLE), M, D, K256, 30, 0}; pg8::PanelOrder S{c0, nh, M / 256, 4};
            pg8::EpiBf16P E{(pg8::bf16_t*)((unsigned char*)ap_->out + OUT_T), D};
            pg8::gemm_phase<pg8::EpiBf16P, pg8::PanelOrder, true, true>(lds + RING_OFF, g, S, E); }
          __syncthreads();
          const int wb0 = gb0;
          if (l == 0 && (int)blockIdx.x >= wb0) { LAUNDER(); const LayerW L1 = layer_ptrs(*ap_, 1);
            prologue_weights(L1, (unsigned char*)ap_->out + OUT_W1, lds, ((int)blockIdx.x - wb0) * NWAVES + wave, (G - wb0) * NWAVES, wave, lane); }
        }
#endif
#if PH(7)
        { LAUNDER(); const LayerW L = layer_ptrs(*ap_, l); const int c0 = (int)blockIdx.x - hb0;
#ifndef S5_REPS
#define S5_REPS 1
#endif
          for (int rep5_ = 0; rep5_ < S5_REPS; ++rep5_)
          if (c0 >= 0) for (int it = c0; it < 32; it += G - hb0)
              s5_wave_mfma(WSP(const bf16, WS_BIG), WSP(const float, WS_S5P) + 40960 * l, L.s5_cre, L.s5_cim, L.s5_d, WSP(bf16, WS_YG), lds + wave * WAVE_LDS, it * 8 + wave, lane); }
        if (G >= 256 && (int)blockIdx.x >= hb0 && (int)blockIdx.x < hb0 + 32) {
          LAUNDER(); const int c0 = (int)blockIdx.x - hb0; unsigned* f5 = WSP(unsigned, WS_CTL) + CW_S5F + (l * 16 + (c0 >> 1)) * 64;
          asm volatile("s_waitcnt vmcnt(0)" ::: "memory"); __syncthreads();
          if (tid == 0) { __builtin_amdgcn_fence(__ATOMIC_RELEASE, "agent"); asm volatile("s_waitcnt vmcnt(0)" ::: "memory"); __hip_atomic_fetch_add(f5, 1u, RLX_AGENT);
              unsigned sp = 0; while (__hip_atomic_load(f5, RLX_AGENT) < 2u) { __builtin_amdgcn_s_sleep(2); if (++sp > (1u << 22)) break; } }
          __syncthreads();
          __builtin_amdgcn_fence(__ATOMIC_ACQUIRE, "agent"); asm volatile("s_waitcnt vmcnt(0)" ::: "memory");
          const int p0 = 8 * (c0 >> 1) + 4 * (c0 & 1);
          pg8::Gemm g{WSP(const pg8::bf16_t, WS_YG), WB(W_GLU), M, 256, K256, 30, 0}; pg8::PanelOrder S{p0, 1, p0 + 4, 1};
          pg8::EpiGLU E{WSP(const pg8::bf16_t, WS_YG), WSP(pg8::bf16_t, WS_Y) + (size_t)2 * M * 256, ap_->in[25] + l * 256};
          pg8::gemm_phase<pg8::EpiGLU, pg8::PanelOrder, true, true>(lds + RING_OFF, g, S, E); }
#endif
#if PH(8)
        { LAUNDER(); unsigned* flag = WSP(unsigned, WS_CTL) + CW_FLAG + 64 * l; const unsigned need = (unsigned)(G - gb0);
          __syncthreads();
          if (tid == 0) { unsigned sp = 0; while (__hip_atomic_load(flag, RLX_AGENT) < need) { __builtin_amdgcn_s_sleep(2); if (++sp > (1u << 22)) break; } }
          __syncthreads();
          __builtin_amdgcn_fence(__ATOMIC_ACQUIRE, "agent"); asm volatile("s_waitcnt vmcnt(0)" ::: "memory");
          unsigned* qctr = WSP(unsigned, WS_CTL) + CW_QUEUE + 64 * l;
          for (;;) { unsigned idx = 0; if (lane == 0) idx = __hip_atomic_fetch_add(qctr, 1u, RLX_AGENT); idx = __builtin_amdgcn_readfirstlane(idx);
              if (idx >= 8192u / MOBA_NQG) break;
              const int qsl = idx & (16 / MOBA_NQG - 1), bh = (idx / (16 / MOBA_NQG)) & 63, qb = 7 - (int)(idx / (1024 / MOBA_NQG));
              moba_mfma_item<MOBA_NQG>(WSP(const bf16, WS_BIG), WSP(const float, WS_KMEAN) + (size_t)l * 32768, WSP(const bf16, WS_VT), WSP(bf16, WS_Y) + (size_t)3 * M * 256, bh, qb, qsl, lane); } }
#endif
        GRID_BAR();
#if PH(11)
#ifndef G11_REPS
#define G11_REPS 1
#endif
        for (int rep11_ = 0; rep11_ < G11_REPS; ++rep11_)
        { LAUNDER(); pg8::StaticOrder S0; S0.init(M, NGATE, G, bid);
          pg8::Gemm g{WSP(const pg8::bf16_t, WS_HB), WB(W_GATE), M, NGATE, K1024, 30, 0};
          pg8::EpiGateP E{WSP(const pg8::bf16_t, WS_Y), WB(W_BR), WSP(pg8::bf16_t, WS_BIG + 184 * MiB), WSP(pg8::rowss_t, WS_ROWSS) + (size_t)(4 * l + 1) * M, (size_t)M * 256};
#pragma nounroll
          for (int r = 0; ; ++r) { pg8::OneUnit S1; if (!S0.next(r, S1.u)) break;
              pg8::gemm_phase<pg8::EpiGateP, pg8::OneUnit, false, true>(lds + RING_OFF, g, S1, E);
              __syncthreads(); }
          GROUP_BAR(); }
#endif
#if PH(12)
#ifndef OUT_REPS
#define OUT_REPS 1
#endif
        for (int rep12_ = 0; rep12_ < OUT_REPS; ++rep12_)
        { LAUNDER(); pg8::Gemm g{WSP(const pg8::bf16_t, WS_BIG + 184 * MiB), WB(W_OUT), M, D, K1024, 30, 0}; pg8::StaticOrder S; S.init(M, D, G, bid);
          const bool real_ = (rep12_ + 1 == OUT_REPS);
          pg8::EpiRes E{WSP(const pg8::bf16_t, WS_HB), real_ ? WSP(pg8::bf16_t, WS_HB) : WSP(pg8::bf16_t, WS_BIG + 128 * MiB), real_ ? WSP(pg8::rowss_t, WS_ROWSS) + (size_t)(4 * l + 2) * M : WSP(pg8::rowss_t, WS_BIG + 200 * MiB), 1.0f};
          pg8::gemm_phase<pg8::EpiRes, pg8::StaticOrder, true, true>(lds + RING_OFF, g, S, E);
          GROUP_BAR(); }
#endif
#if PH(13)
#ifndef GU_REPS
#define GU_REPS 1
#endif
        for (int repg_ = 0; repg_ < GU_REPS; ++repg_)
        { LAUNDER(); pg8::Gemm g{WSP(const pg8::bf16_t, WS_HB), WB(W_GU2), M, NGU, K1024, 30, 0}; pg8::StaticOrder S; S.init(M, NGU, G, bid);
          SC_RESET(); pg8::EpiSwiGLU E{WSP(pg8::bf16_t, WS_BIG), WSP(pg8::rowss_t, WS_ROWSS) + (size_t)(4 * l + 2) * M, FF, SC_PTR};
          pg8::gemm_phase<pg8::EpiSwiGLU, pg8::StaticOrder, true, true>(lds + RING_OFF, g, S, E);
          GROUP_BAR(); }
#endif
#if PH(14)
#ifndef DOWN_REPS
#define DOWN_REPS 1
#endif
        for (int rep14_ = 0; rep14_ < DOWN_REPS; ++rep14_)
        { LAUNDER(); pg8::Gemm g{WSP(const pg8::bf16_t, WS_BIG), WB(W_D2), M, D, KFF, 30, 0}; pg8::StaticOrder S; S.init(M, D, G, bid);
          const bool real_ = (rep14_ + 1 == DOWN_REPS);
          pg8::EpiRes E{WSP(const pg8::bf16_t, WS_HB), real_ ? WSP(pg8::bf16_t, WS_HB) : WSP(pg8::bf16_t, WS_BIG + 184 * MiB), real_ ? WSP(pg8::rowss_t, WS_ROWSS) + (size_t)(4 * l + 3) * M : WSP(pg8::rowss_t, WS_BIG + 250 * MiB), 0.5f};
          pg8::gemm_phase<pg8::EpiRes, pg8::StaticOrder, DOWN_ALIGN, DOWN_SP2>(lds + RING_OFF, g, S, E);
          GROUP_BAR(); }
#endif
#if PH(16)
#ifndef PLE_REPS
#define PLE_REPS 1
#endif
        for (int rep16_ = 0; rep16_ < PLE_REPS; ++rep16_)
        { LAUNDER(); pg8::Gemm g{WSP(const pg8::bf16_t, WS_HB), WB(W_PG), M, D, K1024, 30, 0}; pg8::StaticOrder S; S.init(M, D, G, bid);
          const bool real_ = (rep16_ + 1 == PLE_REPS);
          pg8::EpiPle E{WSP(const pg8::bf16_t, WS_HB), (const pg8::bf16_t*)((unsigned char*)ap_->out + OUT_T), !real_ ? WSP(pg8::bf16_t, WS_BIG + 128 * MiB) : l == 0 ? (pg8::bf16_t*)((unsigned char*)ap_->out + OUT_T) : WSP(pg8::bf16_t, WS_BIG + 184 * MiB),
                        WSP(pg8::rowss_t, WS_ROWSS) + (size_t)(4 * l + 3) * M, real_ ? WSP(pg8::rowss_t, WS_ROWSS) + (size_t)(4 * l + 4) * M : WSP(pg8::rowss_t, WS_BIG + 200 * MiB)};
          pg8::gemm_phase<pg8::EpiPle, pg8::StaticOrder, true, true>(lds + RING_OFF, g, S, E);
          if (l + 1 < DEPTH) GROUP_BAR(); else GRID_BAR(); }
#endif
    }
#if PH(17)
#ifdef PROBE_REP0
#pragma nounroll
    for (int rep_ = 0; rep_ < PROBE_REP0; ++rep_)
#endif
    { LAUNDER(); final_norm(WSP(const bf16, WS_BIG + 184 * MiB), ap_->out, WSP(pg8::rowss_t, WS_ROWSS) + (size_t)8 * M, ap_->in[35], GW, NGW, lane); }
#endif
}

extern "C" void kernel_launch(void* const* d_in, const int* in_sizes, int n_in, void* d_out, int out_size, void* d_ws, size_t ws_size, hipStream_t stream) {
    static int grid = 0;
    if (grid == 0) {
        if (n_in != 36 || out_size != M * D || ws_size < WS_END) { fprintf(stderr, "kernel_launch: unexpected shapes (n_in %d, out %d, ws %zu); nothing launched\n", n_in, out_size, ws_size); grid = -1; return; }
        int dev = 0, cus = 0, per_cu = 0;
        if (hipGetDevice(&dev) != hipSuccess || hipDeviceGetAttribute(&cus, hipDeviceAttributeMultiprocessorCount, dev) != hipSuccess) { grid = -1; return; }
        if (hipFuncSetAttribute((const void*)mk_fwd, hipFuncAttributeMaxDynamicSharedMemorySize, LDS_BYTES) != hipSuccess) { fprintf(stderr, "kernel_launch: hipFuncSetAttribute failed\n"); grid = -1; return; }
        if (hipOccupancyMaxActiveBlocksPerMultiprocessor(&per_cu, (const void*)mk_fwd, NWAVES * 64, LDS_BYTES) != hipSuccess || per_cu < 1) { fprintf(stderr, "kernel_launch: occupancy query says %d\n", per_cu); per_cu = 1; }
        (void)hipGetLastError();
        if (cus < 256) { fprintf(stderr, "kernel_launch: %d CUs; the mixer phase's workgroup roles need 256; nothing launched\n", cus); grid = -1; return; }
        grid = 256;
    }
    if (grid < 0) return;
    if (hipMemsetAsync((char*)d_ws + WS_CTL, 0, CTL_ZERO_BYTES, stream) != hipSuccess) return;
    Args a{};
    for (int i = 0; i < 36; ++i) a.in[i] = (const float*)d_in[i];
    a.out = (float*)d_out; a.ws = (unsigned char*)d_ws;
    hipLaunchKernelGGL(mk_fwd, dim3(grid), dim3(NWAVES * 64), LDS_BYTES, stream, a);
}
```

```cpp
#include <hip/hip_runtime.h>
#include <cstdio>
#include <cstdint>
namespace pg8 {
#define PG8_LAS __attribute__((address_space(3)))
typedef unsigned short bf16_t;
typedef short bf16x8 __attribute__((ext_vector_type(8)));
typedef float f32x4 __attribute__((ext_vector_type(4)));
typedef unsigned u32x4 __attribute__((ext_vector_type(4)));
constexpr int BM = 256, BK = 64, HALF = 128, HTB = HALF * BK * 2  , STAGE_BYTES = 8 * HTB, NXCD = 8, WGM = 8;

__host__ __device__ __forceinline__ int lds_byte(int r, int c) { const int st = (r >> 4) * 2 + (c >> 5), rr = r & 15, cc = c & 31, ob = rr * 64 + cc * 2; return st * 1024 + (ob ^ (((ob >> 9) & 1) << 5)); }
__host__ __device__ __forceinline__ void stage_rc(int b, int& R, int& C) { const int st = b / 1024, sb = b % 1024, swz = sb ^ (((sb >> 9) & 1) << 5); R = (st >> 1) * 16 + swz / 64; C = (st & 1) * 32 + (swz % 64) / 2; }
__host__ __device__ __forceinline__ int perm32(int rho) { const int n = rho >> 4, i = rho & 15; return 8 * (i >> 2) + 4 * n + (i & 3); }

struct Unit { int pm, pn; };
struct Gemm { const bf16_t* A; const bf16_t* Bt; int M, N, K; int ashift; size_t astride; };

struct StaticOrder {
    int nM, nN, nwg, G, c;
    __host__ __device__ __forceinline__ void init(int M, int N, int G_, int c_) { nM = M / BM; nN = N / BM; nwg = nM * nN; G = G_; c = c_; }
    __host__ __device__ __forceinline__ bool next(int i, Unit& u) const {
        const long L = (long)i * G + c; if (L >= nwg) return false;
        int wgid = (int)L; { const int q = nwg / NXCD, r = nwg % NXCD, xcd = wgid % NXCD, off = wgid / NXCD; wgid = (xcd < r ? xcd * (q + 1) : r * (q + 1) + (xcd - r) * q) + off; }
        const int nig = WGM * nN, gid = wgid / nig, fm = gid * WGM, gsz = (nM - fm) < WGM ? (nM - fm) : WGM;
        u.pm = fm + ((wgid % nig) % gsz); u.pn = (wgid % nig) / gsz; return true;
    }
    __device__ __forceinline__ void a_ready(const Unit&) const {}
    __device__ __forceinline__ void done(const Unit&) const {}
};
struct PanelOrder {
    int pm0, stride, nM, nN;
    __host__ __device__ __forceinline__ bool next(int i, Unit& u) const { const int p = pm0 + (i / nN) * stride; if (p >= nM) return false; u.pm = p; u.pn = i % nN; return true; }
    __device__ __forceinline__ void a_ready(const Unit&) const {}
    __device__ __forceinline__ void done(const Unit&) const {}
};
struct OneUnit {
    Unit u;
    __host__ __device__ __forceinline__ bool next(int i, Unit& o) const { if (i != 0) return false; o = u; return true; }
    __device__ __forceinline__ void a_ready(const Unit&) const {}
    __device__ __forceinline__ void done(const Unit&) const {}
};
#define PG8_GAS __attribute__((address_space(1)))

typedef unsigned u32x2 __attribute__((ext_vector_type(2)));
__device__ __forceinline__ unsigned cvt_pk_bf16(float lo, float hi) { unsigned r; asm volatile("v_cvt_pk_bf16_f32 %0, %1, %2" : "=v"(r) : "v"(lo), "v"(hi)); return r; }
__device__ __forceinline__ unsigned cvt_pk_bf16_t(float lo, float hi) { unsigned r; asm volatile("s_nop 1\n\tv_cvt_pk_bf16_f32 %0, %1, %2" : "=v"(r) : "v"(lo), "v"(hi)); return r; }
__device__ __forceinline__ float bf_lo(unsigned w) { return __uint_as_float(w << 16); }
__device__ __forceinline__ float bf_hi(unsigned w) { return __uint_as_float(w & 0xffff0000u); }
__device__ __forceinline__ float sigm(float x) { return __builtin_amdgcn_rcpf(1.0f + __expf(-x)); }
__device__ __forceinline__ float silu(float x) { return x * sigm(x); }
constexpr float RMS_EPS = 1e-6f;
typedef unsigned long long rowss_t;
constexpr float RSS_SCALE = 16777216.0f;
__device__ __forceinline__ float rms_scale(const rowss_t* rowss, int row) { return rsqrtf((float)rowss[row] * (1.0f / (1024.0f * RSS_SCALE)) + RMS_EPS); }
__device__ __forceinline__ void rowss_add(rowss_t* p, float ss) { __hip_atomic_fetch_add((PG8_GAS rowss_t*)p, (rowss_t)(ss * RSS_SCALE), __ATOMIC_RELAXED, __HIP_MEMORY_SCOPE_AGENT); }
__device__ __forceinline__ u32x4 pack8(const f32x4 a, const f32x4 b) { u32x4 w; w.x = cvt_pk_bf16(a[0], a[1]); w.y = cvt_pk_bf16(a[2], a[3]); w.z = cvt_pk_bf16(b[0], b[1]); w.w = cvt_pk_bf16(b[2], b[3]); return w; }

#define EPI_ROW(ai, m) (row0 + (ai) * HALF + (m) * 16)
__device__ __forceinline__ void load_scales(const rowss_t* rowss, int row0, float (&r)[8]) {
    rowss_t v[8];
#pragma unroll
    for (int g = 0; g < 8; ++g) v[g] = ((const PG8_GAS rowss_t*)rowss)[EPI_ROW(g >> 2, g & 3)];
#pragma unroll
    for (int g = 0; g < 8; ++g) r[g] = rsqrtf((float)v[g] * (1.0f / (1024.0f * RSS_SCALE)) + RMS_EPS);
}
__device__ __forceinline__ void cached_scales(const rowss_t* rowss, PG8_LAS float* sc, int pm, int wr, int wc, int fr, int fq, float (&r)[8]) {
    const int tag = *(const PG8_LAS int*)(sc + 256);
    if (tag != pm) {
        const int tid = (wr * 4 + wc) * 64 + fq * 16 + fr;
        if (tid < 256) { const rowss_t v = *(const __attribute__((address_space(1))) rowss_t*)(rowss + (size_t)pm * BM + tid); sc[tid] = rsqrtf((float)v * (1.0f / (1024.0f * RSS_SCALE)) + RMS_EPS); }
        asm volatile("s_waitcnt lgkmcnt(0)" ::: "memory");
        __builtin_amdgcn_s_barrier();
        if (tid == 0) *(PG8_LAS int*)(sc + 256) = pm;
    }
    asm volatile("" ::: "memory");
#pragma unroll
    for (int g = 0; g < 8; ++g) r[g] = sc[wr * 64 + fr + (g >> 2) * HALF + (g & 3) * 16];
}
struct EpiSwiGLU {
    static constexpr bool PERM = true, AFTER_DRAIN = false; static constexpr int TAIL_OPS = 8;
    bf16_t* act; const rowss_t* rowss; int ldc; PG8_LAS float* sc;
    __device__ __forceinline__ void operator()(const f32x4 (&acc)[2][2][4][2], const Unit& u, int wr, int wc, int fr, int fq) const {
        const int row0 = u.pm * BM + wr * 64 + fr, col0 = u.pn * 128 + wc * 32 + 8 * fq;
        float rs[8]; cached_scales(rowss, sc, u.pm, wr, wc, fr, fq, rs);
#pragma unroll
        for (int ai = 0; ai < 2; ++ai)
#pragma unroll
            for (int m = 0; m < 4; ++m) { const int row = EPI_ROW(ai, m); const float r = rs[ai * 4 + m];
                f32x4 o0, o1;
#pragma unroll
                for (int e = 0; e < 4; ++e) { o0[e] = silu(acc[ai][0][m][0][e] * r) * (acc[ai][1][m][0][e] * r); o1[e] = silu(acc[ai][0][m][1][e] * r) * (acc[ai][1][m][1][e] * r); }
                *(PG8_GAS u32x4*)(act + (size_t)row * ldc + col0) = pack8(o0, o1); }
    }
};
struct EpiBf16P {
    static constexpr bool PERM = true, AFTER_DRAIN = false; static constexpr int TAIL_OPS = 0;
    bf16_t* O; int ldc;
    __device__ __forceinline__ void operator()(const f32x4 (&acc)[2][2][4][2], const Unit& u, int wr, int wc, int fr, int fq) const {
        const int row0 = u.pm * BM + wr * 64 + fr, col0 = u.pn * BM + wc * 32 + 8 * fq;
#pragma unroll
        for (int ai = 0; ai < 2; ++ai)
#pragma unroll
            for (int m = 0; m < 4; ++m) { bf16_t* rowp = O + (size_t)EPI_ROW(ai, m) * ldc + col0;
#pragma unroll
                for (int bj = 0; bj < 2; ++bj) *(PG8_GAS u32x4*)(rowp + bj * HALF) = pack8(acc[ai][bj][m][0], acc[ai][bj][m][1]); }
    }
};
__device__ __forceinline__ void unpack8(const u32x4 w, f32x4& a, f32x4& b) { a[0] = bf_lo(w.x); a[1] = bf_hi(w.x); a[2] = bf_lo(w.y); a[3] = bf_hi(w.y); b[0] = bf_lo(w.z); b[1] = bf_hi(w.z); b[2] = bf_lo(w.w); b[3] = bf_hi(w.w); }
__device__ __forceinline__ float sumsq8(const f32x4 v0, const f32x4 v1) { return (v0[0] * v0[0] + v0[1] * v0[1]) + (v0[2] * v0[2] + v0[3] * v0[3]) + (v1[0] * v1[0] + v1[1] * v1[1]) + (v1[2] * v1[2] + v1[3] * v1[3]); }
struct EpiRes {
    static constexpr bool PERM = true, AFTER_DRAIN = false; static constexpr int TAIL_OPS = 0;
    const bf16_t* base; bf16_t* hb; rowss_t* rowss_next; float scale;
    __device__ __forceinline__ void operator()(const f32x4 (&acc)[2][2][4][2], const Unit& u, int wr, int wc, int fr, int fq) const {
        const int row0 = u.pm * BM + wr * 64 + fr, col0 = u.pn * BM + wc * 32 + 8 * fq;
#pragma unroll
        for (int ai = 0; ai < 2; ++ai) {
            u32x4 bw[4][2];
#pragma unroll
            for (int m = 0; m < 4; ++m)
#pragma unroll
                for (int bj = 0; bj < 2; ++bj) bw[m][bj] = *(const PG8_GAS u32x4*)(base + (size_t)EPI_ROW(ai, m) * 1024 + col0 + bj * HALF);
#pragma unroll
            for (int m = 0; m < 4; ++m) { const int row = EPI_ROW(ai, m); const size_t off = (size_t)row * 1024 + col0; float ss = 0.f;
#pragma unroll
                for (int bj = 0; bj < 2; ++bj) { f32x4 b0, b1; unpack8(bw[m][bj], b0, b1);
                    const f32x4 v0 = b0 + acc[ai][bj][m][0] * scale, v1 = b1 + acc[ai][bj][m][1] * scale;
                    *(PG8_GAS u32x4*)(hb + off + bj * HALF) = pack8(v0, v1); ss += sumsq8(v0, v1); }
                ss += __shfl_xor(ss, 16); ss += __shfl_xor(ss, 32);
                if (fq == 0) rowss_add(rowss_next + row, ss); }
            asm volatile("" ::: "memory"); }
    }
};
struct EpiMixIn {
    static constexpr bool PERM = true, AFTER_DRAIN = false; static constexpr int TAIL_OPS = 0;
    bf16_t* proj; float* scal; const rowss_t* rowss; PG8_LAS float* sc;
    __device__ __forceinline__ void operator()(const f32x4 (&acc)[2][2][4][2], const Unit& u, int wr, int wc, int fr, int fq) const {
        const int row0 = u.pm * BM + wr * 64 + fr;
        float rs[8]; cached_scales(rowss, sc, u.pm, wr, wc, fr, fq, rs);
        if (u.pn < 9) { const int col0 = u.pn * BM + wc * 32 + 8 * fq;
#pragma unroll
            for (int ai = 0; ai < 2; ++ai)
#pragma unroll
                for (int m = 0; m < 4; ++m) { const float r = rs[ai * 4 + m]; bf16_t* rowp = proj + (size_t)EPI_ROW(ai, m) * 3072 + col0;
#pragma unroll
                    for (int bj = 0; bj < 2; ++bj) *(PG8_GAS u32x4*)(rowp + bj * HALF) = pack8(acc[ai][bj][m][0] * r, acc[ai][bj][m][1] * r); }
        } else if (wc == 0 && fq < 2) {
#pragma unroll
            for (int ai = 0; ai < 2; ++ai)
#pragma unroll
                for (int m = 0; m < 4; ++m) { const float r = rs[ai * 4 + m]; float* rowp = scal + (size_t)EPI_ROW(ai, m) * 16 + 8 * fq;
                    *(PG8_GAS f32x4*)(rowp) = acc[ai][0][m][0] * r; *(PG8_GAS f32x4*)(rowp + 4) = acc[ai][0][m][1] * r; }
        }
    }
};
struct EpiGateMerge {
    static constexpr bool PERM = false, AFTER_DRAIN = false; static constexpr int TAIL_OPS = 0;
    const bf16_t* P; bf16_t* merged; const rowss_t* rowss;
    __device__ __forceinline__ void operator()(const f32x4 (&acc)[2][2][4][2], const Unit& u, int wr, int wc, int fr, int fq) const {
        const int row0 = u.pm * BM + wr * 64 + fr, j0 = u.pn * 64 + wc * 16 + 4 * fq;
        float rs[8]; load_scales(rowss, row0, rs);
#pragma unroll
        for (int ai = 0; ai < 2; ++ai) {
            u32x2 pw[4][4];
#pragma unroll
            for (int m = 0; m < 4; ++m)
#pragma unroll
                for (int b = 0; b < 4; ++b) pw[m][b] = *(const PG8_GAS u32x2*)(P + (size_t)EPI_ROW(ai, m) * 4096 + j0 + b * 1024);
#pragma unroll
            for (int m = 0; m < 4; ++m) { const float r = rs[ai * 4 + m];
                f32x4 s = (f32x4){0.f, 0.f, 0.f, 0.f};
#pragma unroll
                for (int bj = 0; bj < 2; ++bj)
#pragma unroll
                    for (int n = 0; n < 2; ++n) { const u32x2 pv = pw[m][2 * bj + n]; const f32x4 a = acc[ai][bj][m][n];
                        s[0] += sigm(a[0] * r) * bf_lo(pv.x); s[1] += sigm(a[1] * r) * bf_hi(pv.x); s[2] += sigm(a[2] * r) * bf_lo(pv.y); s[3] += sigm(a[3] * r) * bf_hi(pv.y); }
                u32x2 w; w.x = cvt_pk_bf16(s[0], s[1]); w.y = cvt_pk_bf16(s[2], s[3]); *(PG8_GAS u32x2*)(merged + (size_t)EPI_ROW(ai, m) * 1024 + j0) = w; }
            asm volatile("" ::: "memory"); }
    }
};
struct EpiGateMergeAD {
    static constexpr bool PERM = false, AFTER_DRAIN = true; static constexpr int TAIL_OPS = 0;
    const bf16_t* P; bf16_t* merged; const rowss_t* rowss;
    __device__ __forceinline__ void fused(f32x4 (&acc)[2][2][4][2], const Unit& u, int wr, int wc, int fr, int fq, PG8_LAS unsigned char* lds, int wid, int lane) const {
        const int row0 = u.pm * BM + wr * 64 + fr, j0 = u.pn * 64 + wc * 16 + 4 * fq;
        float rs[8]; load_scales(rowss, row0, rs);
#ifdef AD_BARS
#pragma unroll
        for (int s = 0; s < 16; ++s) { asm volatile("s_waitcnt vmcnt(0) lgkmcnt(0)" ::: "memory"); __builtin_amdgcn_s_barrier(); asm volatile("" ::: "memory"); }
#endif

        u32x2 gp[2][2][4][2];
#pragma unroll
        for (int ai = 0; ai < 2; ++ai)
#pragma unroll
            for (int bj = 0; bj < 2; ++bj)
#pragma unroll
                for (int m = 0; m < 4; ++m)
#pragma unroll
                    for (int n = 0; n < 2; ++n) { const float r = rs[ai * 4 + m]; const f32x4 a = acc[ai][bj][m][n];
                        gp[ai][bj][m][n].x = cvt_pk_bf16_t(sigm(a[0] * r), sigm(a[1] * r)); gp[ai][bj][m][n].y = cvt_pk_bf16_t(sigm(a[2] * r), sigm(a[3] * r));
                        acc[ai][bj][m][n] = (f32x4){0.f, 0.f, 0.f, 0.f}; }
#pragma unroll
        for (int ai = 0; ai < 2; ++ai) {
            u32x2 pw[4][4];
#pragma unroll
            for (int m = 0; m < 4; ++m)
#pragma unroll
                for (int b = 0; b < 4; ++b) pw[m][b] = *(const PG8_GAS u32x2*)(P + (size_t)EPI_ROW(ai, m) * 4096 + j0 + b * 1024);
#pragma unroll
            for (int m = 0; m < 4; ++m) {
                f32x4 s = (f32x4){0.f, 0.f, 0.f, 0.f};
#pragma unroll
                for (int bj = 0; bj < 2; ++bj)
#pragma unroll
                    for (int n = 0; n < 2; ++n) { const u32x2 pv = pw[m][2 * bj + n]; const u32x2 g = gp[ai][bj][m][n];
                        s[0] += bf_lo(g.x) * bf_lo(pv.x); s[1] += bf_hi(g.x) * bf_hi(pv.x); s[2] += bf_lo(g.y) * bf_lo(pv.y); s[3] += bf_hi(g.y) * bf_hi(pv.y); }
                u32x2 w; w.x = cvt_pk_bf16(s[0], s[1]); w.y = cvt_pk_bf16(s[2], s[3]); *(PG8_GAS u32x2*)(merged + (size_t)EPI_ROW(ai, m) * 1024 + j0) = w; }
            asm volatile("" ::: "memory"); }
    }
};
struct EpiGLU {
    static constexpr bool PERM = true, AFTER_DRAIN = false; static constexpr int TAIL_OPS = 0;
    const bf16_t* yg; bf16_t* out; const float* bias;
    __device__ __forceinline__ void operator()(const f32x4 (&acc)[2][2][4][2], const Unit& u, int wr, int wc, int fr, int fq) const {
        const int row0 = u.pm * BM + wr * 64 + fr, col0 = u.pn * BM + wc * 32 + 8 * fq;
        f32x4 bb[2][2];
#pragma unroll
        for (int bj = 0; bj < 2; ++bj) { bb[bj][0] = *(const PG8_GAS f32x4*)(bias + col0 + bj * HALF); bb[bj][1] = *(const PG8_GAS f32x4*)(bias + col0 + bj * HALF + 4); }
#pragma unroll
        for (int ai = 0; ai < 2; ++ai) {
            u32x4 yw[4][2];
#pragma unroll
            for (int m = 0; m < 4; ++m)
#pragma unroll
                for (int bj = 0; bj < 2; ++bj) yw[m][bj] = *(const PG8_GAS u32x4*)(yg + (size_t)EPI_ROW(ai, m) * 256 + col0 + bj * HALF);
#pragma unroll
            for (int m = 0; m < 4; ++m) { const size_t off = (size_t)EPI_ROW(ai, m) * 256 + col0;
#pragma unroll
                for (int bj = 0; bj < 2; ++bj) { f32x4 y0, y1; unpack8(yw[m][bj], y0, y1); const f32x4 a0 = acc[ai][bj][m][0] + bb[bj][0], a1 = acc[ai][bj][m][1] + bb[bj][1]; f32x4 o0, o1;
#pragma unroll
                    for (int e = 0; e < 4; ++e) { o0[e] = y0[e] * sigm(a0[e]); o1[e] = y1[e] * sigm(a1[e]); }
                    *(PG8_GAS u32x4*)(out + off + bj * HALF) = pack8(o0, o1); } }
            asm volatile("" ::: "memory"); }
    }
};
struct EpiPle {
    static constexpr bool PERM = true, AFTER_DRAIN = false; static constexpr int TAIL_OPS = 0;
    const bf16_t* h; const bf16_t* T; bf16_t* hout; const rowss_t* rowss; rowss_t* rowss_next;
    __device__ __forceinline__ void operator()(const f32x4 (&acc)[2][2][4][2], const Unit& u, int wr, int wc, int fr, int fq) const {
        const int row0 = u.pm * BM + wr * 64 + fr, col0 = u.pn * BM + wc * 32 + 8 * fq;
        float rs[8]; load_scales(rowss, row0, rs);
#pragma unroll
        for (int ai = 0; ai < 2; ++ai)
#pragma unroll
          for (int mh = 0; mh < 2; ++mh) {
            u32x4 bw[2][2], tw[2][2];
#pragma unroll
            for (int mm = 0; mm < 2; ++mm)
#pragma unroll
                for (int bj = 0; bj < 2; ++bj) { const size_t off = (size_t)EPI_ROW(ai, 2 * mh + mm) * 1024 + col0 + bj * HALF; bw[mm][bj] = *(const PG8_GAS u32x4*)(h + off); tw[mm][bj] = *(const PG8_GAS u32x4*)(T + off); }
#pragma unroll
            for (int mm = 0; mm < 2; ++mm) { const int m = 2 * mh + mm; const int row = EPI_ROW(ai, m); const float r = rs[ai * 4 + m]; const size_t off = (size_t)row * 1024 + col0; float ss = 0.f;
#pragma unroll
                for (int bj = 0; bj < 2; ++bj) { f32x4 b0, b1, t0, t1; unpack8(bw[mm][bj], b0, b1); unpack8(tw[mm][bj], t0, t1);
                    const f32x4 a0 = acc[ai][bj][m][0] * r, a1 = acc[ai][bj][m][1] * r; f32x4 v0, v1;
#pragma unroll
                    for (int e = 0; e < 4; ++e) { v0[e] = b0[e] + t0[e] * sigm(a0[e]); v1[e] = b1[e] + t1[e] * sigm(a1[e]); }
                    *(PG8_GAS u32x4*)(hout + off + bj * HALF) = pack8(v0, v1); ss += sumsq8(v0, v1); }
                ss += __shfl_xor(ss, 16); ss += __shfl_xor(ss, 32);
                if (fq == 0) rowss_add(rowss_next + row, ss); }
            asm volatile("" ::: "memory"); }
    }
};

__device__ __forceinline__ float dpp_row_xor(float v, int step) {
    const int x = __float_as_int(v); int r;
    switch (step) { case 0: r = __builtin_amdgcn_update_dpp(0, x, 0xB1, 0xF, 0xF, true); break; case 1: r = __builtin_amdgcn_update_dpp(0, x, 0x4E, 0xF, 0xF, true); break;
                    case 2: r = __builtin_amdgcn_update_dpp(0, x, 0x141, 0xF, 0xF, true); break; default: r = __builtin_amdgcn_update_dpp(0, x, 0x140, 0xF, 0xF, true); break; }
    return __int_as_float(r);
}
struct EpiMoba {
    static constexpr bool PERM = true, AFTER_DRAIN = false; static constexpr int TAIL_OPS = 0;
    bf16_t* proj; bf16_t* vt; float* kmean; const float* rope; const rowss_t* rowss;
    __device__ __forceinline__ void operator()(const f32x4 (&acc)[2][2][4][2], const Unit& u, int wr, int wc, int fr_in, int fq_in) const {
        int fr = fr_in, fq = fq_in; asm volatile("" : "+v"(fr), "+v"(fq));
        const int row0 = u.pm * BM + wr * 64 + fr;
        float rs[8]; load_scales(rowss, row0, rs);
        if (u.pn < 2) {
            const int pc = (u.pn == 0 ? 2304 : 2560) + wc * 64 + 8 * fq;
            f32x4 ks[4];
#pragma unroll
            for (int j = 0; j < 4; ++j) ks[j] = (f32x4){0.f, 0.f, 0.f, 0.f};
#pragma unroll
            for (int ai = 0; ai < 2; ++ai)
#pragma unroll
              for (int mh = 0; mh < 2; ++mh) {
                f32x4 cs[2][4];
#pragma unroll
                for (int mm = 0; mm < 2; ++mm) { const float* tp = rope + (size_t)EPI_ROW(ai, 2 * mh + mm) * 64 + 8 * fq; cs[mm][0] = *(const PG8_GAS f32x4*)(tp); cs[mm][1] = *(const PG8_GAS f32x4*)(tp + 4); cs[mm][2] = *(const PG8_GAS f32x4*)(tp + 32); cs[mm][3] = *(const PG8_GAS f32x4*)(tp + 36); }
#pragma unroll
                for (int mm = 0; mm < 2; ++mm) { const int m = 2 * mh + mm; const float r = rs[ai * 4 + m]; bf16_t* rowp = proj + (size_t)EPI_ROW(ai, m) * 3072 + pc;
                    const f32x4 a0 = acc[ai][0][m][0] * r, a1 = acc[ai][0][m][1] * r, b0 = acc[ai][1][m][0] * r, b1 = acc[ai][1][m][1] * r;
                    const f32x4 o10 = a0 * cs[mm][0] - b0 * cs[mm][2], o11 = a1 * cs[mm][1] - b1 * cs[mm][3], o20 = b0 * cs[mm][0] + a0 * cs[mm][2], o21 = b1 * cs[mm][1] + a1 * cs[mm][3];
                    *(PG8_GAS u32x4*)(rowp) = pack8(o10, o11); *(PG8_GAS u32x4*)(rowp + 32) = pack8(o20, o21);
                    ks[0] += o10; ks[1] += o11; ks[2] += o20; ks[3] += o21; }
                asm volatile("" ::: "memory"); }
            if (u.pn == 1) {
#pragma unroll
                for (int j = 0; j < 4; ++j)
#pragma unroll
                    for (int e = 0; e < 4; ++e) { float v = ks[j][e];
#pragma unroll
                        for (int st = 0; st < 4; ++st) v += dpp_row_xor(v, st);
                        ks[j][e] = v; }
                if (fr == 0) { const int b = u.pm >> 3, blk = u.pm & 7; float* kp = kmean + (size_t)((b * 4 + wc) * 8 + blk) * 64 + 8 * fq;
#pragma unroll
                    for (int e = 0; e < 4; ++e) { __hip_atomic_fetch_add((PG8_GAS float*)kp + e, ks[0][e] * (1.0f / 256.0f), __ATOMIC_RELAXED, __HIP_MEMORY_SCOPE_AGENT); __hip_atomic_fetch_add((PG8_GAS float*)kp + 4 + e, ks[1][e] * (1.0f / 256.0f), __ATOMIC_RELAXED, __HIP_MEMORY_SCOPE_AGENT);
                        __hip_atomic_fetch_add((PG8_GAS float*)kp + 32 + e, ks[2][e] * (1.0f / 256.0f), __ATOMIC_RELAXED, __HIP_MEMORY_SCOPE_AGENT); __hip_atomic_fetch_add((PG8_GAS float*)kp + 36 + e, ks[3][e] * (1.0f / 256.0f), __ATOMIC_RELAXED, __HIP_MEMORY_SCOPE_AGENT); } }
            }
        } else {
            const int b = u.pm >> 3, s0 = (u.pm & 7) * 256 + wr * 64 + fr;
#pragma unroll
            for (int ai = 0; ai < 2; ++ai)
#pragma unroll
                for (int m = 0; m < 4; ++m) { const float r = rs[ai * 4 + m]; const int s = s0 + ai * HALF + m * 16;
#pragma unroll
                    for (int bj = 0; bj < 2; ++bj) { const int hh = 2 * bj + (wc >> 1), d0 = 32 * (wc & 1) + 8 * fq; PG8_GAS bf16_t* vp = (PG8_GAS bf16_t*)vt + ((size_t)(b * 4 + hh) * 64 + d0) * 2048 + s;
                        const u32x4 w = pack8(acc[ai][bj][m][0] * r, acc[ai][bj][m][1] * r);
                        vp[0 * 2048] = (bf16_t)(w.x & 0xffffu); vp[1 * 2048] = (bf16_t)(w.x >> 16); vp[2 * 2048] = (bf16_t)(w.y & 0xffffu); vp[3 * 2048] = (bf16_t)(w.y >> 16);
                        vp[4 * 2048] = (bf16_t)(w.z & 0xffffu); vp[5 * 2048] = (bf16_t)(w.z >> 16); vp[6 * 2048] = (bf16_t)(w.w & 0xffffu); vp[7 * 2048] = (bf16_t)(w.w >> 16); } }
        }
    }
};


struct EpiGateP {
    static constexpr bool PERM = false, AFTER_DRAIN = true; static constexpr int TAIL_OPS = 0;
    const bf16_t* Y; const bf16_t* Wbr; bf16_t* merged; const rowss_t* rowss;
    size_t ybstride;
    __device__ __forceinline__ void fused(f32x4 (&acc)[2][2][4][2], const Unit& u, int wr, int wc, int fr, int fq, PG8_LAS unsigned char* lds, int wid, int lane) const {
        const int row0 = u.pm * BM + wr * 64 + fr;
        float rs[8]; load_scales(rowss, row0, rs);
        const int tid = wid * 64 + lane;
        unsigned voffA[2]; unsigned voffB;
#pragma unroll
        for (int i = 0; i < 2; ++i) { int R, C; stage_rc(tid * 16 + i * 8192, R, C); voffA[i] = (unsigned)(R * 256 + C) * 2u; }
        { int R, C; stage_rc(tid * 16, R, C); voffB = (unsigned)(R * 256 + C) * 2u; }
        const unsigned ldsw = (unsigned)wid * 1024u;
        const int aoff = lds_byte(wr * 64 + fr, fq * 8), boff = lds_byte(wc * 16 + fr, fq * 8);
        const char* ya = (const char*)Y + (size_t)u.pm * BM * 256 * 2;
        const char* wb = (const char*)Wbr + (size_t)u.pn * 64 * 256 * 2;
#define GP_STAGE(s_) do { const int b_ = (s_) >> 2, kt_ = (s_) & 3; const char* ga_ = ya + (size_t)b_ * ybstride * 2 + kt_ * 128; const char* gb_ = wb + (size_t)b_ * 1024 * 256 * 2 + kt_ * 128; PG8_LAS unsigned char* d_ = lds + ((s_) % 3) * 40960; \
            _Pragma("unroll") for (int h_ = 0; h_ < 2; ++h_) _Pragma("unroll") for (int i_ = 0; i_ < 2; ++i_) \
                __builtin_amdgcn_global_load_lds((const unsigned*)(ga_ + (size_t)h_ * HALF * 256 * 2 + voffA[i_]), (PG8_LAS unsigned*)(d_ + h_ * 16384 + ldsw + i_ * 8192), 16, 0, 0); \
            __builtin_amdgcn_global_load_lds((const unsigned*)(gb_ + voffB), (PG8_LAS unsigned*)(d_ + 32768 + ldsw), 16, 0, 0); } while (0)
        GP_STAGE(0); GP_STAGE(1);
        u32x2 gp[2][2][4][2];
#pragma unroll
        for (int ai = 0; ai < 2; ++ai)
#pragma unroll
            for (int bj = 0; bj < 2; ++bj)
#pragma unroll
                for (int m = 0; m < 4; ++m)
#pragma unroll
                    for (int n = 0; n < 2; ++n) { const float r = rs[ai * 4 + m]; const f32x4 a = acc[ai][bj][m][n];
                        gp[ai][bj][m][n].x = cvt_pk_bf16_t(sigm(a[0] * r), sigm(a[1] * r)); gp[ai][bj][m][n].y = cvt_pk_bf16_t(sigm(a[2] * r), sigm(a[3] * r));
                        acc[ai][bj][m][n] = (f32x4){0.f, 0.f, 0.f, 0.f}; }
#pragma unroll
        for (int s = 0; s < 16; ++s) {
            if (s < 15) asm volatile("s_waitcnt vmcnt(5)" ::: "memory"); else asm volatile("s_waitcnt vmcnt(0)" ::: "memory");
            __builtin_amdgcn_s_barrier(); asm volatile("" ::: "memory");
            if (s + 2 < 16) GP_STAGE(s + 2);
            const PG8_LAS unsigned char* bo = lds + (s % 3) * 40960; const int bj = (s >> 2) >> 1, n = (s >> 2) & 1;
            bf16x8 Bf[2];
#pragma unroll
            for (int k = 0; k < 2; ++k) Bf[k] = *(const PG8_LAS bf16x8*)(bo + 32768 + boff + k * 1024);
#pragma unroll
            for (int ai = 0; ai < 2; ++ai) { bf16x8 At[4][2];
#pragma unroll
                for (int m = 0; m < 4; ++m)
#pragma unroll
                    for (int k = 0; k < 2; ++k) At[m][k] = *(const PG8_LAS bf16x8*)(bo + ai * 16384 + aoff + m * 2048 + k * 1024);
#pragma unroll
                for (int m = 0; m < 4; ++m)
#pragma unroll
                    for (int k = 0; k < 2; ++k) acc[ai][bj][m][n] = __builtin_amdgcn_mfma_f32_16x16x32_bf16(Bf[k], At[m][k], acc[ai][bj][m][n], 0, 0, 0); }
            asm volatile("s_waitcnt lgkmcnt(0)" ::: "memory");
        }
#undef GP_STAGE
        const int j0 = u.pn * 64 + wc * 16 + 4 * fq;
#pragma unroll
        for (int ai = 0; ai < 2; ++ai)
#pragma unroll
            for (int m = 0; m < 4; ++m) { f32x4 s4 = (f32x4){0.f, 0.f, 0.f, 0.f};
#pragma unroll
                for (int bj = 0; bj < 2; ++bj)
#pragma unroll
                    for (int n = 0; n < 2; ++n) { const u32x2 g = gp[ai][bj][m][n]; const f32x4 p = acc[ai][bj][m][n];
                        s4[0] += bf_lo(g.x) * p[0]; s4[1] += bf_hi(g.x) * p[1]; s4[2] += bf_lo(g.y) * p[2]; s4[3] += bf_hi(g.y) * p[3]; }
                u32x2 w; w.x = cvt_pk_bf16(s4[0], s4[1]); w.y = cvt_pk_bf16(s4[2], s4[3]); *(PG8_GAS u32x2*)(merged + (size_t)EPI_ROW(ai, m) * 1024 + j0) = w; }
    }
};
template <class Epi, class Sched, bool ALIGN_EPI = false, bool SP2 = false>
__device__ __forceinline__ void gemm_phase(PG8_LAS unsigned char* lds, const Gemm g, const Sched& S, const Epi& E) {
    int tid_ = threadIdx.x; asm volatile("" : "+v"(tid_));
    const int tid = tid_, wid = __builtin_amdgcn_readfirstlane(tid >> 6), lane = tid & 63, wr = wid >> 2, wc = wid & 3, fr = lane & 15, fq = lane >> 4;
    const int K = g.K, nt = K / BK;
    unsigned voffA[2], voffB[2];
#pragma unroll
    for (int i = 0; i < 2; ++i) { int R, C; stage_rc(tid * 16 + i * 8192, R, C); const int Rb = Epi::PERM ? ((R & ~31) + perm32(R & 31)) : R;
        voffA[i] = (unsigned)(R * K + C) * 2u; voffB[i] = (unsigned)(Rb * K + C) * 2u; }
    const size_t kstep = (size_t)(BK * 2);
    const size_t hstep = (size_t)HALF * K * 2;
    const size_t tstep = 2 * hstep;
    const unsigned ldsw = (unsigned)wid * 1024u;
    const int aoff = lds_byte(wr * 64 + fr, fq * 8), boff = lds_byte(wc * 32 + fr, fq * 8);
#define PG8_SA(b, h) (((b) * 2 + (h)) * HTB)
#define PG8_SB(b, h) ((4 + (b) * 2 + (h)) * HTB)
#define PG8_STAGE(bufoff, gbase, voff) do { _Pragma("unroll") for (int _i = 0; _i < 2; ++_i) \
        __builtin_amdgcn_global_load_lds((const unsigned*)((const char*)(gbase) + (voff)[_i]), (PG8_LAS unsigned*)(lds + (bufoff) + ldsw + _i * 8192), 16, 0, 0); } while (0)
#define PG8_LDA(dst, b, h) do { _Pragma("unroll") for (int m = 0; m < 4; ++m) _Pragma("unroll") for (int k = 0; k < 2; ++k) dst[m][k] = *(const PG8_LAS bf16x8*)(lds + PG8_SA(b, h) + aoff + m * 2048 + k * 1024); } while (0)
#define PG8_LDB(dst, b, h) do { _Pragma("unroll") for (int n = 0; n < 2; ++n) _Pragma("unroll") for (int k = 0; k < 2; ++k) dst[n][k] = *(const PG8_LAS bf16x8*)(lds + PG8_SB(b, h) + boff + n * 2048 + k * 1024); } while (0)
#define PG8_MMA(ai, bj, At, Bt) do { __builtin_amdgcn_s_setprio(1); _Pragma("unroll") for (int m = 0; m < 4; ++m) _Pragma("unroll") for (int n = 0; n < 2; ++n) _Pragma("unroll") for (int k = 0; k < 2; ++k) \
        acc[ai][bj][m][n] = __builtin_amdgcn_mfma_f32_16x16x32_bf16(Bt[n][k], At[m][k], acc[ai][bj][m][n], 0, 0, 0); __builtin_amdgcn_s_setprio(0); } while (0)
#define PG8_WAIT_V(n) asm volatile("s_waitcnt vmcnt(" #n ")" ::: "memory")
#define PG8_WAIT_L(n) asm volatile("s_waitcnt lgkmcnt(" #n ")" ::: "memory")
#define PG8_BAR __builtin_amdgcn_s_barrier()
#define PG8_SCHED __builtin_amdgcn_sched_barrier(0)
    Unit cur, nxt; int ui = 0;
    if (!S.next(0, cur)) return;
    f32x4 acc[2][2][4][2];
#pragma unroll
    for (int a = 0; a < 2; ++a)
#pragma unroll
        for (int b = 0; b < 2; ++b)
#pragma unroll
            for (int m = 0; m < 4; ++m)
#pragma unroll
                for (int n = 0; n < 2; ++n) acc[a][b][m][n] = (f32x4){0.f, 0.f, 0.f, 0.f};
    bf16x8 At[4][2], B0[2][2], B1[2][2];
    const char* cA = (const char*)g.A + (size_t)(cur.pn >> g.ashift) * g.astride + (size_t)cur.pm * tstep; const char* cB = (const char*)g.Bt + (size_t)cur.pn * tstep;
    S.a_ready(cur);
    if constexpr (SP2) {
        PG8_STAGE(PG8_SB(0, 0), cB, voffB); PG8_STAGE(PG8_SB(0, 1), cB + hstep, voffB); PG8_STAGE(PG8_SA(0, 0), cA, voffA); PG8_STAGE(PG8_SA(0, 1), cA + hstep, voffA);
        if (wr == 1) PG8_BAR;
        PG8_WAIT_V(2); PG8_BAR;
        PG8_STAGE(PG8_SB(1, 0), cB + kstep, voffB); PG8_STAGE(PG8_SA(1, 0), cA + kstep, voffA); PG8_STAGE(PG8_SB(1, 1), cB + hstep + kstep, voffB);
        PG8_WAIT_V(6); PG8_BAR;
    } else {
        PG8_STAGE(PG8_SB(0, 0), cB, voffB); PG8_STAGE(PG8_SA(0, 0), cA, voffA); PG8_STAGE(PG8_SB(0, 1), cB + hstep, voffB); PG8_STAGE(PG8_SA(0, 1), cA + hstep, voffA);
        if (wr == 1) PG8_BAR;
        PG8_WAIT_V(4); PG8_BAR;
        PG8_STAGE(PG8_SB(1, 0), cB + kstep, voffB); PG8_STAGE(PG8_SA(1, 0), cA + kstep, voffA); PG8_STAGE(PG8_SB(1, 1), cB + hstep + kstep, voffB);
        PG8_WAIT_V(6); PG8_BAR;
    }
    for (;;) {
        const bool has_next = S.next(ui + 1, nxt);
        const char* nA = has_next ? (const char*)g.A + (size_t)(nxt.pn >> g.ashift) * g.astride + (size_t)nxt.pm * tstep : cA; const char* nB = has_next ? (const char*)g.Bt + (size_t)nxt.pn * tstep : cB;
        for (int t = 0; t < nt; t += 2) {
            const bool last = (t == nt - 2);
            const char* a1 = cA + (size_t)(t + 1) * kstep;
            const char* a2 = last ? nA : cA + (size_t)(t + 2) * kstep; const char* b2 = last ? nB : cB + (size_t)(t + 2) * kstep;
            const char* a3 = a2 + kstep; const char* b3 = b2 + kstep;
            if (last && has_next) S.a_ready(nxt);
            if constexpr (SP2) {
            PG8_LDB(B0, 0, 0); PG8_LDB(B1, 0, 1); PG8_SCHED; PG8_LDA(At, 0, 0); PG8_STAGE(PG8_SA(1, 1), a1 + hstep, voffA);
            PG8_WAIT_V(8); PG8_WAIT_L(0); PG8_BAR; PG8_MMA(0, 0, At, B0); PG8_MMA(0, 1, At, B1); PG8_BAR; PG8_SCHED;
            PG8_LDA(At, 0, 1); PG8_STAGE(PG8_SB(0, 0), b2, voffB); PG8_STAGE(PG8_SB(0, 1), b2 + hstep, voffB); PG8_STAGE(PG8_SA(0, 0), a2, voffA);
            PG8_WAIT_V(8); PG8_WAIT_L(0); PG8_BAR; PG8_MMA(1, 0, At, B0); PG8_MMA(1, 1, At, B1); PG8_BAR; PG8_SCHED;
            PG8_LDB(B0, 1, 0); PG8_LDB(B1, 1, 1); PG8_SCHED; PG8_LDA(At, 1, 0); PG8_STAGE(PG8_SA(0, 1), a2 + hstep, voffA);
            PG8_WAIT_V(8); PG8_WAIT_L(0); PG8_BAR; PG8_MMA(0, 0, At, B0); PG8_MMA(0, 1, At, B1); PG8_BAR; PG8_SCHED;
            PG8_LDA(At, 1, 1); PG8_STAGE(PG8_SB(1, 0), b3, voffB); PG8_STAGE(PG8_SB(1, 1), b3 + hstep, voffB); PG8_STAGE(PG8_SA(1, 0), a3, voffA);
            PG8_WAIT_V(8); PG8_WAIT_L(0); PG8_BAR; PG8_MMA(1, 0, At, B0); PG8_MMA(1, 1, At, B1); PG8_BAR; PG8_SCHED;
            } else {
            PG8_LDB(B0, 0, 0); PG8_SCHED; PG8_LDA(At, 0, 0); PG8_STAGE(PG8_SA(1, 1), a1 + hstep, voffA);
            PG8_WAIT_L(8); PG8_BAR; PG8_WAIT_L(0); PG8_MMA(0, 0, At, B0); PG8_BAR; PG8_SCHED;
            PG8_LDB(B1, 0, 1); PG8_STAGE(PG8_SB(0, 0), b2, voffB);
            PG8_BAR; PG8_WAIT_L(0); PG8_MMA(0, 1, At, B1); PG8_BAR;
            PG8_LDA(At, 0, 1); PG8_STAGE(PG8_SA(0, 0), a2, voffA);
            PG8_BAR; PG8_WAIT_L(0); PG8_MMA(1, 0, At, B0); PG8_BAR; PG8_SCHED;
            PG8_STAGE(PG8_SB(0, 1), b2 + hstep, voffB);
            PG8_WAIT_V(6); PG8_BAR; PG8_MMA(1, 1, At, B1); PG8_BAR;
            PG8_LDB(B0, 1, 0); PG8_SCHED; PG8_LDA(At, 1, 0); PG8_STAGE(PG8_SA(0, 1), a2 + hstep, voffA);
            PG8_WAIT_L(8); PG8_BAR; PG8_WAIT_L(0); PG8_MMA(0, 0, At, B0); PG8_BAR; PG8_SCHED;
            PG8_LDB(B1, 1, 1); PG8_STAGE(PG8_SB(1, 0), b3, voffB);
            PG8_BAR; PG8_WAIT_L(0); PG8_MMA(0, 1, At, B1); PG8_BAR;
            PG8_LDA(At, 1, 1); PG8_STAGE(PG8_SA(1, 0), a3, voffA);
            PG8_BAR; PG8_WAIT_L(0); PG8_MMA(1, 0, At, B0); PG8_BAR; PG8_SCHED;
            PG8_STAGE(PG8_SB(1, 1), b3 + hstep, voffB);
            PG8_WAIT_V(6); PG8_BAR; PG8_MMA(1, 1, At, B1); PG8_BAR;
            }
        }
        if constexpr (ALIGN_EPI) { if (wr == 0) PG8_BAR; }
        if constexpr (!Epi::AFTER_DRAIN) { E(acc, cur, wr, wc, fr, fq); S.done(cur); }
        if (!has_next) break;
#pragma unroll
        for (int a = 0; a < 2; ++a)
#pragma unroll
            for (int b = 0; b < 2; ++b)
#pragma unroll
                for (int m = 0; m < 4; ++m)
#pragma unroll
                    for (int n = 0; n < 2; ++n) acc[a][b][m][n] = (f32x4){0.f, 0.f, 0.f, 0.f};
        cur = nxt; cA = nA; cB = nB; ++ui;
        if constexpr (ALIGN_EPI) { if (wr == 1) PG8_BAR; }
    }
    PG8_WAIT_V(0);
    if constexpr (!ALIGN_EPI) { if (wr == 0) PG8_BAR; }
    PG8_BAR;
    if constexpr (Epi::AFTER_DRAIN) { E.fused(acc, cur, wr, wc, fr, fq, lds, wid, lane); S.done(cur); }
#undef PG8_SA
#undef PG8_SB
#undef PG8_STAGE
#undef PG8_LDA
#undef PG8_LDB
#undef PG8_MMA
#undef PG8_WAIT_V
#undef PG8_WAIT_L
#undef PG8_BAR
#undef PG8_SCHED
}
}


constexpr int NWAVES = 8;
constexpr int BATCH = 16, SEQ = 2048, D = 1024, M = BATCH * SEQ, FF = 2816, NGU = 2 * FF, PLED = 256, DEPTH = 2;
constexpr int NIN_SRC = 3088, NIN = 3328, NPROJ = 3072, NGATE = 4096;
constexpr int PC_GQ = 0, PC_GZ = 768, PC_MQ = 1024, PC_MV = 1536, PC_MO = 1792, PC_S5 = 2048, PC_AQ = 2304, PC_AK = 2560, PC_AV = 2816;

constexpr size_t MiB = 1u << 20;
constexpr size_t WS_CTL = 0, CTL_ZERO_BYTES = 4 * MiB;
constexpr size_t WS_ROWSS = 1 * MiB;
constexpr size_t WS_KMEAN = 3 * MiB + 512 * 1024;
constexpr size_t WS_S5P = 6 * MiB + 512 * 1024;
constexpr size_t WS_SCAL = 4 * MiB;
constexpr size_t WS_W = 8 * MiB;
constexpr size_t W_GU1 = 0, W_D1 = W_GU1 + (size_t)NGU * D * 2, W_IN = W_D1 + (size_t)D * FF * 2, W_GATE = W_IN + (size_t)NIN * D * 2, W_BR = W_GATE + (size_t)NGATE * D * 2,
                 W_GLU = W_BR + (size_t)4096 * 256 * 2, W_OUT = W_GLU + (size_t)256 * 256 * 2, W_GU2 = W_OUT + (size_t)D * D * 2, W_D2 = W_GU2 + (size_t)NGU * D * 2,
                 W_PLE = W_D2 + (size_t)D * FF * 2, W_PG = W_PLE + (size_t)D * PLED * 2, W_END = W_PG + (size_t)D * D * 2;
static_assert(W_END <= 56 * MiB, "weights fit");
constexpr size_t WS_HB = 64 * MiB;
constexpr size_t WS_PB = 128 * MiB;
constexpr size_t WS_Y = 144 * MiB;
constexpr size_t WS_YG = 208 * MiB;
constexpr size_t WS_VT = 224 * MiB;
constexpr size_t WS_BIG = 256 * MiB;
constexpr size_t WS_END = 512 * MiB;
constexpr size_t OUT_W1 = 0, OUT_T = 56 * MiB, OUT_ROPE = 120 * MiB;
constexpr int CW_BAR = 4096, CW_QUEUE = 8192, CW_FLAG = 12288, CW_S5F = 16384, CW_GRP = 20480;

constexpr int RING_OFF = 0;
constexpr int LDS_BYTES = 147456;
constexpr int SC_OFF = 131072;
constexpr int LDSCTL_OFF = LDS_BYTES - 1024;
constexpr int WAVE_LDS = 17408;

#define GAS __attribute__((address_space(1)))
#define LAS __attribute__((address_space(3)))
typedef unsigned short bf16;
typedef unsigned v4u __attribute__((ext_vector_type(4)));
typedef float f32x4 __attribute__((ext_vector_type(4)));
typedef short bf16x8 __attribute__((ext_vector_type(8)));
typedef GAS unsigned gu32;
typedef GAS unsigned long long gu64;
#define RLX_AGENT __ATOMIC_RELAXED, __HIP_MEMORY_SCOPE_AGENT
#define LDS_WAIT() asm volatile("s_waitcnt lgkmcnt(0)" ::: "memory")
#define VM_WAIT() asm volatile("s_waitcnt vmcnt(0)" ::: "memory")
__device__ __forceinline__ unsigned long long rt() { return __builtin_amdgcn_s_memrealtime(); }
__device__ __forceinline__ unsigned f2bf(float f) { unsigned u = __builtin_bit_cast(unsigned, f); return (u + 0x7fffu + ((u >> 16) & 1u)) >> 16; }
typedef float pk2_f32x2 __attribute__((ext_vector_type(2)));
typedef __bf16 pk2_bf16x2 __attribute__((ext_vector_type(2)));
__device__ __forceinline__ unsigned pk2(float lo, float hi) { const pk2_f32x2 v = {lo, hi}; return __builtin_bit_cast(unsigned, __builtin_convertvector(v, pk2_bf16x2)); }

#define XB_TMO      128
#define XB_XCNT(j)  (256  + 64 * (j))
#define XB_XSUB(j)  (1280 + 64 * (j))
#define XB_XGEN(j)  (2304 + 64 * (j))
#define XB_TOP      3328
#define XB_TOPGEN   3392
#define XCD_BAR_WORDS 3456
#define XB_SPIN_CAP (1u << 21)

__device__ __forceinline__ unsigned xb_ld(unsigned* p)              { return __hip_atomic_load(p, __ATOMIC_RELAXED, __HIP_MEMORY_SCOPE_AGENT); }
__device__ __forceinline__ unsigned xb_add(unsigned* p, unsigned v) { return __hip_atomic_fetch_add(p, v, __ATOMIC_RELAXED, __HIP_MEMORY_SCOPE_AGENT); }
__device__ __forceinline__ unsigned xb_xcc_id() { return (unsigned)__builtin_amdgcn_s_getreg((3 << 11) | 20) & 0xFu; }
#define XB_SPIN(cond, bar) do { unsigned _sp = 0; while (cond) { __builtin_amdgcn_s_sleep(1); \
    if ((++_sp & 255u) == 0u) { if (xb_ld(&(bar)[XB_TMO])) break; if (_sp > XB_SPIN_CAP) { atomicAdd(&(bar)[XB_TMO], 1u); break; } } } } while (0)

struct XcdBarrier {
    unsigned* bar; unsigned x;
    volatile LAS unsigned* st;
};

__device__ __forceinline__ XcdBarrier xcd_barrier_post(unsigned* bar, volatile LAS unsigned* st) {
    XcdBarrier b; b.bar = bar; b.x = xb_xcc_id(); b.st = st;
    if (threadIdx.x == 0) (void)xb_add(&bar[XB_XCNT(b.x)], 1u);
    return b;
}
__device__ __forceinline__ void xcd_barrier_complete(unsigned* bar, unsigned x, unsigned& nloc, unsigned& nx) {
    const unsigned G = gridDim.x * gridDim.y * gridDim.z;
    unsigned sum, cnt, mine, sp = 0u;
    for (;;) {
        sum = 0u; cnt = 0u; mine = 0u;
#pragma unroll
        for (unsigned j = 0; j < 16; ++j) { const unsigned c = xb_ld(&bar[XB_XCNT(j)]); sum += c; cnt += (c > 0u) ? 1u : 0u; mine = (j == x) ? c : mine; }
        if (sum == G) break;
        __builtin_amdgcn_s_sleep(1);
        if ((++sp & 255u) == 0u) { if (xb_ld(&bar[XB_TMO])) break; if (sp > XB_SPIN_CAP) { atomicAdd(&bar[XB_TMO], 1u); break; } }
    }
    nloc = mine > 0u ? mine : 1u; nx = cnt > 0u ? cnt : 1u;
}

__device__ __forceinline__ void xcd_barrier(const XcdBarrier& b) {
    asm volatile("s_waitcnt vmcnt(0)" ::: "memory");
    __syncthreads();
    if (threadIdx.x == 0) {
        unsigned* bar = b.bar;
        __builtin_amdgcn_s_waitcnt(0);
        unsigned nloc = b.st[0], nx = b.st[1];
        if (nloc == 0u) { xcd_barrier_complete(bar, b.x, nloc, nx); b.st[0] = nloc; b.st[1] = nx; }
        const unsigned old = xb_add(&bar[XB_XSUB(b.x)], 1u);
        const unsigned gen = old / nloc;
        if (old + 1u == (gen + 1u) * nloc) {
            __builtin_amdgcn_fence(__ATOMIC_RELEASE, "agent");
            asm volatile("s_waitcnt vmcnt(0)" ::: "memory");
            const unsigned og = xb_add(&bar[XB_TOP], 1u);
            const unsigned tg = og / nx;
            if (og + 1u == (tg + 1u) * nx) xb_add(&bar[XB_TOPGEN], 1u);
            else XB_SPIN(xb_ld(&bar[XB_TOPGEN]) == tg, bar);
            __builtin_amdgcn_fence(__ATOMIC_ACQUIRE, "agent");
            xb_add(&bar[XB_XGEN(b.x)], 1u);
            asm volatile("s_waitcnt vmcnt(0)" ::: "memory");
        } else {
            XB_SPIN(xb_ld(&bar[XB_XGEN(b.x)]) == gen, bar);
            __builtin_amdgcn_fence(__ATOMIC_ACQUIRE, "agent");
            asm volatile("s_waitcnt vmcnt(0)" ::: "memory");
        }
    }
    __syncthreads();
}

__device__ __forceinline__ void group_barrier(unsigned* ctr, unsigned target) {
    asm volatile("s_waitcnt vmcnt(0)" ::: "memory");
    __syncthreads();
    if (threadIdx.x == 0) {
        __builtin_amdgcn_s_waitcnt(0);
        __builtin_amdgcn_fence(__ATOMIC_RELEASE, "agent");
        asm volatile("s_waitcnt vmcnt(0)" ::: "memory");
        (void)xb_add(ctr, 1u);
        unsigned sp = 0; while (xb_ld(ctr) < target) { __builtin_amdgcn_s_sleep(1); if (++sp > (1u << 22)) break; }
        __builtin_amdgcn_fence(__ATOMIC_ACQUIRE, "agent");
        asm volatile("s_waitcnt vmcnt(0)" ::: "memory");
    }
    __syncthreads();
}


template <int CTRL> __device__ __forceinline__ float dppx(float x) { return __int_as_float(__builtin_amdgcn_update_dpp(0, __float_as_int(x), CTRL, 0xF, 0xF, true)); }
constexpr int DPP_XOR1 = 0xB1, DPP_XOR2 = 0x4E, DPP_HMIRROR = 0x141, DPP_MIRROR = 0x140;
__device__ __forceinline__ float xrow16_sum(float x) {
    auto s = __builtin_amdgcn_permlane16_swap(__float_as_uint(x), __float_as_uint(x), false, false);
    x = __uint_as_float(s[0]) + __uint_as_float(s[1]);
    auto t = __builtin_amdgcn_permlane32_swap(__float_as_uint(x), __float_as_uint(x), false, false);
    return __uint_as_float(t[0]) + __uint_as_float(t[1]);
}
__device__ __forceinline__ float xrow16_max(float x) {
    auto s = __builtin_amdgcn_permlane16_swap(__float_as_uint(x), __float_as_uint(x), false, false);
    x = fmaxf(__uint_as_float(s[0]), __uint_as_float(s[1]));
    auto t = __builtin_amdgcn_permlane32_swap(__float_as_uint(x), __float_as_uint(x), false, false);
    return fmaxf(__uint_as_float(t[0]), __uint_as_float(t[1]));
}
__device__ __forceinline__ float xhalf_sum(float x) {
    auto t = __builtin_amdgcn_permlane32_swap(__float_as_uint(x), __float_as_uint(x), false, false);
    return __uint_as_float(t[0]) + __uint_as_float(t[1]);
}
__device__ __forceinline__ float red8(float v) { v += dppx<DPP_XOR1>(v); v += dppx<DPP_XOR2>(v); v += dppx<DPP_HMIRROR>(v); return v; }
__device__ __forceinline__ float wave_sum(float v) { v = red8(v); v += dppx<DPP_MIRROR>(v); return xrow16_sum(v); }
__device__ __forceinline__ float wave_max(float v) { v = fmaxf(v, dppx<DPP_XOR1>(v)); v = fmaxf(v, dppx<DPP_XOR2>(v)); v = fmaxf(v, dppx<DPP_HMIRROR>(v)); v = fmaxf(v, dppx<DPP_MIRROR>(v)); return xrow16_max(v); }
__device__ __forceinline__ float bf2f(bf16 b) { return __uint_as_float(((unsigned)b) << 16); }
__device__ __forceinline__ float sigm(float x) { return __builtin_amdgcn_rcpf(1.0f + __expf(-x)); }
__device__ __forceinline__ float silu(float x) { return x * sigm(x); }

template <class Map>
__device__ __forceinline__ void cvt_item(const float* __restrict__ W, int ld, const float* __restrict__ gain, bf16* Bt, int K, int item, int nblk, LAS float* scr, int lane, Map map) {
    const int kb = item / nblk, nb = item % nblk, k0 = 64 * kb, n0 = 32 * nb;
    const int n4 = lane & 7, kr = lane >> 3; const long so = map(n0 + 4 * n4);
    const long sx = so >= 0 ? so : 0; const float keep = so >= 0 ? 1.0f : 0.0f;
    f32x4 v[8]; float gn[8];
#pragma unroll
    for (int i = 0; i < 8; ++i) { v[i] = *(const GAS f32x4*)(W + sx + (size_t)(k0 + 8 * i + kr) * ld); gn[i] = keep; }
    if (gain) {
#pragma unroll
        for (int i = 0; i < 8; ++i) gn[i] = keep * gain[k0 + 8 * i + kr]; }
#pragma unroll
    for (int i = 0; i < 8; ++i) { LAS float* d = scr + (8 * i + kr) * 33 + 4 * n4; const f32x4 w = v[i] * gn[i]; d[0] = w[0]; d[1] = w[1]; d[2] = w[2]; d[3] = w[3]; }
    LDS_WAIT(); asm volatile("" ::: "memory");
    const int c = lane & 7;
#pragma unroll
    for (int j = 0; j < 4; ++j) { const int n = (lane >> 3) + 8 * j; const LAS float* s = scr + (8 * c) * 33 + n;
        v4u o; o.x = pk2(s[0 * 33], s[1 * 33]); o.y = pk2(s[2 * 33], s[3 * 33]); o.z = pk2(s[4 * 33], s[5 * 33]); o.w = pk2(s[6 * 33], s[7 * 33]);
        *(GAS v4u*)(Bt + (size_t)(n0 + n) * K + k0 + 8 * c) = o; }
    LDS_WAIT(); asm volatile("" ::: "memory");
}
struct MapId { __device__ long operator()(int r) const { return r; } };
struct MapGU { __device__ long operator()(int r) const { const int pn = r >> 8, c = r & 255; return c < 128 ? 128 * pn + c : FF + 128 * pn + (c - 128); } };
struct MapIn { __device__ long operator()(int r) const { if (r < 1024) return r; if (r < 2048) return 1032 + (r - 1024); if (r < 2304) return 2064 + (r - 2048);
    if (r < 2560) { const int c = r - 2304; return c < 8 ? 1024 + c : c < 16 ? 2056 + (c - 8) : -1; }
    const int t = (r - 2560) >> 8, c = (r - 2560) & 255; if (t < 2) return 2320 + 256 * t + ((c >> 5) & 3) * 64 + (c >> 7) * 32 + (c & 31); return 2320 + 512 + c; } };
struct MapGate { __device__ long operator()(int r) const { const int pn = r >> 8, c = r & 255, b = 2 * (c >> 7) + ((c >> 4) & 1), jl = 16 * ((c >> 5) & 3) + 4 * ((c >> 2) & 3) + (c & 3); return (long)b * (D * D) + 64 * pn + jl; } };
struct MapBr { __device__ long operator()(int r) const { return (long)(r >> 10) * (256 * D) + (r & 1023); } };

struct LayerW {
    const float *ffn1_norm, *ffn1_w_gu, *ffn1_w_down, *mix_norm, *w_in, *gdn_conv, *gdn_a_log, *gdn_dt_bias, *gdn_norm, *mlstm_conv, *mlstm_i_bias, *mlstm_f_bias, *mlstm_norm,
                *s5_lre, *s5_lim, *s5_bre, *s5_bim, *s5_cre, *s5_cim, *s5_d, *s5_log_dt, *s5_w_glu, *s5_b_glu, *w_gate, *w_branch, *w_out, *ffn2_norm, *ffn2_w_gu, *ffn2_w_down, *ple_norm, *ple_w_proj, *ple_w_gate;
};

__device__ __forceinline__ void prologue_weights(const LayerW& L, unsigned char* wsw, LAS unsigned char* lds, int gw, int ngw, int wave, int lane) {
    LAS float* scr = (LAS float*)(lds + RING_OFF + wave * WAVE_LDS);
    constexpr int I_GU = (D / 64) * (NGU / 32), I_DN = (FF / 64) * (D / 32), I_IN = (D / 64) * (NIN / 32), I_GT = (D / 64) * (NGATE / 32), I_BR = (256 / 64) * (4096 / 32), I_GL = (256 / 64) * (256 / 32),
                  I_OUT = (D / 64) * (D / 32), I_PLE = (PLED / 64) * (D / 32), I_PG = I_OUT;
    constexpr int NITEMS = 2 * I_GU + 2 * I_DN + I_IN + I_GT + I_BR + I_GL + I_OUT + I_PLE + I_PG;
    for (int it = gw; it < NITEMS; it += ngw) {
        int r = it;
        if (r < I_GU) { cvt_item(L.ffn1_w_gu, NGU, L.ffn1_norm, (bf16*)(wsw + W_GU1), D, r, NGU / 32, scr, lane, MapGU()); continue; } r -= I_GU;
        if (r < I_GU) { cvt_item(L.ffn2_w_gu, NGU, L.ffn2_norm, (bf16*)(wsw + W_GU2), D, r, NGU / 32, scr, lane, MapGU()); continue; } r -= I_GU;
        if (r < I_DN) { cvt_item(L.ffn1_w_down, D, nullptr, (bf16*)(wsw + W_D1), FF, r, D / 32, scr, lane, MapId()); continue; } r -= I_DN;
        if (r < I_DN) { cvt_item(L.ffn2_w_down, D, nullptr, (bf16*)(wsw + W_D2), FF, r, D / 32, scr, lane, MapId()); continue; } r -= I_DN;
        if (r < I_IN) { cvt_item(L.w_in, NIN_SRC, L.mix_norm, (bf16*)(wsw + W_IN), D, r, NIN / 32, scr, lane, MapIn()); continue; } r -= I_IN;
        if (r < I_GT) { cvt_item(L.w_gate, D, L.mix_norm, (bf16*)(wsw + W_GATE), D, r, NGATE / 32, scr, lane, MapGate()); continue; } r -= I_GT;
        if (r < I_BR) { cvt_item(L.w_branch, D, nullptr, (bf16*)(wsw + W_BR), 256, r, 4096 / 32, scr, lane, MapBr()); continue; } r -= I_BR;
        if (r < I_GL) { cvt_item(L.s5_w_glu, 256, nullptr, (bf16*)(wsw + W_GLU), 256, r, 256 / 32, scr, lane, MapId()); continue; } r -= I_GL;
        if (r < I_OUT) { cvt_item(L.w_out, D, nullptr, (bf16*)(wsw + W_OUT), D, r, D / 32, scr, lane, MapId()); continue; } r -= I_OUT;
        if (r < I_PLE) { cvt_item(L.ple_w_proj, D, nullptr, (bf16*)(wsw + W_PLE), PLED, r, D / 32, scr, lane, MapId()); continue; } r -= I_PLE;
        cvt_item(L.ple_w_gate, D, L.ple_norm, (bf16*)(wsw + W_PG), D, r, D / 32, scr, lane, MapId());
    }
}
__device__ __forceinline__ void prologue_s5(const LayerW& L, float* s5p, int gtid, int ngt) {
    for (int i = gtid; i < 1024; i += ngt) { const int g = i >> 6;
        const float dt = expf(L.s5_log_dt[g]), lr = L.s5_lre[i], li = L.s5_lim[i];
        const float th = li * dt; float sn, cs; sincosf(th, &sn, &cs);
        const float em1 = expm1f(lr * dt), mag = em1 + 1.0f;
        const float are = mag * cs, aim = mag * sn;
        const float sh = sinf(0.5f * th); const float arem1 = em1 * cs - 2.0f * sh * sh;
        const float den = lr * lr + li * li;
        const float zre = (arem1 * lr + aim * li) / den, zim = (aim * lr - arem1 * li) / den;
        s5p[i] = are; s5p[1024 + i] = aim;
        for (int n = 0; n < 16; ++n) { const float br = L.s5_bre[i * 16 + n], bi = L.s5_bim[i * 16 + n];
            s5p[2048 + i * 16 + n] = zre * br - zim * bi; s5p[2048 + 16384 + i * 16 + n] = zre * bi + zim * br; } }
}
__device__ __forceinline__ void cvt_rows_bf16(const float* src, bf16* dst, size_t n, size_t gtid, size_t ngt) {
    size_t i = gtid * 8;
    for (; i + 3 * ngt * 8 < n; i += 4 * ngt * 8) {
        f32x4 a[4], b[4];
#pragma unroll
        for (int u = 0; u < 4; ++u) { a[u] = *(const GAS f32x4*)(src + i + u * ngt * 8); b[u] = *(const GAS f32x4*)(src + i + u * ngt * 8 + 4); }
#pragma unroll
        for (int u = 0; u < 4; ++u) { v4u o; o.x = pk2(a[u][0], a[u][1]); o.y = pk2(a[u][2], a[u][3]); o.z = pk2(b[u][0], b[u][1]); o.w = pk2(b[u][2], b[u][3]); *(GAS v4u*)(dst + i + u * ngt * 8) = o; } }
    for (; i < n; i += ngt * 8) { const f32x4 a = *(const GAS f32x4*)(src + i), b = *(const GAS f32x4*)(src + i + 4);
        v4u o; o.x = pk2(a[0], a[1]); o.y = pk2(a[2], a[3]); o.z = pk2(b[0], b[1]); o.w = pk2(b[2], b[3]); *(GAS v4u*)(dst + i) = o; }
}
__device__ __forceinline__ void prologue_rope(const int* positions, float* rope, size_t gtid, size_t ngt) {
    for (size_t i = gtid; i < (size_t)M * 32; i += ngt) { const size_t row = i >> 5; const int k = (int)(i & 31);
        const float invf = expf(-(float)k * (2.0f / 64.0f) * 9.210340371976184f); float sn, cs; sincosf((float)positions[row] * invf, &sn, &cs);
        rope[row * 64 + k] = cs; rope[row * 64 + 32 + k] = sn; }
}
__device__ __forceinline__ void x_to_hb(const float* x, bf16* hb, pg8::rowss_t* rowss, int gw, int ngw, int lane) {
    for (int m0 = gw; m0 < M; m0 += 2 * ngw) {
        f32x4 v[2][4]; float s[2];
#pragma unroll
        for (int u = 0; u < 2; ++u) { const int m = m0 + u * ngw; if (m < M) { const GAS f32x4* xr = (const GAS f32x4*)(x + (size_t)m * D) + lane;
#pragma unroll
            for (int j = 0; j < 4; ++j) v[u][j] = xr[64 * j]; } }
#pragma unroll
        for (int u = 0; u < 2; ++u) { const int m = m0 + u * ngw; if (m < M) { s[u] = 0.f;
#pragma unroll
            for (int j = 0; j < 4; ++j) s[u] += (v[u][j][0] * v[u][j][0] + v[u][j][1] * v[u][j][1]) + (v[u][j][2] * v[u][j][2] + v[u][j][3] * v[u][j][3]);
            s[u] = wave_sum(s[u]); if (lane == 0) rowss[m] = (pg8::rowss_t)(s[u] * pg8::RSS_SCALE);
            GAS unsigned long long* o8 = (GAS unsigned long long*)(hb + (size_t)m * D) + lane;
#pragma unroll
            for (int j = 0; j < 4; ++j) o8[64 * j] = (unsigned long long)pk2(v[u][j][0], v[u][j][1]) | ((unsigned long long)pk2(v[u][j][2], v[u][j][3]) << 32); } } }
}
__device__ __forceinline__ void final_norm(const bf16* h, float* out, const pg8::rowss_t* rowss, const float* w, int gw, int ngw, int lane) {
    const GAS f32x4* wp = (const GAS f32x4*)(w + 16 * lane); const f32x4 g0 = wp[0], g1 = wp[1], g2 = wp[2], g3 = wp[3];
    for (int m0 = gw; m0 < M; m0 += 4 * ngw) {
        v4u hw[4][2]; float r[4];
#pragma unroll
        for (int u = 0; u < 4; ++u) { const int m = m0 + u * ngw; if (m < M) { const GAS v4u* hp = (const GAS v4u*)(h + (size_t)m * D + 16 * lane); hw[u][0] = hp[0]; hw[u][1] = hp[1]; r[u] = pg8::rms_scale(rowss, m); } }
#pragma unroll
        for (int u = 0; u < 4; ++u) { const int m = m0 + u * ngw; if (m < M) { GAS f32x4* op = (GAS f32x4*)(out + (size_t)m * D + 16 * lane); const float rr = r[u];
            op[0] = (f32x4){__uint_as_float(hw[u][0].x << 16) * rr * g0[0], __uint_as_float(hw[u][0].x & 0xffff0000u) * rr * g0[1], __uint_as_float(hw[u][0].y << 16) * rr * g0[2], __uint_as_float(hw[u][0].y & 0xffff0000u) * rr * g0[3]};
            op[1] = (f32x4){__uint_as_float(hw[u][0].z << 16) * rr * g1[0], __uint_as_float(hw[u][0].z & 0xffff0000u) * rr * g1[1], __uint_as_float(hw[u][0].w << 16) * rr * g1[2], __uint_as_float(hw[u][0].w & 0xffff0000u) * rr * g1[3]};
            op[2] = (f32x4){__uint_as_float(hw[u][1].x << 16) * rr * g2[0], __uint_as_float(hw[u][1].x & 0xffff0000u) * rr * g2[1], __uint_as_float(hw[u][1].y << 16) * rr * g2[2], __uint_as_float(hw[u][1].y & 0xffff0000u) * rr * g2[3]};
            op[3] = (f32x4){__uint_as_float(hw[u][1].z << 16) * rr * g3[0], __uint_as_float(hw[u][1].z & 0xffff0000u) * rr * g3[1], __uint_as_float(hw[u][1].w << 16) * rr * g3[2], __uint_as_float(hw[u][1].w & 0xffff0000u) * rr * g3[3]}; } } }
}

__device__ __forceinline__ float softplusf(float x) { return fmaxf(x, 0.f) + __logf(1.0f + __expf(-fabsf(x))); }
__device__ __forceinline__ float gelu_tanh(float y) { const float z = 0.7978845608028654f * (y + 0.044715f * y * y * y); const float th = 1.0f - 2.0f * __builtin_amdgcn_rcpf(1.0f + __expf(2.0f * z)); return 0.5f * y * (1.0f + th); }
template <int NQG>
__device__ __forceinline__ void moba_mfma_item(const bf16* proj, const float* kmean, const bf16* vt, bf16* y3, int bh, int qb, int wsl, int lane) {
    constexpr int NQ = 16 * NQG;
    const int b = bh >> 2, h = bh & 3, fr = lane & 15, fq = lane >> 4;
    const int t0 = qb * 256 + wsl * NQ; const size_t rowb = (size_t)b * SEQ;
    unsigned selmask = 0;
    { const GAS v4u* qp = (const GAS v4u*)(proj + (rowb + t0 + (lane & (NQ - 1))) * NPROJ + PC_AQ + h * 64);
      float qv[64];
#pragma unroll
      for (int c = 0; c < 8; ++c) { const v4u w = qp[c]; qv[8 * c + 0] = __uint_as_float(w.x << 16); qv[8 * c + 1] = __uint_as_float(w.x & 0xffff0000u); qv[8 * c + 2] = __uint_as_float(w.y << 16); qv[8 * c + 3] = __uint_as_float(w.y & 0xffff0000u);
          qv[8 * c + 4] = __uint_as_float(w.z << 16); qv[8 * c + 5] = __uint_as_float(w.z & 0xffff0000u); qv[8 * c + 6] = __uint_as_float(w.w << 16); qv[8 * c + 7] = __uint_as_float(w.w & 0xffff0000u); }
      float gs[7];
#pragma unroll
      for (int n = 0; n < 7; ++n) { float a = -3.0e38f; if (n < qb) { const GAS float* km = (const GAS float*)kmean + (size_t)(bh * 8 + n) * 64; a = 0.f;
#pragma unroll
              for (int d = 0; d < 64; ++d) a += qv[d] * km[d]; }
          gs[n] = a; }
#pragma unroll
      for (int r = 0; r < 3; ++r) { int best = -1; float bv = -3.0e38f;
#pragma unroll
          for (int n = 0; n < 7; ++n) if (n < qb && !((selmask >> n) & 1u) && gs[n] > bv) { bv = gs[n]; best = n; }
          if (best >= 0) selmask |= 1u << best; } }
    unsigned mskp = 0;
#pragma unroll
    for (int qg = 0; qg < NQG; ++qg) mskp |= ((unsigned)__shfl((int)selmask, 16 * qg + fr) & 0xffu) << (8 * qg);
    unsigned umask = 0;
#pragma unroll
    for (int n = 0; n < 7; ++n) if (__ballot((selmask >> n) & 1u) != 0ull) umask |= 1u << n;
    bf16x8 qf[NQG][2];
#pragma unroll
    for (int qg = 0; qg < NQG; ++qg)
#pragma unroll
        for (int ks = 0; ks < 2; ++ks) qf[qg][ks] = *(const GAS bf16x8*)(proj + (rowb + t0 + 16 * qg + fr) * NPROJ + PC_AQ + h * 64 + 32 * ks + 8 * fq);
    f32x4 o[4][NQG];
#pragma unroll
    for (int dt = 0; dt < 4; ++dt)
#pragma unroll
        for (int qg = 0; qg < NQG; ++qg) o[dt][qg] = (f32x4){0.f, 0.f, 0.f, 0.f};
    float mrun[NQG], lrun[NQG];
#pragma unroll
    for (int qg = 0; qg < NQG; ++qg) { mrun[qg] = -1.0e30f; lrun[qg] = 0.f; }
    const float cexp = 0.125f * 1.4426950408889634f;
    const int kperm = 8 * (fr >> 2) + (fr & 3);
    for (int it = 0; it <= qb; ++it) {
        const int nb = (it == 0) ? qb : it - 1;
        if (it > 0 && !((umask >> nb) & 1u)) continue;
        const int nsteps = (it == 0) ? (wsl * NQ + NQ - 1) / 32 + 1 : 8;
        bf16x8 kfn[2][2];
        { const size_t kb0 = rowb + nb * 256;
#pragma unroll
          for (int kt = 0; kt < 2; ++kt)
#pragma unroll
              for (int ks = 0; ks < 2; ++ks) kfn[kt][ks] = *(const GAS bf16x8*)(proj + (kb0 + kperm + 4 * kt) * NPROJ + PC_AK + h * 64 + 32 * ks + 8 * fq); }
        for (int st = 0; st < nsteps; ++st) {
            bf16x8 kf[2][2], vf[4];
#pragma unroll
            for (int kt = 0; kt < 2; ++kt) { kf[kt][0] = kfn[kt][0]; kf[kt][1] = kfn[kt][1]; }
#pragma unroll
            for (int dt = 0; dt < 4; ++dt) vf[dt] = *(const GAS bf16x8*)(vt + ((size_t)bh * 64 + 16 * dt + fr) * SEQ + nb * 256 + 32 * st + 8 * fq);
            if (st + 1 < nsteps) { const size_t kb = rowb + nb * 256 + 32 * (st + 1);
#pragma unroll
                for (int kt = 0; kt < 2; ++kt)
#pragma unroll
                    for (int ks = 0; ks < 2; ++ks) kfn[kt][ks] = *(const GAS bf16x8*)(proj + (kb + kperm + 4 * kt) * NPROJ + PC_AK + h * 64 + 32 * ks + 8 * fq); }
            f32x4 s[2][NQG];
#pragma unroll
            for (int kt = 0; kt < 2; ++kt)
#pragma unroll
                for (int qg = 0; qg < NQG; ++qg) { f32x4 a = (f32x4){0.f, 0.f, 0.f, 0.f};
                    a = __builtin_amdgcn_mfma_f32_16x16x32_bf16(kf[kt][0], qf[qg][0], a, 0, 0, 0); a = __builtin_amdgcn_mfma_f32_16x16x32_bf16(kf[kt][1], qf[qg][1], a, 0, 0, 0); s[kt][qg] = a; }
            bf16x8 pf[NQG];
#pragma unroll
            for (int qg = 0; qg < NQG; ++qg) {
                const int qloc = NQ * wsl + 16 * qg + fr; const bool sel = (mskp >> (8 * qg + nb)) & 1u;
                float mx = -1.0e30f;
#pragma unroll
                for (int kt = 0; kt < 2; ++kt)
#pragma unroll
                    for (int i = 0; i < 4; ++i) { const int kloc = 32 * st + 8 * fq + 4 * kt + i; const bool ok = (it == 0) ? (kloc <= qloc) : sel; const float v = ok ? s[kt][qg][i] : -1.0e30f; s[kt][qg][i] = v; mx = fmaxf(mx, v); }
                mx = xrow16_max(mx);
                const float mnew = fmaxf(mrun[qg], mx), alpha = __builtin_amdgcn_exp2f((mrun[qg] - mnew) * cexp); mrun[qg] = mnew;
                float ps = 0.f; float p[8];
#pragma unroll
                for (int kt = 0; kt < 2; ++kt)
#pragma unroll
                    for (int i = 0; i < 4; ++i) { const float e = __builtin_amdgcn_exp2f((s[kt][qg][i] - mnew) * cexp); p[4 * kt + i] = e; ps += e; }
                lrun[qg] = lrun[qg] * alpha + ps;
#pragma unroll
                for (int dt = 0; dt < 4; ++dt) o[dt][qg] *= alpha;
                v4u pw; pw.x = pk2(p[0], p[1]); pw.y = pk2(p[2], p[3]); pw.z = pk2(p[4], p[5]); pw.w = pk2(p[6], p[7]);
                pf[qg] = __builtin_bit_cast(bf16x8, pw);
            }
#pragma unroll
            for (int dt = 0; dt < 4; ++dt)
#pragma unroll
                for (int qg = 0; qg < NQG; ++qg) o[dt][qg] = __builtin_amdgcn_mfma_f32_16x16x32_bf16(vf[dt], pf[qg], o[dt][qg], 0, 0, 0);
        }
    }
#pragma unroll
    for (int qg = 0; qg < NQG; ++qg) { float l = xrow16_sum(lrun[qg]); const float inv = 1.0f / l;
        bf16* orow = y3 + (rowb + t0 + 16 * qg + fr) * 256 + h * 64 + 4 * fq;
#pragma unroll
        for (int dt = 0; dt < 4; ++dt) { const f32x4 v = o[dt][qg] * inv; *(GAS unsigned long long*)(orow + 16 * dt) = (unsigned long long)pk2(v[0], v[1]) | ((unsigned long long)pk2(v[2], v[3]) << 32); } }
}
typedef float f32x2 __attribute__((ext_vector_type(2)));
typedef unsigned u32x2_t __attribute__((ext_vector_type(2)));
constexpr int S2_XA = 0, S2_KN = 16384, S2_VV = 32768, S2_AB = 49152, S2_BUF = 50176, S2_OB = 2 * S2_BUF, S2_QD = S2_OB + 32768, S2_XT = S2_QD + 512, S2_CW = S2_XT + 32 * 68 * 4, S2_FA = S2_KN + 8960  ;
static_assert(S2_CW + 3 * 4 * 64 * 4 + 128 + 256 <= LDSCTL_OFF, "LDS map of the sequential mixers");
template <bool GDN>
__device__ __forceinline__ void seq_mixer2(const bf16* proj, const float* scal, const float* convw, const float* p0, const float* p1, const float* normw, bf16* yout, LAS unsigned char* lds, int bh, int tid) {
    const int wave = __builtin_amdgcn_readfirstlane(tid >> 6), lane = tid & 63;
    const int b = bh >> 2, h = bh & 3; const size_t rowb = (size_t)b * SEQ;
    constexpr int CIN = GDN ? 768 : 512, PCQ = GDN ? PC_GQ : PC_MQ;
    if (wave == 4) { LAS float* cwl = (LAS float*)(lds + S2_CW);
        for (int i = lane; i < 3 * 4 * 64; i += 64) { const int ty = i >> 8, j = (i >> 6) & 3, dd = i & 63; cwl[i] = (GDN || ty < 2) ? convw[j * CIN + ty * 256 + h * 64 + dd] : 0.f; }
        if (lane < 32) cwl[768 + lane] = 0.f; { unsigned no_ = (unsigned)(((GDN ? 0 : h * 64) + lane) * 4); asm volatile("" : "+v"(no_)); cwl[800 + lane] = *(const float*)((const char*)normw + no_); } }
    __syncthreads();
    if (wave < 4) {
        const int fr = lane & 15, fq = lane >> 4, e = 16 * wave + fr, sel = fr & 3;
        f32x4 ST[4];
#pragma unroll
        for (int T = 0; T < 4; ++T) ST[T] = (f32x4){0.f, 0.f, 0.f, 0.f};
        const unsigned wmask = (fq == 0) ? 0xffffffffu : 0u;
        v4u b0 = (v4u){0u, 0u, 0u, 0u}, b1 = b0, b2 = b0, b3 = b0;
        __builtin_amdgcn_s_setprio(3);
        for (int c = 0; c < SEQ / 64; ++c) {
            __syncthreads();
            const LAS bf16* XA = (const LAS bf16*)(lds + (c & 1) * S2_BUF + S2_XA) + (sel >> 1) * 128 + (sel & 1) * 64 + 8 * fq;
            const LAS unsigned char* KP = lds + (c & 1) * S2_BUF + S2_KN + fr * 16;
            const LAS float* VV = (const LAS float*)(lds + (c & 1) * S2_BUF + S2_VV) + e; const LAS float* AB = (const LAS float*)(lds + (c & 1) * S2_BUF + S2_AB);
            LAS float* OB = (LAS float*)(lds + S2_OB + (c & 1) * 16384) + e;
            bf16x8 a0n, a1n, kpn; f32x4 ab1n, ab2n; float v1n, v2n;
#define S2_LOAD(tp) do { a0n = *(const LAS bf16x8*)(XA + (tp) * 256); a1n = *(const LAS bf16x8*)(XA + (tp) * 256 + 32); kpn = *(const LAS bf16x8*)(KP + (tp) * 272); \
            v1n = VV[(tp) * 128]; v2n = VV[(tp) * 128 + 64]; ab1n = *(const LAS f32x4*)(AB + 8 * (tp)); ab2n = *(const LAS f32x4*)(AB + 8 * (tp) + 4); } while (0)
            S2_LOAD(0);
#pragma unroll 4
            for (int tp = 0; tp < 32; ++tp) {
                const bf16x8 a0 = a0n, a1 = a1n, kp = kpn; const f32x4 ab1 = ab1n, ab2 = ab2n; const float ve1 = v1n, ve2 = v2n;
                v4u bl, bhh; bl.x = pk2(ST[0][0], ST[0][1]); bl.y = pk2(ST[0][2], ST[0][3]); bl.z = pk2(ST[1][0], ST[1][1]); bl.w = pk2(ST[1][2], ST[1][3]);
                bhh.x = pk2(ST[2][0], ST[2][1]); bhh.y = pk2(ST[2][2], ST[2][3]); bhh.z = pk2(ST[3][0], ST[3][1]); bhh.w = pk2(ST[3][2], ST[3][3]);
                f32x4 d = (f32x4){0.f, 0.f, 0.f, 0.f};
                d = __builtin_amdgcn_mfma_f32_16x16x32_bf16(a0, __builtin_bit_cast(bf16x8, bl), d, 0, 0, 0);
                d = __builtin_amdgcn_mfma_f32_16x16x32_bf16(a1, __builtin_bit_cast(bf16x8, bhh), d, 0, 0, 0);
                __builtin_amdgcn_sched_barrier(0);
                S2_LOAD(tp + 1);
                __builtin_amdgcn_sched_barrier(0);
                float o1, o2, vn1, vn2;
                if (GDN) { vn1 = ve1 - ab1[1] * d[0]; o1 = ab1[0] * d[1] + vn1 * ab1[2];
                    const float sk2 = ab1[0] * d[2] + ab2[3] * vn1, sq2 = ab1[0] * d[3] + ab1[3] * vn1;
                    vn2 = ve2 - ab2[1] * sk2; o2 = ab2[0] * sq2 + vn2 * ab2[2]; }
                else { vn1 = ve1; o1 = ab1[0] * d[1] + ve1 * ab1[2]; const float sq2 = ab1[0] * d[3] + ab1[3] * ve1; vn2 = ve2; o2 = ab2[0] * sq2 + ve2 * ab2[2]; }
                const float aa = ab1[0] * ab2[0], c1 = ab2[0] * vn1;
#pragma unroll
                for (int T = 0; T < 4; ++T) ST[T] *= aa;
                const unsigned w = pk2(c1, vn2) & wmask;
                b0.x = w; b1.y = w; b2.z = w; b3.w = w;
                ST[0] = __builtin_amdgcn_mfma_f32_16x16x32_bf16(kp, __builtin_bit_cast(bf16x8, b0), ST[0], 0, 0, 0);
                ST[1] = __builtin_amdgcn_mfma_f32_16x16x32_bf16(kp, __builtin_bit_cast(bf16x8, b1), ST[1], 0, 0, 0);
                ST[2] = __builtin_amdgcn_mfma_f32_16x16x32_bf16(kp, __builtin_bit_cast(bf16x8, b2), ST[2], 0, 0, 0);
                ST[3] = __builtin_amdgcn_mfma_f32_16x16x32_bf16(kp, __builtin_bit_cast(bf16x8, b3), ST[3], 0, 0, 0);
                OB[tp * 128] = o1; OB[tp * 128 + 64] = o2;
            }
#undef S2_LOAD
        }
        __builtin_amdgcn_s_setprio(0);
        __syncthreads();
        __syncthreads();
    } else {
        const float s0 = GDN ? __expf(p0[h]) : p0[h], s1 = p1[h];
        const int ht = tid - 256, dgrp = ht & 7, d0 = 8 * dgrp, tg = ht >> 3;
        const int xpos = (dgrp >> 2) * 32 + (dgrp & 1) * 16 + ((dgrp >> 1) & 1) * 4;
        const LAS float* CW0 = (const LAS float*)(lds + S2_CW) + d0;
        const int e0 = (lane & 7) * 8;
        float nstate = 0.f;
#define S2_UNPK(W_, A_) do { const v4u w_ = (W_); A_[0] = __uint_as_float(w_.x << 16); A_[1] = __uint_as_float(w_.x & 0xffff0000u); A_[2] = __uint_as_float(w_.y << 16); A_[3] = __uint_as_float(w_.y & 0xffff0000u); \
                    A_[4] = __uint_as_float(w_.z << 16); A_[5] = __uint_as_float(w_.z & 0xffff0000u); A_[6] = __uint_as_float(w_.w << 16); A_[7] = __uint_as_float(w_.w & 0xffff0000u); } while (0)
        v4u rq[5], rk[5], rv[5]; float sg[2][2]; v4u zws[2];
        const int zh = 2 * (wave - 4);
#define S2_PREF(cn) do { const int s_ = (cn) * 64 + 2 * tg; \
            unsigned off_ = (unsigned)((((int)rowb + s_ - 3) * NPROJ + PCQ + h * 64 + d0) * 2); asm volatile("" : "+v"(off_));     \
            _Pragma("unroll") for (int r = 0; r < 5; ++r) { rq[r] = (v4u){0u, 0u, 0u, 0u}; rk[r] = rq[r]; \
                if (s_ - 3 + r >= 0) { const char* src_ = (const char*)proj + (off_ + (unsigned)(r * NPROJ * 2)); rq[r] = *(const GAS v4u*)src_; rk[r] = *(const GAS v4u*)(src_ + 512); } } } while (0)
#define S2_PREF_V(cn) do { const int s_ = (cn) * 64 + 2 * tg; \
            unsigned off_ = (unsigned)((((int)rowb + s_ - 3) * NPROJ + PCQ + h * 64 + d0) * 2); asm volatile("" : "+v"(off_)); \
            _Pragma("unroll") for (int r = 0; r < 5; ++r) { rv[r] = (v4u){0u, 0u, 0u, 0u}; \
                if (s_ - 3 + r >= 0) { const char* src_ = (const char*)proj + (off_ + (unsigned)(r * NPROJ * 2)); \
                    if (GDN) rv[r] = *(const GAS v4u*)(src_ + 1024); else if (r >= 3) rv[r] = *(const GAS v4u*)(src_ + (PC_MV - PCQ) * 2); } } \
            unsigned so_ = (unsigned)((((int)rowb + s_) * 16 + h) * 4); asm volatile("" : "+v"(so_)); const float* sb_ = (const float*)((const char*)scal + so_); \
            _Pragma("unroll") for (int i = 0; i < 2; ++i) { sg[i][0] = sb_[i * 16 + (GDN ? 0 : 8)]; sg[i][1] = sb_[i * 16 + (GDN ? 4 : 12)]; } } while (0)
#define S2_PREF_Z(cc_) do { unsigned zo_ = (unsigned)((((int)rowb + (cc_) * 64 + (lane >> 3) + zh * 8) * NPROJ + (GDN ? PC_GZ : PC_MO) + h * 64 + e0) * 2); asm volatile("" : "+v"(zo_)); \
            _Pragma("unroll") for (int i8 = 0; i8 < 2; ++i8) zws[i8] = *(const GAS v4u*)((const char*)proj + (zo_ + (unsigned)(i8 * 8 * NPROJ * 2))); } while (0)
        S2_PREF(0);
        for (int c = 0; c <= SEQ / 64 + 1; ++c) {
            if (c >= 2) {
                const int cc = c - 2; const LAS float* OB = (const LAS float*)(lds + S2_OB + (cc & 1) * 16384); const LAS float* QD = (const LAS float*)(lds + S2_QD) + (cc & 1) * 64;
#pragma unroll
                for (int i8 = 0; i8 < 2; ++i8) { const int t = (zh + i8) * 8 + (lane >> 3); const size_t row = rowb + cc * 64 + t;
                    f32x4 oa = *(const LAS f32x4*)(OB + t * 64 + e0), ob = *(const LAS f32x4*)(OB + t * 64 + e0 + 4);
                    if (!GDN) { const float inv = 1.0f / fmaxf(fabsf(QD[t]), 1.0f); oa *= inv; ob *= inv; }
                    float ss = (oa[0] * oa[0] + oa[1] * oa[1]) + (oa[2] * oa[2] + oa[3] * oa[3]) + (ob[0] * ob[0] + ob[1] * ob[1]) + (ob[2] * ob[2] + ob[3] * ob[3]);
                    ss = red8(ss);
                    const float r = rsqrtf(ss * (1.0f / 64.0f) + 1e-6f);
                    float z[8]; S2_UNPK(zws[i8], z);
                    float y[8]; const f32x4 nw0 = *(const LAS f32x4*)(lds + S2_CW + 3200 + 4 * e0), nw1 = *(const LAS f32x4*)(lds + S2_CW + 3200 + 4 * e0 + 16);
#pragma unroll
                    for (int i = 0; i < 8; ++i) { const float ov = (i < 4 ? oa[i] * nw0[i & 3] : ob[i - 4] * nw1[i & 3]) * r; y[i] = GDN ? ov * silu(z[i]) : ov * sigm(z[i]); }
                    v4u yo; yo.x = pk2(y[0], y[1]); yo.y = pk2(y[2], y[3]); yo.z = pk2(y[4], y[5]); yo.w = pk2(y[6], y[7]);
                    *(GAS v4u*)((char*)yout + (unsigned)(((int)row * 256 + h * 64 + e0) * 2)) = yo; }
            }
            if (c < SEQ / 64) {
                S2_PREF_V(c);
                LAS bf16* XA = (LAS bf16*)(lds + (c & 1) * S2_BUF + S2_XA); LAS unsigned char* KPb = lds + (c & 1) * S2_BUF + S2_KN; LAS float* VV = (LAS float*)(lds + (c & 1) * S2_BUF + S2_VV); LAS float* AB = (LAS float*)(lds + (c & 1) * S2_BUF + S2_AB);
#pragma unroll
                for (int i = 0; i < 2; ++i) { const int t = 2 * tg + i;
                    const LAS float* CW = CW0; asm volatile("" : "+v"(CW));
                    float q[8], k[8];
#pragma unroll
                    for (int ii = 0; ii < 8; ++ii) { q[ii] = 0.f; k[ii] = 0.f; }
#pragma unroll
                    for (int j = 0; j < 4; ++j) { const f32x4 wq0 = *(const LAS f32x4*)(CW + j * 64), wq1 = *(const LAS f32x4*)(CW + j * 64 + 4), wk0 = *(const LAS f32x4*)(CW + (4 + j) * 64), wk1 = *(const LAS f32x4*)(CW + (4 + j) * 64 + 4);
                        float x[8]; S2_UNPK(rq[i + j], x);
#pragma unroll
                        for (int ii = 0; ii < 4; ++ii) { q[ii] += wq0[ii] * x[ii]; q[4 + ii] += wq1[ii] * x[4 + ii]; }
                        S2_UNPK(rk[i + j], x);
#pragma unroll
                        for (int ii = 0; ii < 4; ++ii) { k[ii] += wk0[ii] * x[ii]; k[4 + ii] += wk1[ii] * x[4 + ii]; }
                        if (j & 1) asm volatile("" ::: "memory"); }
                    float ssq = 0.f, ssk = 0.f;
#pragma unroll
                    for (int ii = 0; ii < 8; ++ii) { q[ii] = silu(q[ii]); k[ii] = silu(k[ii]); ssq += q[ii] * q[ii]; ssk += k[ii] * k[ii]; }
                    float scq = 1.0f, sck = 1.0f;
                    if (GDN) { ssq = red8(ssq); ssk = red8(ssk);
                        scq = rsqrtf(ssq + 1e-6f) * 0.125f; sck = rsqrtf(ssk + 1e-6f); }
                    else sck = 0.125f * __expf(sg[i][0] + s0);
                    float kq = 0.f;
#pragma unroll
                    for (int ii = 0; ii < 8; ++ii) { q[ii] *= scq; k[ii] *= sck; kq += q[ii] * k[ii]; }
                    kq = red8(kq);
                    float k12 = 0.f, kq12 = 0.f;
                    float kp[8];
                    if (i == 1) { const u32x2_t w0 = *(const LAS u32x2_t*)(XA + (t - 1) * 128 + xpos), w1 = *(const LAS u32x2_t*)(XA + (t - 1) * 128 + xpos + 8);
                        kp[0] = __uint_as_float(w0.x << 16); kp[1] = __uint_as_float(w0.x & 0xffff0000u); kp[2] = __uint_as_float(w0.y << 16); kp[3] = __uint_as_float(w0.y & 0xffff0000u);
                        kp[4] = __uint_as_float(w1.x << 16); kp[5] = __uint_as_float(w1.x & 0xffff0000u); kp[6] = __uint_as_float(w1.y << 16); kp[7] = __uint_as_float(w1.y & 0xffff0000u);
#pragma unroll
                        for (int ii = 0; ii < 8; ++ii) { k12 += kp[ii] * k[ii]; kq12 += kp[ii] * q[ii]; }
                        k12 = red8(k12); kq12 = red8(kq12); }
                    v4u qb, kb; qb.x = pk2(q[0], q[1]); qb.y = pk2(q[2], q[3]); qb.z = pk2(q[4], q[5]); qb.w = pk2(q[6], q[7]); kb.x = pk2(k[0], k[1]); kb.y = pk2(k[2], k[3]); kb.z = pk2(k[4], k[5]); kb.w = pk2(k[6], k[7]);
                    *(LAS u32x2_t*)(XA + t * 128 + xpos) = (u32x2_t){kb.x, kb.y}; *(LAS u32x2_t*)(XA + t * 128 + xpos + 8) = (u32x2_t){kb.z, kb.w};
                    *(LAS u32x2_t*)(XA + t * 128 + 64 + xpos) = (u32x2_t){qb.x, qb.y}; *(LAS u32x2_t*)(XA + t * 128 + 64 + xpos + 8) = (u32x2_t){qb.z, qb.w};
                    if (i == 1) {
#pragma unroll
                        for (int ii = 0; ii < 8; ++ii) *(LAS unsigned*)(KPb + tg * 272 + (8 * (dgrp & 1) + ii) * 16 + (dgrp >> 1) * 4) = pk2(kp[ii], k[ii]); }
                    float be = 1.0f;
                    if (GDN) be = sigm(sg[i][0]);
                    if (dgrp == 0) { f32x4 abv;
                        if (GDN) { const float al = __expf(-s0 * softplusf(sg[i][1] + s1)); abv = (f32x4){al, al * be, kq, k12}; }
                        else { abv = (f32x4){sigm(sg[i][1] + s1), 0.f, kq, 0.f}; *(LAS float*)(lds + (c & 1) * S2_BUF + S2_FA + 4 * t) = abv[0]; }
                        *(LAS f32x4*)(AB + 4 * t) = abv; if (i == 1) AB[4 * (t - 1) + 3] = kq12; }
                    float v[8];
                    if (GDN) {
#pragma unroll
                        for (int ii = 0; ii < 8; ++ii) v[ii] = 0.f;
#pragma unroll
                        for (int j = 0; j < 4; ++j) { float x[8]; S2_UNPK(rv[i + j], x); const f32x4 wv0 = *(const LAS f32x4*)(CW + (8 + j) * 64), wv1 = *(const LAS f32x4*)(CW + (8 + j) * 64 + 4);
#pragma unroll
                            for (int ii = 0; ii < 4; ++ii) { v[ii] += wv0[ii] * x[ii]; v[4 + ii] += wv1[ii] * x[4 + ii]; } }
#pragma unroll
                        for (int ii = 0; ii < 8; ++ii) v[ii] = silu(v[ii]) * be;
                    } else S2_UNPK(rv[3 + i], v);
                    *(LAS f32x4*)(VV + t * 64 + d0) = (f32x4){v[0], v[1], v[2], v[3]}; *(LAS f32x4*)(VV + t * 64 + d0 + 4) = (f32x4){v[4], v[5], v[6], v[7]};
                    asm volatile("" ::: "memory"); }
                if (c + 1 < SEQ / 64) S2_PREF(c + 1);
            }
            if (c >= 1 && c <= SEQ / 64) S2_PREF_Z(c - 1);
            __syncthreads();
            if (!GDN && wave == 5 && c < SEQ / 64) {
                const int lpos = 32 * (lane >> 5) + 8 * ((lane & 15) >> 2) + 4 * ((lane >> 4) & 1) + (lane & 3); const LAS bf16* XQ = (const LAS bf16*)(lds + (c & 1) * S2_BUF + S2_XA) + 64 + lpos; const LAS bf16* XK = (const LAS bf16*)(lds + (c & 1) * S2_BUF + S2_XA) + lpos; const LAS float* AB = (const LAS float*)(lds + (c & 1) * S2_BUF + S2_AB);
                LAS float* QD = (LAS float*)(lds + S2_QD) + (c & 1) * 64; LAS float* XT = (LAS float*)(lds + S2_XT); const LAS float* FA = (const LAS float*)(lds + (c & 1) * S2_BUF + S2_FA);
                for (int hf = 0; hf < 2; ++hf) {
#pragma unroll 1
                    for (int g16 = 0; g16 < 2; ++g16) {
                        const int t0 = hf * 32 + g16 * 16; float fa[16], ka[16], qa[16], xo[16];
#pragma unroll
                        for (int j4 = 0; j4 < 4; ++j4) { const f32x4 f4 = *(const LAS f32x4*)(FA + t0 + 4 * j4); fa[4 * j4] = f4[0]; fa[4 * j4 + 1] = f4[1]; fa[4 * j4 + 2] = f4[2]; fa[4 * j4 + 3] = f4[3]; }
#pragma unroll
                        for (int j = 0; j < 16; ++j) { ka[j] = bf2f(XK[(t0 + j) * 128]); qa[j] = bf2f(XQ[(t0 + j) * 128]); }
#pragma unroll
                        for (int j = 0; j < 16; ++j) { nstate = nstate * fa[j] + ka[j]; xo[j] = nstate * qa[j]; }
#pragma unroll
                        for (int j = 0; j < 16; ++j) XT[(g16 * 16 + j) * 68 + lane] = xo[j];
                    }
                    LDS_WAIT(); asm volatile("" ::: "memory");
                    const LAS float* xr = XT + (lane & 31) * 68 + (lane >> 5) * 32; f32x4 s4 = (f32x4){0.f, 0.f, 0.f, 0.f};
#pragma unroll
                    for (int dd = 0; dd < 8; ++dd) s4 += *(const LAS f32x4*)(xr + 4 * dd);
                    float sm = (s4[0] + s4[1]) + (s4[2] + s4[3]);
                    sm = xhalf_sum(sm);
                    if (lane < 32) QD[hf * 32 + lane] = sm;
                    LDS_WAIT(); asm volatile("" ::: "memory");
                }
            }
        }
#undef S2_UNPK
#undef S2_PREF
#undef S2_PREF_V
#undef S2_PREF_Z
    }
}
__device__ __forceinline__ void s5_wave_mfma(const bf16* proj, const float* s5p, const float* cre, const float* cim, const float* dsk_in, bf16* yg, LAS unsigned char* wl, int item, int lane) {
    const int b = item >> 4, g = item & 15, fr = lane & 15, fq = lane >> 4, p = lane;
    LAS float* bu = (LAS float*)wl;
    LAS bf16* xs = (LAS bf16*)(wl + 16 * 132 * 4);
    bf16x8 bfr[8];
#pragma unroll
    for (int tau = 0; tau < 8; ++tau) { const int pp = 16 * tau + fr, ps = pp >> 1, c = pp & 1; v4u w = (v4u){0u, 0u, 0u, 0u};
        if (fq < 2) { const float* src = s5p + 2048 + (c ? 16384 : 0) + (size_t)(g * 64 + ps) * 16 + 8 * fq; w.x = pk2(src[0], src[1]); w.y = pk2(src[2], src[3]); w.z = pk2(src[4], src[5]); w.w = pk2(src[6], src[7]); }
        bfr[tau] = __builtin_bit_cast(bf16x8, w); }
    bf16x8 cfr[4];
#pragma unroll
    for (int ks = 0; ks < 4; ++ks) { const int p0 = (32 * ks + 8 * fq) >> 1; const float* r = cre + (size_t)(g * 16 + fr) * 64 + p0; const float* im = cim + (size_t)(g * 16 + fr) * 64 + p0;
        v4u w; w.x = pk2(r[0], -im[0]); w.y = pk2(r[1], -im[1]); w.z = pk2(r[2], -im[2]); w.w = pk2(r[3], -im[3]); cfr[ks] = __builtin_bit_cast(bf16x8, w); }
    const float ar = s5p[g * 64 + p], ai = s5p[1024 + g * 64 + p];
    float dsk[4];
#pragma unroll
    for (int j = 0; j < 4; ++j) dsk[j] = dsk_in[g * 16 + 4 * fq + j];
    float xr = 0.f, xi = 0.f;
    const size_t rowb = (size_t)b * SEQ;
    const bf16* ubase = proj + (rowb + fr) * NPROJ + PC_S5 + g * 16;
    v4u unext = (v4u){0u, 0u, 0u, 0u}; unsigned long long usk_next = 0ull;
    if (fq < 2) unext = *(const GAS v4u*)(ubase + 8 * fq);
    usk_next = *(const GAS unsigned long long*)(ubase + 4 * fq);
    for (int c = 0; c < SEQ / 16; ++c) {
        const v4u ucur = unext; const unsigned long long usk = usk_next;
        if (c + 1 < SEQ / 16) { const bf16* un = ubase + (size_t)(c + 1) * 16 * NPROJ; if (fq < 2) unext = *(const GAS v4u*)(un + 8 * fq); usk_next = *(const GAS unsigned long long*)(un + 4 * fq); }
        const bf16x8 ufr = __builtin_bit_cast(bf16x8, ucur);
#pragma unroll
        for (int tau = 0; tau < 8; ++tau) { f32x4 d = (f32x4){0.f, 0.f, 0.f, 0.f}; d = __builtin_amdgcn_mfma_f32_16x16x32_bf16(bfr[tau], ufr, d, 0, 0, 0);
            *(LAS f32x4*)(bu + fr * 132 + 16 * tau + 4 * fq) = d; }
        LDS_WAIT(); asm volatile("" ::: "memory");
#pragma unroll 4
        for (int t = 0; t < 16; ++t) { const f32x2 bb = *(const LAS f32x2*)(bu + t * 132 + 2 * p);
            const float nr = ar * xr - ai * xi + bb.x, ni = ar * xi + ai * xr + bb.y; xr = nr; xi = ni;
            *(LAS unsigned*)(xs + t * 136 + 2 * p) = pk2(xr, xi); }
        LDS_WAIT(); asm volatile("" ::: "memory");
        f32x4 y = (f32x4){0.f, 0.f, 0.f, 0.f};
#pragma unroll
        for (int ks = 0; ks < 4; ++ks) { const bf16x8 xf = *(const LAS bf16x8*)(xs + fr * 136 + 32 * ks + 8 * fq); y = __builtin_amdgcn_mfma_f32_16x16x32_bf16(cfr[ks], xf, y, 0, 0, 0); }
        const float u4[4] = {__uint_as_float((unsigned)usk << 16), __uint_as_float((unsigned)usk & 0xffff0000u), __uint_as_float((unsigned)(usk >> 32) << 16), __uint_as_float((unsigned)(usk >> 32) & 0xffff0000u)};
        float o[4];
#pragma unroll
        for (int j = 0; j < 4; ++j) o[j] = gelu_tanh(y[j] + dsk[j] * u4[j]);
        *(GAS unsigned long long*)(yg + (rowb + c * 16 + fr) * 256 + g * 16 + 4 * fq) = (unsigned long long)pk2(o[0], o[1]) | ((unsigned long long)pk2(o[2], o[3]) << 32);
        LDS_WAIT(); asm volatile("" ::: "memory");
    }
}
#ifndef PHASE_MASK
#define PHASE_MASK 0xFFFFFFFFu
#endif
#define PH(k) ((PHASE_MASK >> (k)) & 1u)
#ifndef SEQ_REPS
#define SEQ_REPS 1
#endif
#ifndef DOWN_FLIP
#define DOWN_FLIP 0
#endif
#ifndef DOWN_SP2
#define DOWN_SP2 true
#endif
#ifndef DOWN_ALIGN
#define DOWN_ALIGN true
#endif
#ifndef MOBA_NQG
#define MOBA_NQG 4
#endif
struct Args { const float* in[36]; float* out; unsigned char* ws; };
typedef const Args __attribute__((address_space(4))) CArgs;
__device__ __forceinline__ LayerW layer_ptrs(CArgs& a, int l) {
    LayerW L;
    L.ffn1_norm = a.in[3] + (size_t)l * D; L.ffn1_w_gu = a.in[4] + (size_t)l * D * NGU; L.ffn1_w_down = a.in[5] + (size_t)l * FF * D; L.mix_norm = a.in[6] + (size_t)l * D; L.w_in = a.in[7] + (size_t)l * D * NIN_SRC;
    L.gdn_conv = a.in[8] + (size_t)l * 4 * 768; L.gdn_a_log = a.in[9] + l * 4; L.gdn_dt_bias = a.in[10] + l * 4; L.gdn_norm = a.in[11] + l * 64;
    L.mlstm_conv = a.in[12] + (size_t)l * 4 * 512; L.mlstm_i_bias = a.in[13] + l * 4; L.mlstm_f_bias = a.in[14] + l * 4; L.mlstm_norm = a.in[15] + l * 256;
    L.s5_lre = a.in[16] + l * 1024; L.s5_lim = a.in[17] + l * 1024; L.s5_bre = a.in[18] + l * 16384; L.s5_bim = a.in[19] + l * 16384; L.s5_cre = a.in[20] + l * 16384; L.s5_cim = a.in[21] + l * 16384;
    L.s5_d = a.in[22] + l * 256; L.s5_log_dt = a.in[23] + l * 16; L.s5_w_glu = a.in[24] + (size_t)l * 65536; L.s5_b_glu = a.in[25] + l * 256;
    L.w_gate = a.in[26] + (size_t)l * 4 * D * D; L.w_branch = a.in[27] + (size_t)l * 4 * 256 * D; L.w_out = a.in[28] + (size_t)l * D * D;
    L.ffn2_norm = a.in[29] + (size_t)l * D; L.ffn2_w_gu = a.in[30] + (size_t)l * D * NGU; L.ffn2_w_down = a.in[31] + (size_t)l * FF * D;
    L.ple_norm = a.in[32] + (size_t)l * D; L.ple_w_proj = a.in[33] + (size_t)l * PLED * D; L.ple_w_gate = a.in[34] + (size_t)l * D * D;
    return L;
}

__global__ void __launch_bounds__(NWAVES * 64, 2) mk_fwd(Args args_k) {
    (void)args_k;
#define KARGP() ((CArgs*)__builtin_amdgcn_kernarg_segment_ptr())
    extern __shared__ __attribute__((aligned(16))) unsigned char lds_raw[];
    LAS unsigned char* lds = (LAS unsigned char*)lds_raw;
    const int G = gridDim.x;
    for (int u = threadIdx.x; u < (LDS_BYTES - LDSCTL_OFF) / 4; u += NWAVES * 64) ((LAS unsigned*)(lds + LDSCTL_OFF))[u] = 0u;
    __syncthreads();
    (void)xcd_barrier_post((unsigned*)(KARGP()->ws + WS_CTL) + CW_BAR, (volatile LAS unsigned*)(lds + LDSCTL_OFF) + 8);
#define GRID_BAR() do { CArgs* gp_ = KARGP(); asm volatile("" : "+s"(gp_)); unsigned char* bw_ = gp_->ws; asm volatile("" : "+s"(bw_)); XcdBarrier bar_; bar_.bar = (unsigned*)(bw_ + WS_CTL) + CW_BAR; bar_.x = xb_xcc_id(); bar_.st = (volatile LAS unsigned*)(lds + LDSCTL_OFF) + 8; xcd_barrier(bar_); } while (0)
    unsigned gbn = 0;
#define GROUP_BAR() do { ++gbn; CArgs* gq_ = KARGP(); asm volatile("" : "+s"(gq_)); unsigned char* gw_ = gq_->ws; asm volatile("" : "+s"(gw_)); const unsigned gi_ = blockIdx.x & 7u; \
        group_barrier((unsigned*)(gw_ + WS_CTL) + CW_GRP + 64 * gi_, gbn * (((unsigned)G - gi_ + 7u) >> 3)); } while (0)
#define WSP(T, off) ((T*)(wsl + (off)))
#define LAUNDER() CArgs* ap_ = KARGP(); asm volatile("" : "+s"(ap_)); unsigned char* wsl = ap_->ws; asm volatile("" : "+s"(wsl)); int K256 = 256, K1024 = 1024, KFF = FF; asm volatile("" : "+s"(K256), "+s"(K1024), "+s"(KFF)); (void)K256; (void)K1024; (void)KFF; int tid = threadIdx.x; asm volatile("" : "+v"(tid)); const int lane = tid & 63, wave = __builtin_amdgcn_readfirstlane(tid >> 6); (void)lane; (void)wave; int bid = blockIdx.x; asm volatile("" : "+s"(bid)); (void)bid
#define SC_PTR ((LAS float*)(lds + SC_OFF))
#define SC_RESET() do { __syncthreads(); if (tid == 0) *(LAS int*)(lds + SC_OFF + 1024) = -1; __syncthreads(); } while (0)
#define GW (blockIdx.x * NWAVES + wave)
#define NGW (G * NWAVES)

#if PH(0)
#ifdef PROBE_REP0
#pragma nounroll
    for (int rep_ = 0; rep_ < PROBE_REP0; ++rep_)
#endif
    { LAUNDER(); const LayerW L = layer_ptrs(*ap_, 0); const LayerW L1 = layer_ptrs(*ap_, 1);
#ifndef PW_REPS
#define PW_REPS 1
#endif
      for (int rpw_ = 0; rpw_ < PW_REPS; ++rpw_)
      prologue_weights(L, ap_->ws + WS_W, lds, GW, NGW, wave, lane);
      prologue_s5(L, WSP(float, WS_S5P), blockIdx.x * 512 + tid, G * 512);
      prologue_s5(L1, WSP(float, WS_S5P) + 40960, blockIdx.x * 512 + tid, G * 512);
      prologue_rope((const int*)ap_->in[2], (float*)((unsigned char*)ap_->out + OUT_ROPE), (size_t)blockIdx.x * 512 + tid, (size_t)G * 512);
      x_to_hb(ap_->in[0], WSP(bf16, WS_HB), WSP(pg8::rowss_t, WS_ROWSS), GW, NGW, lane); }
    GRID_BAR();
#endif
    const int hb0 = (G >= 256) ? 128 : 0;
    for (int l = 0; l < DEPTH; ++l) {
#define WB(off) ((const pg8::bf16_t*)((l == 0 ? wsl + WS_W : (unsigned char*)ap_->out + OUT_W1) + (off)))
#define HCUR() ((const pg8::bf16_t*)(l == 0 ? wsl + WS_HB : (unsigned char*)ap_->out + OUT_T))
#if PH(1)
#ifndef GU_REPS
#define GU_REPS 1
#endif
        for (int repg_ = 0; repg_ < GU_REPS; ++repg_)
        { LAUNDER(); pg8::Gemm g{HCUR(), WB(W_GU1), M, NGU, K1024, 30, 0}; pg8::StaticOrder S; S.init(M, NGU, G, bid);
          SC_RESET(); pg8::EpiSwiGLU E{WSP(pg8::bf16_t, WS_BIG), WSP(pg8::rowss_t, WS_ROWSS) + (size_t)(4 * l) * M, FF, SC_PTR};
          pg8::gemm_phase<pg8::EpiSwiGLU, pg8::StaticOrder, true, true>(lds + RING_OFF, g, S, E);
          GROUP_BAR(); }
#endif
#if PH(2)
        { LAUNDER(); pg8::Gemm g{WSP(const pg8::bf16_t, WS_BIG), WB(W_D1), M, D, KFF, 30, 0}; pg8::StaticOrder S; S.init(M, D, G, bid);
          pg8::EpiRes E{HCUR(), WSP(pg8::bf16_t, WS_HB), WSP(pg8::rowss_t, WS_ROWSS) + (size_t)(4 * l + 1) * M, 0.5f};
          pg8::gemm_phase<pg8::EpiRes, pg8::StaticOrder, DOWN_ALIGN, DOWN_SP2>(lds + RING_OFF, g, S, E); }
        GRID_BAR();
#endif
#ifdef PROBE_BARS
        for (int pb_ = 0; pb_ < PROBE_BARS; ++pb_) GRID_BAR();
#endif
#if PH(3)
        { LAUNDER(); pg8::Gemm g{WSP(const pg8::bf16_t, WS_HB), WB(W_IN), M, 2560, K1024, 30, 0}; pg8::StaticOrder S; S.init(M, 2560, G, bid);
          SC_RESET(); pg8::EpiMixIn E{WSP(pg8::bf16_t, WS_BIG), WSP(float, WS_SCAL), WSP(pg8::rowss_t, WS_ROWSS) + (size_t)(4 * l + 1) * M, SC_PTR};
          pg8::gemm_phase<pg8::EpiMixIn, pg8::StaticOrder, true, true>(lds + RING_OFF, g, S, E); }
        GRID_BAR();
#endif
#ifdef PROBE_IDLE_US
        { const unsigned long long t0_ = __builtin_amdgcn_s_memrealtime(); while (__builtin_amdgcn_s_memrealtime() - t0_ < (unsigned long long)PROBE_IDLE_US * 100ull) __builtin_amdgcn_s_sleep(32); __syncthreads(); }
#endif
#if PH(5)
        { LAUNDER(); const LayerW L = layer_ptrs(*ap_, l);
          for (int rep_ = 0; rep_ < SEQ_REPS; ++rep_)
          for (int it = blockIdx.x; it < 64; it += G) seq_mixer2<true>(WSP(const bf16, WS_BIG), WSP(const float, WS_SCAL), L.gdn_conv, L.gdn_a_log, L.gdn_dt_bias, L.gdn_norm, WSP(bf16, WS_Y), lds, it, tid); }
#endif
#if PH(6)
        { LAUNDER(); const LayerW L = layer_ptrs(*ap_, l);
          for (int rep_ = 0; rep_ < SEQ_REPS; ++rep_)
          for (int it = blockIdx.x; it < 64 + 64; it += G) if (it >= 64) seq_mixer2<false>(WSP(const bf16, WS_BIG), WSP(const float, WS_SCAL), L.mlstm_conv, L.mlstm_i_bias, L.mlstm_f_bias, L.mlstm_norm, WSP(bf16, WS_Y) + (size_t)M * 256, lds, it - 64, tid); }
#endif
#if PH(15)
        const int gb0 = (G >= 256) ? hb0 + 32 : hb0;
        if ((int)blockIdx.x >= gb0) {
          { LAUNDER(); pg8::Gemm g{WSP(const pg8::bf16_t, WS_HB), WB(W_IN + (size_t)2560 * D * 2), M, 768, K1024, 30, 0}; pg8::StaticOrder S; S.init(M, 768, G - gb0, bid - gb0);
            pg8::EpiMoba E{WSP(pg8::bf16_t, WS_BIG), WSP(pg8::bf16_t, WS_VT), WSP(float, WS_KMEAN) + (size_t)l * 32768, (const float*)((unsigned char*)ap_->out + OUT_ROPE), WSP(pg8::rowss_t, WS_ROWSS) + (size_t)(4 * l + 1) * M};
            pg8::gemm_phase<pg8::EpiMoba, pg8::StaticOrder, true, true>(lds + RING_OFF, g, S, E);
            asm volatile("s_waitcnt vmcnt(0)" ::: "memory"); __syncthreads();
            if (tid == 0) { __builtin_amdgcn_fence(__ATOMIC_RELEASE, "agent"); asm volatile("s_waitcnt vmcnt(0)" ::: "memory"); __hip_atomic_fetch_add(WSP(unsigned, WS_CTL) + CW_FLAG + 64 * l, 1u, RLX_AGENT); } }
          { LAUNDER(); const int nh = G - gb0, c0 = (int)blockIdx.x - gb0;
            for (int pm = c0; pm < M / 256; pm += nh) cvt_rows_bf16(ap_->in[1] + ((size_t)l * M + (size_t)pm * 256) * PLED, WSP(bf16, WS_PB) + (size_t)pm * 256 * PLED, (size_t)256 * PLED, (size_t)tid, (size_t)512);
            asm volatile("s_waitcnt vmcnt(0)" ::: "memory"); __syncthreads();
            pg8::Gemm g{WSP(const pg8::bf16_t, WS_PB), WB(W_PLE), M, D, K256, 30, 0}; pg8::PanelOrder S{c0, nh, M / 256, 4};
            pg8::EpiBf16P E{(pg8::bf16_t*)((unsigned char*)ap_->out + OUT_T), D};
            pg8::gemm_phase<pg8::EpiBf16P, pg8::PanelOrder, true, true>(lds + RING_OFF, g, S, E); }
          __syncthreads();
          const int wb0 = gb0;
          if (l == 0 && (int)blockIdx.x >= wb0) { LAUNDER(); const LayerW L1 = layer_ptrs(*ap_, 1);
            prologue_weights(L1, (unsigned char*)ap_->out + OUT_W1, lds, ((int)blockIdx.x - wb0) * NWAVES + wave, (G - wb0) * NWAVES, wave, lane); }
        }
#endif
#if PH(7)
        { LAUNDER(); const LayerW L = layer_ptrs(*ap_, l); const int c0 = (int)blockIdx.x - hb0;
#ifndef S5_REPS
#define S5_REPS 1
#endif
          for (int rep5_ = 0; rep5_ < S5_REPS; ++rep5_)
          if (c0 >= 0) for (int it = c0; it < 32; it += G - hb0)
              s5_wave_mfma(WSP(const bf16, WS_BIG), WSP(const float, WS_S5P) + 40960 * l, L.s5_cre, L.s5_cim, L.s5_d, WSP(bf16, WS_YG), lds + wave * WAVE_LDS, it * 8 + wave, lane); }
        if (G >= 256 && (int)blockIdx.x >= hb0 && (int)blockIdx.x < hb0 + 32) {
          LAUNDER(); const int c0 = (int)blockIdx.x - hb0; unsigned* f5 = WSP(unsigned, WS_CTL) + CW_S5F + (l * 16 + (c0 >> 1)) * 64;
          asm volatile("s_waitcnt vmcnt(0)" ::: "memory"); __syncthreads();
          if (tid == 0) { __builtin_amdgcn_fence(__ATOMIC_RELEASE, "agent"); asm volatile("s_waitcnt vmcnt(0)" ::: "memory"); __hip_atomic_fetch_add(f5, 1u, RLX_AGENT);
              unsigned sp = 0; while (__hip_atomic_load(f5, RLX_AGENT) < 2u) { __builtin_amdgcn_s_sleep(2); if (++sp > (1u << 22)) break; } }
          __syncthreads();
          __builtin_amdgcn_fence(__ATOMIC_ACQUIRE, "agent"); asm volatile("s_waitcnt vmcnt(0)" ::: "memory");
          const int p0 = 8 * (c0 >> 1) + 4 * (c0 & 1);
          pg8::Gemm g{WSP(const pg8::bf16_t, WS_YG), WB(W_GLU), M, 256, K256, 30, 0}; pg8::PanelOrder S{p0, 1, p0 + 4, 1};
          pg8::EpiGLU E{WSP(const pg8::bf16_t, WS_YG), WSP(pg8::bf16_t, WS_Y) + (size_t)2 * M * 256, ap_->in[25] + l * 256};
          pg8::gemm_phase<pg8::EpiGLU, pg8::PanelOrder, true, true>(lds + RING_OFF, g, S, E); }
#endif
#if PH(8)
        { LAUNDER(); unsigned* flag = WSP(unsigned, WS_CTL) + CW_FLAG + 64 * l; const unsigned need = (unsigned)(G - gb0);
          __syncthreads();
          if (tid == 0) { unsigned sp = 0; while (__hip_atomic_load(flag, RLX_AGENT) < need) { __builtin_amdgcn_s_sleep(2); if (++sp > (1u << 22)) break; } }
          __syncthreads();
          __builtin_amdgcn_fence(__ATOMIC_ACQUIRE, "agent"); asm volatile("s_waitcnt vmcnt(0)" ::: "memory");
          unsigned* qctr = WSP(unsigned, WS_CTL) + CW_QUEUE + 64 * l;
          for (;;) { unsigned idx = 0; if (lane == 0) idx = __hip_atomic_fetch_add(qctr, 1u, RLX_AGENT); idx = __builtin_amdgcn_readfirstlane(idx);
              if (idx >= 8192u / MOBA_NQG) break;
              const int qsl = idx & (16 / MOBA_NQG - 1), bh = (idx / (16 / MOBA_NQG)) & 63, qb = 7 - (int)(idx / (1024 / MOBA_NQG));
              moba_mfma_item<MOBA_NQG>(WSP(const bf16, WS_BIG), WSP(const float, WS_KMEAN) + (size_t)l * 32768, WSP(const bf16, WS_VT), WSP(bf16, WS_Y) + (size_t)3 * M * 256, bh, qb, qsl, lane); } }
#endif
        GRID_BAR();
#if PH(11)
#ifndef G11_REPS
#define G11_REPS 1
#endif
        for (int rep11_ = 0; rep11_ < G11_REPS; ++rep11_)
        { LAUNDER(); pg8::StaticOrder S0; S0.init(M, NGATE, G, bid);
          pg8::Gemm g{WSP(const pg8::bf16_t, WS_HB), WB(W_GATE), M, NGATE, K1024, 30, 0};
          pg8::EpiGateP E{WSP(const pg8::bf16_t, WS_Y), WB(W_BR), WSP(pg8::bf16_t, WS_BIG + 184 * MiB), WSP(pg8::rowss_t, WS_ROWSS) + (size_t)(4 * l + 1) * M, (size_t)M * 256};
#pragma nounroll
          for (int r = 0; ; ++r) { pg8::OneUnit S1; if (!S0.next(r, S1.u)) break;
              pg8::gemm_phase<pg8::EpiGateP, pg8::OneUnit, false, true>(lds + RING_OFF, g, S1, E);
              __syncthreads(); }
          GROUP_BAR(); }
#endif
#if PH(12)
#ifndef OUT_REPS
#define OUT_REPS 1
#endif
        for (int rep12_ = 0; rep12_ < OUT_REPS; ++rep12_)
        { LAUNDER(); pg8::Gemm g{WSP(const pg8::bf16_t, WS_BIG + 184 * MiB), WB(W_OUT), M, D, K1024, 30, 0}; pg8::StaticOrder S; S.init(M, D, G, bid);
          const bool real_ = (rep12_ + 1 == OUT_REPS);
          pg8::EpiRes E{WSP(const pg8::bf16_t, WS_HB), real_ ? WSP(pg8::bf16_t, WS_HB) : WSP(pg8::bf16_t, WS_BIG + 128 * MiB), real_ ? WSP(pg8::rowss_t, WS_ROWSS) + (size_t)(4 * l + 2) * M : WSP(pg8::rowss_t, WS_BIG + 200 * MiB), 1.0f};
          pg8::gemm_phase<pg8::EpiRes, pg8::StaticOrder, true, true>(lds + RING_OFF, g, S, E);
          GROUP_BAR(); }
#endif
#if PH(13)
#ifndef GU_REPS
#define GU_REPS 1
#endif
        for (int repg_ = 0; repg_ < GU_REPS; ++repg_)
        { LAUNDER(); pg8::Gemm g{WSP(const pg8::bf16_t, WS_HB), WB(W_GU2), M, NGU, K1024, 30, 0}; pg8::StaticOrder S; S.init(M, NGU, G, bid);
          SC_RESET(); pg8::EpiSwiGLU E{WSP(pg8::bf16_t, WS_BIG), WSP(pg8::rowss_t, WS_ROWSS) + (size_t)(4 * l + 2) * M, FF, SC_PTR};
          pg8::gemm_phase<pg8::EpiSwiGLU, pg8::StaticOrder, true, true>(lds + RING_OFF, g, S, E);
          GROUP_BAR(); }
#endif
#if PH(14)
#ifndef DOWN_REPS
#define DOWN_REPS 1
#endif
        for (int rep14_ = 0; rep14_ < DOWN_REPS; ++rep14_)
        { LAUNDER(); pg8::Gemm g{WSP(const pg8::bf16_t, WS_BIG), WB(W_D2), M, D, KFF, 30, 0}; pg8::StaticOrder S; S.init(M, D, G, bid);
          const bool real_ = (rep14_ + 1 == DOWN_REPS);
          pg8::EpiRes E{WSP(const pg8::bf16_t, WS_HB), real_ ? WSP(pg8::bf16_t, WS_HB) : WSP(pg8::bf16_t, WS_BIG + 184 * MiB), real_ ? WSP(pg8::rowss_t, WS_ROWSS) + (size_t)(4 * l + 3) * M : WSP(pg8::rowss_t, WS_BIG + 250 * MiB), 0.5f};
          pg8::gemm_phase<pg8::EpiRes, pg8::StaticOrder, DOWN_ALIGN, DOWN_SP2>(lds + RING_OFF, g, S, E);
          GROUP_BAR(); }
#endif
#if PH(16)
#ifndef PLE_REPS
#define PLE_REPS 1
#endif
        for (int rep16_ = 0; rep16_ < PLE_REPS; ++rep16_)
        { LAUNDER(); pg8::Gemm g{WSP(const pg8::bf16_t, WS_HB), WB(W_PG), M, D, K1024, 30, 0}; pg8::StaticOrder S; S.init(M, D, G, bid);
          const bool real_ = (rep16_ + 1 == PLE_REPS);
          pg8::EpiPle E{WSP(const pg8::bf16_t, WS_HB), (const pg8::bf16_t*)((unsigned char*)ap_->out + OUT_T), !real_ ? WSP(pg8::bf16_t, WS_BIG + 128 * MiB) : l == 0 ? (pg8::bf16_t*)((unsigned char*)ap_->out + OUT_T) : WSP(pg8::bf16_t, WS_BIG + 184 * MiB),
                        WSP(pg8::rowss_t, WS_ROWSS) + (size_t)(4 * l + 3) * M, real_ ? WSP(pg8::rowss_t, WS_ROWSS) + (size_t)(4 * l + 4) * M : WSP(pg8::rowss_t, WS_BIG + 200 * MiB)};
          pg8::gemm_phase<pg8::EpiPle, pg8::StaticOrder, true, true>(lds + RING_OFF, g, S, E);
          if (l + 1 < DEPTH) GROUP_BAR(); else GRID_BAR(); }
#endif
    }
#if PH(17)
#ifdef PROBE_REP0
#pragma nounroll
    for (int rep_ = 0; rep_ < PROBE_REP0; ++rep_)
#endif
    { LAUNDER(); final_norm(WSP(const bf16, WS_BIG + 184 * MiB), ap_->out, WSP(pg8::rowss_t, WS_ROWSS) + (size_t)8 * M, ap_->in[35], GW, NGW, lane); }
#endif
}

extern "C" void kernel_launch(void* const* d_in, const int* in_sizes, int n_in, void* d_out, int out_size, void* d_ws, size_t ws_size, hipStream_t stream) {
    static int grid = 0;
    if (grid == 0) {
        if (n_in != 36 || out_size != M * D || ws_size < WS_END) { fprintf(stderr, "kernel_launch: unexpected shapes (n_in %d, out %d, ws %zu); nothing launched\n", n_in, out_size, ws_size); grid = -1; return; }
        int dev = 0, cus = 0, per_cu = 0;
        if (hipGetDevice(&dev) != hipSuccess || hipDeviceGetAttribute(&cus, hipDeviceAttributeMultiprocessorCount, dev) != hipSuccess) { grid = -1; return; }
        if (hipFuncSetAttribute((const void*)mk_fwd, hipFuncAttributeMaxDynamicSharedMemorySize, LDS_BYTES) != hipSuccess) { fprintf(stderr, "kernel_launch: hipFuncSetAttribute failed\n"); grid = -1; return; }
        if (hipOccupancyMaxActiveBlocksPerMultiprocessor(&per_cu, (const void*)mk_fwd, NWAVES * 64, LDS_BYTES) != hipSuccess || per_cu < 1) { fprintf(stderr, "kernel_launch: occupancy query says %d\n", per_cu); per_cu = 1; }
        (void)hipGetLastError();
        if (cus < 256) { fprintf(stderr, "kernel_launch: %d CUs; the mixer phase's workgroup roles need 256; nothing launched\n", cus); grid = -1; return; }
        grid = 256;
    }
    if (grid < 0) return;
    if (hipMemsetAsync((char*)d_ws + WS_CTL, 0, CTL_ZERO_BYTES, stream) != hipSuccess) return;
    Args a{};
    for (int i = 0; i < 36; ++i) a.in[i] = (const float*)d_in[i];
    a.out = (float*)d_out; a.ws = (unsigned char*)d_ws;
    hipLaunchKernelGGL(mk_fwd, dim3(grid), dim3(NWAVES * 64), LDS_BYTES, stream, a);
}
```
